# Optimizing an MI355X kernel written in HIP

```python
import jax, jax.numpy as jnp
from jax import lax
import numpy as np

D_MODEL = 1024
BATCH = 8
SEQ = 4096
DEPTH = 2

EPS = 1e-6
MLSTM_HEADS = 4
MLSTM_HEAD_DIM = 128
MLSTM_WIDTH = MLSTM_HEADS * MLSTM_HEAD_DIM
MLSTM_CHUNK = 128
CONV_GROUPS = 4
CONV_CH = D_MODEL // 2
CONV_K = 3
IN0_WIDTH = 4 * MLSTM_WIDTH + 2 * MLSTM_HEADS + 3 * CONV_CH
MIX0_WIDTH = MLSTM_WIDTH + CONV_CH
SB_HEADS = 16
SB_HEAD_DIM = D_MODEL // SB_HEADS
SB_BLOCK = 128
PEER_HEADS = 8
PEER_NKEYS = 128
PEER_EXPERTS = PEER_NKEYS * PEER_NKEYS
PEER_QDIM = 256
PEER_HALF = PEER_QDIM // 2
PEER_TOPK = 16
PEER_TOKEN_BLOCK = 128

kernel_name = "hybrid_mlstm_conv_stickbreak_peer"


def rmsnorm(x, g):
    xf = x.astype(jnp.float32)
    y = xf * lax.rsqrt(jnp.mean(xf * xf, axis=-1, keepdims=True) + EPS)
    return (y * g.astype(jnp.float32)).astype(x.dtype)


def ada_params(c, w, b):
    mod = jnp.einsum("bd,de->be", jax.nn.silu(c), w) + b
    return jnp.split(mod, 6, axis=-1)


def modulate(x, g, shift, scale):
    return rmsnorm(x, g) * (1 + scale[:, None, :]) + shift[:, None, :]


def mlstm_chunkwise(q, k, v, i_pre, f_pre):
    B, H, S, dh = q.shape
    L = MLSTM_CHUNK
    NC = S // L
    f32 = jnp.float32
    qc = (q.astype(f32) * dh ** -0.5).reshape(B, H, NC, L, dh)
    kc = k.astype(f32).reshape(B, H, NC, L, dh)
    vc = v.astype(f32).reshape(B, H, NC, L, dh)
    log_f = jax.nn.log_sigmoid(f_pre.astype(f32)).reshape(B, H, NC, L)
    log_i = i_pre.astype(f32).reshape(B, H, NC, L)
    b = jnp.cumsum(log_f, axis=-1)
    g_chunk = b[..., -1]
    a = g_chunk[..., None] - b + log_i

    def step(carry, inp):
        s_, n_, m_ = carry
        k_, v_, a_, g_ = inp
        m_new = jnp.maximum(g_ + m_, jnp.max(a_, axis=-1))
        decay = jnp.exp(g_ + m_ - m_new)
        w = jnp.exp(a_ - m_new[..., None])
        s_new = decay[..., None, None] * s_ + jnp.einsum("bhl,bhld,bhle->bhde", w, k_, v_)
        n_new = decay[..., None] * n_ + jnp.einsum("bhl,bhld->bhd", w, k_)
        return (s_new, n_new, m_new), (s_, n_, m_)

    init = (jnp.zeros((B, H, dh, dh), f32), jnp.zeros((B, H, dh), f32), jnp.zeros((B, H), f32))
    xs = (jnp.moveaxis(kc, 2, 0), jnp.moveaxis(vc, 2, 0), jnp.moveaxis(a, 2, 0), jnp.moveaxis(g_chunk, 2, 0))
    _, (s_prev, n_prev, m_prev) = lax.scan(step, init, xs)
    s_prev = jnp.moveaxis(s_prev, 0, 2)
    n_prev = jnp.moveaxis(n_prev, 0, 2)
    m_prev = jnp.moveaxis(m_prev, 0, 2)

    causal = jnp.tril(jnp.ones((L, L), dtype=bool))
    log_d = jnp.where(causal, b[..., :, None] - b[..., None, :] + log_i[..., None, :], -jnp.inf)
    inter_log = b + m_prev[..., None]
    m_t = jnp.maximum(inter_log, jnp.max(log_d, axis=-1))
    qk = jnp.einsum("bhcld,bhcsd->bhcls", qc, kc) * jnp.exp(log_d - m_t[..., None])
    inter_w = jnp.exp(inter_log - m_t)
    num = jnp.einsum("bhcls,bhcsd->bhcld", qk, vc) + inter_w[..., None] * jnp.einsum("bhcld,bhcde->bhcle", qc, s_prev)
    den = jnp.sum(qk, axis=-1) + inter_w * jnp.einsum("bhcld,bhcd->bhcl", qc, n_prev)
    h = num / jnp.maximum(jnp.abs(den), jnp.exp(-m_t))[..., None]
    return h.reshape(B, H, S, dh).astype(q.dtype)


def mlstm_conv_mixer(h, w_in, b_igate, b_fgate, conv_w, mlstm_norm, w_out):
    B, S, _ = h.shape
    W, Hn, dh = MLSTM_WIDTH, MLSTM_HEADS, MLSTM_HEAD_DIM
    proj = jnp.einsum("bsd,de->bse", h, w_in)
    cuts = [W, 2 * W, 3 * W, 4 * W, 4 * W + Hn, 4 * W + 2 * Hn,
            4 * W + 2 * Hn + CONV_CH, 4 * W + 2 * Hn + 2 * CONV_CH]
    q, k, v, o, gi, gf, cb, cc, ch = jnp.split(proj, cuts, axis=-1)

    def heads(t):
        return t.reshape(B, S, Hn, dh).transpose(0, 2, 1, 3)

    hm = mlstm_chunkwise(heads(q), heads(k), heads(v),
                         (gi + b_igate).transpose(0, 2, 1), (gf + b_fgate).transpose(0, 2, 1))
    hm = rmsnorm(hm.transpose(0, 2, 1, 3), mlstm_norm.reshape(Hn, dh))
    hm = hm.reshape(B, S, W) * jax.nn.sigmoid(o)
    u = cc * ch
    conv = lax.conv_general_dilated(u, conv_w[:, None, :], window_strides=(1,),
                                    padding=[(CONV_K - 1, 0)],
                                    dimension_numbers=("NWC", "WIO", "NWC"),
                                    feature_group_count=CONV_CH)
    hc = cb * conv
    return jnp.einsum("bse,ed->bsd", jnp.concatenate([hm, hc], axis=-1), w_out)


def stick_breaking_mixer(h, w_qkv, q_norm, k_norm, w_out):
    B, S, _ = h.shape
    f32 = jnp.float32
    qkv = jnp.einsum("bsd,de->bse", h, w_qkv).reshape(B, S, 3, SB_HEADS, SB_HEAD_DIM)
    q = rmsnorm(qkv[:, :, 0], q_norm).astype(f32).transpose(0, 2, 1, 3)
    k = rmsnorm(qkv[:, :, 1], k_norm).astype(f32).transpose(0, 2, 1, 3)
    v = qkv[:, :, 2].astype(f32).transpose(0, 2, 1, 3)
    scale = SB_HEAD_DIM ** -0.5
    outs = []
    for blk in range(S // SB_BLOCK):
        q0 = blk * SB_BLOCK
        kend = q0 + SB_BLOCK
        z = jnp.einsum("bhtd,bhsd->bhts", q[:, :, q0:kend], k[:, :, :kend]) * scale
        strict = jnp.arange(kend)[None, :] < (q0 + jnp.arange(SB_BLOCK))[:, None]
        log_1mb = jnp.where(strict, jax.nn.log_sigmoid(-z), 0.0)
        between = lax.cumsum(log_1mb, axis=3, reverse=True) - log_1mb
        att = jnp.where(strict, jnp.exp(jax.nn.log_sigmoid(z) + between), 0.0)
        outs.append(jnp.einsum("bhts,bhsd->bhtd", att, v[:, :, :kend]))
    o = jnp.concatenate(outs, axis=2).transpose(0, 2, 1, 3).reshape(B, S, D_MODEL).astype(h.dtype)
    return jnp.einsum("bse,ed->bsd", o, w_out)


def peer_ffn(h, w_query, sub_keys1, sub_keys2, expert_u, expert_v):
    B, S, D = h.shape
    K = PEER_TOPK
    q = jnp.einsum("bsd,de->bse", h, w_query).reshape(B, S, PEER_HEADS, 2, PEER_HALF)
    s1 = jnp.einsum("bshd,nd->bshn", q[..., 0, :], sub_keys1)
    s2 = jnp.einsum("bshd,nd->bshn", q[..., 1, :], sub_keys2)
    v1, i1 = lax.top_k(s1, K)
    v2, i2 = lax.top_k(s2, K)
    cand = (v1[..., :, None] + v2[..., None, :]).reshape(B, S, PEER_HEADS, K * K)
    top_v, top_i = lax.top_k(cand, K)
    e1 = jnp.take_along_axis(i1, top_i // K, axis=-1)
    e2 = jnp.take_along_axis(i2, top_i % K, axis=-1)
    expert = e1 * PEER_NKEYS + e2
    gate = jax.nn.softmax(top_v.astype(jnp.float32), axis=-1).astype(h.dtype)
    nb = (B * S) // PEER_TOKEN_BLOCK
    xb = h.reshape(nb, PEER_TOKEN_BLOCK, D)
    eb = expert.reshape(nb, PEER_TOKEN_BLOCK, PEER_HEADS, K)
    gb = gate.reshape(nb, PEER_TOKEN_BLOCK, PEER_HEADS, K)

    def block(args):
        xt, et, gt = args
        act = jax.nn.gelu(jnp.einsum("td,thkd->thk", xt, expert_u[et]), approximate=False) * gt
        return jnp.einsum("thk,thkd->td", act, expert_v[et])

    return lax.map(block, (xb, eb, gb)).reshape(B, S, D)


def setup_inputs(seed: int = 0) -> dict:
    key = jax.random.key(seed)
    ks = iter(jax.random.split(key, 40))
    nrm = lambda shape, s: jax.random.normal(next(ks), shape, jnp.float32) * s
    gain = lambda n: 1.0 + 0.02 * jax.random.normal(next(ks), (n,), jnp.float32)
    D = D_MODEL
    inp = {}
    inp["x"] = nrm((BATCH, SEQ, D), 1.0)
    inp["c"] = nrm((BATCH, D), 1.0)
    inp["l0_ada_w"] = nrm((D, 6 * D), 0.2 * D ** -0.5)
    inp["l0_ada_b"] = nrm((6 * D,), 0.01)
    inp["l0_norm_mix"] = gain(D)
    inp["l0_w_in"] = nrm((D, IN0_WIDTH), D ** -0.5)
    inp["l0_b_igate"] = nrm((MLSTM_HEADS,), 0.5)
    inp["l0_b_fgate"] = jnp.linspace(3.0, 6.0, MLSTM_HEADS, dtype=jnp.float32) + nrm((MLSTM_HEADS,), 0.1)
    inp["l0_conv_w"] = nrm((CONV_K, CONV_CH), CONV_K ** -0.5)
    inp["l0_mlstm_norm"] = gain(MLSTM_WIDTH)
    inp["l0_w_out"] = nrm((MIX0_WIDTH, D), MIX0_WIDTH ** -0.5)
    inp["l0_norm_ffn"] = gain(D)
    inp["l0_peer_wq"] = nrm((D, PEER_HEADS * PEER_QDIM), D ** -0.5)
    inp["l0_peer_k1"] = nrm((PEER_NKEYS, PEER_HALF), PEER_HALF ** -0.5)
    inp["l0_peer_k2"] = nrm((PEER_NKEYS, PEER_HALF), PEER_HALF ** -0.5)
    inp["l0_peer_u"] = nrm((PEER_EXPERTS, D), D ** -0.5)
    inp["l0_peer_v"] = nrm((PEER_EXPERTS, D), PEER_HEADS ** -0.5)
    inp["l1_ada_w"] = nrm((D, 6 * D), 0.2 * D ** -0.5)
    inp["l1_ada_b"] = nrm((6 * D,), 0.01)
    inp["l1_norm_mix"] = gain(D)
    inp["l1_w_qkv"] = nrm((D, 3 * D), D ** -0.5)
    inp["l1_q_norm"] = gain(SB_HEAD_DIM)
    inp["l1_k_norm"] = gain(SB_HEAD_DIM)
    inp["l1_w_out"] = nrm((D, D), D ** -0.5)
    inp["l1_norm_ffn"] = gain(D)
    inp["l1_peer_wq"] = nrm((D, PEER_HEADS * PEER_QDIM), D ** -0.5)
    inp["l1_peer_k1"] = nrm((PEER_NKEYS, PEER_HALF), PEER_HALF ** -0.5)
    inp["l1_peer_k2"] = nrm((PEER_NKEYS, PEER_HALF), PEER_HALF ** -0.5)
    inp["l1_peer_u"] = nrm((PEER_EXPERTS, D), D ** -0.5)
    inp["l1_peer_v"] = nrm((PEER_EXPERTS, D), PEER_HEADS ** -0.5)
    return inp


def reference(x, c,
              l0_ada_w, l0_ada_b, l0_norm_mix, l0_w_in, l0_b_igate, l0_b_fgate, l0_conv_w,
              l0_mlstm_norm, l0_w_out, l0_norm_ffn, l0_peer_wq, l0_peer_k1, l0_peer_k2,
              l0_peer_u, l0_peer_v,
              l1_ada_w, l1_ada_b, l1_norm_mix, l1_w_qkv, l1_q_norm, l1_k_norm, l1_w_out,
              l1_norm_ffn, l1_peer_wq, l1_peer_k1, l1_peer_k2, l1_peer_u, l1_peer_v):
    layers = [
        dict(ada_w=l0_ada_w, ada_b=l0_ada_b, norm_mix=l0_norm_mix, norm_ffn=l0_norm_ffn,
             peer=(l0_peer_wq, l0_peer_k1, l0_peer_k2, l0_peer_u, l0_peer_v),
             mix=(l0_w_in, l0_b_igate, l0_b_fgate, l0_conv_w, l0_mlstm_norm, l0_w_out)),
        dict(ada_w=l1_ada_w, ada_b=l1_ada_b, norm_mix=l1_norm_mix, norm_ffn=l1_norm_ffn,
             peer=(l1_peer_wq, l1_peer_k1, l1_peer_k2, l1_peer_u, l1_peer_v),
             mix=(l1_w_qkv, l1_q_norm, l1_k_norm, l1_w_out)),
    ]
    for layer in range(DEPTH):
        p = layers[layer]
        sh1, sc1, g1, sh2, sc2, g2 = ada_params(c, p["ada_w"], p["ada_b"])
        h = modulate(x, p["norm_mix"], sh1, sc1)
        if layer % 2 == 0:
            y = mlstm_conv_mixer(h, *p["mix"])
        else:
            y = stick_breaking_mixer(h, *p["mix"])
        x = x + (1 + g1)[:, None, :] * y
        h = modulate(x, p["norm_ffn"], sh2, sc2)
        x = x + (1 + g2)[:, None, :] * peer_ffn(h, *p["peer"])
    return x
```

```cpp
#include <hip/hip_runtime.h>
#include <cstdio>
#include <cstdint>
#include <cmath>
namespace pg8 {
#define PG8_LAS __attribute__((address_space(3)))
typedef unsigned short bf16_t;
typedef short bf16x8 __attribute__((ext_vector_type(8)));
typedef float f32x4 __attribute__((ext_vector_type(4)));
typedef unsigned u32x4 __attribute__((ext_vector_type(4)));
constexpr int BM = 256, BK = 64, HALF = 128, HTB = HALF * BK * 2  , STAGE_BYTES = 8 * HTB, NXCD = 8, WGM = 8;

__host__ __device__ __forceinline__ int lds_byte(int r, int c) { const int st = (r >> 4) * 2 + (c >> 5), rr = r & 15, cc = c & 31, ob = rr * 64 + cc * 2; return st * 1024 + (ob ^ (((ob >> 9) & 1) << 5)); }
__host__ __device__ __forceinline__ void stage_rc(int b, int& R, int& C) { const int st = b / 1024, sb = b % 1024, swz = sb ^ (((sb >> 9) & 1) << 5); R = (st >> 1) * 16 + swz / 64; C = (st & 1) * 32 + (swz % 64) / 2; }
__host__ __device__ __forceinline__ int perm32(int rho) { const int n = rho >> 4, i = rho & 15; return 8 * (i >> 2) + 4 * n + (i & 3); }

struct Unit { int pm, pn; };
struct Gemm { const bf16_t* A; const bf16_t* Bt; int M, N, K; };

struct StaticOrder {
    int nM, nN, nwg, G, c;
    __host__ __device__ void init(int M, int N, int G_, int c_) { nM = M / BM; nN = N / BM; nwg = nM * nN; G = G_; c = c_; }
    __host__ __device__ bool next(int i, Unit& u) const {
        const long L = (long)i * G + c; if (L >= nwg) return false;
        int wgid = (int)L; { const int q = nwg / NXCD, r = nwg % NXCD, xcd = wgid % NXCD, off = wgid / NXCD; wgid = (xcd < r ? xcd * (q + 1) : r * (q + 1) + (xcd - r) * q) + off; }
        const int nig = WGM * nN, gid = wgid / nig, fm = gid * WGM, gsz = (nM - fm) < WGM ? (nM - fm) : WGM;
        u.pm = fm + ((wgid % nig) % gsz); u.pn = (wgid % nig) / gsz; return true;
    }
    __device__ __forceinline__ void a_ready(const Unit&) const {}
    __device__ __forceinline__ void done(const Unit&) const {}
};

__device__ __forceinline__ unsigned cvt_pk_bf16(float lo, float hi) { unsigned r; asm volatile("v_cvt_pk_bf16_f32 %0, %1, %2" : "=v"(r) : "v"(lo), "v"(hi)); return r; }
typedef float f32x2 __attribute__((ext_vector_type(2)));
__device__ __forceinline__ f32x2 gelu_pk(f32x2 v) {
    const f32x2 av = __builtin_elementwise_abs(v), d = av * 0.2316418882f + 1.0f;
    f32x2 t; t.x = __builtin_amdgcn_rcpf(d.x); t.y = __builtin_amdgcn_rcpf(d.y);
    f32x2 q = t * 0.5307027145f + (-0.7265760135f); q = q * t + 0.7107068705f; q = q * t + (-0.142248368f); q = q * t + 0.127414796f; q = q * t;
    const f32x2 s = (v * v) * (-0.72134752044f);
    f32x2 e; e.x = __builtin_amdgcn_exp2f(s.x); e.y = __builtin_amdgcn_exp2f(s.y);
    const f32x2 m = v * (q * e), r = v - m;
    f32x2 o; o.x = v.x < 0.f ? m.x : r.x; o.y = v.y < 0.f ? m.y : r.y; return o;
}

template <int ACT  > struct EpiBf16 {
    static constexpr bool PERM = true, AFTER_DRAIN = false; static_assert(ACT == 0 || ACT == 1, "EpiBf16: ACT is 0 (none) or 1 (gelu_pk)");
    bf16_t* O; int ldc; const float* bias; int split_cols; size_t split_stride; float scale0;
    __device__ __forceinline__ void operator()(const f32x4 (&acc)[2][2][4][2], const Unit& u, int wr, int wc, int fr, int fq) const {
        const int row0 = u.pm * BM + wr * 64 + fr; int colt = u.pn * BM; bf16_t* base = O;
        float sc = 1.f; if (split_cols) { const int t = colt / split_cols; base += (size_t)t * split_stride; colt -= t * split_cols; if (t == 0) sc = scale0; }
        const int col0 = colt + wc * 32 + 8 * fq, bcol0 = u.pn * BM + wc * 32 + 8 * fq;
        f32x4 bv[2][2];
#pragma unroll
        for (int bj = 0; bj < 2; ++bj)
#pragma unroll
            for (int n = 0; n < 2; ++n) bv[bj][n] = bias ? *(const f32x4*)(bias + bcol0 + bj * HALF + 4 * n) : (f32x4){0.f, 0.f, 0.f, 0.f};
#pragma unroll
        for (int ai = 0; ai < 2; ++ai)
#pragma unroll
            for (int m = 0; m < 4; ++m) { bf16_t* rowp = base + (size_t)(row0 + ai * HALF + m * 16) * ldc + col0;
#pragma unroll
                for (int bj = 0; bj < 2; ++bj) { f32x4 v0 = acc[ai][bj][m][0] + bv[bj][0], v1 = acc[ai][bj][m][1] + bv[bj][1];
                    if (ACT == 1) { f32x2 a = gelu_pk((f32x2){v0[0], v0[1]}), b = gelu_pk((f32x2){v0[2], v0[3]}), c = gelu_pk((f32x2){v1[0], v1[1]}), d = gelu_pk((f32x2){v1[2], v1[3]});
                        v0 = (f32x4){a.x, a.y, b.x, b.y}; v1 = (f32x4){c.x, c.y, d.x, d.y}; }
                    v0 = v0 * sc; v1 = v1 * sc; u32x4 w; w.x = cvt_pk_bf16(v0[0], v0[1]); w.y = cvt_pk_bf16(v0[2], v0[3]); w.z = cvt_pk_bf16(v1[0], v1[1]); w.w = cvt_pk_bf16(v1[2], v1[3]);
                    *(u32x4*)(rowp + bj * HALF) = w; } }
    }
};
template <class Epi, class Sched, bool ALIGN_EPI = false, bool SP2 = false>
__device__ __forceinline__ void gemm_phase(PG8_LAS unsigned char* lds, const Gemm g, const Sched& S, const Epi& E) {
    const int tid = threadIdx.x, wid = __builtin_amdgcn_readfirstlane(tid >> 6), lane = tid & 63, wr = wid >> 2, wc = wid & 3, fr = lane & 15, fq = lane >> 4;
    const int K = g.K, nt = K / BK;
    unsigned voffA[2], voffB[2];
#pragma unroll
    for (int i = 0; i < 2; ++i) { int R, C; stage_rc(tid * 16 + i * 8192, R, C); const int Rb = Epi::PERM ? ((R & ~31) + perm32(R & 31)) : R;
        voffA[i] = (unsigned)(R * K + C) * 2u; voffB[i] = (unsigned)(Rb * K + C) * 2u; }
    const size_t kstep = (size_t)(BK * 2);
    const size_t hstep = (size_t)HALF * K * 2;
    const size_t tstep = 2 * hstep;
    const unsigned ldsw = (unsigned)wid * 1024u;
    const int aoff = lds_byte(wr * 64 + fr, fq * 8), boff = lds_byte(wc * 32 + fr, fq * 8);
#define PG8_SA(b, h) (((b) * 2 + (h)) * HTB)
#define PG8_SB(b, h) ((4 + (b) * 2 + (h)) * HTB)
#define PG8_STAGE(bufoff, gbase, voff) do { _Pragma("unroll") for (int _i = 0; _i < 2; ++_i) \
        __builtin_amdgcn_global_load_lds((const unsigned*)((const char*)(gbase) + (voff)[_i]), (PG8_LAS unsigned*)(lds + (bufoff) + ldsw + _i * 8192), 16, 0, 0); } while (0)
#define PG8_LDA(dst, b, h) do { _Pragma("unroll") for (int m = 0; m < 4; ++m) _Pragma("unroll") for (int k = 0; k < 2; ++k) dst[m][k] = *(const PG8_LAS bf16x8*)(lds + PG8_SA(b, h) + aoff + m * 2048 + k * 1024); } while (0)
#define PG8_LDB(dst, b, h) do { _Pragma("unroll") for (int n = 0; n < 2; ++n) _Pragma("unroll") for (int k = 0; k < 2; ++k) dst[n][k] = *(const PG8_LAS bf16x8*)(lds + PG8_SB(b, h) + boff + n * 2048 + k * 1024); } while (0)
#define PG8_MMA(ai, bj, At, Bt) do { __builtin_amdgcn_s_setprio(1); _Pragma("unroll") for (int m = 0; m < 4; ++m) _Pragma("unroll") for (int n = 0; n < 2; ++n) _Pragma("unroll") for (int k = 0; k < 2; ++k) \
        acc[ai][bj][m][n] = __builtin_amdgcn_mfma_f32_16x16x32_bf16(Bt[n][k], At[m][k], acc[ai][bj][m][n], 0, 0, 0); __builtin_amdgcn_s_setprio(0); } while (0)
#define PG8_WAIT_V(n) asm volatile("s_waitcnt vmcnt(" #n ")" ::: "memory")
#define PG8_WAIT_L(n) asm volatile("s_waitcnt lgkmcnt(" #n ")" ::: "memory")
#define PG8_BAR __builtin_amdgcn_s_barrier()
#define PG8_SCHED __builtin_amdgcn_sched_barrier(0)
    Unit cur, nxt; int ui = 0;
    if (!S.next(0, cur)) return;
    f32x4 acc[2][2][4][2];
#pragma unroll
    for (int a = 0; a < 2; ++a)
#pragma unroll
        for (int b = 0; b < 2; ++b)
#pragma unroll
            for (int m = 0; m < 4; ++m)
#pragma unroll
                for (int n = 0; n < 2; ++n) acc[a][b][m][n] = (f32x4){0.f, 0.f, 0.f, 0.f};
    bf16x8 At[4][2], B0[2][2], B1[2][2];
    const char* cA = (const char*)g.A + (size_t)cur.pm * tstep; const char* cB = (const char*)g.Bt + (size_t)cur.pn * tstep;
    S.a_ready(cur);
    if constexpr (SP2) {
        PG8_STAGE(PG8_SB(0, 0), cB, voffB); PG8_STAGE(PG8_SB(0, 1), cB + hstep, voffB); PG8_STAGE(PG8_SA(0, 0), cA, voffA); PG8_STAGE(PG8_SA(0, 1), cA + hstep, voffA);
        if (wr == 1) PG8_BAR;
        PG8_WAIT_V(2); PG8_BAR;
        PG8_STAGE(PG8_SB(1, 0), cB + kstep, voffB); PG8_STAGE(PG8_SA(1, 0), cA + kstep, voffA); PG8_STAGE(PG8_SB(1, 1), cB + hstep + kstep, voffB);
        PG8_WAIT_V(6); PG8_BAR;
    } else {
        PG8_STAGE(PG8_SB(0, 0), cB, voffB); PG8_STAGE(PG8_SA(0, 0), cA, voffA); PG8_STAGE(PG8_SB(0, 1), cB + hstep, voffB); PG8_STAGE(PG8_SA(0, 1), cA + hstep, voffA);
        if (wr == 1) PG8_BAR;
        PG8_WAIT_V(4); PG8_BAR;
        PG8_STAGE(PG8_SB(1, 0), cB + kstep, voffB); PG8_STAGE(PG8_SA(1, 0), cA + kstep, voffA); PG8_STAGE(PG8_SB(1, 1), cB + hstep + kstep, voffB);
        PG8_WAIT_V(6); PG8_BAR;
    }
    for (;;) {
        const bool has_next = S.next(ui + 1, nxt);
        const char* nA = has_next ? (const char*)g.A + (size_t)nxt.pm * tstep : cA; const char* nB = has_next ? (const char*)g.Bt + (size_t)nxt.pn * tstep : cB;
        for (int t = 0; t < nt; t += 2) {
            const bool last = (t == nt - 2);
            const char* a1 = cA + (size_t)(t + 1) * kstep;
            const char* a2 = last ? nA : cA + (size_t)(t + 2) * kstep; const char* b2 = last ? nB : cB + (size_t)(t + 2) * kstep;
            const char* a3 = a2 + kstep; const char* b3 = b2 + kstep;
            if (last && has_next) S.a_ready(nxt);
            if constexpr (SP2) {
            PG8_LDB(B0, 0, 0); PG8_LDB(B1, 0, 1); PG8_SCHED; PG8_LDA(At, 0, 0); PG8_STAGE(PG8_SA(1, 1), a1 + hstep, voffA);
            PG8_WAIT_V(8); PG8_WAIT_L(0); PG8_BAR; PG8_MMA(0, 0, At, B0); PG8_MMA(0, 1, At, B1); PG8_BAR; PG8_SCHED;
            PG8_LDA(At, 0, 1); PG8_STAGE(PG8_SB(0, 0), b2, voffB); PG8_STAGE(PG8_SB(0, 1), b2 + hstep, voffB); PG8_STAGE(PG8_SA(0, 0), a2, voffA);
            PG8_WAIT_V(8); PG8_WAIT_L(0); PG8_BAR; PG8_MMA(1, 0, At, B0); PG8_MMA(1, 1, At, B1); PG8_BAR; PG8_SCHED;
            PG8_LDB(B0, 1, 0); PG8_LDB(B1, 1, 1); PG8_SCHED; PG8_LDA(At, 1, 0); PG8_STAGE(PG8_SA(0, 1), a2 + hstep, voffA);
            PG8_WAIT_V(8); PG8_WAIT_L(0); PG8_BAR; PG8_MMA(0, 0, At, B0); PG8_MMA(0, 1, At, B1); PG8_BAR; PG8_SCHED;
            PG8_LDA(At, 1, 1); PG8_STAGE(PG8_SB(1, 0), b3, voffB); PG8_STAGE(PG8_SB(1, 1), b3 + hstep, voffB); PG8_STAGE(PG8_SA(1, 0), a3, voffA);
            PG8_WAIT_V(8); PG8_WAIT_L(0); PG8_BAR; PG8_MMA(1, 0, At, B0); PG8_MMA(1, 1, At, B1); PG8_BAR; PG8_SCHED;
            } else {
            PG8_LDB(B0, 0, 0); PG8_SCHED; PG8_LDA(At, 0, 0); PG8_STAGE(PG8_SA(1, 1), a1 + hstep, voffA);
            PG8_WAIT_L(8); PG8_BAR; PG8_WAIT_L(0); PG8_MMA(0, 0, At, B0); PG8_BAR; PG8_SCHED;
            PG8_LDB(B1, 0, 1); PG8_STAGE(PG8_SB(0, 0), b2, voffB);
            PG8_BAR; PG8_WAIT_L(0); PG8_MMA(0, 1, At, B1); PG8_BAR;
            PG8_LDA(At, 0, 1); PG8_STAGE(PG8_SA(0, 0), a2, voffA);
            PG8_BAR; PG8_WAIT_L(0); PG8_MMA(1, 0, At, B0); PG8_BAR; PG8_SCHED;
            PG8_STAGE(PG8_SB(0, 1), b2 + hstep, voffB);
            PG8_WAIT_V(6); PG8_BAR; PG8_MMA(1, 1, At, B1); PG8_BAR;
            PG8_LDB(B0, 1, 0); PG8_SCHED; PG8_LDA(At, 1, 0); PG8_STAGE(PG8_SA(0, 1), a2 + hstep, voffA);
            PG8_WAIT_L(8); PG8_BAR; PG8_WAIT_L(0); PG8_MMA(0, 0, At, B0); PG8_BAR; PG8_SCHED;
            PG8_LDB(B1, 1, 1); PG8_STAGE(PG8_SB(1, 0), b3, voffB);
            PG8_BAR; PG8_WAIT_L(0); PG8_MMA(0, 1, At, B1); PG8_BAR;
            PG8_LDA(At, 1, 1); PG8_STAGE(PG8_SA(1, 0), a3, voffA);
            PG8_BAR; PG8_WAIT_L(0); PG8_MMA(1, 0, At, B0); PG8_BAR; PG8_SCHED;
            PG8_STAGE(PG8_SB(1, 1), b3 + hstep, voffB);
            PG8_WAIT_V(6); PG8_BAR; PG8_MMA(1, 1, At, B1); PG8_BAR;
            }
        }
        if constexpr (ALIGN_EPI) { if (wr == 0) PG8_BAR; }
        if constexpr (!Epi::AFTER_DRAIN) { E(acc, cur, wr, wc, fr, fq); S.done(cur); }
        if (!has_next) break;
#pragma unroll
        for (int a = 0; a < 2; ++a)
#pragma unroll
            for (int b = 0; b < 2; ++b)
#pragma unroll
                for (int m = 0; m < 4; ++m)
#pragma unroll
                    for (int n = 0; n < 2; ++n) acc[a][b][m][n] = (f32x4){0.f, 0.f, 0.f, 0.f};
        cur = nxt; cA = nA; cB = nB; ++ui;
        if constexpr (ALIGN_EPI) { if (wr == 1) PG8_BAR; }
    }
    PG8_WAIT_V(0);
    if constexpr (!ALIGN_EPI) { if (wr == 0) PG8_BAR; }
    PG8_BAR;
    if constexpr (Epi::AFTER_DRAIN) { E.fused(acc, cur, wr, wc, fr, fq, lds, wid, lane); S.done(cur); }
#undef PG8_SA
#undef PG8_SB
#undef PG8_STAGE
#undef PG8_LDA
#undef PG8_LDB
#undef PG8_MMA
#undef PG8_WAIT_V
#undef PG8_WAIT_L
#undef PG8_BAR
#undef PG8_SCHED
}
}
#define GAS __attribute__((address_space(1)))
#define LAS __attribute__((address_space(3)))
typedef unsigned short bf16;
typedef unsigned v4u __attribute__((ext_vector_type(4)));
typedef float f32x4 __attribute__((ext_vector_type(4)));
typedef short bf16x8 __attribute__((ext_vector_type(8)));
typedef GAS unsigned gu32;
typedef GAS unsigned long long gu64;
#define RLX_AGENT __ATOMIC_RELAXED, __HIP_MEMORY_SCOPE_AGENT
#define LDS_WAIT() asm volatile("s_waitcnt lgkmcnt(0)" ::: "memory")
#define VM_WAIT() asm volatile("s_waitcnt vmcnt(0)" ::: "memory")
__device__ __forceinline__ unsigned long long rt() { return __builtin_amdgcn_s_memrealtime(); }
__device__ __forceinline__ unsigned f2bf(float f) { unsigned u = __builtin_bit_cast(unsigned, f); return (u + 0x7fffu + ((u >> 16) & 1u)) >> 16; }
__device__ __forceinline__ unsigned pk2(float lo, float hi) { return f2bf(lo) | (f2bf(hi) << 16); }

#define XB_TMO      128
#define XB_XCNT(j)  (256  + 64 * (j))
#define XB_XSUB(j)  (1280 + 64 * (j))
#define XB_XGEN(j)  (2304 + 64 * (j))
#define XB_TOP      3328
#define XB_TOPGEN   3392
#define XCD_BAR_WORDS 3456
#define XB_SPIN_CAP (1u << 18)

__device__ __forceinline__ unsigned xb_ld(unsigned* p)              { return __hip_atomic_load(p, __ATOMIC_RELAXED, __HIP_MEMORY_SCOPE_AGENT); }
__device__ __forceinline__ unsigned xb_add(unsigned* p, unsigned v) { return __hip_atomic_fetch_add(p, v, __ATOMIC_RELAXED, __HIP_MEMORY_SCOPE_AGENT); }
__device__ __forceinline__ unsigned xb_xcc_id() { return (unsigned)__builtin_amdgcn_s_getreg((3 << 11) | 20) & 0xFu; }
#define XB_SPIN(cond, bar) do { unsigned _sp = 0; while (cond) { __builtin_amdgcn_s_sleep(1); \
    if ((++_sp & 255u) == 0u) { if (xb_ld(&(bar)[XB_TMO])) break; if (_sp > XB_SPIN_CAP) { atomicAdd(&(bar)[XB_TMO], 1u); break; } } } } while (0)

struct XcdBarrier {
    unsigned* bar; unsigned x;
    volatile LAS unsigned* st;
};

__device__ __forceinline__ XcdBarrier xcd_barrier_post(unsigned* bar, volatile LAS unsigned* st) {
    XcdBarrier b; b.bar = bar; b.x = xb_xcc_id(); b.st = st;
    if (threadIdx.x == 0) (void)xb_add(&bar[XB_XCNT(b.x)], 1u);
    return b;
}
__device__ __forceinline__ void xcd_barrier_complete(unsigned* bar, unsigned x, unsigned& nloc, unsigned& nx) {
    const unsigned G = gridDim.x * gridDim.y * gridDim.z;
    unsigned sum, cnt, mine, sp = 0u;
    for (;;) {
        sum = 0u; cnt = 0u; mine = 0u;
#pragma unroll
        for (unsigned j = 0; j < 16; ++j) { const unsigned c = xb_ld(&bar[XB_XCNT(j)]); sum += c; cnt += (c > 0u) ? 1u : 0u; mine = (j == x) ? c : mine; }
        if (sum == G) break;
        __builtin_amdgcn_s_sleep(1);
        if ((++sp & 255u) == 0u) { if (xb_ld(&bar[XB_TMO])) break; if (sp > XB_SPIN_CAP) { atomicAdd(&bar[XB_TMO], 1u); break; } }
    }
    nloc = mine > 0u ? mine : 1u; nx = cnt > 0u ? cnt : 1u;
}

__device__ __forceinline__ void xcd_barrier(const XcdBarrier& b) {
    asm volatile("s_waitcnt vmcnt(0)" ::: "memory");
    __syncthreads();
    if (threadIdx.x == 0) {
        unsigned* bar = b.bar;
        __builtin_amdgcn_s_waitcnt(0);
        unsigned nloc = b.st[0], nx = b.st[1];
        if (nloc == 0u) { xcd_barrier_complete(bar, b.x, nloc, nx); b.st[0] = nloc; b.st[1] = nx; }
        const unsigned old = xb_add(&bar[XB_XSUB(b.x)], 1u);
        const unsigned gen = old / nloc;
        if (old + 1u == (gen + 1u) * nloc) {
            __builtin_amdgcn_fence(__ATOMIC_RELEASE, "agent");
            asm volatile("s_waitcnt vmcnt(0)" ::: "memory");
            const unsigned og = xb_add(&bar[XB_TOP], 1u);
            const unsigned tg = og / nx;
            if (og + 1u == (tg + 1u) * nx) xb_add(&bar[XB_TOPGEN], 1u);
            else XB_SPIN(xb_ld(&bar[XB_TOPGEN]) == tg, bar);
            __builtin_amdgcn_fence(__ATOMIC_ACQUIRE, "agent");
            xb_add(&bar[XB_XGEN(b.x)], 1u);
            asm volatile("s_waitcnt vmcnt(0)" ::: "memory");
        } else {
            XB_SPIN(xb_ld(&bar[XB_XGEN(b.x)]) == gen, bar);
            __builtin_amdgcn_fence(__ATOMIC_ACQUIRE, "agent");
            asm volatile("s_waitcnt vmcnt(0)" ::: "memory");
        }
    }
    __syncthreads();
}
constexpr int NWAVES = 8;
constexpr int NB = 8, SEQ = 4096, DM = 1024, NTOK = NB * SEQ;
constexpr int INW = 3592, INP = 3584;
constexpr float EPS = 1e-6f;
constexpr size_t MiB = 1u << 20;
constexpr size_t WS_CTL = 0, CTL_ZERO_BYTES = 1 * MiB;
constexpr size_t WS_MOD = 1 * MiB;
constexpr size_t WS_LF = 2 * MiB, WS_LI = WS_LF + 512 * 1024;
constexpr size_t WS_FC = 3 * MiB;
constexpr size_t WS_WIN = 4 * MiB, WS_WOUT0 = 11 * MiB, WS_WC0 = 13 * MiB, WS_WQKV = 17 * MiB, WS_WOUT1 = 23 * MiB, WS_WC1 = 25 * MiB;
constexpr size_t WS_H = 32 * MiB;
constexpr size_t WS_BIG = 96 * MiB;
constexpr size_t WS_IDS = 320 * MiB, WS_GATES = 336 * MiB;
constexpr size_t WS_END = 352 * MiB;
constexpr int CW_BAR = 4096;
constexpr int RING_BYTES = 131072, LDSCTL_OFF = RING_BYTES, MISC_OFF = LDSCTL_OFF + 320, LDS_BYTES = 147456;

__device__ __forceinline__ float wave_sum(float v) {
#pragma unroll
    for (int o = 1; o < 64; o <<= 1) v += __shfl_xor(v, o);
    return v;
}
__device__ __forceinline__ float bf2f(unsigned short b) { return __uint_as_float((unsigned)b << 16); }
__device__ __forceinline__ float bflo(unsigned w) { return __uint_as_float(w << 16); }
__device__ __forceinline__ float bfhi(unsigned w) { return __uint_as_float(w & 0xffff0000u); }
__device__ __forceinline__ float sigmoidf_(float x) { return 1.f / (1.f + __expf(-x)); }
__device__ __forceinline__ float softplusf_(float x) { return fmaxf(x, 0.f) + __logf(1.f + __expf(-fabsf(x))); }
__device__ __forceinline__ float logsigmoidf_(float x) { return fminf(x, 0.f) - __logf(1.f + __expf(-fabsf(x))); }
__device__ __forceinline__ float gelu_exact(float x) { return 0.5f * x * (1.f + erff(x * 0.70710678118654752f)); }

struct Args { const float* in[30]; float* out; unsigned char* ws; int ph_lo, ph_hi; };

struct Ctx {
    LAS unsigned char* lds;
    int tid, lane, wave, G, bid;
    int gw, NGW;
    long gt, NGT;
};
struct EpiResid {
    static constexpr bool PERM = false, AFTER_DRAIN = false;
    const float* base; float* out; const float* gate;
    __device__ __forceinline__ void operator()(const pg8::f32x4 (&acc)[2][2][4][2], const pg8::Unit& u, int wr, int wc, int fr, int fq) const {
        using pg8::f32x4;
        const int col0 = u.pn * 256 + wc * 32 + 4 * fq;
        const float* gp = gate + (size_t)((u.pm * 256) / SEQ) * 6144 + col0;
        f32x4 gv[2][2];
#pragma unroll
        for (int bj = 0; bj < 2; ++bj)
#pragma unroll
            for (int n = 0; n < 2; ++n) { gv[bj][n] = *(const f32x4*)(gp + bj * 128 + n * 16); gv[bj][n] = gv[bj][n] + 1.0f; }
#pragma unroll
        for (int ai = 0; ai < 2; ++ai)
#pragma unroll
            for (int m = 0; m < 4; ++m) {
                const int r = ai * 128 + wr * 64 + m * 16 + fr; const size_t off = (size_t)(u.pm * 256 + r) * DM + col0;
#pragma unroll
                for (int bj = 0; bj < 2; ++bj)
#pragma unroll
                    for (int n = 0; n < 2; ++n) {
                        const f32x4 bs = *(const f32x4*)(base + off + bj * 128 + n * 16);
                        *(f32x4*)(out + off + bj * 128 + n * 16) = bs + gv[bj][n] * acc[ai][bj][m][n];
                    }
            }
    }
};

__device__ __forceinline__ void transpose_item(const float* W, int ldw, int src_col0, bf16* WT, int K, int dst_row0, int k0, LAS float* scr, int lane) {
#pragma unroll 8
    for (int i = 0; i < 32; ++i) { const int kk = 2 * i + (lane >> 5); scr[kk * 33 + (lane & 31)] = W[(size_t)(k0 + kk) * ldw + src_col0 + (lane & 31)]; }
    LDS_WAIT(); asm volatile("" ::: "memory");
    const int c = lane & 7;
#pragma unroll
    for (int j = 0; j < 4; ++j) { const int n = (lane >> 3) + 8 * j; const LAS float* s = scr + (8 * c) * 33 + n;
        v4u o; o.x = pk2(s[0 * 33], s[1 * 33]); o.y = pk2(s[2 * 33], s[3 * 33]); o.z = pk2(s[4 * 33], s[5 * 33]); o.w = pk2(s[6 * 33], s[7 * 33]);
        *(GAS v4u*)(WT + (size_t)(dst_row0 + n) * K + k0 + 8 * c) = o; }
    LDS_WAIT(); asm volatile("" ::: "memory");
}

__device__ __forceinline__ void phase_prep(const Ctx& C, const Args& A) {
    unsigned char* ws = A.ws;
    {
        LAS float* scr = (LAS float*)(C.lds + C.wave * 16384);
        constexpr int I_IN = 16 * (INP / 32), I_O = 16 * 32, I_QKV = 16 * 96;
        constexpr int NIT = I_IN + I_O + I_QKV + I_O;
        for (int it = C.gw; it < NIT; it += C.NGW) {
            int r = it;
            if (r < I_IN) { const int kb = r / (INP / 32), nb = r % (INP / 32); const int dst = nb * 32, src = dst + (dst >= 2048 ? 8 : 0);
                transpose_item(A.in[5], INW, src, (bf16*)(ws + WS_WIN), 1024, dst, kb * 64, scr, C.lane); continue; } r -= I_IN;
            if (r < I_O) { const int kb = r / 32, nb = r % 32; transpose_item(A.in[10], 1024, nb * 32, (bf16*)(ws + WS_WOUT0), 1024, nb * 32, kb * 64, scr, C.lane); continue; } r -= I_O;
            if (r < I_QKV) { const int kb = r / 96, nb = r % 96; transpose_item(A.in[20], 3072, nb * 32, (bf16*)(ws + WS_WQKV), 1024, nb * 32, kb * 64, scr, C.lane); continue; } r -= I_QKV;
            { const int kb = r / 32, nb = r % 32; transpose_item(A.in[23], 1024, nb * 32, (bf16*)(ws + WS_WOUT1), 1024, nb * 32, kb * 64, scr, C.lane); }
        }
    }
    for (int l = 0; l < 2; ++l) {
        const float* Wq = A.in[l ? 25 : 12]; const float* K1 = A.in[l ? 26 : 13]; const float* K2 = A.in[l ? 27 : 14];
        bf16* Wc = (bf16*)(ws + (l ? WS_WC1 : WS_WC0));
        for (long it = C.gt; it < 2048L * 1024; it += C.NGT) {
            const int k = (int)(it & 1023), n = (int)(it >> 10), hh = n >> 7, key = n & 127;
            const float* kr = ((hh & 1) ? K2 : K1) + key * 128; const float* wr = Wq + (size_t)k * 2048 + hh * 128;
            float s = 0.f;
#pragma unroll 4
            for (int d = 0; d < 128; d += 4) { const f32x4 a = *(const f32x4*)(kr + d), b = *(const f32x4*)(wr + d); s += a.x * b.x + a.y * b.y + a.z * b.z + a.w * b.w; }
            Wc[(size_t)n * 1024 + k] = (bf16)f2bf(s);
        }
    }
    {
        LAS float* sc = (LAS float*)C.lds;
        __syncthreads();
        for (int i = C.tid; i < NB * DM; i += NWAVES * 64) { const float v = A.in[1][i]; sc[i] = v / (1.f + __expf(-v)); }
        __syncthreads();
        float* mod = (float*)(ws + WS_MOD);
        for (long it = C.gt; it < 2L * 6144; it += C.NGT) {
            const int l = (int)(it / 6144), j = (int)(it % 6144);
            const float* W = A.in[l ? 17 : 2]; const float bias = A.in[l ? 18 : 3][j];
            float acc[NB];
#pragma unroll
            for (int b = 0; b < NB; ++b) acc[b] = bias;
#pragma unroll 4
            for (int k = 0; k < DM; ++k) { const float w = W[(size_t)k * 6144 + j];
#pragma unroll
                for (int b = 0; b < NB; ++b) acc[b] += sc[b * DM + k] * w; }
#pragma unroll
            for (int b = 0; b < NB; ++b) mod[(size_t)(l * NB + b) * 6144 + j] = acc[b];
        }
        __syncthreads();
    }
}

template <bool GATES>
__device__ __forceinline__ void phase_rowpass(const Ctx& C, const Args& A, const float* xin, const float* gain, const float* modl  , int ch_shift, int ch_scale, bf16* hout) {
    for (int row = C.gw; row < NTOK; row += C.NGW) {
        const int b = row >> 12;
        const float* xr = xin + (size_t)row * DM + 4 * C.lane;
        f32x4 v[4]; float ss = 0.f;
#pragma unroll
        for (int j = 0; j < 4; ++j) { v[j] = *(const f32x4*)(xr + 256 * j); ss += v[j].x * v[j].x + v[j].y * v[j].y + v[j].z * v[j].z + v[j].w * v[j].w; }
        const float rstd = rsqrtf(wave_sum(ss) * (1.f / DM) + EPS);
        const float* shp = modl + (size_t)b * 6144 + ch_shift * 1024 + 4 * C.lane; const float* scp = modl + (size_t)b * 6144 + ch_scale * 1024 + 4 * C.lane;
        f32x4 h[4];
#pragma unroll
        for (int j = 0; j < 4; ++j) { const f32x4 g = *(const f32x4*)(gain + 4 * C.lane + 256 * j), sc = *(const f32x4*)(scp + 256 * j), sh = *(const f32x4*)(shp + 256 * j);
            h[j] = v[j] * rstd * g * (sc + 1.0f) + sh;
            uint2 o; o.x = pk2(h[j].x, h[j].y); o.y = pk2(h[j].z, h[j].w);
            *(uint2*)(hout + (size_t)row * DM + 4 * C.lane + 256 * j) = o; }
        if (GATES) {
            float d[8];
#pragma unroll
            for (int q = 0; q < 8; ++q) d[q] = 0.f;
            const float* Wg = A.in[5] + 2048;
#pragma unroll
            for (int j = 0; j < 4; ++j)
#pragma unroll
                for (int e = 0; e < 4; ++e) { const int k = 4 * C.lane + 256 * j + e; const float hv = h[j][e];
                    const f32x4 w0 = *(const f32x4*)(Wg + (size_t)k * INW), w1 = *(const f32x4*)(Wg + (size_t)k * INW + 4);
                    d[0] += hv * w0.x; d[1] += hv * w0.y; d[2] += hv * w0.z; d[3] += hv * w0.w; d[4] += hv * w1.x; d[5] += hv * w1.y; d[6] += hv * w1.z; d[7] += hv * w1.w; }
#pragma unroll
            for (int q = 0; q < 8; ++q) d[q] = wave_sum(d[q]);
            if (C.lane == 0) {
                const int s = row & (SEQ - 1); float* LF = (float*)(A.ws + WS_LF); float* LI = (float*)(A.ws + WS_LI);
#pragma unroll
                for (int hh = 0; hh < 4; ++hh) { LI[(size_t)(b * 4 + hh) * SEQ + s] = d[hh] + A.in[6][hh]; LF[(size_t)(b * 4 + hh) * SEQ + s] = logsigmoidf_(d[4 + hh] + A.in[7][hh]); }
            }
        }
    }
}

__device__ __forceinline__ void phase_mlstm_prefix(const Ctx& C, const Args& A) {
    const float* LF = (const float*)(A.ws + WS_LF); float* FC = (float*)(A.ws + WS_FC);
    for (int bh = C.gw; bh < 32; bh += C.NGW) {
        const float* p = LF + (size_t)bh * SEQ + 64 * C.lane; float a[64]; float run = 0.f;
#pragma unroll
        for (int i = 0; i < 64; i += 4) { const f32x4 x = *(const f32x4*)(p + i); run += x.x; a[i] = run; run += x.y; a[i + 1] = run; run += x.z; a[i + 2] = run; run += x.w; a[i + 3] = run; }
        float incl = run;
#pragma unroll
        for (int o = 1; o < 64; o <<= 1) { const float t = __shfl_up(incl, o); if (C.lane >= o) incl += t; }
        const float excl = incl - run;
        float* q = FC + (size_t)bh * SEQ + 64 * C.lane;
#pragma unroll
        for (int i = 0; i < 64; i += 4) { f32x4 o4 = {a[i] + excl, a[i + 1] + excl, a[i + 2] + excl, a[i + 3] + excl}; *(f32x4*)(q + i) = o4; }
    }
}
__device__ __forceinline__ void phase_conv(const Ctx& C, const Args& A) {
    const bf16* P = (const bf16*)(A.ws + WS_BIG); bf16* mix = (bf16*)(A.ws + WS_H); const float* cw = A.in[8];
    for (long it = C.gt; it < (long)NTOK * 64; it += C.NGT) {
        const int cg = (int)(it & 63), tok = (int)(it >> 6), t = tok & (SEQ - 1), c0 = cg * 8;
        float conv[8];
#pragma unroll
        for (int e = 0; e < 8; ++e) conv[e] = 0.f;
#pragma unroll
        for (int k = 0; k < 3; ++k) {
            const int dt = 2 - k;
            if (t - dt >= 0) {
                const bf16* r = P + (size_t)(tok - dt) * INP;
                const v4u cc = *(const v4u*)(r + 2560 + c0), chv = *(const v4u*)(r + 3072 + c0);
                const f32x4 w0 = *(const f32x4*)(cw + k * 512 + c0), w1 = *(const f32x4*)(cw + k * 512 + c0 + 4);
                conv[0] += w0.x * bflo(cc.x) * bflo(chv.x); conv[1] += w0.y * bfhi(cc.x) * bfhi(chv.x);
                conv[2] += w0.z * bflo(cc.y) * bflo(chv.y); conv[3] += w0.w * bfhi(cc.y) * bfhi(chv.y);
                conv[4] += w1.x * bflo(cc.z) * bflo(chv.z); conv[5] += w1.y * bfhi(cc.z) * bfhi(chv.z);
                conv[6] += w1.z * bflo(cc.w) * bflo(chv.w); conv[7] += w1.w * bfhi(cc.w) * bfhi(chv.w);
            }
        }
        const v4u cb = *(const v4u*)(P + (size_t)tok * INP + 2048 + c0);
        v4u o; o.x = pk2(conv[0] * bflo(cb.x), conv[1] * bfhi(cb.x)); o.y = pk2(conv[2] * bflo(cb.y), conv[3] * bfhi(cb.y));
        o.z = pk2(conv[4] * bflo(cb.z), conv[5] * bfhi(cb.z)); o.w = pk2(conv[6] * bflo(cb.w), conv[7] * bfhi(cb.w));
        *(v4u*)(mix + (size_t)tok * DM + 512 + c0) = o;
    }
}
__device__ __forceinline__ void phase_mlstm_naive(const Ctx& C, const Args& A) {
    const bf16* P = (const bf16*)(A.ws + WS_BIG); bf16* mix = (bf16*)(A.ws + WS_H);
    const float* FC = (const float*)(A.ws + WS_FC); const float* LI = (const float*)(A.ws + WS_LI);
    const float* gain = A.in[9];
    for (int it = C.gw; it < 32 * (SEQ / 4); it += C.NGW) {
        const int bh = it & 31, t0 = (it >> 5) * 4, b = bh >> 2, hh = bh & 3;
        const size_t rowb = (size_t)b * SEQ;
        float q0[4], q1[4], Ft[4], n0[4], n1[4], den[4];
#pragma unroll
        for (int i = 0; i < 4; ++i) { const unsigned w = *(const unsigned*)(P + (rowb + t0 + i) * INP + hh * 128 + 2 * C.lane);
            q0[i] = bflo(w) * 0.08838834764831845f; q1[i] = bfhi(w) * 0.08838834764831845f; Ft[i] = FC[(size_t)bh * SEQ + t0 + i]; n0[i] = n1[i] = den[i] = 0.f; }
        for (int s = 0; s <= t0 + 3; ++s) {
            const unsigned kw = *(const unsigned*)(P + (rowb + s) * INP + 512 + hh * 128 + 2 * C.lane);
            const unsigned vw = *(const unsigned*)(P + (rowb + s) * INP + 1024 + hh * 128 + 2 * C.lane);
            const float k0 = bflo(kw), k1 = bfhi(kw), v0 = bflo(vw), v1 = bfhi(vw);
            const float e = LI[(size_t)bh * SEQ + s] - FC[(size_t)bh * SEQ + s];
#pragma unroll
            for (int i = 0; i < 4; ++i) {
                const float dot = wave_sum(q0[i] * k0 + q1[i] * k1);
                const float w = (s <= t0 + i) ? dot * __expf(Ft[i] + e) : 0.f;
                n0[i] += w * v0; n1[i] += w * v1; den[i] += w;
            }
        }
#pragma unroll
        for (int i = 0; i < 4; ++i) {
            const float dn = 1.f / fmaxf(fabsf(den[i]), 1.f);
            const float h0 = n0[i] * dn, h1 = n1[i] * dn;
            const float rstd = rsqrtf(wave_sum(h0 * h0 + h1 * h1) * (1.f / 128.f) + EPS);
            const unsigned ow = *(const unsigned*)(P + (rowb + t0 + i) * INP + 1536 + hh * 128 + 2 * C.lane);
            const float g0 = gain[hh * 128 + 2 * C.lane], g1 = gain[hh * 128 + 2 * C.lane + 1];
            *(unsigned*)(mix + (rowb + t0 + i) * DM + hh * 128 + 2 * C.lane) = pk2(h0 * rstd * g0 * sigmoidf_(bflo(ow)), h1 * rstd * g1 * sigmoidf_(bfhi(ow)));
        }
    }
}

__device__ __forceinline__ void phase_topk_naive(const Ctx& C, const Args& A) {
    const bf16* SC = (const bf16*)(A.ws + WS_BIG); int* ids = (int*)(A.ws + WS_IDS); float* gates = (float*)(A.ws + WS_GATES);
    LAS float* L = (LAS float*)C.lds;
    const int tid = C.tid;
    for (long it = C.gt; it < (long)NTOK * 8; it += C.NGT) {
        const int head = (int)(it & 7), tok = (int)(it >> 3);
        for (int half = 0; half < 2; ++half) {
            const bf16* sc = SC + (size_t)tok * 2048 + head * 256 + half * 128;
            float pv = INFINITY; int pi = -1;
            for (int r = 0; r < 16; ++r) {
                float best = -INFINITY; int bi = 128;
                for (int i = 0; i < 128; ++i) { const float v = bf2f(sc[i]); const bool lt = (v < pv) || (v == pv && i > pi); if (lt && v > best) { best = v; bi = i; } }
                L[(half * 16 + r) * 512 + tid] = best; L[(32 + half * 16 + r) * 512 + tid] = __int_as_float(bi); pv = best; pi = bi;
            }
        }
        float pv = INFINITY; int pi = -1; float tv0 = 0.f, ssum = 0.f;
        for (int r = 0; r < 16; ++r) {
            float best = -INFINITY; int bi = 256;
            for (int i = 0; i < 16; ++i) { const float a = L[i * 512 + tid];
                for (int j = 0; j < 16; ++j) { const float v = a + L[(16 + j) * 512 + tid]; const int idx = i * 16 + j; const bool lt = (v < pv) || (v == pv && idx > pi); if (lt && v > best) { best = v; bi = idx; } } }
            const int e1 = __float_as_int(L[(32 + (bi >> 4)) * 512 + tid]), e2 = __float_as_int(L[(48 + (bi & 15)) * 512 + tid]);
            if (r == 0) tv0 = best;
            const float ex = __expf(best - tv0); ssum += ex;
            ids[(size_t)tok * 128 + head * 16 + r] = e1 * 128 + e2; gates[(size_t)tok * 128 + head * 16 + r] = ex;
            pv = best; pi = bi;
        }
        const float inv = 1.f / ssum;
        for (int r = 0; r < 16; ++r) gates[(size_t)tok * 128 + head * 16 + r] *= inv;
    }
}
__device__ __forceinline__ void phase_gather_naive(const Ctx& C, const Args& A, const float* U, const float* V, const float* g2  ) {
    const bf16* H = (const bf16*)(A.ws + WS_H); const int* ids = (const int*)(A.ws + WS_IDS); const float* gates = (const float*)(A.ws + WS_GATES);
    for (int tok = C.gw; tok < NTOK; tok += C.NGW) {
        f32x4 h[4], acc[4];
#pragma unroll
        for (int j = 0; j < 4; ++j) { const uint2 w = *(const uint2*)(H + (size_t)tok * DM + 4 * C.lane + 256 * j); h[j] = (f32x4){bflo(w.x), bfhi(w.x), bflo(w.y), bfhi(w.y)}; acc[j] = (f32x4){0.f, 0.f, 0.f, 0.f}; }
        for (int r = 0; r < 128; ++r) {
            const int e = __builtin_amdgcn_readfirstlane(ids[(size_t)tok * 128 + r]); const float gt = gates[(size_t)tok * 128 + r];
            const float* ur = U + (size_t)e * DM + 4 * C.lane; const float* vr = V + (size_t)e * DM + 4 * C.lane;
            float p = 0.f;
#pragma unroll
            for (int j = 0; j < 4; ++j) { const f32x4 u = *(const f32x4*)(ur + 256 * j); p += h[j].x * u.x + h[j].y * u.y + h[j].z * u.z + h[j].w * u.w; }
            const float act = gelu_exact(wave_sum(p)) * gt;
#pragma unroll
            for (int j = 0; j < 4; ++j) { const f32x4 v = *(const f32x4*)(vr + 256 * j); acc[j] = acc[j] + v * act; }
        }
        const int b = tok >> 12;
#pragma unroll
        for (int j = 0; j < 4; ++j) { float* o = A.out + (size_t)tok * DM + 4 * C.lane + 256 * j; const f32x4 g = *(const f32x4*)(g2 + (size_t)b * 6144 + 4 * C.lane + 256 * j);
            *(f32x4*)o = *(const f32x4*)o + (g + 1.0f) * acc[j]; }
    }
}

__device__ __forceinline__ void phase_attn_naive(const Ctx& C, const Args& A) {
    const bf16* QKV = (const bf16*)(A.ws + WS_BIG); bf16* O = (bf16*)(A.ws + WS_H);
    const float* qg = A.in[21]; const float* kg = A.in[22];
    for (long it = C.gt; it < (long)NTOK * 16; it += C.NGT) {
        const int hd = (int)(it & 15), tok = (int)(it >> 4), t = tok & (SEQ - 1);
        float q[64], o[64];
        { float ss = 0.f;
#pragma unroll
          for (int c = 0; c < 8; ++c) { const v4u w = *(const v4u*)(QKV + (size_t)tok * 3072 + hd * 64 + c * 8);
              q[c * 8 + 0] = bflo(w.x); q[c * 8 + 1] = bfhi(w.x); q[c * 8 + 2] = bflo(w.y); q[c * 8 + 3] = bfhi(w.y); q[c * 8 + 4] = bflo(w.z); q[c * 8 + 5] = bfhi(w.z); q[c * 8 + 6] = bflo(w.w); q[c * 8 + 7] = bfhi(w.w); }
#pragma unroll
          for (int d = 0; d < 64; ++d) ss += q[d] * q[d];
          const float rs = rsqrtf(ss * (1.f / 64.f) + EPS) * 0.125f;
#pragma unroll
          for (int d = 0; d < 64; ++d) { q[d] *= rs * qg[d]; o[d] = 0.f; } }
        float c = 0.f;
        for (int s = t - 1; s >= 0; --s) {
            const bf16* kr = QKV + (size_t)(tok - t + s) * 3072 + 1024 + hd * 64;
            float z = 0.f, ss = 0.f;
#pragma unroll
            for (int cc = 0; cc < 8; ++cc) { const v4u w = *(const v4u*)(kr + cc * 8);
                const float k0 = bflo(w.x), k1 = bfhi(w.x), k2 = bflo(w.y), k3 = bfhi(w.y), k4 = bflo(w.z), k5 = bfhi(w.z), k6 = bflo(w.w), k7 = bfhi(w.w);
                ss += k0 * k0 + k1 * k1 + k2 * k2 + k3 * k3 + k4 * k4 + k5 * k5 + k6 * k6 + k7 * k7;
                z += q[cc * 8 + 0] * k0 * kg[cc * 8 + 0] + q[cc * 8 + 1] * k1 * kg[cc * 8 + 1] + q[cc * 8 + 2] * k2 * kg[cc * 8 + 2] + q[cc * 8 + 3] * k3 * kg[cc * 8 + 3]
                   + q[cc * 8 + 4] * k4 * kg[cc * 8 + 4] + q[cc * 8 + 5] * k5 * kg[cc * 8 + 5] + q[cc * 8 + 6] * k6 * kg[cc * 8 + 6] + q[cc * 8 + 7] * k7 * kg[cc * 8 + 7]; }
            z *= rsqrtf(ss * (1.f / 64.f) + EPS);
            const float sp = softplusf_(z);
            const float att = __expf(z - sp - c);
            c += sp;
            const bf16* vr = kr + 1024;
#pragma unroll
            for (int cc = 0; cc < 8; ++cc) { const v4u w = *(const v4u*)(vr + cc * 8);
                o[cc * 8 + 0] += att * bflo(w.x); o[cc * 8 + 1] += att * bfhi(w.x); o[cc * 8 + 2] += att * bflo(w.y); o[cc * 8 + 3] += att * bfhi(w.y);
                o[cc * 8 + 4] += att * bflo(w.z); o[cc * 8 + 5] += att * bfhi(w.z); o[cc * 8 + 6] += att * bflo(w.w); o[cc * 8 + 7] += att * bfhi(w.w); }
            if (c > 104.f) break;
        }
#pragma unroll
        for (int cc = 0; cc < 8; ++cc) { v4u w; w.x = pk2(o[cc * 8 + 0], o[cc * 8 + 1]); w.y = pk2(o[cc * 8 + 2], o[cc * 8 + 3]); w.z = pk2(o[cc * 8 + 4], o[cc * 8 + 5]); w.w = pk2(o[cc * 8 + 6], o[cc * 8 + 7]);
            *(v4u*)(O + (size_t)tok * DM + hd * 64 + cc * 8) = w; }
    }
}
constexpr int N_PHASES = 18;
#ifndef MK_ONE_LAUNCH
#define MK_ONE_LAUNCH 0
#endif

__global__ void __launch_bounds__(NWAVES * 64, 2) mk_fwd(Args args) {
    extern __shared__ __attribute__((aligned(16))) unsigned char lds_raw[];
    Ctx C;
    C.lds = (LAS unsigned char*)lds_raw;
    C.tid = threadIdx.x; C.lane = C.tid & 63; C.wave = __builtin_amdgcn_readfirstlane(C.tid >> 6);
    C.G = gridDim.x; C.bid = blockIdx.x;
    C.gw = C.bid * NWAVES + C.wave; C.NGW = C.G * NWAVES;
    C.gt = (long)C.bid * (NWAVES * 64) + C.tid; C.NGT = (long)C.G * (NWAVES * 64);
    unsigned char* ws = args.ws;
    volatile LAS unsigned* MISC = (volatile LAS unsigned*)(C.lds + MISC_OFF);
    for (int u = C.tid; u < (LDS_BYTES - LDSCTL_OFF) / 4; u += NWAVES * 64) ((LAS unsigned*)(C.lds + LDSCTL_OFF))[u] = 0u;
    __syncthreads();
#if MK_ONE_LAUNCH
    XcdBarrier bar = xcd_barrier_post((unsigned*)((gu32*)(ws + WS_CTL) + CW_BAR), MISC + 8);
#define GRID_BAR() xcd_barrier(bar)
#else
    (void)MISC;
#define GRID_BAR() do {} while (0)
#endif
    const int lo = args.ph_lo, hi = args.ph_hi;
#define IN(k) (lo <= (k) && (k) < hi)
#define SEAM(k) do { if (IN(k) && IN((k) + 1)) GRID_BAR(); } while (0)
    float* mod0 = (float*)(ws + WS_MOD); float* mod1 = mod0 + (size_t)NB * 6144;
    bf16* Hb = (bf16*)(ws + WS_H); bf16* BIG = (bf16*)(ws + WS_BIG);

    if (IN(0)) { phase_prep(C, args); } SEAM(0);
    if (IN(1)) { phase_rowpass<true>(C, args, args.in[0], args.in[4], mod0, 0, 1, Hb); } SEAM(1);
    if (IN(2)) { pg8::Gemm g{Hb, (const bf16*)(ws + WS_WIN), NTOK, INP, DM}; pg8::StaticOrder S; S.init(NTOK, INP, C.G, C.bid);
        pg8::EpiBf16<0> E{BIG, INP, nullptr, 0, 0, 1.f};
        pg8::gemm_phase<pg8::EpiBf16<0>, pg8::StaticOrder, true, true>(C.lds, g, S, E); } SEAM(2);
    if (IN(3)) { phase_mlstm_prefix(C, args); phase_conv(C, args); } SEAM(3);
    if (IN(4)) { phase_mlstm_naive(C, args); } SEAM(4);
    if (IN(5)) { pg8::Gemm g{Hb, (const bf16*)(ws + WS_WOUT0), NTOK, DM, DM}; pg8::StaticOrder S; S.init(NTOK, DM, C.G, C.bid);
        EpiResid E{args.in[0], args.out, mod0 + 2 * 1024};
        pg8::gemm_phase<EpiResid, pg8::StaticOrder, true, true>(C.lds, g, S, E); } SEAM(5);
    if (IN(6)) { phase_rowpass<false>(C, args, args.out, args.in[11], mod0, 3, 4, Hb); } SEAM(6);
    if (IN(7)) { pg8::Gemm g{Hb, (const bf16*)(ws + WS_WC0), NTOK, 2048, DM}; pg8::StaticOrder S; S.init(NTOK, 2048, C.G, C.bid);
        pg8::EpiBf16<0> E{BIG, 2048, nullptr, 0, 0, 1.f};
        pg8::gemm_phase<pg8::EpiBf16<0>, pg8::StaticOrder, true, true>(C.lds, g, S, E); } SEAM(7);
    if (IN(8)) { phase_topk_naive(C, args); } SEAM(8);
    if (IN(9)) { phase_gather_naive(C, args, args.in[15], args.in[16], mod0 + 5 * 1024); } SEAM(9);
    if (IN(10)) { phase_rowpass<false>(C, args, args.out, args.in[19], mod1, 0, 1, Hb); } SEAM(10);
    if (IN(11)) { pg8::Gemm g{Hb, (const bf16*)(ws + WS_WQKV), NTOK, 3072, DM}; pg8::StaticOrder S; S.init(NTOK, 3072, C.G, C.bid);
        pg8::EpiBf16<0> E{BIG, 3072, nullptr, 0, 0, 1.f};
        pg8::gemm_phase<pg8::EpiBf16<0>, pg8::StaticOrder, true, true>(C.lds, g, S, E); } SEAM(11);
    if (IN(12)) { phase_attn_naive(C, args); } SEAM(12);
    if (IN(13)) { pg8::Gemm g{Hb, (const bf16*)(ws + WS_WOUT1), NTOK, DM, DM}; pg8::StaticOrder S; S.init(NTOK, DM, C.G, C.bid);
        EpiResid E{args.out, args.out, mod1 + 2 * 1024};
        pg8::gemm_phase<EpiResid, pg8::StaticOrder, true, true>(C.lds, g, S, E); } SEAM(13);
    if (IN(14)) { phase_rowpass<false>(C, args, args.out, args.in[24], mod1, 3, 4, Hb); } SEAM(14);
    if (IN(15)) { pg8::Gemm g{Hb, (const bf16*)(ws + WS_WC1), NTOK, 2048, DM}; pg8::StaticOrder S; S.init(NTOK, 2048, C.G, C.bid);
        pg8::EpiBf16<0> E{BIG, 2048, nullptr, 0, 0, 1.f};
        pg8::gemm_phase<pg8::EpiBf16<0>, pg8::StaticOrder, true, true>(C.lds, g, S, E); } SEAM(15);
    if (IN(16)) { phase_topk_naive(C, args); } SEAM(16);
    if (IN(17)) { phase_gather_naive(C, args, args.in[28], args.in[29], mod1 + 5 * 1024); }
#undef IN
#undef SEAM
}

extern "C" void kernel_launch(void* const* d_in, const int* in_sizes, int n_in, void* d_out, int out_size, void* d_ws, size_t ws_size, hipStream_t stream) {
    static int grid = 0;
    if (grid == 0) {
        if (n_in != 30 || out_size != NTOK * DM || ws_size < WS_END) { fprintf(stderr, "kernel_launch: unexpected shapes (n_in %d out %d ws %zu)\n", n_in, out_size, ws_size); grid = -1; return; }
        int dev = 0, cus = 0;
        if (hipGetDevice(&dev) != hipSuccess || hipDeviceGetAttribute(&cus, hipDeviceAttributeMultiprocessorCount, dev) != hipSuccess) { grid = -1; return; }
        if (hipFuncSetAttribute((const void*)mk_fwd, hipFuncAttributeMaxDynamicSharedMemorySize, LDS_BYTES) != hipSuccess) { fprintf(stderr, "kernel_launch: hipFuncSetAttribute failed\n"); grid = -1; return; }
        int per_cu = 0;
        if (hipOccupancyMaxActiveBlocksPerMultiprocessor(&per_cu, (const void*)mk_fwd, NWAVES * 64, LDS_BYTES) != hipSuccess || per_cu < 1) fprintf(stderr, "kernel_launch: occupancy query reports %d\n", per_cu);
        (void)hipGetLastError();
        grid = cus;
    }
    if (grid < 0) return;
    (void)hipMemsetAsync((char*)d_ws + WS_CTL, 0, CTL_ZERO_BYTES, stream);
    Args a{};
    for (int i = 0; i < 30; ++i) a.in[i] = (const float*)d_in[i];
    a.out = (float*)d_out; a.ws = (unsigned char*)d_ws;
#if MK_ONE_LAUNCH
    a.ph_lo = 0; a.ph_hi = N_PHASES;
    hipLaunchKernelGGL(mk_fwd, dim3(grid), dim3(NWAVES * 64), LDS_BYTES, stream, a);
#else
    for (int p = 0; p < N_PHASES; ++p) { a.ph_lo = p; a.ph_hi = p + 1; hipLaunchKernelGGL(mk_fwd, dim3(grid), dim3(NWAVES * 64), LDS_BYTES, stream, a); }
#endif
}
```

```cpp
#include <hip/hip_runtime.h>
#include <cstdio>
#include <cstdint>
#include <cmath>
#define PROBE_MASK 0
namespace pg8 {
#define PG8_LAS __attribute__((address_space(3)))
typedef unsigned short bf16_t;
typedef short bf16x8 __attribute__((ext_vector_type(8)));
typedef float f32x4 __attribute__((ext_vector_type(4)));
typedef unsigned u32x4 __attribute__((ext_vector_type(4)));
constexpr int BM = 256, BK = 64, HALF = 128, HTB = HALF * BK * 2  , STAGE_BYTES = 8 * HTB, NXCD = 8, WGM = 8;

__host__ __device__ __forceinline__ int lds_byte(int r, int c) { const int st = (r >> 4) * 2 + (c >> 5), rr = r & 15, cc = c & 31, ob = rr * 64 + cc * 2; return st * 1024 + (ob ^ (((ob >> 9) & 1) << 5)); }
__host__ __device__ __forceinline__ void stage_rc(int b, int& R, int& C) { const int st = b / 1024, sb = b % 1024, swz = sb ^ (((sb >> 9) & 1) << 5); R = (st >> 1) * 16 + swz / 64; C = (st & 1) * 32 + (swz % 64) / 2; }
__host__ __device__ __forceinline__ int perm32(int rho) { const int n = rho >> 4, i = rho & 15; return 8 * (i >> 2) + 4 * n + (i & 3); }

struct Unit { int pm, pn; };
struct Gemm { const bf16_t* A; const bf16_t* Bt; int M, N, K; };

struct StaticOrder {
    int nM, nN, nwg, G, c;
    __host__ __device__ void init(int M, int N, int G_, int c_) { nM = M / BM; nN = N / BM; nwg = nM * nN; G = G_; c = c_; }
    __host__ __device__ bool next(int i, Unit& u) const {
        const long L = (long)i * G + c; if (L >= nwg) return false;
        int wgid = (int)L; { const int q = nwg / NXCD, r = nwg % NXCD, xcd = wgid % NXCD, off = wgid / NXCD; wgid = (xcd < r ? xcd * (q + 1) : r * (q + 1) + (xcd - r) * q) + off; }
        const int nig = WGM * nN, gid = wgid / nig, fm = gid * WGM, gsz = (nM - fm) < WGM ? (nM - fm) : WGM;
        u.pm = fm + ((wgid % nig) % gsz); u.pn = (wgid % nig) / gsz; return true;
    }
    __device__ __forceinline__ void a_ready(const Unit&) const {}
    __device__ __forceinline__ void done(const Unit&) const {}
};

__device__ __forceinline__ unsigned cvt_pk_bf16(float lo, float hi) { unsigned r; asm volatile("v_cvt_pk_bf16_f32 %0, %1, %2" : "=v"(r) : "v"(lo), "v"(hi)); return r; }
typedef float f32x2 __attribute__((ext_vector_type(2)));
__device__ __forceinline__ f32x2 gelu_pk(f32x2 v) {
    const f32x2 av = __builtin_elementwise_abs(v), d = av * 0.2316418882f + 1.0f;
    f32x2 t; t.x = __builtin_amdgcn_rcpf(d.x); t.y = __builtin_amdgcn_rcpf(d.y);
    f32x2 q = t * 0.5307027145f + (-0.7265760135f); q = q * t + 0.7107068705f; q = q * t + (-0.142248368f); q = q * t + 0.127414796f; q = q * t;
    const f32x2 s = (v * v) * (-0.72134752044f);
    f32x2 e; e.x = __builtin_amdgcn_exp2f(s.x); e.y = __builtin_amdgcn_exp2f(s.y);
    const f32x2 m = v * (q * e), r = v - m;
    f32x2 o; o.x = v.x < 0.f ? m.x : r.x; o.y = v.y < 0.f ? m.y : r.y; return o;
}

template <int ACT  > struct EpiBf16 {
    static constexpr bool PERM = true, AFTER_DRAIN = false; static_assert(ACT == 0 || ACT == 1, "EpiBf16: ACT is 0 (none) or 1 (gelu_pk)");
    bf16_t* O; int ldc; const float* bias; int split_cols; size_t split_stride; float scale0;
    __device__ __forceinline__ void operator()(const f32x4 (&acc)[2][2][4][2], const Unit& u, int wr, int wc, int fr, int fq) const {
        const int row0 = u.pm * BM + wr * 64 + fr; int colt = u.pn * BM; bf16_t* base = O;
        float sc = 1.f; if (split_cols) { const int t = colt / split_cols; base += (size_t)t * split_stride; colt -= t * split_cols; if (t == 0) sc = scale0; }
        const int col0 = colt + wc * 32 + 8 * fq, bcol0 = u.pn * BM + wc * 32 + 8 * fq;
        f32x4 bv[2][2];
#pragma unroll
        for (int bj = 0; bj < 2; ++bj)
#pragma unroll
            for (int n = 0; n < 2; ++n) bv[bj][n] = bias ? *(const f32x4*)(bias + bcol0 + bj * HALF + 4 * n) : (f32x4){0.f, 0.f, 0.f, 0.f};
#pragma unroll
        for (int ai = 0; ai < 2; ++ai)
#pragma unroll
            for (int m = 0; m < 4; ++m) { bf16_t* rowp = base + (size_t)(row0 + ai * HALF + m * 16) * ldc + col0;
#pragma unroll
                for (int bj = 0; bj < 2; ++bj) { f32x4 v0 = acc[ai][bj][m][0] + bv[bj][0], v1 = acc[ai][bj][m][1] + bv[bj][1];
                    if (ACT == 1) { f32x2 a = gelu_pk((f32x2){v0[0], v0[1]}), b = gelu_pk((f32x2){v0[2], v0[3]}), c = gelu_pk((f32x2){v1[0], v1[1]}), d = gelu_pk((f32x2){v1[2], v1[3]});
                        v0 = (f32x4){a.x, a.y, b.x, b.y}; v1 = (f32x4){c.x, c.y, d.x, d.y}; }
                    v0 = v0 * sc; v1 = v1 * sc; u32x4 w; w.x = cvt_pk_bf16(v0[0], v0[1]); w.y = cvt_pk_bf16(v0[2], v0[3]); w.z = cvt_pk_bf16(v1[0], v1[1]); w.w = cvt_pk_bf16(v1[2], v1[3]);
                    *(u32x4*)(rowp + bj * HALF) = w; } }
    }
};
typedef int i32x4 __attribute__((ext_vector_type(4)));
template <bool I8> struct AccSel { typedef f32x4 type; };
template <> struct AccSel<true> { typedef i32x4 type; };
template <class Epi, class Sched, bool ALIGN_EPI = false, bool SP2 = false, bool I8 = false>
__device__ __forceinline__ void gemm_phase(PG8_LAS unsigned char* lds, const Gemm g, const Sched& S, const Epi& E) {
    const int tid = threadIdx.x, wid = __builtin_amdgcn_readfirstlane(tid >> 6), lane = tid & 63, wr = wid >> 2, wc = wid & 3, fr = lane & 15, fq = lane >> 4;
    const int K = g.K, nt = K / BK;
    unsigned voffA[2], voffB[2];
#pragma unroll
    for (int i = 0; i < 2; ++i) { int R, C; stage_rc(tid * 16 + i * 8192, R, C); const int Rb = Epi::PERM ? ((R & ~31) + perm32(R & 31)) : R;
        voffA[i] = (unsigned)(R * K + C) * 2u; voffB[i] = (unsigned)(Rb * K + C) * 2u; }
    const size_t kstep = (size_t)(BK * 2);
    const size_t hstep = (size_t)HALF * K * 2;
    const size_t tstep = 2 * hstep;
    const unsigned ldsw = (unsigned)wid * 1024u;
    const int aoff = lds_byte(wr * 64 + fr, fq * 8), boff = lds_byte(wc * 32 + fr, fq * 8);
#define PG8_SA(b, h) (((b) * 2 + (h)) * HTB)
#define PG8_SB(b, h) ((4 + (b) * 2 + (h)) * HTB)
#define PG8_STAGE(bufoff, gbase, voff) do { _Pragma("unroll") for (int _i = 0; _i < 2; ++_i) \
        __builtin_amdgcn_global_load_lds((const unsigned*)((const char*)(gbase) + (voff)[_i]), (PG8_LAS unsigned*)(lds + (bufoff) + ldsw + _i * 8192), 16, 0, 0); } while (0)
#define PG8_LDA(dst, b, h) do { _Pragma("unroll") for (int m = 0; m < 4; ++m) _Pragma("unroll") for (int k = 0; k < 2; ++k) dst[m][k] = *(const PG8_LAS bf16x8*)(lds + PG8_SA(b, h) + aoff + m * 2048 + k * 1024); } while (0)
#define PG8_LDB(dst, b, h) do { _Pragma("unroll") for (int n = 0; n < 2; ++n) _Pragma("unroll") for (int k = 0; k < 2; ++k) dst[n][k] = *(const PG8_LAS bf16x8*)(lds + PG8_SB(b, h) + boff + n * 2048 + k * 1024); } while (0)
#define PG8_MMA(ai, bj, At, Bt) do { __builtin_amdgcn_s_setprio(1); _Pragma("unroll") for (int m = 0; m < 4; ++m) _Pragma("unroll") for (int n = 0; n < 2; ++n) _Pragma("unroll") for (int k = 0; k < 2; ++k) \
        { if constexpr (I8) acc[ai][bj][m][n] = __builtin_bit_cast(acc_t, __builtin_amdgcn_mfma_i32_16x16x64_i8(__builtin_bit_cast(i32x4, Bt[n][k]), __builtin_bit_cast(i32x4, At[m][k]), __builtin_bit_cast(i32x4, acc[ai][bj][m][n]), 0, 0, 0)); \
          else acc[ai][bj][m][n] = __builtin_bit_cast(acc_t, __builtin_amdgcn_mfma_f32_16x16x32_bf16(Bt[n][k], At[m][k], __builtin_bit_cast(f32x4, acc[ai][bj][m][n]), 0, 0, 0)); } __builtin_amdgcn_s_setprio(0); } while (0)
#define PG8_WAIT_V(n) asm volatile("s_waitcnt vmcnt(" #n ")" ::: "memory")
#define PG8_WAIT_L(n) asm volatile("s_waitcnt lgkmcnt(" #n ")" ::: "memory")
#define PG8_BAR __builtin_amdgcn_s_barrier()
#define PG8_SCHED __builtin_amdgcn_sched_barrier(0)
    Unit cur, nxt; int ui = 0;
    if (!S.next(0, cur)) return;
    typedef typename AccSel<I8>::type acc_t; const acc_t acc_zero = {};
    acc_t acc[2][2][4][2];
#pragma unroll
    for (int a = 0; a < 2; ++a)
#pragma unroll
        for (int b = 0; b < 2; ++b)
#pragma unroll
            for (int m = 0; m < 4; ++m)
#pragma unroll
                for (int n = 0; n < 2; ++n) acc[a][b][m][n] = acc_zero;
    bf16x8 At[4][2], B0[2][2], B1[2][2];
    const char* cA = (const char*)g.A + (size_t)cur.pm * tstep; const char* cB = (const char*)g.Bt + (size_t)cur.pn * tstep;
    S.a_ready(cur);
    if constexpr (SP2) {
        PG8_STAGE(PG8_SB(0, 0), cB, voffB); PG8_STAGE(PG8_SB(0, 1), cB + hstep, voffB); PG8_STAGE(PG8_SA(0, 0), cA, voffA); PG8_STAGE(PG8_SA(0, 1), cA + hstep, voffA);
        if (wr == 1) PG8_BAR;
        PG8_WAIT_V(2); PG8_BAR;
        PG8_STAGE(PG8_SB(1, 0), cB + kstep, voffB); PG8_STAGE(PG8_SA(1, 0), cA + kstep, voffA); PG8_STAGE(PG8_SB(1, 1), cB + hstep + kstep, voffB);
        PG8_WAIT_V(6); PG8_BAR;
    } else {
        PG8_STAGE(PG8_SB(0, 0), cB, voffB); PG8_STAGE(PG8_SA(0, 0), cA, voffA); PG8_STAGE(PG8_SB(0, 1), cB + hstep, voffB); PG8_STAGE(PG8_SA(0, 1), cA + hstep, voffA);
        if (wr == 1) PG8_BAR;
        PG8_WAIT_V(4); PG8_BAR;
        PG8_STAGE(PG8_SB(1, 0), cB + kstep, voffB); PG8_STAGE(PG8_SA(1, 0), cA + kstep, voffA); PG8_STAGE(PG8_SB(1, 1), cB + hstep + kstep, voffB);
        PG8_WAIT_V(6); PG8_BAR;
    }
    for (;;) {
        const bool has_next = S.next(ui + 1, nxt);
        const char* nA = has_next ? (const char*)g.A + (size_t)nxt.pm * tstep : cA; const char* nB = has_next ? (const char*)g.Bt + (size_t)nxt.pn * tstep : cB;
        for (int t = 0; t < nt; t += 2) {
            const bool last = (t == nt - 2);
            const char* a1 = cA + (size_t)(t + 1) * kstep;
            const char* a2 = last ? nA : cA + (size_t)(t + 2) * kstep; const char* b2 = last ? nB : cB + (size_t)(t + 2) * kstep;
            const char* a3 = a2 + kstep; const char* b3 = b2 + kstep;
            if (last && has_next) S.a_ready(nxt);
            if constexpr (SP2) {
            PG8_LDB(B0, 0, 0); PG8_LDB(B1, 0, 1); PG8_SCHED; PG8_LDA(At, 0, 0); PG8_STAGE(PG8_SA(1, 1), a1 + hstep, voffA);
            PG8_WAIT_V(8); PG8_WAIT_L(0); PG8_BAR; PG8_MMA(0, 0, At, B0); PG8_MMA(0, 1, At, B1); PG8_BAR; PG8_SCHED;
            PG8_LDA(At, 0, 1); PG8_STAGE(PG8_SB(0, 0), b2, voffB); PG8_STAGE(PG8_SB(0, 1), b2 + hstep, voffB); PG8_STAGE(PG8_SA(0, 0), a2, voffA);
            PG8_WAIT_V(8); PG8_WAIT_L(0); PG8_BAR; PG8_MMA(1, 0, At, B0); PG8_MMA(1, 1, At, B1); PG8_BAR; PG8_SCHED;
            PG8_LDB(B0, 1, 0); PG8_LDB(B1, 1, 1); PG8_SCHED; PG8_LDA(At, 1, 0); PG8_STAGE(PG8_SA(0, 1), a2 + hstep, voffA);
            PG8_WAIT_V(8); PG8_WAIT_L(0); PG8_BAR; PG8_MMA(0, 0, At, B0); PG8_MMA(0, 1, At, B1); PG8_BAR; PG8_SCHED;
            PG8_LDA(At, 1, 1); PG8_STAGE(PG8_SB(1, 0), b3, voffB); PG8_STAGE(PG8_SB(1, 1), b3 + hstep, voffB); PG8_STAGE(PG8_SA(1, 0), a3, voffA);
            PG8_WAIT_V(8); PG8_WAIT_L(0); PG8_BAR; PG8_MMA(1, 0, At, B0); PG8_MMA(1, 1, At, B1); PG8_BAR; PG8_SCHED;
            } else {
            PG8_LDB(B0, 0, 0); PG8_SCHED; PG8_LDA(At, 0, 0); PG8_STAGE(PG8_SA(1, 1), a1 + hstep, voffA);
            PG8_WAIT_L(8); PG8_BAR; PG8_WAIT_L(0); PG8_MMA(0, 0, At, B0); PG8_BAR; PG8_SCHED;
            PG8_LDB(B1, 0, 1); PG8_STAGE(PG8_SB(0, 0), b2, voffB);
            PG8_BAR; PG8_WAIT_L(0); PG8_MMA(0, 1, At, B1); PG8_BAR;
            PG8_LDA(At, 0, 1); PG8_STAGE(PG8_SA(0, 0), a2, voffA);
            PG8_BAR; PG8_WAIT_L(0); PG8_MMA(1, 0, At, B0); PG8_BAR; PG8_SCHED;
            PG8_STAGE(PG8_SB(0, 1), b2 + hstep, voffB);
            PG8_WAIT_V(6); PG8_BAR; PG8_MMA(1, 1, At, B1); PG8_BAR;
            PG8_LDB(B0, 1, 0); PG8_SCHED; PG8_LDA(At, 1, 0); PG8_STAGE(PG8_SA(0, 1), a2 + hstep, voffA);
            PG8_WAIT_L(8); PG8_BAR; PG8_WAIT_L(0); PG8_MMA(0, 0, At, B0); PG8_BAR; PG8_SCHED;
            PG8_LDB(B1, 1, 1); PG8_STAGE(PG8_SB(1, 0), b3, voffB);
            PG8_BAR; PG8_WAIT_L(0); PG8_MMA(0, 1, At, B1); PG8_BAR;
            PG8_LDA(At, 1, 1); PG8_STAGE(PG8_SA(1, 0), a3, voffA);
            PG8_BAR; PG8_WAIT_L(0); PG8_MMA(1, 0, At, B0); PG8_BAR; PG8_SCHED;
            PG8_STAGE(PG8_SB(1, 1), b3 + hstep, voffB);
            PG8_WAIT_V(6); PG8_BAR; PG8_MMA(1, 1, At, B1); PG8_BAR;
            }
        }
        if constexpr (ALIGN_EPI) { if (wr == 0) PG8_BAR; }
        if constexpr (!Epi::AFTER_DRAIN) { E(acc, cur, wr, wc, fr, fq); S.done(cur); }
        if (!has_next) break;
#pragma unroll
        for (int a = 0; a < 2; ++a)
#pragma unroll
            for (int b = 0; b < 2; ++b)
#pragma unroll
                for (int m = 0; m < 4; ++m)
#pragma unroll
                    for (int n = 0; n < 2; ++n) acc[a][b][m][n] = acc_zero;
        cur = nxt; cA = nA; cB = nB; ++ui;
        if constexpr (ALIGN_EPI) { if (wr == 1) PG8_BAR; }
    }
    PG8_WAIT_V(0);
    if constexpr (!ALIGN_EPI) { if (wr == 0) PG8_BAR; }
    PG8_BAR;
    if constexpr (Epi::AFTER_DRAIN) { E.fused(acc, cur, wr, wc, fr, fq, lds, wid, lane); S.done(cur); }
#undef PG8_SA
#undef PG8_SB
#undef PG8_STAGE
#undef PG8_LDA
#undef PG8_LDB
#undef PG8_MMA
#undef PG8_WAIT_V
#undef PG8_WAIT_L
#undef PG8_BAR
#undef PG8_SCHED
}
}
#define GAS __attribute__((address_space(1)))
#define LAS __attribute__((address_space(3)))
typedef unsigned short bf16;
typedef unsigned v4u __attribute__((ext_vector_type(4)));
typedef float f32x4 __attribute__((ext_vector_type(4)));
typedef short bf16x8 __attribute__((ext_vector_type(8)));
typedef GAS unsigned gu32;
typedef GAS unsigned long long gu64;
#define RLX_AGENT __ATOMIC_RELAXED, __HIP_MEMORY_SCOPE_AGENT
#define LDS_WAIT() asm volatile("s_waitcnt lgkmcnt(0)" ::: "memory")
#define VM_WAIT() asm volatile("s_waitcnt vmcnt(0)" ::: "memory")
__device__ __forceinline__ unsigned long long rt() { return __builtin_amdgcn_s_memrealtime(); }
__device__ __forceinline__ unsigned f2bf(float f) { unsigned u = __builtin_bit_cast(unsigned, f); return (u + 0x7fffu + ((u >> 16) & 1u)) >> 16; }
typedef float pk2_f32x2 __attribute__((ext_vector_type(2))); typedef __bf16 pk2_bf16x2 __attribute__((ext_vector_type(2)));
__device__ __forceinline__ unsigned pk2(float lo, float hi) { const pk2_f32x2 v = {lo, hi}; return __builtin_bit_cast(unsigned, __builtin_convertvector(v, pk2_bf16x2)); }

#define XB_TMO      128
#define XB_XCNT(j)  (256  + 64 * (j))
#define XB_XSUB(j)  (1280 + 64 * (j))
#define XB_XGEN(j)  (2304 + 64 * (j))
#define XB_TOP      3328
#define XB_TOPGEN   3392
#define XCD_BAR_WORDS 3456
#define XB_SPIN_CAP (1u << 18)

__device__ __forceinline__ unsigned xb_ld(unsigned* p)              { return __hip_atomic_load(p, __ATOMIC_RELAXED, __HIP_MEMORY_SCOPE_AGENT); }
__device__ __forceinline__ unsigned xb_add(unsigned* p, unsigned v) { return __hip_atomic_fetch_add(p, v, __ATOMIC_RELAXED, __HIP_MEMORY_SCOPE_AGENT); }
__device__ __forceinline__ unsigned xb_xcc_id() { return (unsigned)__builtin_amdgcn_s_getreg((3 << 11) | 20) & 0xFu; }
#define XB_SPIN(cond, bar) do { unsigned _sp = 0; while (cond) { __builtin_amdgcn_s_sleep(1); \
    if ((++_sp & 255u) == 0u) { if (xb_ld(&(bar)[XB_TMO])) break; if (_sp > XB_SPIN_CAP) { atomicAdd(&(bar)[XB_TMO], 1u); break; } } } } while (0)

struct XcdBarrier {
    unsigned* bar; unsigned x;
    volatile LAS unsigned* st;
};

__device__ __forceinline__ XcdBarrier xcd_barrier_post(unsigned* bar, volatile LAS unsigned* st) {
    XcdBarrier b; b.bar = bar; b.x = xb_xcc_id(); b.st = st;
    if (threadIdx.x == 0) (void)xb_add(&bar[XB_XCNT(b.x)], 1u);
    return b;
}
__device__ __forceinline__ void xcd_barrier_complete(unsigned* bar, unsigned x, unsigned& nloc, unsigned& nx) {
    const unsigned G = gridDim.x * gridDim.y * gridDim.z;
    unsigned sum, cnt, mine, sp = 0u;
    for (;;) {
        sum = 0u; cnt = 0u; mine = 0u;
#pragma unroll
        for (unsigned j = 0; j < 16; ++j) { const unsigned c = xb_ld(&bar[XB_XCNT(j)]); sum += c; cnt += (c > 0u) ? 1u : 0u; mine = (j == x) ? c : mine; }
        if (sum == G) break;
        __builtin_amdgcn_s_sleep(1);
        if ((++sp & 255u) == 0u) { if (xb_ld(&bar[XB_TMO])) break; if (sp > XB_SPIN_CAP) { atomicAdd(&bar[XB_TMO], 1u); break; } }
    }
    nloc = mine > 0u ? mine : 1u; nx = cnt > 0u ? cnt : 1u;
}

__device__ __forceinline__ void xcd_barrier(const XcdBarrier& b) {
    asm volatile("s_waitcnt vmcnt(0)" ::: "memory");
    __syncthreads();
    if (threadIdx.x == 0) {
        unsigned* bar = b.bar;
        __builtin_amdgcn_s_waitcnt(0);
        unsigned nloc = b.st[0], nx = b.st[1];
        if (nloc == 0u) { xcd_barrier_complete(bar, b.x, nloc, nx); b.st[0] = nloc; b.st[1] = nx; }
        const unsigned old = xb_add(&bar[XB_XSUB(b.x)], 1u);
        const unsigned gen = old / nloc;
        if (old + 1u == (gen + 1u) * nloc) {
            __builtin_amdgcn_fence(__ATOMIC_RELEASE, "agent");
            asm volatile("s_waitcnt vmcnt(0)" ::: "memory");
            const unsigned og = xb_add(&bar[XB_TOP], 1u);
            const unsigned tg = og / nx;
            if (og + 1u == (tg + 1u) * nx) xb_add(&bar[XB_TOPGEN], 1u);
            else XB_SPIN(xb_ld(&bar[XB_TOPGEN]) == tg, bar);
            __builtin_amdgcn_fence(__ATOMIC_ACQUIRE, "agent");
            xb_add(&bar[XB_XGEN(b.x)], 1u);
            asm volatile("s_waitcnt vmcnt(0)" ::: "memory");
        } else {
            XB_SPIN(xb_ld(&bar[XB_XGEN(b.x)]) == gen, bar);
            __builtin_amdgcn_fence(__ATOMIC_ACQUIRE, "agent");
            asm volatile("s_waitcnt vmcnt(0)" ::: "memory");
        }
    }
    __syncthreads();
}
#ifndef MK_ONE_LAUNCH
#define MK_ONE_LAUNCH 1
#endif
constexpr int NWAVES = 8;
constexpr int NB = 8, SEQ = 4096, DM = 1024, NTOK = NB * SEQ;
constexpr int INW = 3592, INP = 3584;
constexpr float EPS = 1e-6f;
constexpr size_t MiB = 1u << 20;
constexpr size_t WS_CTL = 0, CTL_ZERO_BYTES = 1 * MiB;
constexpr size_t WS_MOD = 1 * MiB;
constexpr size_t WS_LF = 2 * MiB, WS_LI = WS_LF + 512 * 1024;
constexpr size_t WS_FC = 3 * MiB;
constexpr size_t WS_WIN = 4 * MiB, WS_WOUT0 = 11 * MiB, WS_WC0 = 13 * MiB, WS_WQKV = 17 * MiB, WS_WOUT1 = 23 * MiB, WS_WC1 = 25 * MiB;
constexpr size_t WS_H = 32 * MiB;
constexpr size_t WS_BIG = 96 * MiB;
constexpr size_t WS_IDS = 320 * MiB, WS_GATES = 336 * MiB;
constexpr size_t WS_END = 352 * MiB;
constexpr int CW_BAR = 4096;
constexpr int RING_BYTES = 131072, LDSCTL_OFF = RING_BYTES, MISC_OFF = LDSCTL_OFF + 320, LDS_BYTES = 147456;

__device__ __forceinline__ float wave_sum(float v) {
#pragma unroll
    for (int o = 1; o < 64; o <<= 1) v += __shfl_xor(v, o);
    return v;
}
__device__ __forceinline__ float wave_max(float v) {
#pragma unroll
    for (int o = 1; o < 64; o <<= 1) v = fmaxf(v, __shfl_xor(v, o));
    return v;
}
__device__ __forceinline__ float bf2f(unsigned short b) { return __uint_as_float((unsigned)b << 16); }
__device__ __forceinline__ float bflo(unsigned w) { return __uint_as_float(w << 16); }
__device__ __forceinline__ float bfhi(unsigned w) { return __uint_as_float(w & 0xffff0000u); }
__device__ __forceinline__ float sigmoidf_(float x) { return 1.f / (1.f + __expf(-x)); }
__device__ __forceinline__ float softplusf_(float x) { return fmaxf(x, 0.f) + __logf(1.f + __expf(-fabsf(x))); }
__device__ __forceinline__ float logsigmoidf_(float x) { return fminf(x, 0.f) - __logf(1.f + __expf(-fabsf(x))); }
__device__ __forceinline__ float gelu_exact(float x) { return 0.5f * x * (1.f + erff(x * 0.70710678118654752f)); }
__device__ __forceinline__ float gelu_as(float v) {
    const float av = fabsf(v), t = __builtin_amdgcn_rcpf(av * 0.2316418882f + 1.0f);
    float q = t * 0.5307027145f + (-0.7265760135f); q = q * t + 0.7107068705f; q = q * t + (-0.142248368f); q = q * t + 0.127414796f; q = q * t;
    const float e = __builtin_amdgcn_exp2f((v * v) * (-0.72134752044f));
    const float m = v * (q * e);
    return v < 0.f ? m : v - m;
}

struct Args { const float* in[30]; float* out; unsigned char* ws; int ph_lo, ph_hi; };

struct Ctx {
    LAS unsigned char* lds;
    int tid, lane, wave, G, bid;
    int gw, NGW;
    long gt, NGT;
};
template <bool BASE_BF16>
struct EpiResid {
    static constexpr bool PERM = true, AFTER_DRAIN = false;
    const void* base; bf16* out; const float* gate;
    __device__ __forceinline__ void operator()(const pg8::f32x4 (&acc)[2][2][4][2], const pg8::Unit& u, int wr, int wc, int fr, int fq) const {
        using pg8::f32x4;
        const int col0 = u.pn * 256 + wc * 32 + 8 * fq;
        const float* gp = gate + (size_t)((u.pm * 256) / SEQ) * 6144 + col0;
        f32x4 gv[2][2];
#pragma unroll
        for (int bj = 0; bj < 2; ++bj)
#pragma unroll
            for (int n = 0; n < 2; ++n) { gv[bj][n] = *(const f32x4*)(gp + bj * 128 + 4 * n); gv[bj][n] = gv[bj][n] + 1.0f; }
#pragma unroll
        for (int ai = 0; ai < 2; ++ai)
#pragma unroll
            for (int m = 0; m < 4; ++m) {
                const int r = ai * 128 + wr * 64 + m * 16 + fr; const size_t off = (size_t)(u.pm * 256 + r) * DM + col0;
#pragma unroll
                for (int bj = 0; bj < 2; ++bj) {
                    f32x4 b0, b1;
                    if (BASE_BF16) { const v4u w = *(const v4u*)((const bf16*)base + off + bj * 128); b0 = (f32x4){bflo(w.x), bfhi(w.x), bflo(w.y), bfhi(w.y)}; b1 = (f32x4){bflo(w.z), bfhi(w.z), bflo(w.w), bfhi(w.w)}; }
                    else { b0 = *(const f32x4*)((const float*)base + off + bj * 128); b1 = *(const f32x4*)((const float*)base + off + bj * 128 + 4); }
                    const f32x4 v0 = b0 + gv[bj][0] * acc[ai][bj][m][0], v1 = b1 + gv[bj][1] * acc[ai][bj][m][1];
                    v4u o; o.x = pk2(v0[0], v0[1]); o.y = pk2(v0[2], v0[3]); o.z = pk2(v1[0], v1[1]); o.w = pk2(v1[2], v1[3]);
                    *(v4u*)(out + off + bj * 128) = o;
                }
            }
    }
};

constexpr size_t WS_SA = WS_MOD + 768 * 1024;
constexpr size_t OUT_W8 = 96 * MiB;
constexpr size_t OUT_W8IN = OUT_W8, OUT_W8C0 = OUT_W8 + 4 * MiB, OUT_W8QKV = OUT_W8 + 6 * MiB, OUT_W8C1 = OUT_W8 + 9 * MiB, OUT_SW = OUT_W8 + 11 * MiB;
constexpr int SW_IN = 0, SW_C0 = 4096, SW_QKV = 8192, SW_C1 = 12288;
__device__ __forceinline__ void quantize_rows(const Ctx& C, const bf16* W, int N, unsigned char* W8, float* SW) {
    for (int n = C.gw; n < N; n += C.NGW) {
        const v4u w0 = *(const v4u*)(W + (size_t)n * DM + 16 * C.lane), w1 = *(const v4u*)(W + (size_t)n * DM + 16 * C.lane + 8);
        float x[16] = {bflo(w0.x), bfhi(w0.x), bflo(w0.y), bfhi(w0.y), bflo(w0.z), bfhi(w0.z), bflo(w0.w), bfhi(w0.w), bflo(w1.x), bfhi(w1.x), bflo(w1.y), bfhi(w1.y), bflo(w1.z), bfhi(w1.z), bflo(w1.w), bfhi(w1.w)};
        float am = 0.f;
#pragma unroll
        for (int i = 0; i < 16; ++i) am = fmaxf(am, fabsf(x[i]));
        am = fmaxf(wave_max(am), 1e-30f); const float qi = 127.f / am;
        v4u o;
#pragma unroll
        for (int q = 0; q < 4; ++q) { const int q0 = (int)rintf(x[4 * q] * qi), q1 = (int)rintf(x[4 * q + 1] * qi), q2 = (int)rintf(x[4 * q + 2] * qi), q3 = (int)rintf(x[4 * q + 3] * qi);
            o[q] = ((unsigned)q0 & 255u) | (((unsigned)q1 & 255u) << 8) | (((unsigned)q2 & 255u) << 16) | ((unsigned)q3 << 24); }
        *(v4u*)(W8 + (size_t)n * DM + 16 * C.lane) = o;
        if (C.lane == 0) SW[n] = am * (1.f / 127.f);
    }
}
struct EpiBf16I8 {
    static constexpr bool PERM = true, AFTER_DRAIN = false;
    bf16* O; int ldc; const float* sa; const float* sw;
    __device__ __forceinline__ void operator()(const pg8::i32x4 (&acc)[2][2][4][2], const pg8::Unit& u, int wr, int wc, int fr, int fq) const {
        using pg8::f32x4;
        const int col0 = u.pn * 256 + wc * 32 + 8 * fq;
        f32x4 cs[2][2];
#pragma unroll
        for (int bj = 0; bj < 2; ++bj)
#pragma unroll
            for (int n = 0; n < 2; ++n) cs[bj][n] = *(const f32x4*)(sw + col0 + bj * 128 + 4 * n);
#pragma unroll
        for (int ai = 0; ai < 2; ++ai)
#pragma unroll
            for (int m = 0; m < 4; ++m) { const int row = u.pm * 256 + ai * 128 + wr * 64 + m * 16 + fr; const float rs = sa[row];
                bf16* rowp = O + (size_t)row * ldc + col0;
#pragma unroll
                for (int bj = 0; bj < 2; ++bj) { const pg8::i32x4 a0 = acc[ai][bj][m][0], a1 = acc[ai][bj][m][1];
                    v4u w; w.x = pk2((float)a0[0] * rs * cs[bj][0][0], (float)a0[1] * rs * cs[bj][0][1]); w.y = pk2((float)a0[2] * rs * cs[bj][0][2], (float)a0[3] * rs * cs[bj][0][3]);
                    w.z = pk2((float)a1[0] * rs * cs[bj][1][0], (float)a1[1] * rs * cs[bj][1][1]); w.w = pk2((float)a1[2] * rs * cs[bj][1][2], (float)a1[3] * rs * cs[bj][1][3]);
                    *(v4u*)(rowp + bj * 128) = w; } }
    }
};

__device__ __forceinline__ void transpose_item(const float* W, int ldw, int src_col0, bf16* WT, int K, int dst_row0, int k0, LAS float* scr, int lane) {
#pragma unroll 8
    for (int i = 0; i < 32; ++i) { const int kk = 2 * i + (lane >> 5); scr[kk * 33 + (lane & 31)] = W[(size_t)(k0 + kk) * ldw + src_col0 + (lane & 31)]; }
    LDS_WAIT(); asm volatile("" ::: "memory");
    const int c = lane & 7;
#pragma unroll
    for (int j = 0; j < 4; ++j) { const int n = (lane >> 3) + 8 * j; const LAS float* s = scr + (8 * c) * 33 + n;
        v4u o; o.x = pk2(s[0 * 33], s[1 * 33]); o.y = pk2(s[2 * 33], s[3 * 33]); o.z = pk2(s[4 * 33], s[5 * 33]); o.w = pk2(s[6 * 33], s[7 * 33]);
        *(GAS v4u*)(WT + (size_t)(dst_row0 + n) * K + k0 + 8 * c) = o; }
    LDS_WAIT(); asm volatile("" ::: "memory");
}

__device__ __forceinline__ void phase_prep(const Ctx& C, const Args& A) {
    unsigned char* ws = A.ws;
    {
        LAS float* scr = (LAS float*)(C.lds + C.wave * 16384);
        constexpr int I_IN = 16 * (INP / 32), I_O = 16 * 32, I_QKV = 16 * 96;
        constexpr int NIT = I_IN + I_O + I_QKV + I_O;
        for (int it = C.gw; it < NIT; it += C.NGW) {
            int r = it;
            if (r < I_IN) { const int kb = r / (INP / 32), nb = r % (INP / 32); const int dst = nb * 32, src = dst + (dst >= 2048 ? 8 : 0);
                transpose_item(A.in[5], INW, src, (bf16*)(ws + WS_WIN), 1024, dst, kb * 64, scr, C.lane); continue; } r -= I_IN;
            if (r < I_O) { const int kb = r / 32, nb = r % 32; transpose_item(A.in[10], 1024, nb * 32, (bf16*)(ws + WS_WOUT0), 1024, nb * 32, kb * 64, scr, C.lane); continue; } r -= I_O;
            if (r < I_QKV) { const int kb = r / 96, nb = r % 96; const int src = (nb >> 3) * 256 + 64 * (nb & 3) + 32 * ((nb >> 2) & 1);
                transpose_item(A.in[20], 3072, src, (bf16*)(ws + WS_WQKV), 1024, nb * 32, kb * 64, scr, C.lane); continue; } r -= I_QKV;
            { const int kb = r / 32, nb = r % 32; transpose_item(A.in[23], 1024, nb * 32, (bf16*)(ws + WS_WOUT1), 1024, nb * 32, kb * 64, scr, C.lane); }
        }
    }
    {
        LAS float* sc = (LAS float*)C.lds;
        LAS float* red = (LAS float*)(C.lds + 32768);
        if (C.bid < 96) {
            __syncthreads();
            for (int i = C.tid; i < NB * DM; i += NWAVES * 64) { const float v = A.in[1][i]; sc[i] = v / (1.f + __expf(-v)); }
            __syncthreads();
            for (int item = C.bid; item < 96; item += C.G) {
                const int l = item / 48, jc = item % 48;
                const float* W = A.in[l ? 17 : 2] + 128 * jc + 2 * C.lane;
                float a0[NB], a1[NB];
#pragma unroll
                for (int b = 0; b < NB; ++b) a0[b] = a1[b] = 0.f;
#pragma unroll 32
                for (int kk = 0; kk < 128; ++kk) { const int k = 128 * C.wave + kk; const float2 w = *(const float2*)(W + (size_t)k * 6144);
#pragma unroll
                    for (int b = 0; b < NB; ++b) { const float s = sc[b * DM + k]; a0[b] += s * w.x; a1[b] += s * w.y; } }
#pragma unroll
                for (int b = 0; b < NB; ++b) { red[(C.wave * NB + b) * 128 + 2 * C.lane] = a0[b]; red[(C.wave * NB + b) * 128 + 2 * C.lane + 1] = a1[b]; }
                __syncthreads();
                float* mod = (float*)(ws + WS_MOD);
                for (int o = C.tid; o < NB * 128; o += NWAVES * 64) { const int b = o >> 7, j = o & 127; float s = A.in[l ? 18 : 3][128 * jc + j];
#pragma unroll
                    for (int w = 0; w < NWAVES; ++w) s += red[(w * NB + b) * 128 + j];
                    mod[(size_t)(l * NB + b) * 6144 + 128 * jc + j] = s; }
                __syncthreads();
            }
        }
    }
    {
        LAS float* kt = (LAS float*)C.lds;
        LAS float* wt = (LAS float*)(C.lds + 128 * 132 * 4);
        for (int item = C.bid; item < 512; item += C.G) {
            const int l = item >> 8, hh = (item >> 4) & 15, kb = item & 15;
            const float* Wq = A.in[l ? 25 : 12]; const float* Kh = A.in[l ? ((hh & 1) ? 27 : 26) : ((hh & 1) ? 14 : 13)];
            bf16* Wc = (bf16*)(ws + (l ? WS_WC1 : WS_WC0));
            __syncthreads();
#pragma unroll
            for (int i = 0; i < 8; ++i) { const int id = C.tid + 512 * i, row = id >> 5, c4 = id & 31; *(LAS f32x4*)(kt + row * 132 + 4 * c4) = *(const f32x4*)(Kh + row * 128 + 4 * c4); }
#pragma unroll
            for (int i = 0; i < 4; ++i) { const int id = C.tid + 512 * i, row = id >> 5, c4 = id & 31; *(LAS f32x4*)(wt + row * 132 + 4 * c4) = *(const f32x4*)(Wq + (size_t)(kb * 64 + row) * 2048 + hh * 128 + 4 * c4); }
            __syncthreads();
            const int key = C.tid & 127, kg = C.tid >> 7;
            float acc[16];
#pragma unroll
            for (int i = 0; i < 16; ++i) acc[i] = 0.f;
#pragma unroll 2
            for (int d4 = 0; d4 < 32; ++d4) { const f32x4 kv = *(const LAS f32x4*)(kt + key * 132 + 4 * d4);
#pragma unroll
                for (int i = 0; i < 16; ++i) { const f32x4 wv = *(const LAS f32x4*)(wt + (kg * 16 + i) * 132 + 4 * d4); acc[i] += (kv.x * wv.x + kv.y * wv.y) + (kv.z * wv.z + kv.w * wv.w); } }
            v4u o0, o1; o0.x = pk2(acc[0], acc[1]); o0.y = pk2(acc[2], acc[3]); o0.z = pk2(acc[4], acc[5]); o0.w = pk2(acc[6], acc[7]);
            o1.x = pk2(acc[8], acc[9]); o1.y = pk2(acc[10], acc[11]); o1.z = pk2(acc[12], acc[13]); o1.w = pk2(acc[14], acc[15]);
            bf16* dst = Wc + (size_t)(hh * 128 + key) * 1024 + kb * 64 + kg * 16;
            *(v4u*)dst = o0; *(v4u*)(dst + 8) = o1;
        }
        __syncthreads();
    }
}

template <bool GATES, bool IN_BF16, bool OUT_I8 = false>
__device__ __forceinline__ void phase_rowpass(const Ctx& C, const Args& A, const void* xin, const float* gain, const float* modl  , int ch_shift, int ch_scale, bf16* hout, float* sa = nullptr) {
    f32x4 wg0[GATES ? 16 : 1], wg1[GATES ? 16 : 1];
    if (GATES) {
        const float* Wg = A.in[5] + 2048;
#pragma unroll
        for (int j = 0; j < 4; ++j)
#pragma unroll
            for (int e = 0; e < 4; ++e) { const int k = 4 * C.lane + 256 * j + e; wg0[4 * j + e] = *(const f32x4*)(Wg + (size_t)k * INW); wg1[4 * j + e] = *(const f32x4*)(Wg + (size_t)k * INW + 4); }
    }
    for (int row = C.gw; row < NTOK; row += C.NGW) {
        const int b = row >> 12;
        f32x4 v[4]; float ss = 0.f;
#pragma unroll
        for (int j = 0; j < 4; ++j) {
            if (IN_BF16) { const uint2 w = *(const uint2*)((const bf16*)xin + (size_t)row * DM + 4 * C.lane + 256 * j); v[j] = (f32x4){bflo(w.x), bfhi(w.x), bflo(w.y), bfhi(w.y)}; }
            else v[j] = *(const f32x4*)((const float*)xin + (size_t)row * DM + 4 * C.lane + 256 * j);
            ss += v[j].x * v[j].x + v[j].y * v[j].y + v[j].z * v[j].z + v[j].w * v[j].w; }
        const float rstd = rsqrtf(wave_sum(ss) * (1.f / DM) + EPS);
        const float* shp = modl + (size_t)b * 6144 + ch_shift * 1024 + 4 * C.lane; const float* scp = modl + (size_t)b * 6144 + ch_scale * 1024 + 4 * C.lane;
        f32x4 h[4];
#pragma unroll
        for (int j = 0; j < 4; ++j) { const f32x4 g = *(const f32x4*)(gain + 4 * C.lane + 256 * j), sc = *(const f32x4*)(scp + 256 * j), sh = *(const f32x4*)(shp + 256 * j);
            h[j] = v[j] * rstd * g * (sc + 1.0f) + sh;
            if (!OUT_I8) { uint2 o; o.x = pk2(h[j].x, h[j].y); o.y = pk2(h[j].z, h[j].w);
                *(uint2*)(hout + (size_t)row * DM + 4 * C.lane + 256 * j) = o; } }
        if (OUT_I8) {
            float am = 0.f;
#pragma unroll
            for (int j = 0; j < 4; ++j) am = fmaxf(am, fmaxf(fmaxf(fabsf(h[j].x), fabsf(h[j].y)), fmaxf(fabsf(h[j].z), fabsf(h[j].w))));
            am = fmaxf(wave_max(am), 1e-20f); const float qi = 127.f / am;
            unsigned char* h8 = (unsigned char*)hout + (size_t)row * DM + 4 * C.lane;
#pragma unroll
            for (int j = 0; j < 4; ++j) { const int q0 = (int)rintf(h[j].x * qi), q1 = (int)rintf(h[j].y * qi), q2 = (int)rintf(h[j].z * qi), q3 = (int)rintf(h[j].w * qi);
                *(unsigned*)(h8 + 256 * j) = ((unsigned)q0 & 255u) | (((unsigned)q1 & 255u) << 8) | (((unsigned)q2 & 255u) << 16) | ((unsigned)q3 << 24); }
            if (C.lane == 0) sa[row] = am * (1.f / 127.f);
        }
        if (GATES) {
            f32x4 d0 = {0.f, 0.f, 0.f, 0.f}, d1 = {0.f, 0.f, 0.f, 0.f};
#pragma unroll
            for (int j = 0; j < 4; ++j)
#pragma unroll
                for (int e = 0; e < 4; ++e) { const float hv = h[j][e]; d0 += wg0[4 * j + e] * hv; d1 += wg1[4 * j + e] * hv; }
            float d[8] = {d0.x, d0.y, d0.z, d0.w, d1.x, d1.y, d1.z, d1.w};
#pragma unroll
            for (int q = 0; q < 8; ++q) d[q] = wave_sum(d[q]);
            if (C.lane == 0) {
                const int s = row & (SEQ - 1); float* LF = (float*)(A.ws + WS_LF); float* LI = (float*)(A.ws + WS_LI);
#pragma unroll
                for (int hh = 0; hh < 4; ++hh) { LI[(size_t)(b * 4 + hh) * SEQ + s] = d[hh] + A.in[6][hh]; LF[(size_t)(b * 4 + hh) * SEQ + s] = logsigmoidf_(d[4 + hh] + A.in[7][hh]); }
            }
        }
    }
}

__device__ __forceinline__ void phase_conv(const Ctx& C, const Args& A) {
    const bf16* P = (const bf16*)(A.ws + WS_BIG); bf16* mix = (bf16*)(A.ws + WS_H); const float* cw = A.in[8];
    for (long it = C.gt; it < (long)NTOK * 64; it += C.NGT) {
        const int cg = (int)(it & 63), tok = (int)(it >> 6), t = tok & (SEQ - 1), c0 = cg * 8;
        float conv[8];
#pragma unroll
        for (int e = 0; e < 8; ++e) conv[e] = 0.f;
#pragma unroll
        for (int k = 0; k < 3; ++k) {
            const int dt = 2 - k;
            if (t - dt >= 0) {
                const bf16* r = P + (size_t)(tok - dt) * INP;
                const v4u cc = *(const v4u*)(r + 2560 + c0), chv = *(const v4u*)(r + 3072 + c0);
                const f32x4 w0 = *(const f32x4*)(cw + k * 512 + c0), w1 = *(const f32x4*)(cw + k * 512 + c0 + 4);
                conv[0] += w0.x * bflo(cc.x) * bflo(chv.x); conv[1] += w0.y * bfhi(cc.x) * bfhi(chv.x);
                conv[2] += w0.z * bflo(cc.y) * bflo(chv.y); conv[3] += w0.w * bfhi(cc.y) * bfhi(chv.y);
                conv[4] += w1.x * bflo(cc.z) * bflo(chv.z); conv[5] += w1.y * bfhi(cc.z) * bfhi(chv.z);
                conv[6] += w1.z * bflo(cc.w) * bflo(chv.w); conv[7] += w1.w * bfhi(cc.w) * bfhi(chv.w);
            }
        }
        const v4u cb = *(const v4u*)(P + (size_t)tok * INP + 2048 + c0);
        v4u o; o.x = pk2(conv[0] * bflo(cb.x), conv[1] * bfhi(cb.x)); o.y = pk2(conv[2] * bflo(cb.y), conv[3] * bfhi(cb.y));
        o.z = pk2(conv[4] * bflo(cb.z), conv[5] * bfhi(cb.z)); o.w = pk2(conv[6] * bflo(cb.w), conv[7] * bfhi(cb.w));
        *(v4u*)(mix + (size_t)tok * DM + 512 + c0) = o;
    }
}
constexpr size_t WS_TAB = 352 * MiB;
constexpr size_t TAB_BYTES = (size_t)16384 * 1024;
constexpr size_t WS_TSC = WS_TAB + 4 * TAB_BYTES;
constexpr size_t WS_XB = 420 * MiB;
constexpr size_t WS_END2 = WS_XB + 64 * MiB;
typedef float f32x2 __attribute__((ext_vector_type(2)));
typedef __bf16 bf16x2_t __attribute__((ext_vector_type(2)));
typedef unsigned u32x2 __attribute__((ext_vector_type(2)));
__device__ __forceinline__ float dot2bf(unsigned a, unsigned b, float c) { return __builtin_amdgcn_fdot2_f32_bf16(__builtin_bit_cast(bf16x2_t, a), __builtin_bit_cast(bf16x2_t, b), c, false); }
template <int CTRL> __device__ __forceinline__ unsigned dppu(unsigned v) { return (unsigned)__builtin_amdgcn_update_dpp(0, (int)v, CTRL, 0xF, 0xF, true); }
__device__ __forceinline__ float wave_sum_dpp(float v) {
    v += __uint_as_float(dppu<0xB1>(__float_as_uint(v)));
    v += __uint_as_float(dppu<0x4E>(__float_as_uint(v)));
    v += __uint_as_float(dppu<0x124>(__float_as_uint(v)));
    v += __uint_as_float(dppu<0x128>(__float_as_uint(v)));
    const unsigned u = __float_as_uint(v);
    return (__uint_as_float(__builtin_amdgcn_readlane(u, 0)) + __uint_as_float(__builtin_amdgcn_readlane(u, 16))) + (__uint_as_float(__builtin_amdgcn_readlane(u, 32)) + __uint_as_float(__builtin_amdgcn_readlane(u, 48)));
}
__device__ __forceinline__ void ins16(unsigned (&val)[16], unsigned k) {
#pragma unroll
    for (int j = 0; j < 16; ++j) { const unsigned t = val[j] < k ? val[j] : k; val[j] = val[j] < k ? k : val[j]; k = t; }
}
#define PEER_CE(x, i, l) { const unsigned a_ = x[i] < x[l] ? x[l] : x[i], b_ = x[i] < x[l] ? x[i] : x[l]; x[i] = a_; x[l] = b_; }
__device__ __forceinline__ void sort16_desc(unsigned (&x)[16]) {
#pragma unroll
    for (int k = 2; k <= 16; k <<= 1)
#pragma unroll
        for (int j = k >> 1; j > 0; j >>= 1)
#pragma unroll
            for (int i = 0; i < 16; ++i) { const int l = i ^ j; if (l > i) { if ((i & k) == 0) { PEER_CE(x, i, l) } else { PEER_CE(x, l, i) } } }
}
__device__ __forceinline__ void merge16_desc(unsigned (&v)[16], const unsigned (&s)[16]) {
#pragma unroll
    for (int i = 0; i < 16; ++i) v[i] = v[i] < s[15 - i] ? s[15 - i] : v[i];
#pragma unroll
    for (int j = 8; j > 0; j >>= 1)
#pragma unroll
        for (int i = 0; i < 16; ++i) { const int l = i ^ j; if (l > i) PEER_CE(v, i, l) }
}
__device__ __forceinline__ unsigned ord32(unsigned b) { return b ^ ((unsigned)((int)b >> 31) | 0x80000000u); }
__device__ __forceinline__ float unord(unsigned o, unsigned mask) { o &= mask; return __uint_as_float((o & 0x80000000u) ? (o ^ 0x80000000u) : (~o & mask)); }

template <bool NEXT, int DRY = 0>
__device__ __forceinline__ void phase_peer(const Ctx& C, const Args& A, const unsigned char* Utab, const unsigned char* Vtab, const float* SU, const float* SV, const float* g2  ,
                                           const float* ngain, const float* nmod  , const XcdBarrier& bar) {
    const bf16* SC = (const bf16*)(A.ws + WS_BIG); bf16* Hb = (bf16*)(A.ws + WS_H);
#ifndef PEER_NBK
#define PEER_NBK 32
#endif
    constexpr int NBK = PEER_NBK, BSH = (NBK == 32 ? 9 : NBK == 64 ? 8 : 7), BPL = NBK / 16;
    LAS unsigned char* wb = C.lds + C.wave * (1024 + 32 * NBK + 8192);
    LAS unsigned char* IDXB = wb; LAS unsigned* CNT = (LAS unsigned*)(wb + 1024); LAS unsigned* PRE = (LAS unsigned*)(wb + 1024 + 16 * NBK); LAS v4u* ENT = (LAS v4u*)(wb + 1024 + 32 * NBK);
#ifndef PEER_SYNC_EVERY
#define PEER_SYNC_EVERY 32
#endif
    const bool wg_uniform = (DRY != 6) && ((NTOK / 4) % C.NGW == 0);
    unsigned flip = 0u;
#ifdef PEER_STAGGER
    if (C.wave >= 4) { const unsigned long long t0_ = __builtin_amdgcn_s_memrealtime(); while (__builtin_amdgcn_s_memrealtime() - t0_ < (unsigned long long)PEER_STAGGER) __builtin_amdgcn_s_sleep(16); }
#endif
    const int gw_ = (DRY == 6) ? ((C.bid >> 1) * NWAVES + C.wave) : C.gw, ngw_ = (DRY == 6) ? (C.NGW >> 1) : C.NGW;
    if (DRY == 6 && (C.bid & 1)) return;
    for (int tb = gw_; tb < NTOK / 4; tb += ngw_) {
        const int tok0 = tb * 4;
#if MK_ONE_LAUNCH && defined(PEER_SYNC)
        if (tb >= C.NGW) xcd_barrier(bar);
#endif
        int lane = C.lane; asm volatile("" : "+v"(lane));
        const int par = lane & 1, tl = lane >> 4, grp = lane & 15, head = grp >> 1, i16 = lane & 15;
        {
            unsigned val[16];
            const v4u* sp = (const v4u*)(SC + (size_t)(tok0 + tl) * 2048 + grp * 128);
            v4u raw[16];
#pragma unroll
            for (int c = 0; c < 16; ++c) raw[c] = sp[c];
#pragma unroll
            for (int c = 0; c < 16; c += 2) {
                const v4u c0 = raw[c], c1 = raw[c + 1];
                const unsigned ib = 127u - 8u * (unsigned)c;
                unsigned ks[16];
#pragma unroll
                for (int e = 0; e < 4; ++e) { ks[2 * e] = (ord32(c0[e] << 16) & 0xFFFF0000u) | (ib - 2u * e); ks[2 * e + 1] = (ord32(c0[e] & 0xFFFF0000u) & 0xFFFF0000u) | (ib - 2u * e - 1u);
                    ks[8 + 2 * e] = (ord32(c1[e] << 16) & 0xFFFF0000u) | (ib - 8u - 2u * e); ks[9 + 2 * e] = (ord32(c1[e] & 0xFFFF0000u) & 0xFFFF0000u) | (ib - 9u - 2u * e); }
                sort16_desc(ks);
                if (c == 0) {
#pragma unroll
                    for (int j = 0; j < 16; ++j) val[j] = ks[j];
                } else merge16_desc(val, ks);
            }
#pragma unroll
            for (int z = 0; z < NBK / 16; ++z) CNT[lane + 64 * z] = 0u;
            float X[16], Y[16];
            v4u ib4 = {0u, 0u, 0u, 0u};
#pragma unroll
            for (int j = 0; j < 16; ++j) { X[j] = unord(val[j], 0xFFFF0000u); Y[j] = unord(dppu<0xB1>(val[j]), 0xFFFF0000u); ib4[j >> 2] |= (127u - (val[j] & 127u)) << (8 * (j & 3)); }
            *(LAS v4u*)(IDXB + lane * 16) = ib4;
            unsigned cand[16], cb2[16];
            unsigned parv = (unsigned)par; asm volatile("" : "+v"(parv));
#define PEER_CKEY(p, q) ((((p) == (q)) && parv) ? 0u : ((ord32(__float_as_uint(X[p] + Y[q])) & 0xFFFFFF00u) | (255u - ((unsigned)((p) * 16 + (q)) + parv * (unsigned)(15 * ((q) - (p)))))))
            cand[0] = PEER_CKEY(0, 0); cand[1] = PEER_CKEY(0, 1); cand[2] = PEER_CKEY(0, 2); cand[3] = PEER_CKEY(0, 3); cand[4] = PEER_CKEY(0, 4); cand[5] = PEER_CKEY(0, 5); cand[6] = PEER_CKEY(0, 6); cand[7] = PEER_CKEY(0, 7);
            cand[8] = PEER_CKEY(0, 8); cand[9] = PEER_CKEY(0, 9); cand[10] = PEER_CKEY(0, 10); cand[11] = PEER_CKEY(0, 11); cand[12] = PEER_CKEY(0, 12); cand[13] = PEER_CKEY(0, 13); cand[14] = PEER_CKEY(0, 14); cand[15] = PEER_CKEY(0, 15);
            cb2[0] = PEER_CKEY(1, 1); cb2[1] = PEER_CKEY(1, 2); cb2[2] = PEER_CKEY(1, 3); cb2[3] = PEER_CKEY(1, 4); cb2[4] = PEER_CKEY(1, 5); cb2[5] = PEER_CKEY(1, 6); cb2[6] = PEER_CKEY(1, 7);
            cb2[7] = PEER_CKEY(2, 2); cb2[8] = PEER_CKEY(2, 3); cb2[9] = PEER_CKEY(2, 4); cb2[10] = PEER_CKEY(3, 3); cb2[11] = 0u; cb2[12] = 0u; cb2[13] = 0u; cb2[14] = 0u; cb2[15] = 0u;
#undef PEER_CKEY
            sort16_desc(cand); sort16_desc(cb2); merge16_desc(cand, cb2);
            unsigned mg[16]; float fv[16]; float mx = -INFINITY;
#pragma unroll
            for (int k = 0; k < 16; ++k) { const unsigned o = dppu<0xB1>(cand[15 - k]); mg[k] = cand[k] < o ? o : cand[k]; fv[k] = unord(mg[k], 0xFFFFFF00u); mx = fmaxf(mx, fv[k]); }
            float ssum = 0.f;
#pragma unroll
            for (int k = 0; k < 16; ++k) { fv[k] = __expf(fv[k] - mx); ssum += fv[k]; }
            const float inv = 1.f / ssum;
            asm volatile("s_waitcnt lgkmcnt(0)" ::: "memory");
            unsigned eid[8], rk[8]; float esu[8], egv[8];
#pragma unroll
            for (int k = 0; k < 8; ++k) { const unsigned fi = 255u - (mg[k] & 255u);
                const unsigned e1 = IDXB[(lane & ~1) * 16 + (fi >> 4)], e2 = IDXB[(lane | 1) * 16 + (fi & 15u)];
                eid[k] = e1 * 128u + e2;
                rk[k] = __hip_atomic_fetch_add(CNT + tl * NBK + (eid[k] >> BSH), 1u, __ATOMIC_RELAXED, __HIP_MEMORY_SCOPE_WORKGROUP);
                esu[k] = SU[eid[k]]; egv[k] = fv[k] * inv * SV[eid[k]]; }
            asm volatile("s_waitcnt lgkmcnt(0)" ::: "memory");
            { unsigned cb[BPL]; unsigned s = 0u;
#pragma unroll
              for (int z = 0; z < BPL; ++z) { cb[z] = CNT[tl * NBK + BPL * i16 + z]; s += cb[z]; }
              const unsigned tot = s;
              s += dppu<0x111>(s); s += dppu<0x112>(s); s += dppu<0x114>(s); s += dppu<0x118>(s);
              unsigned ex = s - tot;
#pragma unroll
              for (int z = 0; z < BPL; ++z) { PRE[tl * NBK + BPL * i16 + z] = ex; ex += cb[z]; } }
            asm volatile("s_waitcnt lgkmcnt(0)" ::: "memory");
#pragma unroll
            for (int k = 0; k < 8; ++k) { unsigned pos = PRE[tl * NBK + (eid[k] >> BSH)] + rk[k]; pos = flip ? 127u - pos : pos;
                ENT[tl * 128 + pos] = (v4u){eid[k], __float_as_uint(esu[k]), __float_as_uint(egv[k]), 0u}; }
            asm volatile("s_waitcnt lgkmcnt(0)" ::: "memory");
            flip ^= 1u;
        }
        if (wg_uniform) __syncthreads();
        if (DRY != 3) {
            const int tok = tok0 + tl; const int b = tok >> 12;
            LAS v4u* E = ENT + tl * 128;
            float cmax = 0.f;
            {
                unsigned hq[16]; const float hs = ((const float*)(A.ws + WS_SA))[tok];
#pragma unroll
                for (int j = 0; j < 4; ++j) { const v4u hw = *(const v4u*)(A.ws + WS_IDS + (size_t)tok * DM + 256 * j + 16 * i16); hq[4 * j] = hw.x; hq[4 * j + 1] = hw.y; hq[4 * j + 2] = hw.z; hq[4 * j + 3] = hw.w; }
                v4u B[8][4]; unsigned idr[8]; float mine = 0.f;
#define PEER_LOADI(R_, tab, id_) { const unsigned off = ((id_) & (DRY == 2 ? 1023u : 16383u)) * 1024u + 16u * (unsigned)i16; \
                _Pragma("unroll") for (int j = 0; j < 4; ++j) R_[j] = (DRY == 5 && j >= 2) ? R_[j - 2] : *(const v4u*)((tab) + off + 256 * j); }
#define PEER_DOTS(U_, t_) { int d0 = 0, d1 = 0, d2 = 0, d3 = 0; \
                _Pragma("unroll") for (int e = 0; e < 4; ++e) { d0 = __builtin_amdgcn_sdot4((int)U_[0][e], (int)hq[e], d0, false); d1 = __builtin_amdgcn_sdot4((int)U_[1][e], (int)hq[4 + e], d1, false); \
                    d2 = __builtin_amdgcn_sdot4((int)U_[2][e], (int)hq[8 + e], d2, false); d3 = __builtin_amdgcn_sdot4((int)U_[3][e], (int)hq[12 + e], d3, false); } \
                unsigned ds_ = (unsigned)((d0 + d1) + (d2 + d3)); ds_ += dppu<0xB1>(ds_); ds_ += dppu<0x4E>(ds_); ds_ += dppu<0x124>(ds_); ds_ += dppu<0x128>(ds_); \
                mine = (i16 == ((t_) & 15)) ? (float)(int)ds_ : mine; }
#pragma unroll
                for (int k = 0; k < 8; ++k) idr[k] = E[k].x;
#pragma unroll
                for (int k = 0; k < 8; ++k) PEER_LOADI(B[k], Utab, idr[k])
#pragma unroll 1
                for (int r = 0; r < 128; r += 8) {
                    if (wg_uniform && (r & (PEER_SYNC_EVERY - 1)) == 0 && r) __syncthreads();
                    if (r + 8 < 128) {
#pragma unroll
                        for (int k = 0; k < 8; ++k) idr[k] = E[r + 8 + k].x;
                    }
#pragma unroll
                    for (int k = 0; k < 8; ++k) { PEER_DOTS(B[k], r + k) if (r + 8 < 128) PEER_LOADI(B[k], Utab, idr[k]) }
                    if (r & 8) {
                        const int t = (r & ~15) + i16; const v4u en = E[t];
                        const float cf = gelu_as(mine * (__uint_as_float(en.y) * hs)) * __uint_as_float(en.z);
                        ((LAS float*)(E + t))[3] = cf; cmax = fmaxf(cmax, fabsf(cf));
                    }
                }
#undef PEER_DOTS
            }
            if (wg_uniform) __syncthreads();
            cmax = fmaxf(cmax, __uint_as_float(dppu<0xB1>(__float_as_uint(cmax)))); cmax = fmaxf(cmax, __uint_as_float(dppu<0x4E>(__float_as_uint(cmax))));
            cmax = fmaxf(cmax, __uint_as_float(dppu<0x124>(__float_as_uint(cmax)))); cmax = fmaxf(cmax, __uint_as_float(dppu<0x128>(__float_as_uint(cmax))));
            cmax = fmaxf(cmax, 1e-30f);
            int acci[4][16];
#pragma unroll
            for (int j = 0; j < 4; ++j)
#pragma unroll
                for (int e = 0; e < 16; ++e) acci[j][e] = 0;
            if (DRY != 4) {
                const float cq = 127.f / cmax;
                asm volatile("s_waitcnt lgkmcnt(0)" ::: "memory");
                unsigned pk0, pk1;
                { int q[8];
#pragma unroll
                  for (int k = 0; k < 8; ++k) q[k] = (int)rintf(((const LAS float*)(E + 8 * i16 + k))[3] * cq);
                  pk0 = ((unsigned)q[0] & 255u) | (((unsigned)q[1] & 255u) << 8) | (((unsigned)q[2] & 255u) << 16) | ((unsigned)q[3] << 24);
                  pk1 = ((unsigned)q[4] & 255u) | (((unsigned)q[5] & 255u) << 8) | (((unsigned)q[6] & 255u) << 16) | ((unsigned)q[7] << 24); }
                asm volatile("s_waitcnt lgkmcnt(0)" ::: "memory");
                ((LAS unsigned*)(E + 2 * i16))[1] = pk0; ((LAS unsigned*)(E + 2 * i16 + 1))[1] = pk1;
                asm volatile("s_waitcnt lgkmcnt(0)" ::: "memory");
                v4u Ba[4][2], Bb[4][2];
#define PEER_LOADG(B_, g_, hf_) { _Pragma("unroll") for (int n = 0; n < 4; ++n) { const unsigned id_ = E[4 * (g_) + n].x; const unsigned off = (id_ & (DRY == 2 ? 1023u : 16383u)) * 1024u + 16u * (unsigned)i16 + 512u * (hf_); \
                    _Pragma("unroll") for (int jj = 0; jj < 2; ++jj) B_[n][jj] = *(const v4u*)(Vtab + off + 256 * jj); } }
#define PEER_GROUP(B_, g_, hf_) { const unsigned a4 = ((const LAS unsigned*)(E + (g_)))[1]; \
                    _Pragma("unroll") for (int jj = 0; jj < 2; ++jj) _Pragma("unroll") for (int e = 0; e < 4; ++e) { \
                        const unsigned p01l = __builtin_amdgcn_perm(B_[1][jj][e], B_[0][jj][e], 0x05010400u), p01h = __builtin_amdgcn_perm(B_[1][jj][e], B_[0][jj][e], 0x07030602u); \
                        const unsigned p23l = __builtin_amdgcn_perm(B_[3][jj][e], B_[2][jj][e], 0x05010400u), p23h = __builtin_amdgcn_perm(B_[3][jj][e], B_[2][jj][e], 0x07030602u); \
                        acci[2 * (hf_) + jj][4 * e + 0] = __builtin_amdgcn_sdot4((int)__builtin_amdgcn_perm(p23l, p01l, 0x05040100u), (int)a4, acci[2 * (hf_) + jj][4 * e + 0], false); \
                        acci[2 * (hf_) + jj][4 * e + 1] = __builtin_amdgcn_sdot4((int)__builtin_amdgcn_perm(p23l, p01l, 0x07060302u), (int)a4, acci[2 * (hf_) + jj][4 * e + 1], false); \
                        acci[2 * (hf_) + jj][4 * e + 2] = __builtin_amdgcn_sdot4((int)__builtin_amdgcn_perm(p23h, p01h, 0x05040100u), (int)a4, acci[2 * (hf_) + jj][4 * e + 2], false); \
                        acci[2 * (hf_) + jj][4 * e + 3] = __builtin_amdgcn_sdot4((int)__builtin_amdgcn_perm(p23h, p01h, 0x07060302u), (int)a4, acci[2 * (hf_) + jj][4 * e + 3], false); } }
                PEER_LOADG(Ba, 0, 0)
#pragma unroll 1
                for (int g = 0; g < 32; ++g) {
                    if (wg_uniform && (g & (PEER_SYNC_EVERY / 4 - 1)) == 0 && g) __syncthreads();
                    PEER_LOADG(Bb, g, 1)
                    PEER_GROUP(Ba, g, 0)
                    if (g + 1 < 32) PEER_LOADG(Ba, g + 1, 0)
                    PEER_GROUP(Bb, g, 1)
                }
#undef PEER_LOADG
#undef PEER_GROUP
            }
            const float osc = cmax * (1.f / 127.f);
            f32x2 acc[4][8];
#pragma unroll
            for (int j = 0; j < 4; ++j)
#pragma unroll
                for (int e = 0; e < 8; ++e) acc[j][e] = (f32x2){(float)acci[j][2 * e] * osc, (float)acci[j][2 * e + 1] * osc};
#undef PEER_LOADI
            float ss = 0.f;
#pragma unroll
            for (int j = 0; j < 4; ++j) { const size_t eo = (size_t)tok * DM + 256 * j + 16 * i16; const float* gp = g2 + (size_t)b * 6144 + 256 * j + 16 * i16;
                bf16* XBp = (bf16*)(A.ws + WS_XB) + eo; const v4u xw0 = *(const v4u*)XBp, xw1 = *(const v4u*)(XBp + 8);
                unsigned ow[8];
#pragma unroll
                for (int q = 0; q < 4; ++q) { const unsigned w0 = q < 2 ? xw0[2 * q] : xw1[2 * q - 4], w1 = q < 2 ? xw0[2 * q + 1] : xw1[2 * q - 3]; const f32x4 g0 = *(const f32x4*)(gp + 4 * q);
                    const f32x4 xn = {bflo(w0) + (1.f + g0[0]) * acc[j][2 * q].x, bfhi(w0) + (1.f + g0[1]) * acc[j][2 * q].y, bflo(w1) + (1.f + g0[2]) * acc[j][2 * q + 1].x, bfhi(w1) + (1.f + g0[3]) * acc[j][2 * q + 1].y};
                    if (NEXT) { ow[2 * q] = pk2(xn[0], xn[1]); ow[2 * q + 1] = pk2(xn[2], xn[3]); }
                    else if (DRY == 0 || xn[0] == 1234.5678f) *(f32x4*)(A.out + eo + 4 * q) = xn;
                    acc[j][2 * q] = (f32x2){xn[0], xn[1]}; acc[j][2 * q + 1] = (f32x2){xn[2], xn[3]};
                    ss += (xn[0] * xn[0] + xn[1] * xn[1]) + (xn[2] * xn[2] + xn[3] * xn[3]); }
                if (NEXT && (DRY == 0 || ss == 1234.5678f)) { *(v4u*)XBp = (v4u){ow[0], ow[1], ow[2], ow[3]}; *(v4u*)(XBp + 8) = (v4u){ow[4], ow[5], ow[6], ow[7]}; } }
            if (DRY != 0) { if (ss == 1234.5678f) A.out[tok] = ss; }
            if (NEXT && DRY == 0) {
                ss += __uint_as_float(dppu<0xB1>(__float_as_uint(ss))); ss += __uint_as_float(dppu<0x4E>(__float_as_uint(ss)));
                ss += __uint_as_float(dppu<0x124>(__float_as_uint(ss))); ss += __uint_as_float(dppu<0x128>(__float_as_uint(ss)));
                const float rstd = rsqrtf(ss * (1.f / DM) + EPS);
#pragma unroll
                for (int j = 0; j < 4; ++j) { const int c0 = 256 * j + 16 * i16; const float* shp = nmod + (size_t)b * 6144 + c0; const float* scp = shp + 1024;
                    unsigned ow[8];
#pragma unroll
                    for (int q = 0; q < 4; ++q) { const f32x4 gn = *(const f32x4*)(ngain + c0 + 4 * q), sc = *(const f32x4*)(scp + 4 * q), sh = *(const f32x4*)(shp + 4 * q);
                        ow[2 * q] = pk2(acc[j][2 * q].x * rstd * gn[0] * (1.f + sc[0]) + sh[0], acc[j][2 * q].y * rstd * gn[1] * (1.f + sc[1]) + sh[1]);
                        ow[2 * q + 1] = pk2(acc[j][2 * q + 1].x * rstd * gn[2] * (1.f + sc[2]) + sh[2], acc[j][2 * q + 1].y * rstd * gn[3] * (1.f + sc[3]) + sh[3]); }
                    *(v4u*)(Hb + (size_t)tok * DM + c0) = (v4u){ow[0], ow[1], ow[2], ow[3]}; *(v4u*)(Hb + (size_t)tok * DM + c0 + 8) = (v4u){ow[4], ow[5], ow[6], ow[7]}; }
            }
        }
    }
}
__device__ __forceinline__ void convert_tables_int8(const Ctx& C, const Args& A) {
    unsigned char* T8 = A.ws + WS_TAB; float* TS = (float*)(A.ws + WS_TSC);
    for (int R0 = C.gw * 4; R0 < 4 * 16384; R0 += C.NGW * 4) {
        const int t = R0 >> 14;
        const float* src = A.in[t == 0 ? 15 : t == 1 ? 16 : t == 2 ? 28 : 29] + (size_t)(R0 & 16383) * DM + 16 * C.lane;
        f32x4 x[4][4]; float am[4];
#pragma unroll
        for (int r = 0; r < 4; ++r) { am[r] = 0.f;
#pragma unroll
            for (int q = 0; q < 4; ++q) x[r][q] = *(const f32x4*)(src + (size_t)r * DM + 4 * q); }
#pragma unroll
        for (int r = 0; r < 4; ++r) {
#pragma unroll
            for (int q = 0; q < 4; ++q) am[r] = fmaxf(am[r], fmaxf(fmaxf(fabsf(x[r][q].x), fabsf(x[r][q].y)), fmaxf(fabsf(x[r][q].z), fabsf(x[r][q].w))));
            am[r] = wave_max(am[r]);
            const float sc = (am[r] > 0.f) ? 127.f / am[r] : 1.f, inv = (am[r] > 0.f) ? am[r] * (1.f / 127.f) : 1.f;
            v4u o;
#pragma unroll
            for (int q = 0; q < 4; ++q) { const int q0 = (int)rintf(x[r][q].x * sc), q1 = (int)rintf(x[r][q].y * sc), q2 = (int)rintf(x[r][q].z * sc), q3 = (int)rintf(x[r][q].w * sc);
                o[q] = ((unsigned)q0 & 255u) | (((unsigned)q1 & 255u) << 8) | (((unsigned)q2 & 255u) << 16) | ((unsigned)q3 << 24); }
            *(v4u*)(T8 + (size_t)(R0 + r) * DM + 16 * C.lane) = o;
            if (C.lane == 0) TS[R0 + r] = inv;
        }
    }
}
constexpr size_t WS_NL = 3 * MiB, WS_NP = WS_NL + 512 * 1024;
constexpr size_t WS_GC = WS_MOD + 512 * 1024, WS_ML = WS_GC + 4096, WS_MP = WS_ML + 4096;
constexpr size_t OUT_SL = 0, OUT_SP = 64 * MiB;
typedef float f32x16 __attribute__((ext_vector_type(16)));
typedef short s16x4 __attribute__((ext_vector_type(4)));
__device__ __forceinline__ unsigned offb(unsigned row, unsigned ch) { return 256u * row + 16u * (ch ^ (((row & 3u) << 2) | ((row >> 2) & 3u))); }
__device__ __forceinline__ s16x4 tr_read4(unsigned lds_addr) { s16x4 r; asm volatile("ds_read_b64_tr_b16 %0, %1\n\ts_waitcnt lgkmcnt(0)" : "=&v"(r) : "v"(lds_addr) : "memory"); return r; }
__device__ __forceinline__ void tr_read4x2(s16x4& r0, s16x4& r1, unsigned a0, unsigned a1) {
    asm volatile("ds_read_b64_tr_b16 %0, %2\n\tds_read_b64_tr_b16 %1, %3\n\ts_waitcnt lgkmcnt(0)" : "=&v"(r0), "=&v"(r1) : "v"(a0), "v"(a1) : "memory"); }
__device__ __forceinline__ void tr_read4x6(s16x4 (&r)[6], unsigned a0, unsigned a1, unsigned a2, unsigned a3, unsigned a4, unsigned a5) {
    asm volatile("ds_read_b64_tr_b16 %0, %6\n\tds_read_b64_tr_b16 %1, %7\n\tds_read_b64_tr_b16 %2, %8\n\tds_read_b64_tr_b16 %3, %9\n\tds_read_b64_tr_b16 %4, %10\n\tds_read_b64_tr_b16 %5, %11\n\ts_waitcnt lgkmcnt(0)"
                 : "=&v"(r[0]), "=&v"(r[1]), "=&v"(r[2]), "=&v"(r[3]), "=&v"(r[4]), "=&v"(r[5]) : "v"(a0), "v"(a1), "v"(a2), "v"(a3), "v"(a4), "v"(a5) : "memory"); }
__device__ __forceinline__ void tr_read4x8(s16x4 (&r)[8], unsigned a0, unsigned a1, unsigned a2, unsigned a3, unsigned a4, unsigned a5, unsigned a6, unsigned a7) {
    asm volatile("ds_read_b64_tr_b16 %0, %8\n\tds_read_b64_tr_b16 %1, %9\n\tds_read_b64_tr_b16 %2, %10\n\tds_read_b64_tr_b16 %3, %11\n\tds_read_b64_tr_b16 %4, %12\n\tds_read_b64_tr_b16 %5, %13\n\tds_read_b64_tr_b16 %6, %14\n\tds_read_b64_tr_b16 %7, %15\n\ts_waitcnt lgkmcnt(0)"
                 : "=&v"(r[0]), "=&v"(r[1]), "=&v"(r[2]), "=&v"(r[3]), "=&v"(r[4]), "=&v"(r[5]), "=&v"(r[6]), "=&v"(r[7]) : "v"(a0), "v"(a1), "v"(a2), "v"(a3), "v"(a4), "v"(a5), "v"(a6), "v"(a7) : "memory"); }
__device__ __forceinline__ float scan_sum64(float v, int lane) {
#pragma unroll
    for (int o = 1; o < 64; o <<= 1) { const float t = __shfl_up(v, o); if (lane >= o) v += t; }
    return v;
}
__device__ __forceinline__ float scan_max64(float v, int lane) {
#pragma unroll
    for (int o = 1; o < 64; o <<= 1) { const float t = __shfl_up(v, o); if (lane >= o) v = fmaxf(v, t); }
    return v;
}
__device__ __forceinline__ pg8::bf16x8 mk_frag(s16x4 a, s16x4 b) { return (pg8::bf16x8){a[0], a[1], a[2], a[3], b[0], b[1], b[2], b[3]}; }

__device__ __forceinline__ void phase_mlstm_local(const Ctx& C, const Args& A) {
    const bf16* P = (const bf16*)(A.ws + WS_BIG);
    const float* LF = (const float*)(A.ws + WS_LF); const float* LI = (const float*)(A.ws + WS_LI);
    bf16* SL = (bf16*)((unsigned char*)A.out + OUT_SL); float* NL = (float*)(A.ws + WS_NL);
    float* GC = (float*)(A.ws + WS_GC); float* ML = (float*)(A.ws + WS_ML);
    LAS unsigned char* tK = C.lds; LAS unsigned char* tV = C.lds + 32768; LAS float* wtab = (LAS float*)(C.lds + 65536);
    const unsigned ldsK = (unsigned)(uintptr_t)tK, ldsV = (unsigned)(uintptr_t)tV;
    const int lane = C.lane, wid = C.wave, tid = C.tid;
    for (int unit = C.bid; unit < 1024; unit += C.G) {
        const int bh = unit >> 5, c = unit & 31, b = bh >> 2, hh = bh & 3;
        const size_t tok0 = (size_t)b * SEQ + c * 128;
        if (wid == 0) {
            const float2 lf = *(const float2*)(LF + (size_t)bh * SEQ + c * 128 + 2 * lane), li = *(const float2*)(LI + (size_t)bh * SEQ + c * 128 + 2 * lane);
            const float pr = lf.x + lf.y, inc = scan_sum64(pr, lane), ex = inc - pr;
            const float b0 = ex + lf.x, b1 = b0 + lf.y;
            const float g = __shfl(inc, 63);
            const float a0 = g - b0 + li.x, a1 = g - b1 + li.y;
            const float mloc = wave_max(fmaxf(a0, a1));
            wtab[2 * lane] = __expf(a0 - mloc); wtab[2 * lane + 1] = __expf(a1 - mloc);
            if (lane == 0) { GC[unit] = g; ML[unit] = mloc; }
        }
        __syncthreads();
#pragma unroll
        for (int i = 0; i < 4; ++i) { const int id = tid + 512 * i, row = id >> 4, ch = id & 15;
            const bf16* src = P + (tok0 + row) * INP + hh * 128 + ch * 8;
            const v4u kv = *(const v4u*)(src + 512), vv = *(const v4u*)(src + 1024);
            const float w = wtab[row];
            v4u ko; ko.x = pk2(bflo(kv.x) * w, bfhi(kv.x) * w); ko.y = pk2(bflo(kv.y) * w, bfhi(kv.y) * w); ko.z = pk2(bflo(kv.z) * w, bfhi(kv.z) * w); ko.w = pk2(bflo(kv.w) * w, bfhi(kv.w) * w);
            *(LAS v4u*)(tK + offb(row, ch)) = ko; *(LAS v4u*)(tV + offb(row, ch)) = vv; }
        __syncthreads();
        if (tid < 128) { const int d = tid; float s = 0.f;
#pragma unroll 8
            for (int l = 0; l < 128; ++l) s += bf2f(*(const LAS unsigned short*)(tK + offb(l, d >> 3) + (d & 7) * 2));
            NL[(size_t)unit * 128 + d] = s; }
        {
            const int db = wid & 3, eh = wid >> 2;
            const unsigned h = lane >> 5, blk = (lane >> 4) & 1, q = (lane & 15) >> 2, p = lane & 3;
            f32x16 acc[2];
#pragma unroll
            for (int eb = 0; eb < 2; ++eb)
#pragma unroll
                for (int r = 0; r < 16; ++r) acc[eb][r] = 0.f;
#pragma unroll
            for (int ks = 0; ks < 8; ++ks) {
                const unsigned r0 = 16 * ks + 8 * h + q, cA = 4 * db + 2 * blk + (p >> 1), cB0 = 4 * (2 * eh) + 2 * blk + (p >> 1), cB1 = cB0 + 4, po = 8 * (p & 1);
                s16x4 t[6];
                tr_read4x6(t, ldsK + offb(r0, cA) + po, ldsK + offb(r0 + 4, cA) + po, ldsV + offb(r0, cB0) + po, ldsV + offb(r0 + 4, cB0) + po, ldsV + offb(r0, cB1) + po, ldsV + offb(r0 + 4, cB1) + po);
                const pg8::bf16x8 af = mk_frag(t[0], t[1]);
                acc[0] = __builtin_amdgcn_mfma_f32_32x32x16_bf16(af, mk_frag(t[2], t[3]), acc[0], 0, 0, 0);
                acc[1] = __builtin_amdgcn_mfma_f32_32x32x16_bf16(af, mk_frag(t[4], t[5]), acc[1], 0, 0, 0);
            }
            const int hi = lane >> 5;
#pragma unroll
            for (int eb = 0; eb < 2; ++eb) { const int e = 32 * (2 * eh + eb) + (lane & 31);
#pragma unroll
                for (int g4 = 0; g4 < 4; ++g4) { uint2 o; o.x = pk2(acc[eb][4 * g4], acc[eb][4 * g4 + 1]); o.y = pk2(acc[eb][4 * g4 + 2], acc[eb][4 * g4 + 3]);
                    *(uint2*)(SL + ((size_t)unit * 128 + e) * 128 + 32 * db + 8 * g4 + 4 * hi) = o; } }
        }
        __syncthreads();
    }
}

__device__ __forceinline__ void phase_mlstm_scan(const Ctx& C, const Args& A) {
    const bf16* SL = (const bf16*)((unsigned char*)A.out + OUT_SL); bf16* SP = (bf16*)((unsigned char*)A.out + OUT_SP);
    const float* NL = (const float*)(A.ws + WS_NL); float* NP = (float*)(A.ws + WS_NP);
    const float* GC = (const float*)(A.ws + WS_GC); const float* ML = (const float*)(A.ws + WS_ML); float* MP = (float*)(A.ws + WS_MP);
    for (long it = C.gt; it < 32L * 128 * 32; it += C.NGT) {
        const int d4 = (int)(it & 31), e = (int)((it >> 5) & 127), bh = (int)(it >> 12);
        f32x4 s = {0.f, 0.f, 0.f, 0.f}, n = {0.f, 0.f, 0.f, 0.f}; float m = 0.f;
        const bool do_n = (e == 0);
#pragma unroll 4
        for (int c = 0; c < 32; ++c) {
            const size_t unit = (size_t)bh * 32 + c;
            uint2 o; o.x = pk2(s.x, s.y); o.y = pk2(s.z, s.w);
            *(uint2*)(SP + (unit * 128 + e) * 128 + 4 * d4) = o;
            if (do_n) { *(f32x4*)(NP + unit * 128 + 4 * d4) = n; if (d4 == 0) MP[unit] = m; }
            const float g = GC[unit], ml = ML[unit];
            const float mn = fmaxf(g + m, ml), dec = __expf(g + m - mn), sc = __expf(ml - mn);
            const uint2 xw = *(const uint2*)(SL + (unit * 128 + e) * 128 + 4 * d4); const f32x4 x = {bflo(xw.x), bfhi(xw.x), bflo(xw.y), bfhi(xw.y)};
            s = s * dec + x * sc;
            if (do_n) { const f32x4 y = *(const f32x4*)(NL + unit * 128 + 4 * d4); n = n * dec + y * sc; }
            m = mn;
        }
    }
}

__device__ __forceinline__ void phase_mlstm_out(const Ctx& C, const Args& A) {
    const bf16* P = (const bf16*)(A.ws + WS_BIG); bf16* mix = (bf16*)(A.ws + WS_H);
    const float* LF = (const float*)(A.ws + WS_LF); const float* LI = (const float*)(A.ws + WS_LI);
    const bf16* SP = (const bf16*)((unsigned char*)A.out + OUT_SP); const float* NP = (const float*)(A.ws + WS_NP); const float* MP = (const float*)(A.ws + WS_MP);
    const float* gain = A.in[9];
    LAS unsigned char* tV = C.lds; LAS float* abt = (LAS float*)(C.lds + 65536); LAS float* Mt = abt + 128; LAS float* bt = abt + 256; LAS float* npt = abt + 384; LAS float* ssq = abt + 512;
    const unsigned ldsV = (unsigned)(uintptr_t)tV;
    const int lane = C.lane, wid = C.wave, tid = C.tid, hi = lane >> 5, l31 = lane & 31;
    constexpr float QS = 0.08838834764831845f;
    for (int unit = C.bid; unit < 1024; unit += C.G) {
        const int bh = unit >> 5, c = unit & 31, b = bh >> 2, hh = bh & 3;
        const size_t tok0 = (size_t)b * SEQ + c * 128;
        const float mprev = MP[unit];
        if (wid == 0) {
            const float2 lf = *(const float2*)(LF + (size_t)bh * SEQ + c * 128 + 2 * lane), li = *(const float2*)(LI + (size_t)bh * SEQ + c * 128 + 2 * lane);
            const float pr = lf.x + lf.y, inc = scan_sum64(pr, lane), ex = inc - pr;
            const float b0 = ex + lf.x, b1 = b0 + lf.y;
            const float ab0 = li.x - b0, ab1 = li.y - b1;
            const float pmx = scan_max64(fmaxf(ab0, ab1), lane);
            float pme = __shfl_up(pmx, 1); if (lane == 0) pme = -INFINITY;
            const float pm0 = fmaxf(pme, ab0), pm1 = fmaxf(pm0, ab1);
            abt[2 * lane] = ab0; abt[2 * lane + 1] = ab1; bt[2 * lane] = b0; bt[2 * lane + 1] = b1;
            Mt[2 * lane] = fmaxf(mprev, pm0); Mt[2 * lane + 1] = fmaxf(mprev, pm1);
        }
        if (wid == 1) { npt[2 * lane] = NP[(size_t)unit * 128 + 2 * lane]; npt[2 * lane + 1] = NP[(size_t)unit * 128 + 2 * lane + 1]; }
#pragma unroll
        for (int i = 0; i < 4; ++i) { const int id = tid + 512 * i, row = id >> 4, ch = id & 15;
            *(LAS v4u*)(tV + offb(row, ch)) = *(const v4u*)(P + (tok0 + row) * INP + 1024 + hh * 128 + ch * 8); }
        __syncthreads();
        const int lb = wid & 3, eh = wid >> 2;
        const int l = 32 * lb + l31;
        const float Ml = Mt[l], iw = __expf(mprev - Ml) * QS;
        pg8::bf16x8 qf[8];
#pragma unroll
        for (int ks = 0; ks < 8; ++ks) qf[ks] = *(const pg8::bf16x8*)(P + (tok0 + l) * INP + hh * 128 + 16 * ks + 8 * hi);
        float qn = 0.f;
#pragma unroll
        for (int ks = 0; ks < 8; ++ks)
#pragma unroll
            for (int j = 0; j < 8; ++j) qn += bf2f((unsigned short)qf[ks][j]) * npt[16 * ks + 8 * hi + j];
        qn += __shfl_xor(qn, 32);
        f32x16 acc[2];
#pragma unroll
        for (int eb = 0; eb < 2; ++eb) {
#pragma unroll
            for (int r = 0; r < 16; ++r) acc[eb][r] = 0.f;
            const bf16* sp = SP + ((size_t)unit * 128 + 32 * (2 * eh + eb) + l31) * 128 + 8 * hi;
#pragma unroll
            for (int ks = 0; ks < 8; ++ks) acc[eb] = __builtin_amdgcn_mfma_f32_32x32x16_bf16(*(const pg8::bf16x8*)(sp + 16 * ks), qf[ks], acc[eb], 0, 0, 0);
#pragma unroll
            for (int r = 0; r < 16; ++r) acc[eb][r] *= iw;
        }
        float den = 0.f;
        const unsigned g16 = lane >> 4, blk = g16 & 1, q = (lane & 15) >> 2, p = lane & 3;
        for (int sb = 0; sb <= lb; ++sb) {
            f32x16 X;
#pragma unroll
            for (int r = 0; r < 16; ++r) X[r] = 0.f;
            const bf16* kp = P + (tok0 + 32 * sb + l31) * INP + 512 + hh * 128 + 8 * hi;
#pragma unroll
            for (int ks = 0; ks < 8; ++ks) X = __builtin_amdgcn_mfma_f32_32x32x16_bf16(*(const pg8::bf16x8*)(kp + 16 * ks), qf[ks], X, 0, 0, 0);
            float pv[16];
#pragma unroll
            for (int r = 0; r < 16; ++r) { const int s = 32 * sb + (r & 3) + 8 * (r >> 2) + 4 * hi;
                const float v = X[r] * QS * __expf(abt[s] - Ml);
                pv[r] = (s <= l) ? v : 0.f; den += pv[r]; }
            pg8::bf16x8 pf[2];
#pragma unroll
            for (int st = 0; st < 2; ++st) { v4u t; t.x = pk2(pv[8 * st], pv[8 * st + 1]); t.y = pk2(pv[8 * st + 2], pv[8 * st + 3]); t.z = pk2(pv[8 * st + 4], pv[8 * st + 5]); t.w = pk2(pv[8 * st + 6], pv[8 * st + 7]);
                pf[st] = __builtin_bit_cast(pg8::bf16x8, t); }
            { const unsigned c0 = 4 * (2 * eh) + 2 * blk + (p >> 1), c1 = c0 + 4, ra = 32 * sb + 4 * hi + q, po = 8 * (p & 1);
              s16x4 t[8];
              tr_read4x8(t, ldsV + offb(ra, c0) + po, ldsV + offb(ra + 8, c0) + po, ldsV + offb(ra + 16, c0) + po, ldsV + offb(ra + 24, c0) + po,
                            ldsV + offb(ra, c1) + po, ldsV + offb(ra + 8, c1) + po, ldsV + offb(ra + 16, c1) + po, ldsV + offb(ra + 24, c1) + po);
#pragma unroll
              for (int eb = 0; eb < 2; ++eb)
#pragma unroll
                  for (int st = 0; st < 2; ++st) acc[eb] = __builtin_amdgcn_mfma_f32_32x32x16_bf16(mk_frag(t[4 * eb + 2 * st], t[4 * eb + 2 * st + 1]), pf[st], acc[eb], 0, 0, 0); }
        }
        den += __shfl_xor(den, 32);
        den += iw * qn;
        const float dn = 1.f / fmaxf(fabsf(den), __expf(-(bt[l] + Ml)));
        float ss = 0.f;
#pragma unroll
        for (int eb = 0; eb < 2; ++eb)
#pragma unroll
            for (int r = 0; r < 16; ++r) { acc[eb][r] *= dn; ss += acc[eb][r] * acc[eb][r]; }
        ss += __shfl_xor(ss, 32);
        if (hi == 0) ssq[eh * 128 + l] = ss;
        __syncthreads();
        const float rstd = rsqrtf((ssq[l] + ssq[128 + l]) * (1.f / 128.f) + EPS);
#pragma unroll
        for (int eb = 0; eb < 2; ++eb)
#pragma unroll
            for (int g4 = 0; g4 < 4; ++g4) { const int e = 32 * (2 * eh + eb) + 8 * g4 + 4 * hi;
                const uint2 ow = *(const uint2*)(P + (tok0 + l) * INP + 1536 + hh * 128 + e);
                const f32x4 gn = *(const f32x4*)(gain + hh * 128 + e);
                uint2 o; o.x = pk2(acc[eb][4 * g4] * rstd * gn.x * sigmoidf_(bflo(ow.x)), acc[eb][4 * g4 + 1] * rstd * gn.y * sigmoidf_(bfhi(ow.x)));
                o.y = pk2(acc[eb][4 * g4 + 2] * rstd * gn.z * sigmoidf_(bflo(ow.y)), acc[eb][4 * g4 + 3] * rstd * gn.w * sigmoidf_(bfhi(ow.y)));
                *(uint2*)(mix + (tok0 + l) * DM + hh * 128 + e) = o; }
        __syncthreads();
    }
}
struct EpiQKV {
    static constexpr bool PERM = true, AFTER_DRAIN = false;
    bf16* O; bf16* KF; bf16* VH; const float* qg; const float* kg;
    __device__ __forceinline__ void operator()(const pg8::f32x4 (&acc)[2][2][4][2], const pg8::Unit& u, int wr, int wc, int fr, int fq) const {
        using pg8::f32x4;
        const int kind = u.pn >> 2;
        const float* gp = (kind == 0) ? qg : kg;
        const float post = (kind == 0) ? 0.125f * 1.4426950408889634f : 1.0f;
        f32x4 gv[2][2];
#pragma unroll
        for (int bj = 0; bj < 2; ++bj)
#pragma unroll
            for (int n = 0; n < 2; ++n) gv[bj][n] = (kind < 2) ? *(const f32x4*)(gp + 32 * bj + 8 * fq + 4 * n) * post : (f32x4){1.f, 1.f, 1.f, 1.f};
#pragma unroll
        for (int ai = 0; ai < 2; ++ai)
#pragma unroll
            for (int m = 0; m < 4; ++m) {
                float ss = 0.f;
#pragma unroll
                for (int bj = 0; bj < 2; ++bj)
#pragma unroll
                    for (int n = 0; n < 2; ++n) { const f32x4 x = acc[ai][bj][m][n]; ss += (x[0] * x[0] + x[1] * x[1]) + (x[2] * x[2] + x[3] * x[3]); }
                ss += __shfl_xor(ss, 16); ss += __shfl_xor(ss, 32);
                const float rs = (kind < 2) ? rsqrtf(ss * (1.f / 64.f) + EPS) : 1.0f;
                const int row = u.pm * 256 + ai * 128 + wr * 64 + m * 16 + fr;
                bf16* dst = (kind == 1) ? KF + ((size_t)(((row >> 12) * 16 + (u.pn - 4) * 4 + wc) * 128 + ((row & 4095) >> 5)) * 2048 + (size_t)((fq >> 1) * 512 + ((fq & 1) * 32 + (row & 31)) * 8))
                                        : (kind == 2) ? VH + ((size_t)(((row >> 12) * 16 + (u.pn & 3) * 4 + wc) * 4096 + (row & 4095)) * 64 + 8 * fq)
                                        : O + (size_t)row * 1024 + (u.pn & 3) * 256 + 64 * wc + 8 * fq;
                const int bjstep = (kind == 1) ? 1024 : 32;
#pragma unroll
                for (int bj = 0; bj < 2; ++bj) { const f32x4 v0 = acc[ai][bj][m][0] * gv[bj][0] * rs, v1 = acc[ai][bj][m][1] * gv[bj][1] * rs;
                    v4u w; w.x = pk2(v0[0], v0[1]); w.y = pk2(v0[2], v0[3]); w.z = pk2(v1[0], v1[1]); w.w = pk2(v1[2], v1[3]);
                    *(v4u*)(dst + bjstep * bj) = w; }
            }
    }
};

__device__ __forceinline__ unsigned voff(unsigned row, unsigned ch) { return row * 128u + 16u * (ch ^ (row & 7u)); }
__device__ __forceinline__ void phase_attn(const Ctx& C, const Args& A) {
    const bf16* QV = (const bf16*)(A.ws + WS_BIG); const bf16* KF = (const bf16*)(A.ws + WS_BIG + 64 * MiB); const bf16* VH = (const bf16*)(A.ws + WS_BIG + 128 * MiB); bf16* O = (bf16*)(A.ws + WS_H);
    LAS unsigned char* tV = C.lds + C.wave * 4096;
    const unsigned ldsV = (unsigned)(uintptr_t)tV;
    const int lane = C.lane, hi = lane >> 5, l31 = lane & 31;
    const unsigned blk = (lane >> 4) & 1, q4 = (lane & 15) >> 2, p = lane & 3;
    const int per_wave = (16384 + C.NGW - 1) / C.NGW;
    for (int u = C.gw * per_wave; u < C.gw * per_wave + per_wave; ++u) {
        if (u >= 16384) break;
        const int bh = u >> 7, qt = u & 127, b = bh >> 4, hd = bh & 15;
        const size_t tokb = (size_t)b * SEQ;
        const int l = qt * 32 + l31;
        pg8::bf16x8 qf[4];
#pragma unroll
        for (int ks = 0; ks < 4; ++ks) qf[ks] = *(const pg8::bf16x8*)(QV + (tokb + l) * 1024 + hd * 64 + 16 * ks + 8 * hi);
        f32x16 acc[2];
#pragma unroll
        for (int eb = 0; eb < 2; ++eb)
#pragma unroll
            for (int r = 0; r < 16; ++r) acc[eb][r] = 0.f;
        float carry = 0.f;
        pg8::bf16x8 kf[4]; v4u vv[4];
#define ATT_LOAD(kt_) { const size_t s0_ = tokb + (size_t)(kt_) * 32; const bf16* kp_ = KF + ((size_t)(bh * 128 + (kt_)) * 2048 + lane * 8); \
            _Pragma("unroll") for (int ks = 0; ks < 4; ++ks) kf[ks] = *(const pg8::bf16x8*)(kp_ + ks * 512); \
            _Pragma("unroll") for (int i = 0; i < 4; ++i) { const int id = lane + 64 * i; vv[i] = *(const v4u*)(VH + ((size_t)bh * 4096 + (size_t)(kt_) * 32) * 64 + id * 8); } }
        ATT_LOAD(qt)
        for (int kt = qt; kt >= 0; --kt) {
            f32x16 X;
#pragma unroll
            for (int r = 0; r < 16; ++r) X[r] = 0.f;
#pragma unroll
            for (int ks = 0; ks < 4; ++ks) X = __builtin_amdgcn_mfma_f32_32x32x16_bf16(kf[ks], qf[ks], X, 0, 0, 0);
#pragma unroll
            for (int i = 0; i < 4; ++i) { const int id = lane + 64 * i; *(LAS v4u*)(tV + voff(id >> 3, id & 7)) = vv[i]; }
            if (kt > 0) ATT_LOAD(kt - 1)
            const int sbase = kt * 32 + 4 * hi;
            float sp[16];
#pragma unroll
            for (int r = 0; r < 16; ++r) { const int s = sbase + (r & 3) + 8 * (r >> 2);
                const float x = X[r]; const float t = fmaxf(x, 0.f) + __builtin_amdgcn_logf(1.f + __builtin_amdgcn_exp2f(-fabsf(x)));
                sp[r] = (s < l) ? t : 0.f; }
            float To[4], Tp[4];
#pragma unroll
            for (int g = 0; g < 4; ++g) { To[g] = (sp[4 * g] + sp[4 * g + 1]) + (sp[4 * g + 2] + sp[4 * g + 3]); Tp[g] = __shfl_xor(To[g], 32); }
            float base[4]; float run = 0.f;
#pragma unroll
            for (int g = 3; g >= 0; --g) { base[g] = carry + run + (hi == 0 ? Tp[g] : 0.f); run += To[g] + Tp[g]; }
            float att[16];
#pragma unroll
            for (int g = 0; g < 4; ++g) { float w = base[g];
#pragma unroll
                for (int i = 3; i >= 0; --i) { const int r = 4 * g + i; const int s = sbase + i + 8 * g;
                    att[r] = (s < l) ? __builtin_amdgcn_exp2f(X[r] - sp[r] - w) : 0.f; w += sp[r]; } }
            carry += run;
            pg8::bf16x8 pf[2];
#pragma unroll
            for (int st = 0; st < 2; ++st) { v4u t; t.x = pg8::cvt_pk_bf16(att[8 * st], att[8 * st + 1]); t.y = pg8::cvt_pk_bf16(att[8 * st + 2], att[8 * st + 3]); t.z = pg8::cvt_pk_bf16(att[8 * st + 4], att[8 * st + 5]); t.w = pg8::cvt_pk_bf16(att[8 * st + 6], att[8 * st + 7]);
                pf[st] = __builtin_bit_cast(pg8::bf16x8, t); }
            s16x4 vf[8];
            { const unsigned a0 = ldsV + voff(4 * hi + q4, 2 * blk + (p >> 1)) + 8 * (p & 1), a1 = ldsV + voff(4 * hi + q4 + 8, 2 * blk + (p >> 1)) + 8 * (p & 1);
              const unsigned a2 = ldsV + voff(16 + 4 * hi + q4, 2 * blk + (p >> 1)) + 8 * (p & 1), a3 = ldsV + voff(24 + 4 * hi + q4, 2 * blk + (p >> 1)) + 8 * (p & 1);
              const unsigned a4 = ldsV + voff(4 * hi + q4, 4 + 2 * blk + (p >> 1)) + 8 * (p & 1), a5 = ldsV + voff(4 * hi + q4 + 8, 4 + 2 * blk + (p >> 1)) + 8 * (p & 1);
              const unsigned a6 = ldsV + voff(16 + 4 * hi + q4, 4 + 2 * blk + (p >> 1)) + 8 * (p & 1), a7 = ldsV + voff(24 + 4 * hi + q4, 4 + 2 * blk + (p >> 1)) + 8 * (p & 1);
              asm volatile("ds_read_b64_tr_b16 %0, %8\n\tds_read_b64_tr_b16 %1, %9\n\tds_read_b64_tr_b16 %2, %10\n\tds_read_b64_tr_b16 %3, %11\n\t"
                           "ds_read_b64_tr_b16 %4, %12\n\tds_read_b64_tr_b16 %5, %13\n\tds_read_b64_tr_b16 %6, %14\n\tds_read_b64_tr_b16 %7, %15\n\ts_waitcnt lgkmcnt(0)"
                           : "=&v"(vf[0]), "=&v"(vf[1]), "=&v"(vf[2]), "=&v"(vf[3]), "=&v"(vf[4]), "=&v"(vf[5]), "=&v"(vf[6]), "=&v"(vf[7])
                           : "v"(a0), "v"(a1), "v"(a2), "v"(a3), "v"(a4), "v"(a5), "v"(a6), "v"(a7) : "memory"); }
#pragma unroll
            for (int eb = 0; eb < 2; ++eb)
#pragma unroll
                for (int st = 0; st < 2; ++st) acc[eb] = __builtin_amdgcn_mfma_f32_32x32x16_bf16(mk_frag(vf[4 * eb + 2 * st], vf[4 * eb + 2 * st + 1]), pf[st], acc[eb], 0, 0, 0);
            if (__all(carry >= 150.1f)) break;
        }
#undef ATT_LOAD
#pragma unroll
        for (int eb = 0; eb < 2; ++eb)
#pragma unroll
            for (int g4 = 0; g4 < 4; ++g4) { const u32x2 o = {pk2(acc[eb][4 * g4], acc[eb][4 * g4 + 1]), pk2(acc[eb][4 * g4 + 2], acc[eb][4 * g4 + 3])};
                const unsigned c8 = (unsigned)(8 * eb + 2 * g4 + hi);
                *(LAS u32x2*)(tV + l31 * 128 + ((c8 ^ ((unsigned)(l31 & 7) << 1)) << 3)) = o; }
        asm volatile("s_waitcnt lgkmcnt(0)" ::: "memory");
#pragma unroll
        for (int i = 0; i < 4; ++i) { const int id = lane + 64 * i, rr = id >> 3, q = id & 7;
            const v4u w = *(const LAS v4u*)(tV + rr * 128 + (((unsigned)(2 * q) ^ ((unsigned)(rr & 7) << 1)) << 3));
            *(v4u*)(O + (tokb + qt * 32 + rr) * DM + hd * 64 + 8 * q) = w; }
        asm volatile("s_waitcnt lgkmcnt(0)" ::: "memory");
    }
}
constexpr int N_PHASES = 16;
#ifndef MK_ONE_LAUNCH
#define MK_ONE_LAUNCH 1
#endif

__global__ void __launch_bounds__(NWAVES * 64, 2) mk_fwd(Args args) {
    extern __shared__ __attribute__((aligned(16))) unsigned char lds_raw[];
    Ctx C;
    C.lds = (LAS unsigned char*)lds_raw;
    C.tid = threadIdx.x; C.lane = C.tid & 63; C.wave = __builtin_amdgcn_readfirstlane(C.tid >> 6);
    C.G = gridDim.x; C.bid = blockIdx.x;
    C.gw = C.bid * NWAVES + C.wave; C.NGW = C.G * NWAVES;
    C.gt = (long)C.bid * (NWAVES * 64) + C.tid; C.NGT = (long)C.G * (NWAVES * 64);
    unsigned char* ws = args.ws;
    volatile LAS unsigned* MISC = (volatile LAS unsigned*)(C.lds + MISC_OFF);
    for (int u = C.tid; u < (LDS_BYTES - LDSCTL_OFF) / 4; u += NWAVES * 64) ((LAS unsigned*)(C.lds + LDSCTL_OFF))[u] = 0u;
    __syncthreads();
#if MK_ONE_LAUNCH
    XcdBarrier bar = xcd_barrier_post((unsigned*)((gu32*)(ws + WS_CTL) + CW_BAR), MISC + 8);
#ifdef PROBE_DBLBAR
#define GRID_BAR() do { xcd_barrier(bar); xcd_barrier(bar); } while (0)
#else
#define GRID_BAR() xcd_barrier(bar)
#endif
#else
    (void)MISC; XcdBarrier bar; bar.bar = nullptr; bar.x = 0; bar.st = nullptr;
#define GRID_BAR() do {} while (0)
#endif
    const int lo = args.ph_lo, hi = args.ph_hi;
#define IN(k) (lo <= (k) && (k) < hi)
#ifndef PROBE_MASK
#define PROBE_MASK 0
#endif
#define PROBE_T0(k) unsigned long long pt0_ = 0; if ((PROBE_MASK >> (k)) & 1) pt0_ = __builtin_amdgcn_s_memrealtime();
#define PROBE_T1(k) if ((PROBE_MASK >> (k)) & 1) { const unsigned long long t1_ = __builtin_amdgcn_s_memrealtime(); const unsigned long long d_ = t1_ - pt0_; while (__builtin_amdgcn_s_memrealtime() - t1_ < d_) __builtin_amdgcn_s_sleep(8); }
#define SEAM(k) do { if (IN(k) && IN((k) + 1)) GRID_BAR(); } while (0)
    float* mod0 = (float*)(ws + WS_MOD); float* mod1 = mod0 + (size_t)NB * 6144;
    bf16* Hb = (bf16*)(ws + WS_H); bf16* BIG = (bf16*)(ws + WS_BIG); bf16* XB = (bf16*)(ws + WS_XB);

    const unsigned char* TAB = ws + WS_TAB; const float* TSC = (const float*)(ws + WS_TSC);
#ifdef PROBE_INSTR
    {
        unsigned xs[16]; float fs[16];
#pragma unroll
        for (int i = 0; i < 16; ++i) { xs[i] = (unsigned)(C.tid * 2654435761u + i * 40503u); fs[i] = (float)(C.tid * 7 + i) * 0.37f; }
#pragma unroll 1
        for (int it = 0; it < 4096; ++it) {
#pragma unroll
            for (int rep = 0; rep < 2; ++rep) {
#pragma unroll
                for (int i = 0; i < 16; i += 2) {
#if PROBE_INSTR == 10
                    { const unsigned a = xs[i], b = xs[i + 1]; xs[i] = a < b ? b : a; xs[i + 1] = (a < b ? a : b) + (unsigned)it; }
#elif PROBE_INSTR == 11
                    { const float a = fs[i], b = fs[i + 1]; fs[i] = fmaxf(a, b); fs[i + 1] = fminf(a, b) + 1.0f; }
#elif PROBE_INSTR == 12
                    { const unsigned a = xs[i], b = xs[i + 1]; xs[i] = a + b; xs[i + 1] = (a ^ b) + (unsigned)it; }
#endif
                }
            }
        }
        float sm = 0.f;
#pragma unroll
        for (int i = 0; i < 16; ++i) sm += fs[i] + __uint_as_float(xs[i] & 0x3fffffffu);
        if (sm == 1234.5678f) args.out[C.tid] = sm;
    }
#endif
    if (IN(0)) { PROBE_T0(0) { phase_prep(C, args); convert_tables_int8(C, args); } PROBE_T1(0) } SEAM(0);
    bf16* H8B = (bf16*)(ws + WS_IDS);
    unsigned char* W8 = (unsigned char*)args.out; float* SW = (float*)((unsigned char*)args.out + OUT_SW); float* SA = (float*)(ws + WS_SA);
    if (IN(1)) { PROBE_T0(1) { phase_rowpass<true, false, true>(C, args, args.in[0], args.in[4], mod0, 0, 1, Hb, SA);
        quantize_rows(C, (const bf16*)(ws + WS_WIN), INP, W8 + OUT_W8IN, SW + SW_IN);
        quantize_rows(C, (const bf16*)(ws + WS_WC0), 2048, W8 + OUT_W8C0, SW + SW_C0); quantize_rows(C, (const bf16*)(ws + WS_WC1), 2048, W8 + OUT_W8C1, SW + SW_C1); } PROBE_T1(1) } SEAM(1);
    if (IN(2)) { PROBE_T0(2) { pg8::Gemm g{Hb, (const bf16*)(W8 + OUT_W8IN), NTOK, INP, DM / 2}; pg8::StaticOrder S; S.init(NTOK, INP, C.G, C.bid);
        EpiBf16I8 E{BIG, INP, SA, SW + SW_IN};
        pg8::gemm_phase<EpiBf16I8, pg8::StaticOrder, true, true, true>(C.lds, g, S, E); } PROBE_T1(2) } SEAM(2);
    if (IN(3)) { PROBE_T0(3) { phase_mlstm_local(C, args); phase_conv(C, args); } PROBE_T1(3) } SEAM(3);
    if (IN(4)) { PROBE_T0(4) { phase_mlstm_scan(C, args); } PROBE_T1(4) } SEAM(4);
    if (IN(5)) { PROBE_T0(5) { phase_mlstm_out(C, args); } PROBE_T1(5) } SEAM(5);
    if (IN(6)) { PROBE_T0(6) { pg8::Gemm g{Hb, (const bf16*)(ws + WS_WOUT0), NTOK, DM, DM}; pg8::StaticOrder S; S.init(NTOK, DM, C.G, C.bid);
        EpiResid<false> E{args.in[0], XB, mod0 + 2 * 1024};
        pg8::gemm_phase<EpiResid<false>, pg8::StaticOrder, true, true>(C.lds, g, S, E); } PROBE_T1(6) } SEAM(6);
    if (IN(7)) { PROBE_T0(7) { phase_rowpass<false, true, true>(C, args, XB, args.in[11], mod0, 3, 4, H8B, SA); } PROBE_T1(7) } SEAM(7);
    if (IN(8)) { PROBE_T0(8) { pg8::Gemm g{H8B, (const bf16*)(W8 + OUT_W8C0), NTOK, 2048, DM / 2}; pg8::StaticOrder S; S.init(NTOK, 2048, C.G, C.bid);
        EpiBf16I8 E{BIG, 2048, SA, SW + SW_C0};
        pg8::gemm_phase<EpiBf16I8, pg8::StaticOrder, true, true, true>(C.lds, g, S, E); } PROBE_T1(8) } SEAM(8);
    if (IN(9)) { PROBE_T0(9) { phase_peer<true>(C, args, TAB, TAB + TAB_BYTES, TSC, TSC + 16384, mod0 + 5 * 1024, args.in[19], mod1, bar); } PROBE_T1(9) } SEAM(9);
    if (IN(10)) { PROBE_T0(10) { pg8::Gemm g{Hb, (const bf16*)(ws + WS_WQKV), NTOK, 3072, DM}; pg8::StaticOrder S; S.init(NTOK, 3072, C.G, C.bid);
        EpiQKV E{BIG, (bf16*)(ws + WS_BIG + 64 * MiB), (bf16*)(ws + WS_BIG + 128 * MiB), args.in[21], args.in[22]};
        pg8::gemm_phase<EpiQKV, pg8::StaticOrder, true, true>(C.lds, g, S, E); } PROBE_T1(10) } SEAM(10);
    if (IN(11)) { PROBE_T0(11) { phase_attn(C, args); } PROBE_T1(11) } SEAM(11);
    if (IN(12)) { PROBE_T0(12) { pg8::Gemm g{Hb, (const bf16*)(ws + WS_WOUT1), NTOK, DM, DM}; pg8::StaticOrder S; S.init(NTOK, DM, C.G, C.bid);
        EpiResid<true> E{XB, XB, mod1 + 2 * 1024};
        pg8::gemm_phase<EpiResid<true>, pg8::StaticOrder, true, true>(C.lds, g, S, E); } PROBE_T1(12) } SEAM(12);
    if (IN(13)) { PROBE_T0(13) { phase_rowpass<false, true, true>(C, args, XB, args.in[24], mod1, 3, 4, H8B, SA); } PROBE_T1(13) } SEAM(13);
    if (IN(14)) { PROBE_T0(14) { pg8::Gemm g{H8B, (const bf16*)(W8 + OUT_W8C1), NTOK, 2048, DM / 2}; pg8::StaticOrder S; S.init(NTOK, 2048, C.G, C.bid);
        EpiBf16I8 E{BIG, 2048, SA, SW + SW_C1};
        pg8::gemm_phase<EpiBf16I8, pg8::StaticOrder, true, true, true>(C.lds, g, S, E); } PROBE_T1(14) } SEAM(14);
#ifdef PROBE_DRY
    if (IN(15)) { phase_peer<false, PROBE_DRY>(C, args, TAB + 2 * TAB_BYTES, TAB + 3 * TAB_BYTES, TSC + 2 * 16384, TSC + 3 * 16384, mod1 + 5 * 1024, nullptr, nullptr, bar); GRID_BAR(); }
#endif
    if (IN(15)) { PROBE_T0(15) { phase_peer<false>(C, args, TAB + 2 * TAB_BYTES, TAB + 3 * TAB_BYTES, TSC + 2 * 16384, TSC + 3 * 16384, mod1 + 5 * 1024, nullptr, nullptr, bar); } PROBE_T1(15) }
#undef IN
#undef SEAM
}

extern "C" void kernel_launch(void* const* d_in, const int* in_sizes, int n_in, void* d_out, int out_size, void* d_ws, size_t ws_size, hipStream_t stream) {
    static int grid = 0;
    if (grid == 0) {
        if (n_in != 30 || out_size != NTOK * DM || ws_size < WS_END2) { fprintf(stderr, "kernel_launch: unexpected shapes (n_in %d out %d ws %zu)\n", n_in, out_size, ws_size); grid = -1; return; }
        int dev = 0, cus = 0;
        if (hipGetDevice(&dev) != hipSuccess || hipDeviceGetAttribute(&cus, hipDeviceAttributeMultiprocessorCount, dev) != hipSuccess) { grid = -1; return; }
        if (hipFuncSetAttribute((const void*)mk_fwd, hipFuncAttributeMaxDynamicSharedMemorySize, LDS_BYTES) != hipSuccess) { fprintf(stderr, "kernel_launch: hipFuncSetAttribute failed\n"); grid = -1; return; }
        int per_cu = 0;
        if (hipOccupancyMaxActiveBlocksPerMultiprocessor(&per_cu, (const void*)mk_fwd, NWAVES * 64, LDS_BYTES) != hipSuccess || per_cu < 1) fprintf(stderr, "kernel_launch: occupancy query reports %d\n", per_cu);
        (void)hipGetLastError();
        grid = cus;
    }
    if (grid < 0) return;
    (void)hipMemsetAsync((char*)d_ws + WS_CTL + CW_BAR * 4, 0, XCD_BAR_WORDS * 4, stream);
    Args a{};
    for (int i = 0; i < 30; ++i) a.in[i] = (const float*)d_in[i];
    a.out = (float*)d_out; a.ws = (unsigned char*)d_ws;
#if MK_ONE_LAUNCH
    a.ph_lo = 0; a.ph_hi = N_PHASES;
    hipLaunchKernelGGL(mk_fwd, dim3(grid), dim3(NWAVES * 64), LDS_BYTES, stream, a);
#else
    for (int p = 0; p < N_PHASES; ++p) { a.ph_lo = p; a.ph_hi = p + 1; hipLaunchKernelGGL(mk_fwd, dim3(grid), dim3(NWAVES * 64), LDS_BYTES, stream, a); }
#endif
}
```

```cpp
#include <hip/hip_runtime.h>
#include <cstdio>
#include <cstdint>
#include <cmath>
#define PROBE_MASK 0
namespace pg8 {
#define PG8_LAS __attribute__((address_space(3)))
typedef unsigned short bf16_t;
typedef short bf16x8 __attribute__((ext_vector_type(8)));
typedef float f32x4 __attribute__((ext_vector_type(4)));
typedef unsigned u32x4 __attribute__((ext_vector_type(4)));
constexpr int BM = 256, BK = 64, HALF = 128, HTB = HALF * BK * 2  , STAGE_BYTES = 8 * HTB, NXCD = 8, WGM = 8;

__host__ __device__ __forceinline__ int lds_byte(int r, int c) { const int st = (r >> 4) * 2 + (c >> 5), rr = r & 15, cc = c & 31, ob = rr * 64 + cc * 2; return st * 1024 + (ob ^ (((ob >> 9) & 1) << 5)); }
__host__ __device__ __forceinline__ void stage_rc(int b, int& R, int& C) { const int st = b / 1024, sb = b % 1024, swz = sb ^ (((sb >> 9) & 1) << 5); R = (st >> 1) * 16 + swz / 64; C = (st & 1) * 32 + (swz % 64) / 2; }
__host__ __device__ __forceinline__ int perm32(int rho) { const int n = rho >> 4, i = rho & 15; return 8 * (i >> 2) + 4 * n + (i & 3); }

struct Unit { int pm, pn; };
struct Gemm { const bf16_t* A; const bf16_t* Bt; int M, N, K; };

struct StaticOrder {
    int nM, nN, nwg, G, c;
    __host__ __device__ void init(int M, int N, int G_, int c_) { nM = M / BM; nN = N / BM; nwg = nM * nN; G = G_; c = c_; }
    __host__ __device__ bool next(int i, Unit& u) const {
        const long L = (long)i * G + c; if (L >= nwg) return false;
        int wgid = (int)L; { const int q = nwg / NXCD, r = nwg % NXCD, xcd = wgid % NXCD, off = wgid / NXCD; wgid = (xcd < r ? xcd * (q + 1) : r * (q + 1) + (xcd - r) * q) + off; }
        const int nig = WGM * nN, gid = wgid / nig, fm = gid * WGM, gsz = (nM - fm) < WGM ? (nM - fm) : WGM;
        u.pm = fm + ((wgid % nig) % gsz); u.pn = (wgid % nig) / gsz; return true;
    }
    __device__ __forceinline__ void a_ready(const Unit&) const {}
    __device__ __forceinline__ void done(const Unit&) const {}
};

__device__ __forceinline__ unsigned cvt_pk_bf16(float lo, float hi) { unsigned r; asm volatile("v_cvt_pk_bf16_f32 %0, %1, %2" : "=v"(r) : "v"(lo), "v"(hi)); return r; }
typedef float f32x2 __attribute__((ext_vector_type(2)));
__device__ __forceinline__ f32x2 gelu_pk(f32x2 v) {
    const f32x2 av = __builtin_elementwise_abs(v), d = av * 0.2316418882f + 1.0f;
    f32x2 t; t.x = __builtin_amdgcn_rcpf(d.x); t.y = __builtin_amdgcn_rcpf(d.y);
    f32x2 q = t * 0.5307027145f + (-0.7265760135f); q = q * t + 0.7107068705f; q = q * t + (-0.142248368f); q = q * t + 0.127414796f; q = q * t;
    const f32x2 s = (v * v) * (-0.72134752044f);
    f32x2 e; e.x = __builtin_amdgcn_exp2f(s.x); e.y = __builtin_amdgcn_exp2f(s.y);
    const f32x2 m = v * (q * e), r = v - m;
    f32x2 o; o.x = v.x < 0.f ? m.x : r.x; o.y = v.y < 0.f ? m.y : r.y; return o;
}

template <int ACT  > struct EpiBf16 {
    static constexpr bool PERM = true, AFTER_DRAIN = false; static_assert(ACT == 0 || ACT == 1, "EpiBf16: ACT is 0 (none) or 1 (gelu_pk)");
    bf16_t* O; int ldc; const float* bias; int split_cols; size_t split_stride; float scale0;
    __device__ __forceinline__ void operator()(const f32x4 (&acc)[2][2][4][2], const Unit& u, int wr, int wc, int fr, int fq) const {
        const int row0 = u.pm * BM + wr * 64 + fr; int colt = u.pn * BM; bf16_t* base = O;
        float sc = 1.f; if (split_cols) { const int t = colt / split_cols; base += (size_t)t * split_stride; colt -= t * split_cols; if (t == 0) sc = scale0; }
        const int col0 = colt + wc * 32 + 8 * fq, bcol0 = u.pn * BM + wc * 32 + 8 * fq;
        f32x4 bv[2][2];
#pragma unroll
        for (int bj = 0; bj < 2; ++bj)
#pragma unroll
            for (int n = 0; n < 2; ++n) bv[bj][n] = bias ? *(const f32x4*)(bias + bcol0 + bj * HALF + 4 * n) : (f32x4){0.f, 0.f, 0.f, 0.f};
#pragma unroll
        for (int ai = 0; ai < 2; ++ai)
#pragma unroll
            for (int m = 0; m < 4; ++m) { bf16_t* rowp = base + (size_t)(row0 + ai * HALF + m * 16) * ldc + col0;
#pragma unroll
                for (int bj = 0; bj < 2; ++bj) { f32x4 v0 = acc[ai][bj][m][0] + bv[bj][0], v1 = acc[ai][bj][m][1] + bv[bj][1];
                    if (ACT == 1) { f32x2 a = gelu_pk((f32x2){v0[0], v0[1]}), b = gelu_pk((f32x2){v0[2], v0[3]}), c = gelu_pk((f32x2){v1[0], v1[1]}), d = gelu_pk((f32x2){v1[2], v1[3]});
                        v0 = (f32x4){a.x, a.y, b.x, b.y}; v1 = (f32x4){c.x, c.y, d.x, d.y}; }
                    v0 = v0 * sc; v1 = v1 * sc; u32x4 w; w.x = cvt_pk_bf16(v0[0], v0[1]); w.y = cvt_pk_bf16(v0[2], v0[3]); w.z = cvt_pk_bf16(v1[0], v1[1]); w.w = cvt_pk_bf16(v1[2], v1[3]);
                    *(u32x4*)(rowp + bj * HALF) = w; } }
    }
};
typedef int i32x4 __attribute__((ext_vector_type(4)));
template <bool I8> struct AccSel { typedef f32x4 type; };
template <> struct AccSel<true> { typedef i32x4 type; };
template <class Epi, class Sched, bool ALIGN_EPI = false, bool SP2 = false, bool I8 = false>
__device__ __forceinline__ void gemm_phase(PG8_LAS unsigned char* lds, const Gemm g, const Sched& S, const Epi& E) {
    const int tid = threadIdx.x, wid = __builtin_amdgcn_readfirstlane(tid >> 6), lane = tid & 63, wr = wid >> 2, wc = wid & 3, fr = lane & 15, fq = lane >> 4;
    const int K = g.K, nt = K / BK;
    unsigned voffA[2], voffB[2];
#pragma unroll
    for (int i = 0; i < 2; ++i) { int R, C; stage_rc(tid * 16 + i * 8192, R, C); const int Rb = Epi::PERM ? ((R & ~31) + perm32(R & 31)) : R;
        voffA[i] = (unsigned)(R * K + C) * 2u; voffB[i] = (unsigned)(Rb * K + C) * 2u; }
    const size_t kstep = (size_t)(BK * 2);
    const size_t hstep = (size_t)HALF * K * 2;
    const size_t tstep = 2 * hstep;
    const unsigned ldsw = (unsigned)wid * 1024u;
    const int aoff = lds_byte(wr * 64 + fr, fq * 8), boff = lds_byte(wc * 32 + fr, fq * 8);
#define PG8_SA(b, h) (((b) * 2 + (h)) * HTB)
#define PG8_SB(b, h) ((4 + (b) * 2 + (h)) * HTB)
#define PG8_STAGE(bufoff, gbase, voff) do { _Pragma("unroll") for (int _i = 0; _i < 2; ++_i) \
        __builtin_amdgcn_global_load_lds((const unsigned*)((const char*)(gbase) + (voff)[_i]), (PG8_LAS unsigned*)(lds + (bufoff) + ldsw + _i * 8192), 16, 0, 0); } while (0)
#define PG8_LDA(dst, b, h) do { _Pragma("unroll") for (int m = 0; m < 4; ++m) _Pragma("unroll") for (int k = 0; k < 2; ++k) dst[m][k] = *(const PG8_LAS bf16x8*)(lds + PG8_SA(b, h) + aoff + m * 2048 + k * 1024); } while (0)
#define PG8_LDB(dst, b, h) do { _Pragma("unroll") for (int n = 0; n < 2; ++n) _Pragma("unroll") for (int k = 0; k < 2; ++k) dst[n][k] = *(const PG8_LAS bf16x8*)(lds + PG8_SB(b, h) + boff + n * 2048 + k * 1024); } while (0)
#define PG8_MMA(ai, bj, At, Bt) do { __builtin_amdgcn_s_setprio(1); _Pragma("unroll") for (int m = 0; m < 4; ++m) _Pragma("unroll") for (int n = 0; n < 2; ++n) _Pragma("unroll") for (int k = 0; k < 2; ++k) \
        { if constexpr (I8) acc[ai][bj][m][n] = __builtin_bit_cast(acc_t, __builtin_amdgcn_mfma_i32_16x16x64_i8(__builtin_bit_cast(i32x4, Bt[n][k]), __builtin_bit_cast(i32x4, At[m][k]), __builtin_bit_cast(i32x4, acc[ai][bj][m][n]), 0, 0, 0)); \
          else acc[ai][bj][m][n] = __builtin_bit_cast(acc_t, __builtin_amdgcn_mfma_f32_16x16x32_bf16(Bt[n][k], At[m][k], __builtin_bit_cast(f32x4, acc[ai][bj][m][n]), 0, 0, 0)); } __builtin_amdgcn_s_setprio(0); } while (0)
#define PG8_WAIT_V(n) asm volatile("s_waitcnt vmcnt(" #n ")" ::: "memory")
#define PG8_WAIT_L(n) asm volatile("s_waitcnt lgkmcnt(" #n ")" ::: "memory")
#define PG8_BAR __builtin_amdgcn_s_barrier()
#define PG8_SCHED __builtin_amdgcn_sched_barrier(0)
    Unit cur, nxt; int ui = 0;
    if (!S.next(0, cur)) return;
    typedef typename AccSel<I8>::type acc_t; const acc_t acc_zero = {};
    acc_t acc[2][2][4][2];
#pragma unroll
    for (int a = 0; a < 2; ++a)
#pragma unroll
        for (int b = 0; b < 2; ++b)
#pragma unroll
            for (int m = 0; m < 4; ++m)
#pragma unroll
                for (int n = 0; n < 2; ++n) acc[a][b][m][n] = acc_zero;
    bf16x8 At[4][2], B0[2][2], B1[2][2];
    const char* cA = (const char*)g.A + (size_t)cur.pm * tstep; const char* cB = (const char*)g.Bt + (size_t)cur.pn * tstep;
    S.a_ready(cur);
    if constexpr (SP2) {
        PG8_STAGE(PG8_SB(0, 0), cB, voffB); PG8_STAGE(PG8_SB(0, 1), cB + hstep, voffB); PG8_STAGE(PG8_SA(0, 0), cA, voffA); PG8_STAGE(PG8_SA(0, 1), cA + hstep, voffA);
        if (wr == 1) PG8_BAR;
        PG8_WAIT_V(2); PG8_BAR;
        PG8_STAGE(PG8_SB(1, 0), cB + kstep, voffB); PG8_STAGE(PG8_SA(1, 0), cA + kstep, voffA); PG8_STAGE(PG8_SB(1, 1), cB + hstep + kstep, voffB);
        PG8_WAIT_V(6); PG8_BAR;
    } else {
        PG8_STAGE(PG8_SB(0, 0), cB, voffB); PG8_STAGE(PG8_SA(0, 0), cA, voffA); PG8_STAGE(PG8_SB(0, 1), cB + hstep, voffB); PG8_STAGE(PG8_SA(0, 1), cA + hstep, voffA);
        if (wr == 1) PG8_BAR;
        PG8_WAIT_V(4); PG8_BAR;
        PG8_STAGE(PG8_SB(1, 0), cB + kstep, voffB); PG8_STAGE(PG8_SA(1, 0), cA + kstep, voffA); PG8_STAGE(PG8_SB(1, 1), cB + hstep + kstep, voffB);
        PG8_WAIT_V(6); PG8_BAR;
    }
    for (;;) {
        const bool has_next = S.next(ui + 1, nxt);
        const char* nA = has_next ? (const char*)g.A + (size_t)nxt.pm * tstep : cA; const char* nB = has_next ? (const char*)g.Bt + (size_t)nxt.pn * tstep : cB;
        for (int t = 0; t < nt; t += 2) {
            const bool last = (t == nt - 2);
            const char* a1 = cA + (size_t)(t + 1) * kstep;
            const char* a2 = last ? nA : cA + (size_t)(t + 2) * kstep; const char* b2 = last ? nB : cB + (size_t)(t + 2) * kstep;
            const char* a3 = a2 + kstep; const char* b3 = b2 + kstep;
            if (last && has_next) S.a_ready(nxt);
            if constexpr (SP2) {
            PG8_LDB(B0, 0, 0); PG8_LDB(B1, 0, 1); PG8_SCHED; PG8_LDA(At, 0, 0); PG8_STAGE(PG8_SA(1, 1), a1 + hstep, voffA);
            PG8_WAIT_V(8); PG8_WAIT_L(0); PG8_BAR; PG8_MMA(0, 0, At, B0); PG8_MMA(0, 1, At, B1); PG8_BAR; PG8_SCHED;
            PG8_LDA(At, 0, 1); PG8_STAGE(PG8_SB(0, 0), b2, voffB); PG8_STAGE(PG8_SB(0, 1), b2 + hstep, voffB); PG8_STAGE(PG8_SA(0, 0), a2, voffA);
            PG8_WAIT_V(8); PG8_WAIT_L(0); PG8_BAR; PG8_MMA(1, 0, At, B0); PG8_MMA(1, 1, At, B1); PG8_BAR; PG8_SCHED;
            PG8_LDB(B0, 1, 0); PG8_LDB(B1, 1, 1); PG8_SCHED; PG8_LDA(At, 1, 0); PG8_STAGE(PG8_SA(0, 1), a2 + hstep, voffA);
            PG8_WAIT_V(8); PG8_WAIT_L(0); PG8_BAR; PG8_MMA(0, 0, At, B0); PG8_MMA(0, 1, At, B1); PG8_BAR; PG8_SCHED;
            PG8_LDA(At, 1, 1); PG8_STAGE(PG8_SB(1, 0), b3, voffB); PG8_STAGE(PG8_SB(1, 1), b3 + hstep, voffB); PG8_STAGE(PG8_SA(1, 0), a3, voffA);
            PG8_WAIT_V(8); PG8_WAIT_L(0); PG8_BAR; PG8_MMA(1, 0, At, B0); PG8_MMA(1, 1, At, B1); PG8_BAR; PG8_SCHED;
            } else {
            PG8_LDB(B0, 0, 0); PG8_SCHED; PG8_LDA(At, 0, 0); PG8_STAGE(PG8_SA(1, 1), a1 + hstep, voffA);
            PG8_WAIT_L(8); PG8_BAR; PG8_WAIT_L(0); PG8_MMA(0, 0, At, B0); PG8_BAR; PG8_SCHED;
            PG8_LDB(B1, 0, 1); PG8_STAGE(PG8_SB(0, 0), b2, voffB);
            PG8_BAR; PG8_WAIT_L(0); PG8_MMA(0, 1, At, B1); PG8_BAR;
            PG8_LDA(At, 0, 1); PG8_STAGE(PG8_SA(0, 0), a2, voffA);
            PG8_BAR; PG8_WAIT_L(0); PG8_MMA(1, 0, At, B0); PG8_BAR; PG8_SCHED;
            PG8_STAGE(PG8_SB(0, 1), b2 + hstep, voffB);
            PG8_WAIT_V(6); PG8_BAR; PG8_MMA(1, 1, At, B1); PG8_BAR;
            PG8_LDB(B0, 1, 0); PG8_SCHED; PG8_LDA(At, 1, 0); PG8_STAGE(PG8_SA(0, 1), a2 + hstep, voffA);
            PG8_WAIT_L(8); PG8_BAR; PG8_WAIT_L(0); PG8_MMA(0, 0, At, B0); PG8_BAR; PG8_SCHED;
            PG8_LDB(B1, 1, 1); PG8_STAGE(PG8_SB(1, 0), b3, voffB);
            PG8_BAR; PG8_WAIT_L(0); PG8_MMA(0, 1, At, B1); PG8_BAR;
            PG8_LDA(At, 1, 1); PG8_STAGE(PG8_SA(1, 0), a3, voffA);
            PG8_BAR; PG8_WAIT_L(0); PG8_MMA(1, 0, At, B0); PG8_BAR; PG8_SCHED;
            PG8_STAGE(PG8_SB(1, 1), b3 + hstep, voffB);
            PG8_WAIT_V(6); PG8_BAR; PG8_MMA(1, 1, At, B1); PG8_BAR;
            }
        }
        if constexpr (ALIGN_EPI) { if (wr == 0) PG8_BAR; }
        if constexpr (!Epi::AFTER_DRAIN) { E(acc, cur, wr, wc, fr, fq); S.done(cur); }
        if (!has_next) break;
#pragma unroll
        for (int a = 0; a < 2; ++a)
#pragma unroll
            for (int b = 0; b < 2; ++b)
#pragma unroll
                for (int m = 0; m < 4; ++m)
#pragma unroll
                    for (int n = 0; n < 2; ++n) acc[a][b][m][n] = acc_zero;
        cur = nxt; cA = nA; cB = nB; ++ui;
        if constexpr (ALIGN_EPI) { if (wr == 1) PG8_BAR; }
    }
    PG8_WAIT_V(0);
    if constexpr (!ALIGN_EPI) { if (wr == 0) PG8_BAR; }
    PG8_BAR;
    if constexpr (Epi::AFTER_DRAIN) { E.fused(acc, cur, wr, wc, fr, fq, lds, wid, lane); S.done(cur); }
#undef PG8_SA
#undef PG8_SB
#undef PG8_STAGE
#undef PG8_LDA
#undef PG8_LDB
#undef PG8_MMA
#undef PG8_WAIT_V
#undef PG8_WAIT_L
#undef PG8_BAR
#undef PG8_SCHED
}
}
#define GAS __attribute__((address_space(1)))
#define LAS __attribute__((address_space(3)))
typedef unsigned short bf16;
typedef unsigned v4u __attribute__((ext_vector_type(4)));
typedef float f32x4 __attribute__((ext_vector_type(4)));
typedef short bf16x8 __attribute__((ext_vector_type(8)));
typedef GAS unsigned gu32;
typedef GAS unsigned long long gu64;
#define RLX_AGENT __ATOMIC_RELAXED, __HIP_MEMORY_SCOPE_AGENT
#define LDS_WAIT() asm volatile("s_waitcnt lgkmcnt(0)" ::: "memory")
#define VM_WAIT() asm volatile("s_waitcnt vmcnt(0)" ::: "memory")
__device__ __forceinline__ unsigned long long rt() { return __builtin_amdgcn_s_memrealtime(); }
__device__ __forceinline__ unsigned f2bf(float f) { unsigned u = __builtin_bit_cast(unsigned, f); return (u + 0x7fffu + ((u >> 16) & 1u)) >> 16; }
typedef float pk2_f32x2 __attribute__((ext_vector_type(2))); typedef __bf16 pk2_bf16x2 __attribute__((ext_vector_type(2)));
__device__ __forceinline__ unsigned pk2(float lo, float hi) { const pk2_f32x2 v = {lo, hi}; return __builtin_bit_cast(unsigned, __builtin_convertvector(v, pk2_bf16x2)); }

#define XB_TMO      128
#define XB_XCNT(j)  (256  + 64 * (j))
#define XB_XSUB(j)  (1280 + 64 * (j))
#define XB_XGEN(j)  (2304 + 64 * (j))
#define XB_TOP      3328
#define XB_TOPGEN   3392
#define XCD_BAR_WORDS 3456
#define XB_SPIN_CAP (1u << 18)

__device__ __forceinline__ unsigned xb_ld(unsigned* p)              { return __hip_atomic_load(p, __ATOMIC_RELAXED, __HIP_MEMORY_SCOPE_AGENT); }
__device__ __forceinline__ unsigned xb_add(unsigned* p, unsigned v) { return __hip_atomic_fetch_add(p, v, __ATOMIC_RELAXED, __HIP_MEMORY_SCOPE_AGENT); }
__device__ __forceinline__ unsigned xb_xcc_id() { return (unsigned)__builtin_amdgcn_s_getreg((3 << 11) | 20) & 0xFu; }
#define XB_SPIN(cond, bar) do { unsigned _sp = 0; while (cond) { __builtin_amdgcn_s_sleep(1); \
    if ((++_sp & 255u) == 0u) { if (xb_ld(&(bar)[XB_TMO])) break; if (_sp > XB_SPIN_CAP) { atomicAdd(&(bar)[XB_TMO], 1u); break; } } } } while (0)

struct XcdBarrier {
    unsigned* bar; unsigned x;
    volatile LAS unsigned* st;
};

__device__ __forceinline__ XcdBarrier xcd_barrier_post(unsigned* bar, volatile LAS unsigned* st) {
    XcdBarrier b; b.bar = bar; b.x = xb_xcc_id(); b.st = st;
    if (threadIdx.x == 0) (void)xb_add(&bar[XB_XCNT(b.x)], 1u);
    return b;
}
__device__ __forceinline__ void xcd_barrier_complete(unsigned* bar, unsigned x, unsigned& nloc, unsigned& nx) {
    const unsigned G = gridDim.x * gridDim.y * gridDim.z;
    unsigned sum, cnt, mine, sp = 0u;
    for (;;) {
        sum = 0u; cnt = 0u; mine = 0u;
#pragma unroll
        for (unsigned j = 0; j < 16; ++j) { const unsigned c = xb_ld(&bar[XB_XCNT(j)]); sum += c; cnt += (c > 0u) ? 1u : 0u; mine = (j == x) ? c : mine; }
        if (sum == G) break;
        __builtin_amdgcn_s_sleep(1);
        if ((++sp & 255u) == 0u) { if (xb_ld(&bar[XB_TMO])) break; if (sp > XB_SPIN_CAP) { atomicAdd(&bar[XB_TMO], 1u); break; } }
    }
    nloc = mine > 0u ? mine : 1u; nx = cnt > 0u ? cnt : 1u;
}

__device__ __forceinline__ void xcd_barrier(const XcdBarrier& b) {
    asm volatile("s_waitcnt vmcnt(0)" ::: "memory");
    __syncthreads();
    if (threadIdx.x == 0) {
        unsigned* bar = b.bar;
        __builtin_amdgcn_s_waitcnt(0);
        unsigned nloc = b.st[0], nx = b.st[1];
        if (nloc == 0u) { xcd_barrier_complete(bar, b.x, nloc, nx); b.st[0] = nloc; b.st[1] = nx; }
        const unsigned old = xb_add(&bar[XB_XSUB(b.x)], 1u);
        const unsigned gen = old / nloc;
        if (old + 1u == (gen + 1u) * nloc) {
            __builtin_amdgcn_fence(__ATOMIC_RELEASE, "agent");
            asm volatile("s_waitcnt vmcnt(0)" ::: "memory");
            const unsigned og = xb_add(&bar[XB_TOP], 1u);
            const unsigned tg = og / nx;
            if (og + 1u == (tg + 1u) * nx) xb_add(&bar[XB_TOPGEN], 1u);
            else XB_SPIN(xb_ld(&bar[XB_TOPGEN]) == tg, bar);
            __builtin_amdgcn_fence(__ATOMIC_ACQUIRE, "agent");
            xb_add(&bar[XB_XGEN(b.x)], 1u);
            asm volatile("s_waitcnt vmcnt(0)" ::: "memory");
        } else {
            XB_SPIN(xb_ld(&bar[XB_XGEN(b.x)]) == gen, bar);
            __builtin_amdgcn_fence(__ATOMIC_ACQUIRE, "agent");
            asm volatile("s_waitcnt vmcnt(0)" ::: "memory");
        }
    }
    __syncthreads();
}
#ifndef MK_ONE_LAUNCH
#define MK_ONE_LAUNCH 1
#endif
constexpr int NWAVES = 8;
constexpr int NB = 8, SEQ = 4096, DM = 1024, NTOK = NB * SEQ;
constexpr int INW = 3592, INP = 3584;
constexpr float EPS = 1e-6f;
constexpr size_t MiB = 1u << 20;
constexpr size_t WS_CTL = 0, CTL_ZERO_BYTES = 1 * MiB;
constexpr size_t WS_MOD = 1 * MiB;
constexpr size_t WS_LF = 2 * MiB, WS_LI = WS_LF + 512 * 1024;
constexpr size_t WS_FC = 3 * MiB;
constexpr size_t WS_WIN = 4 * MiB, WS_WOUT0 = 11 * MiB, WS_WC0 = 13 * MiB, WS_WQKV = 17 * MiB, WS_WOUT1 = 23 * MiB, WS_WC1 = 25 * MiB;
constexpr size_t WS_H = 32 * MiB;
constexpr size_t WS_BIG = 96 * MiB;
constexpr size_t WS_IDS = 320 * MiB, WS_GATES = 336 * MiB;
constexpr size_t WS_END = 352 * MiB;
constexpr int CW_BAR = 4096;
constexpr int RING_BYTES = 131072, LDSCTL_OFF = RING_BYTES, MISC_OFF = LDSCTL_OFF + 320, LDS_BYTES = 147456;

__device__ __forceinline__ float wave_sum(float v) {
#pragma unroll
    for (int o = 1; o < 64; o <<= 1) v += __shfl_xor(v, o);
    return v;
}
__device__ __forceinline__ float wave_max(float v) {
#pragma unroll
    for (int o = 1; o < 64; o <<= 1) v = fmaxf(v, __shfl_xor(v, o));
    return v;
}
__device__ __forceinline__ float bf2f(unsigned short b) { return __uint_as_float((unsigned)b << 16); }
__device__ __forceinline__ float bflo(unsigned w) { return __uint_as_float(w << 16); }
__device__ __forceinline__ float bfhi(unsigned w) { return __uint_as_float(w & 0xffff0000u); }
__device__ __forceinline__ float sigmoidf_(float x) { return 1.f / (1.f + __expf(-x)); }
__device__ __forceinline__ float softplusf_(float x) { return fmaxf(x, 0.f) + __logf(1.f + __expf(-fabsf(x))); }
__device__ __forceinline__ float logsigmoidf_(float x) { return fminf(x, 0.f) - __logf(1.f + __expf(-fabsf(x))); }
__device__ __forceinline__ float gelu_exact(float x) { return 0.5f * x * (1.f + erff(x * 0.70710678118654752f)); }
__device__ __forceinline__ float gelu_as(float v) {
    const float av = fabsf(v), t = __builtin_amdgcn_rcpf(av * 0.2316418882f + 1.0f);
    float q = t * 0.5307027145f + (-0.7265760135f); q = q * t + 0.7107068705f; q = q * t + (-0.142248368f); q = q * t + 0.127414796f; q = q * t;
    const float e = __builtin_amdgcn_exp2f((v * v) * (-0.72134752044f));
    const float m = v * (q * e);
    return v < 0.f ? m : v - m;
}

struct Args { const float* in[30]; float* out; unsigned char* ws; int ph_lo, ph_hi; };

struct Ctx {
    LAS unsigned char* lds;
    int tid, lane, wave, G, bid;
    int gw, NGW;
    long gt, NGT;
};
template <bool BASE_BF16>
struct EpiResid {
    static constexpr bool PERM = true, AFTER_DRAIN = false;
    const void* base; bf16* out; const float* gate;
    __device__ __forceinline__ void operator()(const pg8::f32x4 (&acc)[2][2][4][2], const pg8::Unit& u, int wr, int wc, int fr, int fq) const {
        using pg8::f32x4;
        const int col0 = u.pn * 256 + wc * 32 + 8 * fq;
        const float* gp = gate + (size_t)((u.pm * 256) / SEQ) * 6144 + col0;
        f32x4 gv[2][2];
#pragma unroll
        for (int bj = 0; bj < 2; ++bj)
#pragma unroll
            for (int n = 0; n < 2; ++n) { gv[bj][n] = *(const f32x4*)(gp + bj * 128 + 4 * n); gv[bj][n] = gv[bj][n] + 1.0f; }
#pragma unroll
        for (int ai = 0; ai < 2; ++ai)
#pragma unroll
            for (int m = 0; m < 4; ++m) {
                const int r = ai * 128 + wr * 64 + m * 16 + fr; const size_t off = (size_t)(u.pm * 256 + r) * DM + col0;
#pragma unroll
                for (int bj = 0; bj < 2; ++bj) {
                    f32x4 b0, b1;
                    if (BASE_BF16) { const v4u w = *(const v4u*)((const bf16*)base + off + bj * 128); b0 = (f32x4){bflo(w.x), bfhi(w.x), bflo(w.y), bfhi(w.y)}; b1 = (f32x4){bflo(w.z), bfhi(w.z), bflo(w.w), bfhi(w.w)}; }
                    else { b0 = *(const f32x4*)((const float*)base + off + bj * 128); b1 = *(const f32x4*)((const float*)base + off + bj * 128 + 4); }
                    const f32x4 v0 = b0 + gv[bj][0] * acc[ai][bj][m][0], v1 = b1 + gv[bj][1] * acc[ai][bj][m][1];
                    v4u o; o.x = pk2(v0[0], v0[1]); o.y = pk2(v0[2], v0[3]); o.z = pk2(v1[0], v1[1]); o.w = pk2(v1[2], v1[3]);
                    *(v4u*)(out + off + bj * 128) = o;
                }
            }
    }
};

constexpr size_t WS_SA = WS_MOD + 768 * 1024;
constexpr size_t OUT_W8 = 96 * MiB;
constexpr size_t OUT_W8IN = OUT_W8, OUT_W8C0 = OUT_W8 + 4 * MiB, OUT_W8QKV = OUT_W8 + 6 * MiB, OUT_W8C1 = OUT_W8 + 9 * MiB, OUT_SW = OUT_W8 + 11 * MiB;
constexpr int SW_IN = 0, SW_C0 = 4096, SW_QKV = 8192, SW_C1 = 12288;
__device__ __forceinline__ void quantize_rows(const Ctx& C, const bf16* W, int N, unsigned char* W8, float* SW) {
    for (int n = C.gw; n < N; n += C.NGW) {
        const v4u w0 = *(const v4u*)(W + (size_t)n * DM + 16 * C.lane), w1 = *(const v4u*)(W + (size_t)n * DM + 16 * C.lane + 8);
        float x[16] = {bflo(w0.x), bfhi(w0.x), bflo(w0.y), bfhi(w0.y), bflo(w0.z), bfhi(w0.z), bflo(w0.w), bfhi(w0.w), bflo(w1.x), bfhi(w1.x), bflo(w1.y), bfhi(w1.y), bflo(w1.z), bfhi(w1.z), bflo(w1.w), bfhi(w1.w)};
        float am = 0.f;
#pragma unroll
        for (int i = 0; i < 16; ++i) am = fmaxf(am, fabsf(x[i]));
        am = fmaxf(wave_max(am), 1e-30f); const float qi = 127.f / am;
        v4u o;
#pragma unroll
        for (int q = 0; q < 4; ++q) { const int q0 = (int)rintf(x[4 * q] * qi), q1 = (int)rintf(x[4 * q + 1] * qi), q2 = (int)rintf(x[4 * q + 2] * qi), q3 = (int)rintf(x[4 * q + 3] * qi);
            o[q] = ((unsigned)q0 & 255u) | (((unsigned)q1 & 255u) << 8) | (((unsigned)q2 & 255u) << 16) | ((unsigned)q3 << 24); }
        *(v4u*)(W8 + (size_t)n * DM + 16 * C.lane) = o;
        if (C.lane == 0) SW[n] = am * (1.f / 127.f);
    }
}
struct EpiBf16I8 {
    static constexpr bool PERM = true, AFTER_DRAIN = false;
    bf16* O; int ldc; const float* sa; const float* sw;
    __device__ __forceinline__ void operator()(const pg8::i32x4 (&acc)[2][2][4][2], const pg8::Unit& u, int wr, int wc, int fr, int fq) const {
        using pg8::f32x4;
        const int col0 = u.pn * 256 + wc * 32 + 8 * fq;
        f32x4 cs[2][2];
#pragma unroll
        for (int bj = 0; bj < 2; ++bj)
#pragma unroll
            for (int n = 0; n < 2; ++n) cs[bj][n] = *(const f32x4*)(sw + col0 + bj * 128 + 4 * n);
#pragma unroll
        for (int ai = 0; ai < 2; ++ai)
#pragma unroll
            for (int m = 0; m < 4; ++m) { const int row = u.pm * 256 + ai * 128 + wr * 64 + m * 16 + fr; const float rs = sa[row];
                bf16* rowp = O + (size_t)row * ldc + col0;
#pragma unroll
                for (int bj = 0; bj < 2; ++bj) { const pg8::i32x4 a0 = acc[ai][bj][m][0], a1 = acc[ai][bj][m][1];
                    v4u w; w.x = pk2((float)a0[0] * rs * cs[bj][0][0], (float)a0[1] * rs * cs[bj][0][1]); w.y = pk2((float)a0[2] * rs * cs[bj][0][2], (float)a0[3] * rs * cs[bj][0][3]);
                    w.z = pk2((float)a1[0] * rs * cs[bj][1][0], (float)a1[1] * rs * cs[bj][1][1]); w.w = pk2((float)a1[2] * rs * cs[bj][1][2], (float)a1[3] * rs * cs[bj][1][3]);
                    *(v4u*)(rowp + bj * 128) = w; } }
    }
};

__device__ __forceinline__ void transpose_item(const float* W, int ldw, int src_col0, bf16* WT, int K, int dst_row0, int k0, LAS float* scr, int lane) {
#pragma unroll 8
    for (int i = 0; i < 32; ++i) { const int kk = 2 * i + (lane >> 5); scr[kk * 33 + (lane & 31)] = W[(size_t)(k0 + kk) * ldw + src_col0 + (lane & 31)]; }
    LDS_WAIT(); asm volatile("" ::: "memory");
    const int c = lane & 7;
#pragma unroll
    for (int j = 0; j < 4; ++j) { const int n = (lane >> 3) + 8 * j; const LAS float* s = scr + (8 * c) * 33 + n;
        v4u o; o.x = pk2(s[0 * 33], s[1 * 33]); o.y = pk2(s[2 * 33], s[3 * 33]); o.z = pk2(s[4 * 33], s[5 * 33]); o.w = pk2(s[6 * 33], s[7 * 33]);
        *(GAS v4u*)(WT + (size_t)(dst_row0 + n) * K + k0 + 8 * c) = o; }
    LDS_WAIT(); asm volatile("" ::: "memory");
}

__device__ __forceinline__ void phase_prep(const Ctx& C, const Args& A) {
    unsigned char* ws = A.ws;
    {
        LAS float* scr = (LAS float*)(C.lds + C.wave * 16384);
        constexpr int I_IN = 16 * (INP / 32), I_O = 16 * 32, I_QKV = 16 * 96;
        constexpr int NIT = I_IN + I_O + I_QKV + I_O;
        for (int it = C.gw; it < NIT; it += C.NGW) {
            int r = it;
            if (r < I_IN) { const int kb = r / (INP / 32), nb = r % (INP / 32); const int dst = nb * 32, src = dst + (dst >= 2048 ? 8 : 0);
                transpose_item(A.in[5], INW, src, (bf16*)(ws + WS_WIN), 1024, dst, kb * 64, scr, C.lane); continue; } r -= I_IN;
            if (r < I_O) { const int kb = r / 32, nb = r % 32; transpose_item(A.in[10], 1024, nb * 32, (bf16*)(ws + WS_WOUT0), 1024, nb * 32, kb * 64, scr, C.lane); continue; } r -= I_O;
            if (r < I_QKV) { const int kb = r / 96, nb = r % 96; const int src = (nb >> 3) * 256 + 64 * (nb & 3) + 32 * ((nb >> 2) & 1);
                transpose_item(A.in[20], 3072, src, (bf16*)(ws + WS_WQKV), 1024, nb * 32, kb * 64, scr, C.lane); continue; } r -= I_QKV;
            { const int kb = r / 32, nb = r % 32; transpose_item(A.in[23], 1024, nb * 32, (bf16*)(ws + WS_WOUT1), 1024, nb * 32, kb * 64, scr, C.lane); }
        }
    }
    {
        LAS float* sc = (LAS float*)C.lds;
        LAS float* red = (LAS float*)(C.lds + 32768);
        if (C.bid < 96) {
            __syncthreads();
            for (int i = C.tid; i < NB * DM; i += NWAVES * 64) { const float v = A.in[1][i]; sc[i] = v / (1.f + __expf(-v)); }
            __syncthreads();
            for (int item = C.bid; item < 96; item += C.G) {
                const int l = item / 48, jc = item % 48;
                const float* W = A.in[l ? 17 : 2] + 128 * jc + 2 * C.lane;
                float a0[NB], a1[NB];
#pragma unroll
                for (int b = 0; b < NB; ++b) a0[b] = a1[b] = 0.f;
#pragma unroll 32
                for (int kk = 0; kk < 128; ++kk) { const int k = 128 * C.wave + kk; const float2 w = *(const float2*)(W + (size_t)k * 6144);
#pragma unroll
                    for (int b = 0; b < NB; ++b) { const float s = sc[b * DM + k]; a0[b] += s * w.x; a1[b] += s * w.y; } }
#pragma unroll
                for (int b = 0; b < NB; ++b) { red[(C.wave * NB + b) * 128 + 2 * C.lane] = a0[b]; red[(C.wave * NB + b) * 128 + 2 * C.lane + 1] = a1[b]; }
                __syncthreads();
                float* mod = (float*)(ws + WS_MOD);
                for (int o = C.tid; o < NB * 128; o += NWAVES * 64) { const int b = o >> 7, j = o & 127; float s = A.in[l ? 18 : 3][128 * jc + j];
#pragma unroll
                    for (int w = 0; w < NWAVES; ++w) s += red[(w * NB + b) * 128 + j];
                    mod[(size_t)(l * NB + b) * 6144 + 128 * jc + j] = s; }
                __syncthreads();
            }
        }
    }
    {
        LAS float* kt = (LAS float*)C.lds;
        LAS float* wt = (LAS float*)(C.lds + 128 * 132 * 4);
        for (int item = C.bid; item < 512; item += C.G) {
            const int l = item >> 8, hh = (item >> 4) & 15, kb = item & 15;
            const float* Wq = A.in[l ? 25 : 12]; const float* Kh = A.in[l ? ((hh & 1) ? 27 : 26) : ((hh & 1) ? 14 : 13)];
            bf16* Wc = (bf16*)(ws + (l ? WS_WC1 : WS_WC0));
            __syncthreads();
#pragma unroll
            for (int i = 0; i < 8; ++i) { const int id = C.tid + 512 * i, row = id >> 5, c4 = id & 31; *(LAS f32x4*)(kt + row * 132 + 4 * c4) = *(const f32x4*)(Kh + row * 128 + 4 * c4); }
#pragma unroll
            for (int i = 0; i < 4; ++i) { const int id = C.tid + 512 * i, row = id >> 5, c4 = id & 31; *(LAS f32x4*)(wt + row * 132 + 4 * c4) = *(const f32x4*)(Wq + (size_t)(kb * 64 + row) * 2048 + hh * 128 + 4 * c4); }
            __syncthreads();
            const int key = C.tid & 127, kg = C.tid >> 7;
            float acc[16];
#pragma unroll
            for (int i = 0; i < 16; ++i) acc[i] = 0.f;
#pragma unroll 2
            for (int d4 = 0; d4 < 32; ++d4) { const f32x4 kv = *(const LAS f32x4*)(kt + key * 132 + 4 * d4);
#pragma unroll
                for (int i = 0; i < 16; ++i) { const f32x4 wv = *(const LAS f32x4*)(wt + (kg * 16 + i) * 132 + 4 * d4); acc[i] += (kv.x * wv.x + kv.y * wv.y) + (kv.z * wv.z + kv.w * wv.w); } }
            v4u o0, o1; o0.x = pk2(acc[0], acc[1]); o0.y = pk2(acc[2], acc[3]); o0.z = pk2(acc[4], acc[5]); o0.w = pk2(acc[6], acc[7]);
            o1.x = pk2(acc[8], acc[9]); o1.y = pk2(acc[10], acc[11]); o1.z = pk2(acc[12], acc[13]); o1.w = pk2(acc[14], acc[15]);
            bf16* dst = Wc + (size_t)(hh * 128 + key) * 1024 + kb * 64 + kg * 16;
            *(v4u*)dst = o0; *(v4u*)(dst + 8) = o1;
        }
        __syncthreads();
    }
}

template <bool GATES, bool IN_BF16, bool OUT_I8 = false>
__device__ __forceinline__ void phase_rowpass(const Ctx& C, const Args& A, const void* xin, const float* gain, const float* modl  , int ch_shift, int ch_scale, bf16* hout, float* sa = nullptr) {
    f32x4 wg0[GATES ? 16 : 1], wg1[GATES ? 16 : 1];
    if (GATES) {
        const float* Wg = A.in[5] + 2048;
#pragma unroll
        for (int j = 0; j < 4; ++j)
#pragma unroll
            for (int e = 0; e < 4; ++e) { const int k = 4 * C.lane + 256 * j + e; wg0[4 * j + e] = *(const f32x4*)(Wg + (size_t)k * INW); wg1[4 * j + e] = *(const f32x4*)(Wg + (size_t)k * INW + 4); }
    }
    for (int row = C.gw; row < NTOK; row += C.NGW) {
        const int b = row >> 12;
        f32x4 v[4]; float ss = 0.f;
#pragma unroll
        for (int j = 0; j < 4; ++j) {
            if (IN_BF16) { const uint2 w = *(const uint2*)((const bf16*)xin + (size_t)row * DM + 4 * C.lane + 256 * j); v[j] = (f32x4){bflo(w.x), bfhi(w.x), bflo(w.y), bfhi(w.y)}; }
            else v[j] = *(const f32x4*)((const float*)xin + (size_t)row * DM + 4 * C.lane + 256 * j);
            ss += v[j].x * v[j].x + v[j].y * v[j].y + v[j].z * v[j].z + v[j].w * v[j].w; }
        const float rstd = rsqrtf(wave_sum(ss) * (1.f / DM) + EPS);
        const float* shp = modl + (size_t)b * 6144 + ch_shift * 1024 + 4 * C.lane; const float* scp = modl + (size_t)b * 6144 + ch_scale * 1024 + 4 * C.lane;
        f32x4 h[4];
#pragma unroll
        for (int j = 0; j < 4; ++j) { const f32x4 g = *(const f32x4*)(gain + 4 * C.lane + 256 * j), sc = *(const f32x4*)(scp + 256 * j), sh = *(const f32x4*)(shp + 256 * j);
            h[j] = v[j] * rstd * g * (sc + 1.0f) + sh;
            if (!OUT_I8) { uint2 o; o.x = pk2(h[j].x, h[j].y); o.y = pk2(h[j].z, h[j].w);
                *(uint2*)(hout + (size_t)row * DM + 4 * C.lane + 256 * j) = o; } }
        if (OUT_I8) {
            float am = 0.f;
#pragma unroll
            for (int j = 0; j < 4; ++j) am = fmaxf(am, fmaxf(fmaxf(fabsf(h[j].x), fabsf(h[j].y)), fmaxf(fabsf(h[j].z), fabsf(h[j].w))));
            am = fmaxf(wave_max(am), 1e-20f); const float qi = 127.f / am;
            unsigned char* h8 = (unsigned char*)hout + (size_t)row * DM + 4 * C.lane;
#pragma unroll
            for (int j = 0; j < 4; ++j) { const int q0 = (int)rintf(h[j].x * qi), q1 = (int)rintf(h[j].y * qi), q2 = (int)rintf(h[j].z * qi), q3 = (int)rintf(h[j].w * qi);
                *(unsigned*)(h8 + 256 * j) = ((unsigned)q0 & 255u) | (((unsigned)q1 & 255u) << 8) | (((unsigned)q2 & 255u) << 16) | ((unsigned)q3 << 24); }
            if (C.lane == 0) sa[row] = am * (1.f / 127.f);
        }
        if (GATES) {
            f32x4 d0 = {0.f, 0.f, 0.f, 0.f}, d1 = {0.f, 0.f, 0.f, 0.f};
#pragma unroll
            for (int j = 0; j < 4; ++j)
#pragma unroll
                for (int e = 0; e < 4; ++e) { const float hv = h[j][e]; d0 += wg0[4 * j + e] * hv; d1 += wg1[4 * j + e] * hv; }
            float d[8] = {d0.x, d0.y, d0.z, d0.w, d1.x, d1.y, d1.z, d1.w};
#pragma unroll
            for (int q = 0; q < 8; ++q) d[q] = wave_sum(d[q]);
            if (C.lane == 0) {
                const int s = row & (SEQ - 1); float* LF = (float*)(A.ws + WS_LF); float* LI = (float*)(A.ws + WS_LI);
#pragma unroll
                for (int hh = 0; hh < 4; ++hh) { LI[(size_t)(b * 4 + hh) * SEQ + s] = d[hh] + A.in[6][hh]; LF[(size_t)(b * 4 + hh) * SEQ + s] = logsigmoidf_(d[4 + hh] + A.in[7][hh]); }
            }
        }
    }
}

__device__ __forceinline__ void phase_conv(const Ctx& C, const Args& A) {
    const bf16* P = (const bf16*)(A.ws + WS_BIG); bf16* mix = (bf16*)(A.ws + WS_H); const float* cw = A.in[8];
    for (long it = C.gt; it < (long)NTOK * 64; it += C.NGT) {
        const int cg = (int)(it & 63), tok = (int)(it >> 6), t = tok & (SEQ - 1), c0 = cg * 8;
        float conv[8];
#pragma unroll
        for (int e = 0; e < 8; ++e) conv[e] = 0.f;
#pragma unroll
        for (int k = 0; k < 3; ++k) {
            const int dt = 2 - k;
            if (t - dt >= 0) {
                const bf16* r = P + (size_t)(tok - dt) * INP;
                const v4u cc = *(const v4u*)(r + 2560 + c0), chv = *(const v4u*)(r + 3072 + c0);
                const f32x4 w0 = *(const f32x4*)(cw + k * 512 + c0), w1 = *(const f32x4*)(cw + k * 512 + c0 + 4);
                conv[0] += w0.x * bflo(cc.x) * bflo(chv.x); conv[1] += w0.y * bfhi(cc.x) * bfhi(chv.x);
                conv[2] += w0.z * bflo(cc.y) * bflo(chv.y); conv[3] += w0.w * bfhi(cc.y) * bfhi(chv.y);
                conv[4] += w1.x * bflo(cc.z) * bflo(chv.z); conv[5] += w1.y * bfhi(cc.z) * bfhi(chv.z);
                conv[6] += w1.z * bflo(cc.w) * bflo(chv.w); conv[7] += w1.w * bfhi(cc.w) * bfhi(chv.w);
            }
        }
        const v4u cb = *(const v4u*)(P + (size_t)tok * INP + 2048 + c0);
        v4u o; o.x = pk2(conv[0] * bflo(cb.x), conv[1] * bfhi(cb.x)); o.y = pk2(conv[2] * bflo(cb.y), conv[3] * bfhi(cb.y));
        o.z = pk2(conv[4] * bflo(cb.z), conv[5] * bfhi(cb.z)); o.w = pk2(conv[6] * bflo(cb.w), conv[7] * bfhi(cb.w));
        *(v4u*)(mix + (size_t)tok * DM + 512 + c0) = o;
    }
}
constexpr size_t WS_TAB = 352 * MiB;
constexpr size_t TAB_BYTES = (size_t)16384 * 1024;
constexpr size_t WS_TSC = WS_TAB + 4 * TAB_BYTES;
constexpr size_t WS_XB = 420 * MiB;
constexpr size_t WS_END2 = WS_XB + 64 * MiB;
typedef float f32x2 __attribute__((ext_vector_type(2)));
typedef __bf16 bf16x2_t __attribute__((ext_vector_type(2)));
typedef unsigned u32x2 __attribute__((ext_vector_type(2)));
__device__ __forceinline__ float dot2bf(unsigned a, unsigned b, float c) { return __builtin_amdgcn_fdot2_f32_bf16(__builtin_bit_cast(bf16x2_t, a), __builtin_bit_cast(bf16x2_t, b), c, false); }
template <int CTRL> __device__ __forceinline__ unsigned dppu(unsigned v) { return (unsigned)__builtin_amdgcn_update_dpp(0, (int)v, CTRL, 0xF, 0xF, true); }
__device__ __forceinline__ float wave_sum_dpp(float v) {
    v += __uint_as_float(dppu<0xB1>(__float_as_uint(v)));
    v += __uint_as_float(dppu<0x4E>(__float_as_uint(v)));
    v += __uint_as_float(dppu<0x124>(__float_as_uint(v)));
    v += __uint_as_float(dppu<0x128>(__float_as_uint(v)));
    const unsigned u = __float_as_uint(v);
    return (__uint_as_float(__builtin_amdgcn_readlane(u, 0)) + __uint_as_float(__builtin_amdgcn_readlane(u, 16))) + (__uint_as_float(__builtin_amdgcn_readlane(u, 32)) + __uint_as_float(__builtin_amdgcn_readlane(u, 48)));
}
__device__ __forceinline__ void ins16(unsigned (&val)[16], unsigned k) {
#pragma unroll
    for (int j = 0; j < 16; ++j) { const unsigned t = val[j] < k ? val[j] : k; val[j] = val[j] < k ? k : val[j]; k = t; }
}
#define PEER_CE(x, i, l) { const unsigned a_ = x[i] < x[l] ? x[l] : x[i], b_ = x[i] < x[l] ? x[i] : x[l]; x[i] = a_; x[l] = b_; }
__device__ __forceinline__ void sort16_desc(unsigned (&x)[16]) {
#pragma unroll
    for (int k = 2; k <= 16; k <<= 1)
#pragma unroll
        for (int j = k >> 1; j > 0; j >>= 1)
#pragma unroll
            for (int i = 0; i < 16; ++i) { const int l = i ^ j; if (l > i) { if ((i & k) == 0) { PEER_CE(x, i, l) } else { PEER_CE(x, l, i) } } }
}
__device__ __forceinline__ void merge16_desc(unsigned (&v)[16], const unsigned (&s)[16]) {
#pragma unroll
    for (int i = 0; i < 16; ++i) v[i] = v[i] < s[15 - i] ? s[15 - i] : v[i];
#pragma unroll
    for (int j = 8; j > 0; j >>= 1)
#pragma unroll
        for (int i = 0; i < 16; ++i) { const int l = i ^ j; if (l > i) PEER_CE(v, i, l) }
}
__device__ __forceinline__ unsigned ord32(unsigned b) { return b ^ ((unsigned)((int)b >> 31) | 0x80000000u); }
__device__ __forceinline__ float unord(unsigned o, unsigned mask) { o &= mask; return __uint_as_float((o & 0x80000000u) ? (o ^ 0x80000000u) : (~o & mask)); }

template <bool NEXT, int DRY = 0>
__device__ __forceinline__ void phase_peer(const Ctx& C, const Args& A, const unsigned char* Utab, const unsigned char* Vtab, const float* SU, const float* SV, const float* g2  ,
                                           const float* ngain, const float* nmod  , const XcdBarrier& bar) {
    const bf16* SC = (const bf16*)(A.ws + WS_BIG); bf16* Hb = (bf16*)(A.ws + WS_H);
#ifndef PEER_NBK
#define PEER_NBK 32
#endif
    constexpr int NBK = PEER_NBK, BSH = (NBK == 32 ? 9 : NBK == 64 ? 8 : 7), BPL = NBK / 16;
    LAS unsigned char* wb = C.lds + C.wave * (1024 + 32 * NBK + 8192);
    LAS unsigned char* IDXB = wb; LAS unsigned* CNT = (LAS unsigned*)(wb + 1024); LAS unsigned* PRE = (LAS unsigned*)(wb + 1024 + 16 * NBK); LAS v4u* ENT = (LAS v4u*)(wb + 1024 + 32 * NBK);
#ifndef PEER_SYNC_EVERY
#define PEER_SYNC_EVERY 32
#endif
    const bool wg_uniform = (DRY != 6) && ((NTOK / 4) % C.NGW == 0);
    unsigned flip = 0u;
#ifdef PEER_STAGGER
    if (C.wave >= 4) { const unsigned long long t0_ = __builtin_amdgcn_s_memrealtime(); while (__builtin_amdgcn_s_memrealtime() - t0_ < (unsigned long long)PEER_STAGGER) __builtin_amdgcn_s_sleep(16); }
#endif
    const int gw_ = (DRY == 6) ? ((C.bid >> 1) * NWAVES + C.wave) : C.gw, ngw_ = (DRY == 6) ? (C.NGW >> 1) : C.NGW;
    if (DRY == 6 && (C.bid & 1)) return;
    for (int tb = gw_; tb < NTOK / 4; tb += ngw_) {
        const int tok0 = tb * 4;
#if MK_ONE_LAUNCH && defined(PEER_SYNC)
        if (tb >= C.NGW) xcd_barrier(bar);
#endif
        int lane = C.lane; asm volatile("" : "+v"(lane));
        const int par = lane & 1, tl = lane >> 4, grp = lane & 15, head = grp >> 1, i16 = lane & 15;
        {
            unsigned val[16];
            const v4u* sp = (const v4u*)(SC + (size_t)(tok0 + tl) * 2048 + grp * 128);
            v4u raw[16];
#pragma unroll
            for (int c = 0; c < 16; ++c) raw[c] = sp[c];
#pragma unroll
            for (int c = 0; c < 16; c += 2) {
                const v4u c0 = raw[c], c1 = raw[c + 1];
                const unsigned ib = 127u - 8u * (unsigned)c;
                unsigned ks[16];
#pragma unroll
                for (int e = 0; e < 4; ++e) { ks[2 * e] = (ord32(c0[e] << 16) & 0xFFFF0000u) | (ib - 2u * e); ks[2 * e + 1] = (ord32(c0[e] & 0xFFFF0000u) & 0xFFFF0000u) | (ib - 2u * e - 1u);
                    ks[8 + 2 * e] = (ord32(c1[e] << 16) & 0xFFFF0000u) | (ib - 8u - 2u * e); ks[9 + 2 * e] = (ord32(c1[e] & 0xFFFF0000u) & 0xFFFF0000u) | (ib - 9u - 2u * e); }
                sort16_desc(ks);
                if (c == 0) {
#pragma unroll
                    for (int j = 0; j < 16; ++j) val[j] = ks[j];
                } else merge16_desc(val, ks);
            }
#pragma unroll
            for (int z = 0; z < NBK / 16; ++z) CNT[lane + 64 * z] = 0u;
            float X[16], Y[16];
            v4u ib4 = {0u, 0u, 0u, 0u};
#pragma unroll
            for (int j = 0; j < 16; ++j) { X[j] = unord(val[j], 0xFFFF0000u); Y[j] = unord(dppu<0xB1>(val[j]), 0xFFFF0000u); ib4[j >> 2] |= (127u - (val[j] & 127u)) << (8 * (j & 3)); }
            *(LAS v4u*)(IDXB + lane * 16) = ib4;
            unsigned cand[16], cb2[16];
            unsigned parv = (unsigned)par; asm volatile("" : "+v"(parv));
#define PEER_CKEY(p, q) ((((p) == (q)) && parv) ? 0u : ((ord32(__float_as_uint(X[p] + Y[q])) & 0xFFFFFF00u) | (255u - ((unsigned)((p) * 16 + (q)) + parv * (unsigned)(15 * ((q) - (p)))))))
            cand[0] = PEER_CKEY(0, 0); cand[1] = PEER_CKEY(0, 1); cand[2] = PEER_CKEY(0, 2); cand[3] = PEER_CKEY(0, 3); cand[4] = PEER_CKEY(0, 4); cand[5] = PEER_CKEY(0, 5); cand[6] = PEER_CKEY(0, 6); cand[7] = PEER_CKEY(0, 7);
            cand[8] = PEER_CKEY(0, 8); cand[9] = PEER_CKEY(0, 9); cand[10] = PEER_CKEY(0, 10); cand[11] = PEER_CKEY(0, 11); cand[12] = PEER_CKEY(0, 12); cand[13] = PEER_CKEY(0, 13); cand[14] = PEER_CKEY(0, 14); cand[15] = PEER_CKEY(0, 15);
            cb2[0] = PEER_CKEY(1, 1); cb2[1] = PEER_CKEY(1, 2); cb2[2] = PEER_CKEY(1, 3); cb2[3] = PEER_CKEY(1, 4); cb2[4] = PEER_CKEY(1, 5); cb2[5] = PEER_CKEY(1, 6); cb2[6] = PEER_CKEY(1, 7);
            cb2[7] = PEER_CKEY(2, 2); cb2[8] = PEER_CKEY(2, 3); cb2[9] = PEER_CKEY(2, 4); cb2[10] = PEER_CKEY(3, 3); cb2[11] = 0u; cb2[12] = 0u; cb2[13] = 0u; cb2[14] = 0u; cb2[15] = 0u;
#undef PEER_CKEY
            sort16_desc(cand); sort16_desc(cb2); merge16_desc(cand, cb2);
            unsigned mg[16]; float fv[16]; float mx = -INFINITY;
#pragma unroll
            for (int k = 0; k < 16; ++k) { const unsigned o = dppu<0xB1>(cand[15 - k]); mg[k] = cand[k] < o ? o : cand[k]; fv[k] = unord(mg[k], 0xFFFFFF00u); mx = fmaxf(mx, fv[k]); }
            float ssum = 0.f;
#pragma unroll
            for (int k = 0; k < 16; ++k) { fv[k] = __expf(fv[k] - mx); ssum += fv[k]; }
            const float inv = 1.f / ssum;
            asm volatile("s_waitcnt lgkmcnt(0)" ::: "memory");
            unsigned eid[8], rk[8]; float esu[8], egv[8];
#pragma unroll
            for (int k = 0; k < 8; ++k) { const unsigned fi = 255u - (mg[k] & 255u);
                const unsigned e1 = IDXB[(lane & ~1) * 16 + (fi >> 4)], e2 = IDXB[(lane | 1) * 16 + (fi & 15u)];
                eid[k] = e1 * 128u + e2;
                rk[k] = __hip_atomic_fetch_add(CNT + tl * NBK + (eid[k] >> BSH), 1u, __ATOMIC_RELAXED, __HIP_MEMORY_SCOPE_WORKGROUP);
                esu[k] = SU[eid[k]]; egv[k] = fv[k] * inv * SV[eid[k]]; }
            asm volatile("s_waitcnt lgkmcnt(0)" ::: "memory");
            { unsigned cb[BPL]; unsigned s = 0u;
#pragma unroll
              for (int z = 0; z < BPL; ++z) { cb[z] = CNT[tl * NBK + BPL * i16 + z]; s += cb[z]; }
              const unsigned tot = s;
              s += dppu<0x111>(s); s += dppu<0x112>(s); s += dppu<0x114>(s); s += dppu<0x118>(s);
              unsigned ex = s - tot;
#pragma unroll
              for (int z = 0; z < BPL; ++z) { PRE[tl * NBK + BPL * i16 + z] = ex; ex += cb[z]; } }
            asm volatile("s_waitcnt lgkmcnt(0)" ::: "memory");
#pragma unroll
            for (int k = 0; k < 8; ++k) { unsigned pos = PRE[tl * NBK + (eid[k] >> BSH)] + rk[k]; pos = flip ? 127u - pos : pos;
                ENT[tl * 128 + pos] = (v4u){eid[k], __float_as_uint(esu[k]), __float_as_uint(egv[k]), 0u}; }
            asm volatile("s_waitcnt lgkmcnt(0)" ::: "memory");
            flip ^= 1u;
        }
        if (wg_uniform) __syncthreads();
        if (DRY != 3) {
            const int tok = tok0 + tl; const int b = tok >> 12;
            LAS v4u* E = ENT + tl * 128;
            float cmax = 0.f;
            {
                unsigned hq[16]; const float hs = ((const float*)(A.ws + WS_SA))[tok];
#pragma unroll
                for (int j = 0; j < 4; ++j) { const v4u hw = *(const v4u*)(A.ws + WS_IDS + (size_t)tok * DM + 256 * j + 16 * i16); hq[4 * j] = hw.x; hq[4 * j + 1] = hw.y; hq[4 * j + 2] = hw.z; hq[4 * j + 3] = hw.w; }
                v4u B[8][4]; unsigned idr[8]; float mine = 0.f;
#define PEER_LOADI(R_, tab, id_) { const unsigned off = ((id_) & (DRY == 2 ? 1023u : 16383u)) * 1024u + 16u * (unsigned)i16; \
                _Pragma("unroll") for (int j = 0; j < 4; ++j) R_[j] = (DRY == 5 && j >= 2) ? R_[j - 2] : *(const v4u*)((tab) + off + 256 * j); }
#define PEER_DOTS(U_, t_) { int d0 = 0, d1 = 0, d2 = 0, d3 = 0; \
                _Pragma("unroll") for (int e = 0; e < 4; ++e) { d0 = __builtin_amdgcn_sdot4((int)U_[0][e], (int)hq[e], d0, false); d1 = __builtin_amdgcn_sdot4((int)U_[1][e], (int)hq[4 + e], d1, false); \
                    d2 = __builtin_amdgcn_sdot4((int)U_[2][e], (int)hq[8 + e], d2, false); d3 = __builtin_amdgcn_sdot4((int)U_[3][e], (int)hq[12 + e], d3, false); } \
                unsigned ds_ = (unsigned)((d0 + d1) + (d2 + d3)); ds_ += dppu<0xB1>(ds_); ds_ += dppu<0x4E>(ds_); ds_ += dppu<0x124>(ds_); ds_ += dppu<0x128>(ds_); \
                mine = (i16 == ((t_) & 15)) ? (float)(int)ds_ : mine; }
#pragma unroll
                for (int k = 0; k < 8; ++k) idr[k] = E[k].x;
#pragma unroll
                for (int k = 0; k < 8; ++k) PEER_LOADI(B[k], Utab, idr[k])
#pragma unroll 1
                for (int r = 0; r < 128; r += 8) {
                    if (wg_uniform && (r & (PEER_SYNC_EVERY - 1)) == 0 && r) __syncthreads();
                    if (r + 8 < 128) {
#pragma unroll
                        for (int k = 0; k < 8; ++k) idr[k] = E[r + 8 + k].x;
                    }
#pragma unroll
                    for (int k = 0; k < 8; ++k) { PEER_DOTS(B[k], r + k) if (r + 8 < 128) PEER_LOADI(B[k], Utab, idr[k]) }
                    if (r & 8) {
                        const int t = (r & ~15) + i16; const v4u en = E[t];
                        const float cf = gelu_as(mine * (__uint_as_float(en.y) * hs)) * __uint_as_float(en.z);
                        ((LAS float*)(E + t))[3] = cf; cmax = fmaxf(cmax, fabsf(cf));
                    }
                }
#undef PEER_DOTS
            }
            if (wg_uniform) __syncthreads();
            cmax = fmaxf(cmax, __uint_as_float(dppu<0xB1>(__float_as_uint(cmax)))); cmax = fmaxf(cmax, __uint_as_float(dppu<0x4E>(__float_as_uint(cmax))));
            cmax = fmaxf(cmax, __uint_as_float(dppu<0x124>(__float_as_uint(cmax)))); cmax = fmaxf(cmax, __uint_as_float(dppu<0x128>(__float_as_uint(cmax))));
            cmax = fmaxf(cmax, 1e-30f);
            int acci[4][16];
#pragma unroll
            for (int j = 0; j < 4; ++j)
#pragma unroll
                for (int e = 0; e < 16; ++e) acci[j][e] = 0;
            if (DRY != 4) {
                const float cq = 127.f / cmax;
                asm volatile("s_waitcnt lgkmcnt(0)" ::: "memory");
                unsigned pk0, pk1;
                { int q[8];
#pragma unroll
                  for (int k = 0; k < 8; ++k) q[k] = (int)rintf(((const LAS float*)(E + 8 * i16 + k))[3] * cq);
                  pk0 = ((unsigned)q[0] & 255u) | (((unsigned)q[1] & 255u) << 8) | (((unsigned)q[2] & 255u) << 16) | ((unsigned)q[3] << 24);
                  pk1 = ((unsigned)q[4] & 255u) | (((unsigned)q[5] & 255u) << 8) | (((unsigned)q[6] & 255u) << 16) | ((unsigned)q[7] << 24); }
                asm volatile("s_waitcnt lgkmcnt(0)" ::: "memory");
                ((LAS unsigned*)(E + 2 * i16))[1] = pk0; ((LAS unsigned*)(E + 2 * i16 + 1))[1] = pk1;
                asm volatile("s_waitcnt lgkmcnt(0)" ::: "memory");
                v4u Ba[4][2], Bb[4][2];
#define PEER_LOADG(B_, g_, hf_) { _Pragma("unroll") for (int n = 0; n < 4; ++n) { const unsigned id_ = E[4 * (g_) + n].x; const unsigned off = (id_ & (DRY == 2 ? 1023u : 16383u)) * 1024u + 16u * (unsigned)i16 + 512u * (hf_); \
                    _Pragma("unroll") for (int jj = 0; jj < 2; ++jj) B_[n][jj] = *(const v4u*)(Vtab + off + 256 * jj); } }
#define PEER_GROUP(B_, g_, hf_) { const unsigned a4 = ((const LAS unsigned*)(E + (g_)))[1]; \
                    _Pragma("unroll") for (int jj = 0; jj < 2; ++jj) _Pragma("unroll") for (int e = 0; e < 4; ++e) { \
                        const unsigned p01l = __builtin_amdgcn_perm(B_[1][jj][e], B_[0][jj][e], 0x05010400u), p01h = __builtin_amdgcn_perm(B_[1][jj][e], B_[0][jj][e], 0x07030602u); \
                        const unsigned p23l = __builtin_amdgcn_perm(B_[3][jj][e], B_[2][jj][e], 0x05010400u), p23h = __builtin_amdgcn_perm(B_[3][jj][e], B_[2][jj][e], 0x07030602u); \
                        acci[2 * (hf_) + jj][4 * e + 0] = __builtin_amdgcn_sdot4((int)__builtin_amdgcn_perm(p23l, p01l, 0x05040100u), (int)a4, acci[2 * (hf_) + jj][4 * e + 0], false); \
                        acci[2 * (hf_) + jj][4 * e + 1] = __builtin_amdgcn_sdot4((int)__builtin_amdgcn_perm(p23l, p01l, 0x07060302u), (int)a4, acci[2 * (hf_) + jj][4 * e + 1], false); \
                        acci[2 * (hf_) + jj][4 * e + 2] = __builtin_amdgcn_sdot4((int)__builtin_amdgcn_perm(p23h, p01h, 0x05040100u), (int)a4, acci[2 * (hf_) + jj][4 * e + 2], false); \
                        acci[2 * (hf_) + jj][4 * e + 3] = __builtin_amdgcn_sdot4((int)__builtin_amdgcn_perm(p23h, p01h, 0x07060302u), (int)a4, acci[2 * (hf_) + jj][4 * e + 3], false); } }
                PEER_LOADG(Ba, 0, 0)
#pragma unroll 1
                for (int g = 0; g < 32; ++g) {
                    if (wg_uniform && (g & (PEER_SYNC_EVERY / 4 - 1)) == 0 && g) __syncthreads();
                    PEER_LOADG(Bb, g, 1)
                    PEER_GROUP(Ba, g, 0)
                    if (g + 1 < 32) PEER_LOADG(Ba, g + 1, 0)
                    PEER_GROUP(Bb, g, 1)
                }
#undef PEER_LOADG
#undef PEER_GROUP
            }
            const float osc = cmax * (1.f / 127.f);
            f32x2 acc[4][8];
#pragma unroll
            for (int j = 0; j < 4; ++j)
#pragma unroll
                for (int e = 0; e < 8; ++e) acc[j][e] = (f32x2){(float)acci[j][2 * e] * osc, (float)acci[j][2 * e + 1] * osc};
#undef PEER_LOADI
            float ss = 0.f;
#pragma unroll
            for (int j = 0; j < 4; ++j) { const size_t eo = (size_t)tok * DM + 256 * j + 16 * i16; const float* gp = g2 + (size_t)b * 6144 + 256 * j + 16 * i16;
                bf16* XBp = (bf16*)(A.ws + WS_XB) + eo; const v4u xw0 = *(const v4u*)XBp, xw1 = *(const v4u*)(XBp + 8);
                unsigned ow[8];
#pragma unroll
                for (int q = 0; q < 4; ++q) { const unsigned w0 = q < 2 ? xw0[2 * q] : xw1[2 * q - 4], w1 = q < 2 ? xw0[2 * q + 1] : xw1[2 * q - 3]; const f32x4 g0 = *(const f32x4*)(gp + 4 * q);
                    const f32x4 xn = {bflo(w0) + (1.f + g0[0]) * acc[j][2 * q].x, bfhi(w0) + (1.f + g0[1]) * acc[j][2 * q].y, bflo(w1) + (1.f + g0[2]) * acc[j][2 * q + 1].x, bfhi(w1) + (1.f + g0[3]) * acc[j][2 * q + 1].y};
                    if (NEXT) { ow[2 * q] = pk2(xn[0], xn[1]); ow[2 * q + 1] = pk2(xn[2], xn[3]); }
                    else if (DRY == 0 || xn[0] == 1234.5678f) *(f32x4*)(A.out + eo + 4 * q) = xn;
                    acc[j][2 * q] = (f32x2){xn[0], xn[1]}; acc[j][2 * q + 1] = (f32x2){xn[2], xn[3]};
                    ss += (xn[0] * xn[0] + xn[1] * xn[1]) + (xn[2] * xn[2] + xn[3] * xn[3]); }
                if (NEXT && (DRY == 0 || ss == 1234.5678f)) { *(v4u*)XBp = (v4u){ow[0], ow[1], ow[2], ow[3]}; *(v4u*)(XBp + 8) = (v4u){ow[4], ow[5], ow[6], ow[7]}; } }
            if (DRY != 0) { if (ss == 1234.5678f) A.out[tok] = ss; }
            if (NEXT && DRY == 0) {
                ss += __uint_as_float(dppu<0xB1>(__float_as_uint(ss))); ss += __uint_as_float(dppu<0x4E>(__float_as_uint(ss)));
                ss += __uint_as_float(dppu<0x124>(__float_as_uint(ss))); ss += __uint_as_float(dppu<0x128>(__float_as_uint(ss)));
                const float rstd = rsqrtf(ss * (1.f / DM) + EPS);
                float am = 0.f;
#pragma unroll
                for (int j = 0; j < 4; ++j) { const int c0 = 256 * j + 16 * i16; const float* shp = nmod + (size_t)b * 6144 + c0; const float* scp = shp + 1024;
#pragma unroll
                    for (int q = 0; q < 4; ++q) { const f32x4 gn = *(const f32x4*)(ngain + c0 + 4 * q), sc = *(const f32x4*)(scp + 4 * q), sh = *(const f32x4*)(shp + 4 * q);
                        const f32x2 h0 = {acc[j][2 * q].x * rstd * gn[0] * (1.f + sc[0]) + sh[0], acc[j][2 * q].y * rstd * gn[1] * (1.f + sc[1]) + sh[1]};
                        const f32x2 h1 = {acc[j][2 * q + 1].x * rstd * gn[2] * (1.f + sc[2]) + sh[2], acc[j][2 * q + 1].y * rstd * gn[3] * (1.f + sc[3]) + sh[3]};
                        acc[j][2 * q] = h0; acc[j][2 * q + 1] = h1; am = fmaxf(am, fmaxf(fmaxf(fabsf(h0.x), fabsf(h0.y)), fmaxf(fabsf(h1.x), fabsf(h1.y)))); } }
                am = fmaxf(am, __uint_as_float(dppu<0xB1>(__float_as_uint(am)))); am = fmaxf(am, __uint_as_float(dppu<0x4E>(__float_as_uint(am))));
                am = fmaxf(am, __uint_as_float(dppu<0x124>(__float_as_uint(am)))); am = fmaxf(am, __uint_as_float(dppu<0x128>(__float_as_uint(am))));
                am = fmaxf(am, 1e-20f); const float qi = 127.f / am;
#pragma unroll
                for (int j = 0; j < 4; ++j) { v4u o;
#pragma unroll
                    for (int q = 0; q < 4; ++q) { const int q0 = (int)rintf(acc[j][2 * q].x * qi), q1 = (int)rintf(acc[j][2 * q].y * qi), q2 = (int)rintf(acc[j][2 * q + 1].x * qi), q3 = (int)rintf(acc[j][2 * q + 1].y * qi);
                        o[q] = ((unsigned)q0 & 255u) | (((unsigned)q1 & 255u) << 8) | (((unsigned)q2 & 255u) << 16) | ((unsigned)q3 << 24); }
                    *(v4u*)(A.ws + WS_IDS + (size_t)tok * DM + 256 * j + 16 * i16) = o; }
                if (i16 == 0) ((float*)(A.ws + WS_SA))[tok] = am * (1.f / 127.f);
            }
        }
    }
}
__device__ __forceinline__ void convert_tables_int8(const Ctx& C, const Args& A) {
    unsigned char* T8 = A.ws + WS_TAB; float* TS = (float*)(A.ws + WS_TSC);
    for (int R0 = C.gw * 4; R0 < 4 * 16384; R0 += C.NGW * 4) {
        const int t = R0 >> 14;
        const float* src = A.in[t == 0 ? 15 : t == 1 ? 16 : t == 2 ? 28 : 29] + (size_t)(R0 & 16383) * DM + 16 * C.lane;
        f32x4 x[4][4]; float am[4];
#pragma unroll
        for (int r = 0; r < 4; ++r) { am[r] = 0.f;
#pragma unroll
            for (int q = 0; q < 4; ++q) x[r][q] = *(const f32x4*)(src + (size_t)r * DM + 4 * q); }
#pragma unroll
        for (int r = 0; r < 4; ++r) {
#pragma unroll
            for (int q = 0; q < 4; ++q) am[r] = fmaxf(am[r], fmaxf(fmaxf(fabsf(x[r][q].x), fabsf(x[r][q].y)), fmaxf(fabsf(x[r][q].z), fabsf(x[r][q].w))));
            am[r] = wave_max(am[r]);
            const float sc = (am[r] > 0.f) ? 127.f / am[r] : 1.f, inv = (am[r] > 0.f) ? am[r] * (1.f / 127.f) : 1.f;
            v4u o;
#pragma unroll
            for (int q = 0; q < 4; ++q) { const int q0 = (int)rintf(x[r][q].x * sc), q1 = (int)rintf(x[r][q].y * sc), q2 = (int)rintf(x[r][q].z * sc), q3 = (int)rintf(x[r][q].w * sc);
                o[q] = ((unsigned)q0 & 255u) | (((unsigned)q1 & 255u) << 8) | (((unsigned)q2 & 255u) << 16) | ((unsigned)q3 << 24); }
            *(v4u*)(T8 + (size_t)(R0 + r) * DM + 16 * C.lane) = o;
            if (C.lane == 0) TS[R0 + r] = inv;
        }
    }
}
constexpr size_t WS_NL = 3 * MiB, WS_NP = WS_NL + 512 * 1024;
constexpr size_t WS_GC = WS_MOD + 512 * 1024, WS_ML = WS_GC + 4096, WS_MP = WS_ML + 4096;
constexpr size_t OUT_SL = 0, OUT_SP = 64 * MiB;
typedef float f32x16 __attribute__((ext_vector_type(16)));
typedef short s16x4 __attribute__((ext_vector_type(4)));
__device__ __forceinline__ unsigned offb(unsigned row, unsigned ch) { return 256u * row + 16u * (ch ^ (((row & 3u) << 2) | ((row >> 2) & 3u))); }
__device__ __forceinline__ s16x4 tr_read4(unsigned lds_addr) { s16x4 r; asm volatile("ds_read_b64_tr_b16 %0, %1\n\ts_waitcnt lgkmcnt(0)" : "=&v"(r) : "v"(lds_addr) : "memory"); return r; }
__device__ __forceinline__ void tr_read4x2(s16x4& r0, s16x4& r1, unsigned a0, unsigned a1) {
    asm volatile("ds_read_b64_tr_b16 %0, %2\n\tds_read_b64_tr_b16 %1, %3\n\ts_waitcnt lgkmcnt(0)" : "=&v"(r0), "=&v"(r1) : "v"(a0), "v"(a1) : "memory"); }
__device__ __forceinline__ void tr_read4x6(s16x4 (&r)[6], unsigned a0, unsigned a1, unsigned a2, unsigned a3, unsigned a4, unsigned a5) {
    asm volatile("ds_read_b64_tr_b16 %0, %6\n\tds_read_b64_tr_b16 %1, %7\n\tds_read_b64_tr_b16 %2, %8\n\tds_read_b64_tr_b16 %3, %9\n\tds_read_b64_tr_b16 %4, %10\n\tds_read_b64_tr_b16 %5, %11\n\ts_waitcnt lgkmcnt(0)"
                 : "=&v"(r[0]), "=&v"(r[1]), "=&v"(r[2]), "=&v"(r[3]), "=&v"(r[4]), "=&v"(r[5]) : "v"(a0), "v"(a1), "v"(a2), "v"(a3), "v"(a4), "v"(a5) : "memory"); }
__device__ __forceinline__ void tr_read4x8(s16x4 (&r)[8], unsigned a0, unsigned a1, unsigned a2, unsigned a3, unsigned a4, unsigned a5, unsigned a6, unsigned a7) {
    asm volatile("ds_read_b64_tr_b16 %0, %8\n\tds_read_b64_tr_b16 %1, %9\n\tds_read_b64_tr_b16 %2, %10\n\tds_read_b64_tr_b16 %3, %11\n\tds_read_b64_tr_b16 %4, %12\n\tds_read_b64_tr_b16 %5, %13\n\tds_read_b64_tr_b16 %6, %14\n\tds_read_b64_tr_b16 %7, %15\n\ts_waitcnt lgkmcnt(0)"
                 : "=&v"(r[0]), "=&v"(r[1]), "=&v"(r[2]), "=&v"(r[3]), "=&v"(r[4]), "=&v"(r[5]), "=&v"(r[6]), "=&v"(r[7]) : "v"(a0), "v"(a1), "v"(a2), "v"(a3), "v"(a4), "v"(a5), "v"(a6), "v"(a7) : "memory"); }
__device__ __forceinline__ float scan_sum64(float v, int lane) {
#pragma unroll
    for (int o = 1; o < 64; o <<= 1) { const float t = __shfl_up(v, o); if (lane >= o) v += t; }
    return v;
}
__device__ __forceinline__ float scan_max64(float v, int lane) {
#pragma unroll
    for (int o = 1; o < 64; o <<= 1) { const float t = __shfl_up(v, o); if (lane >= o) v = fmaxf(v, t); }
    return v;
}
__device__ __forceinline__ pg8::bf16x8 mk_frag(s16x4 a, s16x4 b) { return (pg8::bf16x8){a[0], a[1], a[2], a[3], b[0], b[1], b[2], b[3]}; }

__device__ __forceinline__ void phase_mlstm_local(const Ctx& C, const Args& A) {
    const bf16* P = (const bf16*)(A.ws + WS_BIG);
    const float* LF = (const float*)(A.ws + WS_LF); const float* LI = (const float*)(A.ws + WS_LI);
    bf16* SL = (bf16*)((unsigned char*)A.out + OUT_SL); float* NL = (float*)(A.ws + WS_NL);
    float* GC = (float*)(A.ws + WS_GC); float* ML = (float*)(A.ws + WS_ML);
    LAS unsigned char* tK = C.lds; LAS unsigned char* tV = C.lds + 32768; LAS float* wtab = (LAS float*)(C.lds + 65536);
    const unsigned ldsK = (unsigned)(uintptr_t)tK, ldsV = (unsigned)(uintptr_t)tV;
    const int lane = C.lane, wid = C.wave, tid = C.tid;
    for (int unit = C.bid; unit < 1024; unit += C.G) {
        const int bh = unit >> 5, c = unit & 31, b = bh >> 2, hh = bh & 3;
        const size_t tok0 = (size_t)b * SEQ + c * 128;
        if (wid == 0) {
            const float2 lf = *(const float2*)(LF + (size_t)bh * SEQ + c * 128 + 2 * lane), li = *(const float2*)(LI + (size_t)bh * SEQ + c * 128 + 2 * lane);
            const float pr = lf.x + lf.y, inc = scan_sum64(pr, lane), ex = inc - pr;
            const float b0 = ex + lf.x, b1 = b0 + lf.y;
            const float g = __shfl(inc, 63);
            const float a0 = g - b0 + li.x, a1 = g - b1 + li.y;
            const float mloc = wave_max(fmaxf(a0, a1));
            wtab[2 * lane] = __expf(a0 - mloc); wtab[2 * lane + 1] = __expf(a1 - mloc);
            if (lane == 0) { GC[unit] = g; ML[unit] = mloc; }
        }
        __syncthreads();
#pragma unroll
        for (int i = 0; i < 4; ++i) { const int id = tid + 512 * i, row = id >> 4, ch = id & 15;
            const bf16* src = P + (tok0 + row) * INP + hh * 128 + ch * 8;
            const v4u kv = *(const v4u*)(src + 512), vv = *(const v4u*)(src + 1024);
            const float w = wtab[row];
            v4u ko; ko.x = pk2(bflo(kv.x) * w, bfhi(kv.x) * w); ko.y = pk2(bflo(kv.y) * w, bfhi(kv.y) * w); ko.z = pk2(bflo(kv.z) * w, bfhi(kv.z) * w); ko.w = pk2(bflo(kv.w) * w, bfhi(kv.w) * w);
            *(LAS v4u*)(tK + offb(row, ch)) = ko; *(LAS v4u*)(tV + offb(row, ch)) = vv; }
        __syncthreads();
        if (tid < 128) { const int d = tid; float s = 0.f;
#pragma unroll 8
            for (int l = 0; l < 128; ++l) s += bf2f(*(const LAS unsigned short*)(tK + offb(l, d >> 3) + (d & 7) * 2));
            NL[(size_t)unit * 128 + d] = s; }
        {
            const int db = wid & 3, eh = wid >> 2;
            const unsigned h = lane >> 5, blk = (lane >> 4) & 1, q = (lane & 15) >> 2, p = lane & 3;
            f32x16 acc[2];
#pragma unroll
            for (int eb = 0; eb < 2; ++eb)
#pragma unroll
                for (int r = 0; r < 16; ++r) acc[eb][r] = 0.f;
#pragma unroll
            for (int ks = 0; ks < 8; ++ks) {
                const unsigned r0 = 16 * ks + 8 * h + q, cA = 4 * db + 2 * blk + (p >> 1), cB0 = 4 * (2 * eh) + 2 * blk + (p >> 1), cB1 = cB0 + 4, po = 8 * (p & 1);
                s16x4 t[6];
                tr_read4x6(t, ldsK + offb(r0, cA) + po, ldsK + offb(r0 + 4, cA) + po, ldsV + offb(r0, cB0) + po, ldsV + offb(r0 + 4, cB0) + po, ldsV + offb(r0, cB1) + po, ldsV + offb(r0 + 4, cB1) + po);
                const pg8::bf16x8 af = mk_frag(t[0], t[1]);
                acc[0] = __builtin_amdgcn_mfma_f32_32x32x16_bf16(af, mk_frag(t[2], t[3]), acc[0], 0, 0, 0);
                acc[1] = __builtin_amdgcn_mfma_f32_32x32x16_bf16(af, mk_frag(t[4], t[5]), acc[1], 0, 0, 0);
            }
            const int hi = lane >> 5;
#pragma unroll
            for (int eb = 0; eb < 2; ++eb) { const int e = 32 * (2 * eh + eb) + (lane & 31);
#pragma unroll
                for (int g4 = 0; g4 < 4; ++g4) { uint2 o; o.x = pk2(acc[eb][4 * g4], acc[eb][4 * g4 + 1]); o.y = pk2(acc[eb][4 * g4 + 2], acc[eb][4 * g4 + 3]);
                    *(uint2*)(SL + ((size_t)unit * 128 + e) * 128 + 32 * db + 8 * g4 + 4 * hi) = o; } }
        }
        __syncthreads();
    }
}

__device__ __forceinline__ void phase_mlstm_scan(const Ctx& C, const Args& A) {
    const bf16* SL = (const bf16*)((unsigned char*)A.out + OUT_SL); bf16* SP = (bf16*)((unsigned char*)A.out + OUT_SP);
    const float* NL = (const float*)(A.ws + WS_NL); float* NP = (float*)(A.ws + WS_NP);
    const float* GC = (const float*)(A.ws + WS_GC); const float* ML = (const float*)(A.ws + WS_ML); float* MP = (float*)(A.ws + WS_MP);
    for (long it = C.gt; it < 32L * 128 * 32; it += C.NGT) {
        const int d4 = (int)(it & 31), e = (int)((it >> 5) & 127), bh = (int)(it >> 12);
        f32x4 s = {0.f, 0.f, 0.f, 0.f}, n = {0.f, 0.f, 0.f, 0.f}; float m = 0.f;
        const bool do_n = (e == 0);
#pragma unroll 4
        for (int c = 0; c < 32; ++c) {
            const size_t unit = (size_t)bh * 32 + c;
            uint2 o; o.x = pk2(s.x, s.y); o.y = pk2(s.z, s.w);
            *(uint2*)(SP + (unit * 128 + e) * 128 + 4 * d4) = o;
            if (do_n) { *(f32x4*)(NP + unit * 128 + 4 * d4) = n; if (d4 == 0) MP[unit] = m; }
            const float g = GC[unit], ml = ML[unit];
            const float mn = fmaxf(g + m, ml), dec = __expf(g + m - mn), sc = __expf(ml - mn);
            const uint2 xw = *(const uint2*)(SL + (unit * 128 + e) * 128 + 4 * d4); const f32x4 x = {bflo(xw.x), bfhi(xw.x), bflo(xw.y), bfhi(xw.y)};
            s = s * dec + x * sc;
            if (do_n) { const f32x4 y = *(const f32x4*)(NL + unit * 128 + 4 * d4); n = n * dec + y * sc; }
            m = mn;
        }
    }
}

__device__ __forceinline__ void phase_mlstm_out(const Ctx& C, const Args& A) {
    const bf16* P = (const bf16*)(A.ws + WS_BIG); bf16* mix = (bf16*)(A.ws + WS_H);
    const float* LF = (const float*)(A.ws + WS_LF); const float* LI = (const float*)(A.ws + WS_LI);
    const bf16* SP = (const bf16*)((unsigned char*)A.out + OUT_SP); const float* NP = (const float*)(A.ws + WS_NP); const float* MP = (const float*)(A.ws + WS_MP);
    const float* gain = A.in[9];
    LAS unsigned char* tV = C.lds; LAS float* abt = (LAS float*)(C.lds + 65536); LAS float* Mt = abt + 128; LAS float* bt = abt + 256; LAS float* npt = abt + 384; LAS float* ssq = abt + 512;
    const unsigned ldsV = (unsigned)(uintptr_t)tV;
    const int lane = C.lane, wid = C.wave, tid = C.tid, hi = lane >> 5, l31 = lane & 31;
    constexpr float QS = 0.08838834764831845f;
    for (int unit = C.bid; unit < 1024; unit += C.G) {
        const int bh = unit >> 5, c = unit & 31, b = bh >> 2, hh = bh & 3;
        const size_t tok0 = (size_t)b * SEQ + c * 128;
        const float mprev = MP[unit];
        if (wid == 0) {
            const float2 lf = *(const float2*)(LF + (size_t)bh * SEQ + c * 128 + 2 * lane), li = *(const float2*)(LI + (size_t)bh * SEQ + c * 128 + 2 * lane);
            const float pr = lf.x + lf.y, inc = scan_sum64(pr, lane), ex = inc - pr;
            const float b0 = ex + lf.x, b1 = b0 + lf.y;
            const float ab0 = li.x - b0, ab1 = li.y - b1;
            const float pmx = scan_max64(fmaxf(ab0, ab1), lane);
            float pme = __shfl_up(pmx, 1); if (lane == 0) pme = -INFINITY;
            const float pm0 = fmaxf(pme, ab0), pm1 = fmaxf(pm0, ab1);
            abt[2 * lane] = ab0; abt[2 * lane + 1] = ab1; bt[2 * lane] = b0; bt[2 * lane + 1] = b1;
            Mt[2 * lane] = fmaxf(mprev, pm0); Mt[2 * lane + 1] = fmaxf(mprev, pm1);
        }
        if (wid == 1) { npt[2 * lane] = NP[(size_t)unit * 128 + 2 * lane]; npt[2 * lane + 1] = NP[(size_t)unit * 128 + 2 * lane + 1]; }
#pragma unroll
        for (int i = 0; i < 4; ++i) { const int id = tid + 512 * i, row = id >> 4, ch = id & 15;
            *(LAS v4u*)(tV + offb(row, ch)) = *(const v4u*)(P + (tok0 + row) * INP + 1024 + hh * 128 + ch * 8); }
        __syncthreads();
        const int lb = wid & 3, eh = wid >> 2;
        const int l = 32 * lb + l31;
        const float Ml = Mt[l], iw = __expf(mprev - Ml) * QS;
        pg8::bf16x8 qf[8];
#pragma unroll
        for (int ks = 0; ks < 8; ++ks) qf[ks] = *(const pg8::bf16x8*)(P + (tok0 + l) * INP + hh * 128 + 16 * ks + 8 * hi);
        float qn = 0.f;
#pragma unroll
        for (int ks = 0; ks < 8; ++ks)
#pragma unroll
            for (int j = 0; j < 8; ++j) qn += bf2f((unsigned short)qf[ks][j]) * npt[16 * ks + 8 * hi + j];
        qn += __shfl_xor(qn, 32);
        f32x16 acc[2];
#pragma unroll
        for (int eb = 0; eb < 2; ++eb) {
#pragma unroll
            for (int r = 0; r < 16; ++r) acc[eb][r] = 0.f;
            const bf16* sp = SP + ((size_t)unit * 128 + 32 * (2 * eh + eb) + l31) * 128 + 8 * hi;
#pragma unroll
            for (int ks = 0; ks < 8; ++ks) acc[eb] = __builtin_amdgcn_mfma_f32_32x32x16_bf16(*(const pg8::bf16x8*)(sp + 16 * ks), qf[ks], acc[eb], 0, 0, 0);
#pragma unroll
            for (int r = 0; r < 16; ++r) acc[eb][r] *= iw;
        }
        float den = 0.f;
        const unsigned g16 = lane >> 4, blk = g16 & 1, q = (lane & 15) >> 2, p = lane & 3;
        for (int sb = 0; sb <= lb; ++sb) {
            f32x16 X;
#pragma unroll
            for (int r = 0; r < 16; ++r) X[r] = 0.f;
            const bf16* kp = P + (tok0 + 32 * sb + l31) * INP + 512 + hh * 128 + 8 * hi;
#pragma unroll
            for (int ks = 0; ks < 8; ++ks) X = __builtin_amdgcn_mfma_f32_32x32x16_bf16(*(const pg8::bf16x8*)(kp + 16 * ks), qf[ks], X, 0, 0, 0);
            float pv[16];
#pragma unroll
            for (int r = 0; r < 16; ++r) { const int s = 32 * sb + (r & 3) + 8 * (r >> 2) + 4 * hi;
                const float v = X[r] * QS * __expf(abt[s] - Ml);
                pv[r] = (s <= l) ? v : 0.f; den += pv[r]; }
            pg8::bf16x8 pf[2];
#pragma unroll
            for (int st = 0; st < 2; ++st) { v4u t; t.x = pk2(pv[8 * st], pv[8 * st + 1]); t.y = pk2(pv[8 * st + 2], pv[8 * st + 3]); t.z = pk2(pv[8 * st + 4], pv[8 * st + 5]); t.w = pk2(pv[8 * st + 6], pv[8 * st + 7]);
                pf[st] = __builtin_bit_cast(pg8::bf16x8, t); }
            { const unsigned c0 = 4 * (2 * eh) + 2 * blk + (p >> 1), c1 = c0 + 4, ra = 32 * sb + 4 * hi + q, po = 8 * (p & 1);
              s16x4 t[8];
              tr_read4x8(t, ldsV + offb(ra, c0) + po, ldsV + offb(ra + 8, c0) + po, ldsV + offb(ra + 16, c0) + po, ldsV + offb(ra + 24, c0) + po,
                            ldsV + offb(ra, c1) + po, ldsV + offb(ra + 8, c1) + po, ldsV + offb(ra + 16, c1) + po, ldsV + offb(ra + 24, c1) + po);
#pragma unroll
              for (int eb = 0; eb < 2; ++eb)
#pragma unroll
                  for (int st = 0; st < 2; ++st) acc[eb] = __builtin_amdgcn_mfma_f32_32x32x16_bf16(mk_frag(t[4 * eb + 2 * st], t[4 * eb + 2 * st + 1]), pf[st], acc[eb], 0, 0, 0); }
        }
        den += __shfl_xor(den, 32);
        den += iw * qn;
        const float dn = 1.f / fmaxf(fabsf(den), __expf(-(bt[l] + Ml)));
        float ss = 0.f;
#pragma unroll
        for (int eb = 0; eb < 2; ++eb)
#pragma unroll
            for (int r = 0; r < 16; ++r) { acc[eb][r] *= dn; ss += acc[eb][r] * acc[eb][r]; }
        ss += __shfl_xor(ss, 32);
        if (hi == 0) ssq[eh * 128 + l] = ss;
        __syncthreads();
        const float rstd = rsqrtf((ssq[l] + ssq[128 + l]) * (1.f / 128.f) + EPS);
#pragma unroll
        for (int eb = 0; eb < 2; ++eb)
#pragma unroll
            for (int g4 = 0; g4 < 4; ++g4) { const int e = 32 * (2 * eh + eb) + 8 * g4 + 4 * hi;
                const uint2 ow = *(const uint2*)(P + (tok0 + l) * INP + 1536 + hh * 128 + e);
                const f32x4 gn = *(const f32x4*)(gain + hh * 128 + e);
                uint2 o; o.x = pk2(acc[eb][4 * g4] * rstd * gn.x * sigmoidf_(bflo(ow.x)), acc[eb][4 * g4 + 1] * rstd * gn.y * sigmoidf_(bfhi(ow.x)));
                o.y = pk2(acc[eb][4 * g4 + 2] * rstd * gn.z * sigmoidf_(bflo(ow.y)), acc[eb][4 * g4 + 3] * rstd * gn.w * sigmoidf_(bfhi(ow.y)));
                *(uint2*)(mix + (tok0 + l) * DM + hh * 128 + e) = o; }
        __syncthreads();
    }
}
template <bool I8>
struct EpiQKV {
    static constexpr bool PERM = true, AFTER_DRAIN = false;
    bf16* O; bf16* KF; bf16* VH; const float* qg; const float* kg; const float* sa; const float* sw;
    __device__ __forceinline__ void operator()(const typename pg8::AccSel<I8>::type (&acc)[2][2][4][2], const pg8::Unit& u, int wr, int wc, int fr, int fq) const {
        using pg8::f32x4;
        f32x4 cs[2][2];
#pragma unroll
        for (int bj = 0; bj < 2; ++bj)
#pragma unroll
            for (int n = 0; n < 2; ++n) cs[bj][n] = I8 ? *(const f32x4*)(sw + u.pn * 256 + 128 * bj + 32 * wc + 8 * fq + 4 * n) : (f32x4){1.f, 1.f, 1.f, 1.f};
        const int kind = u.pn >> 2;
        const float* gp = (kind == 0) ? qg : kg;
        const float post = (kind == 0) ? 0.125f * 1.4426950408889634f : 1.0f;
        f32x4 gv[2][2];
#pragma unroll
        for (int bj = 0; bj < 2; ++bj)
#pragma unroll
            for (int n = 0; n < 2; ++n) gv[bj][n] = (kind < 2) ? *(const f32x4*)(gp + 32 * bj + 8 * fq + 4 * n) * post : (f32x4){1.f, 1.f, 1.f, 1.f};
#pragma unroll
        for (int ai = 0; ai < 2; ++ai)
#pragma unroll
            for (int m = 0; m < 4; ++m) {
                const int row = u.pm * 256 + ai * 128 + wr * 64 + m * 16 + fr;
                f32x4 xv[2][2]; float ss = 0.f;
                { const float rsc = I8 ? sa[row] : 1.f;
#pragma unroll
                  for (int bj = 0; bj < 2; ++bj)
#pragma unroll
                      for (int n = 0; n < 2; ++n) { const auto a = acc[ai][bj][m][n]; const f32x4 x = (f32x4){(float)a[0], (float)a[1], (float)a[2], (float)a[3]} * cs[bj][n] * rsc; xv[bj][n] = x;
                          ss += (x[0] * x[0] + x[1] * x[1]) + (x[2] * x[2] + x[3] * x[3]); } }
                ss += __shfl_xor(ss, 16); ss += __shfl_xor(ss, 32);
                const float rs = (kind < 2) ? rsqrtf(ss * (1.f / 64.f) + EPS) : 1.0f;
                bf16* dst = (kind == 1) ? KF + ((size_t)(((row >> 12) * 16 + (u.pn - 4) * 4 + wc) * 128 + ((row & 4095) >> 5)) * 2048 + (size_t)((fq >> 1) * 512 + ((fq & 1) * 32 + (row & 31)) * 8))
                                        : (kind == 2) ? VH + ((size_t)(((row >> 12) * 16 + (u.pn & 3) * 4 + wc) * 4096 + (row & 4095)) * 64 + 8 * fq)
                                        : O + (size_t)row * 1024 + (u.pn & 3) * 256 + 64 * wc + 8 * fq;
                const int bjstep = (kind == 1) ? 1024 : 32;
#pragma unroll
                for (int bj = 0; bj < 2; ++bj) { const f32x4 v0 = xv[bj][0] * gv[bj][0] * rs, v1 = xv[bj][1] * gv[bj][1] * rs;
                    v4u w; w.x = pk2(v0[0], v0[1]); w.y = pk2(v0[2], v0[3]); w.z = pk2(v1[0], v1[1]); w.w = pk2(v1[2], v1[3]);
                    *(v4u*)(dst + bjstep * bj) = w; }
            }
    }
};

__device__ __forceinline__ unsigned voff(unsigned row, unsigned ch) { return row * 128u + 16u * (ch ^ (row & 7u)); }
__device__ __forceinline__ void phase_attn(const Ctx& C, const Args& A) {
    const bf16* QV = (const bf16*)(A.ws + WS_BIG); const bf16* KF = (const bf16*)(A.ws + WS_BIG + 64 * MiB); const bf16* VH = (const bf16*)(A.ws + WS_BIG + 128 * MiB); bf16* O = (bf16*)(A.ws + WS_H);
    LAS unsigned char* tV = C.lds + C.wave * 4096;
    const unsigned ldsV = (unsigned)(uintptr_t)tV;
    const int lane = C.lane, hi = lane >> 5, l31 = lane & 31;
    const unsigned blk = (lane >> 4) & 1, q4 = (lane & 15) >> 2, p = lane & 3;
    const int per_wave = (16384 + C.NGW - 1) / C.NGW;
    for (int u = C.gw * per_wave; u < C.gw * per_wave + per_wave; ++u) {
        if (u >= 16384) break;
        const int bh = u >> 7, qt = u & 127, b = bh >> 4, hd = bh & 15;
        const size_t tokb = (size_t)b * SEQ;
        const int l = qt * 32 + l31;
        pg8::bf16x8 qf[4];
#pragma unroll
        for (int ks = 0; ks < 4; ++ks) qf[ks] = *(const pg8::bf16x8*)(QV + (tokb + l) * 1024 + hd * 64 + 16 * ks + 8 * hi);
        f32x16 acc[2];
#pragma unroll
        for (int eb = 0; eb < 2; ++eb)
#pragma unroll
            for (int r = 0; r < 16; ++r) acc[eb][r] = 0.f;
        float carry = 0.f;
        pg8::bf16x8 kf[4]; v4u vv[4];
#define ATT_LOAD(kt_) { const size_t s0_ = tokb + (size_t)(kt_) * 32; const bf16* kp_ = KF + ((size_t)(bh * 128 + (kt_)) * 2048 + lane * 8); \
            _Pragma("unroll") for (int ks = 0; ks < 4; ++ks) kf[ks] = *(const pg8::bf16x8*)(kp_ + ks * 512); \
            _Pragma("unroll") for (int i = 0; i < 4; ++i) { const int id = lane + 64 * i; vv[i] = *(const v4u*)(VH + ((size_t)bh * 4096 + (size_t)(kt_) * 32) * 64 + id * 8); } }
        ATT_LOAD(qt)
        for (int kt = qt; kt >= 0; --kt) {
            f32x16 X;
#pragma unroll
            for (int r = 0; r < 16; ++r) X[r] = 0.f;
#pragma unroll
            for (int ks = 0; ks < 4; ++ks) X = __builtin_amdgcn_mfma_f32_32x32x16_bf16(kf[ks], qf[ks], X, 0, 0, 0);
#pragma unroll
            for (int i = 0; i < 4; ++i) { const int id = lane + 64 * i; *(LAS v4u*)(tV + voff(id >> 3, id & 7)) = vv[i]; }
            if (kt > 0) ATT_LOAD(kt - 1)
            const int sbase = kt * 32 + 4 * hi;
            float sp[16];
#pragma unroll
            for (int r = 0; r < 16; ++r) { const int s = sbase + (r & 3) + 8 * (r >> 2);
                const float x = X[r]; const float t = fmaxf(x, 0.f) + __builtin_amdgcn_logf(1.f + __builtin_amdgcn_exp2f(-fabsf(x)));
                sp[r] = (s < l) ? t : 0.f; }
            float To[4], Tp[4];
#pragma unroll
            for (int g = 0; g < 4; ++g) { To[g] = (sp[4 * g] + sp[4 * g + 1]) + (sp[4 * g + 2] + sp[4 * g + 3]); Tp[g] = __shfl_xor(To[g], 32); }
            float base[4]; float run = 0.f;
#pragma unroll
            for (int g = 3; g >= 0; --g) { base[g] = carry + run + (hi == 0 ? Tp[g] : 0.f); run += To[g] + Tp[g]; }
            float att[16];
#pragma unroll
            for (int g = 0; g < 4; ++g) { float w = base[g];
#pragma unroll
                for (int i = 3; i >= 0; --i) { const int r = 4 * g + i; const int s = sbase + i + 8 * g;
                    att[r] = (s < l) ? __builtin_amdgcn_exp2f(X[r] - sp[r] - w) : 0.f; w += sp[r]; } }
            carry += run;
            pg8::bf16x8 pf[2];
#pragma unroll
            for (int st = 0; st < 2; ++st) { v4u t; t.x = pg8::cvt_pk_bf16(att[8 * st], att[8 * st + 1]); t.y = pg8::cvt_pk_bf16(att[8 * st + 2], att[8 * st + 3]); t.z = pg8::cvt_pk_bf16(att[8 * st + 4], att[8 * st + 5]); t.w = pg8::cvt_pk_bf16(att[8 * st + 6], att[8 * st + 7]);
                pf[st] = __builtin_bit_cast(pg8::bf16x8, t); }
            s16x4 vf[8];
            { const unsigned a0 = ldsV + voff(4 * hi + q4, 2 * blk + (p >> 1)) + 8 * (p & 1), a1 = ldsV + voff(4 * hi + q4 + 8, 2 * blk + (p >> 1)) + 8 * (p & 1);
              const unsigned a2 = ldsV + voff(16 + 4 * hi + q4, 2 * blk + (p >> 1)) + 8 * (p & 1), a3 = ldsV + voff(24 + 4 * hi + q4, 2 * blk + (p >> 1)) + 8 * (p & 1);
              const unsigned a4 = ldsV + voff(4 * hi + q4, 4 + 2 * blk + (p >> 1)) + 8 * (p & 1), a5 = ldsV + voff(4 * hi + q4 + 8, 4 + 2 * blk + (p >> 1)) + 8 * (p & 1);
              const unsigned a6 = ldsV + voff(16 + 4 * hi + q4, 4 + 2 * blk + (p >> 1)) + 8 * (p & 1), a7 = ldsV + voff(24 + 4 * hi + q4, 4 + 2 * blk + (p >> 1)) + 8 * (p & 1);
              asm volatile("ds_read_b64_tr_b16 %0, %8\n\tds_read_b64_tr_b16 %1, %9\n\tds_read_b64_tr_b16 %2, %10\n\tds_read_b64_tr_b16 %3, %11\n\t"
                           "ds_read_b64_tr_b16 %4, %12\n\tds_read_b64_tr_b16 %5, %13\n\tds_read_b64_tr_b16 %6, %14\n\tds_read_b64_tr_b16 %7, %15\n\ts_waitcnt lgkmcnt(0)"
                           : "=&v"(vf[0]), "=&v"(vf[1]), "=&v"(vf[2]), "=&v"(vf[3]), "=&v"(vf[4]), "=&v"(vf[5]), "=&v"(vf[6]), "=&v"(vf[7])
                           : "v"(a0), "v"(a1), "v"(a2), "v"(a3), "v"(a4), "v"(a5), "v"(a6), "v"(a7) : "memory"); }
#pragma unroll
            for (int eb = 0; eb < 2; ++eb)
#pragma unroll
                for (int st = 0; st < 2; ++st) acc[eb] = __builtin_amdgcn_mfma_f32_32x32x16_bf16(mk_frag(vf[4 * eb + 2 * st], vf[4 * eb + 2 * st + 1]), pf[st], acc[eb], 0, 0, 0);
            if (__all(carry >= 150.1f)) break;
        }
#undef ATT_LOAD
#pragma unroll
        for (int eb = 0; eb < 2; ++eb)
#pragma unroll
            for (int g4 = 0; g4 < 4; ++g4) { const u32x2 o = {pk2(acc[eb][4 * g4], acc[eb][4 * g4 + 1]), pk2(acc[eb][4 * g4 + 2], acc[eb][4 * g4 + 3])};
                const unsigned c8 = (unsigned)(8 * eb + 2 * g4 + hi);
                *(LAS u32x2*)(tV + l31 * 128 + ((c8 ^ ((unsigned)(l31 & 7) << 1)) << 3)) = o; }
        asm volatile("s_waitcnt lgkmcnt(0)" ::: "memory");
#pragma unroll
        for (int i = 0; i < 4; ++i) { const int id = lane + 64 * i, rr = id >> 3, q = id & 7;
            const v4u w = *(const LAS v4u*)(tV + rr * 128 + (((unsigned)(2 * q) ^ ((unsigned)(rr & 7) << 1)) << 3));
            *(v4u*)(O + (tokb + qt * 32 + rr) * DM + hd * 64 + 8 * q) = w; }
        asm volatile("s_waitcnt lgkmcnt(0)" ::: "memory");
    }
}
constexpr int N_PHASES = 16;
#ifndef MK_ONE_LAUNCH
#define MK_ONE_LAUNCH 1
#endif

__global__ void __launch_bounds__(NWAVES * 64, 2) mk_fwd(Args args) {
    extern __shared__ __attribute__((aligned(16))) unsigned char lds_raw[];
    Ctx C;
    C.lds = (LAS unsigned char*)lds_raw;
    C.tid = threadIdx.x; C.lane = C.tid & 63; C.wave = __builtin_amdgcn_readfirstlane(C.tid >> 6);
    C.G = gridDim.x; C.bid = blockIdx.x;
    C.gw = C.bid * NWAVES + C.wave; C.NGW = C.G * NWAVES;
    C.gt = (long)C.bid * (NWAVES * 64) + C.tid; C.NGT = (long)C.G * (NWAVES * 64);
    unsigned char* ws = args.ws;
    volatile LAS unsigned* MISC = (volatile LAS unsigned*)(C.lds + MISC_OFF);
    for (int u = C.tid; u < (LDS_BYTES - LDSCTL_OFF) / 4; u += NWAVES * 64) ((LAS unsigned*)(C.lds + LDSCTL_OFF))[u] = 0u;
    __syncthreads();
#if MK_ONE_LAUNCH
    XcdBarrier bar = xcd_barrier_post((unsigned*)((gu32*)(ws + WS_CTL) + CW_BAR), MISC + 8);
#ifdef PROBE_DBLBAR
#define GRID_BAR() do { xcd_barrier(bar); xcd_barrier(bar); } while (0)
#else
#define GRID_BAR() xcd_barrier(bar)
#endif
#else
    (void)MISC; XcdBarrier bar; bar.bar = nullptr; bar.x = 0; bar.st = nullptr;
#define GRID_BAR() do {} while (0)
#endif
    const int lo = args.ph_lo, hi = args.ph_hi;
#define IN(k) (lo <= (k) && (k) < hi)
#ifndef PROBE_MASK
#define PROBE_MASK 0
#endif
#define PROBE_T0(k) unsigned long long pt0_ = 0; if ((PROBE_MASK >> (k)) & 1) pt0_ = __builtin_amdgcn_s_memrealtime();
#define PROBE_T1(k) if ((PROBE_MASK >> (k)) & 1) { const unsigned long long t1_ = __builtin_amdgcn_s_memrealtime(); const unsigned long long d_ = t1_ - pt0_; while (__builtin_amdgcn_s_memrealtime() - t1_ < d_) __builtin_amdgcn_s_sleep(8); }
#define SEAM(k) do { if (IN(k) && IN((k) + 1)) GRID_BAR(); } while (0)
    float* mod0 = (float*)(ws + WS_MOD); float* mod1 = mod0 + (size_t)NB * 6144;
    bf16* Hb = (bf16*)(ws + WS_H); bf16* BIG = (bf16*)(ws + WS_BIG); bf16* XB = (bf16*)(ws + WS_XB);

    const unsigned char* TAB = ws + WS_TAB; const float* TSC = (const float*)(ws + WS_TSC);
#ifdef PROBE_INSTR
    {
        unsigned xs[16]; float fs[16];
#pragma unroll
        for (int i = 0; i < 16; ++i) { xs[i] = (unsigned)(C.tid * 2654435761u + i * 40503u); fs[i] = (float)(C.tid * 7 + i) * 0.37f; }
#pragma unroll 1
        for (int it = 0; it < 4096; ++it) {
#pragma unroll
            for (int rep = 0; rep < 2; ++rep) {
#pragma unroll
                for (int i = 0; i < 16; i += 2) {
#if PROBE_INSTR == 10
                    { const unsigned a = xs[i], b = xs[i + 1]; xs[i] = a < b ? b : a; xs[i + 1] = (a < b ? a : b) + (unsigned)it; }
#elif PROBE_INSTR == 11
                    { const float a = fs[i], b = fs[i + 1]; fs[i] = fmaxf(a, b); fs[i + 1] = fminf(a, b) + 1.0f; }
#elif PROBE_INSTR == 12
                    { const unsigned a = xs[i], b = xs[i + 1]; xs[i] = a + b; xs[i + 1] = (a ^ b) + (unsigned)it; }
#endif
                }
            }
        }
        float sm = 0.f;
#pragma unroll
        for (int i = 0; i < 16; ++i) sm += fs[i] + __uint_as_float(xs[i] & 0x3fffffffu);
        if (sm == 1234.5678f) args.out[C.tid] = sm;
    }
#endif
    if (IN(0)) { PROBE_T0(0) { phase_prep(C, args); convert_tables_int8(C, args); } PROBE_T1(0) } SEAM(0);
    bf16* H8B = (bf16*)(ws + WS_IDS);
    unsigned char* W8 = (unsigned char*)args.out; float* SW = (float*)((unsigned char*)args.out + OUT_SW); float* SA = (float*)(ws + WS_SA);
    if (IN(1)) { PROBE_T0(1) { phase_rowpass<true, false, true>(C, args, args.in[0], args.in[4], mod0, 0, 1, Hb, SA);
        quantize_rows(C, (const bf16*)(ws + WS_WIN), INP, W8 + OUT_W8IN, SW + SW_IN);
        quantize_rows(C, (const bf16*)(ws + WS_WC0), 2048, W8 + OUT_W8C0, SW + SW_C0); quantize_rows(C, (const bf16*)(ws + WS_WC1), 2048, W8 + OUT_W8C1, SW + SW_C1);
        quantize_rows(C, (const bf16*)(ws + WS_WQKV), 3072, W8 + OUT_W8QKV, SW + SW_QKV); } PROBE_T1(1) } SEAM(1);
    if (IN(2)) { PROBE_T0(2) { pg8::Gemm g{Hb, (const bf16*)(W8 + OUT_W8IN), NTOK, INP, DM / 2}; pg8::StaticOrder S; S.init(NTOK, INP, C.G, C.bid);
        EpiBf16I8 E{BIG, INP, SA, SW + SW_IN};
        pg8::gemm_phase<EpiBf16I8, pg8::StaticOrder, true, true, true>(C.lds, g, S, E); } PROBE_T1(2) } SEAM(2);
    if (IN(3)) { PROBE_T0(3) { phase_mlstm_local(C, args); phase_conv(C, args); } PROBE_T1(3) } SEAM(3);
    if (IN(4)) { PROBE_T0(4) { phase_mlstm_scan(C, args); } PROBE_T1(4) } SEAM(4);
    if (IN(5)) { PROBE_T0(5) { phase_mlstm_out(C, args); } PROBE_T1(5) } SEAM(5);
    if (IN(6)) { PROBE_T0(6) { pg8::Gemm g{Hb, (const bf16*)(ws + WS_WOUT0), NTOK, DM, DM}; pg8::StaticOrder S; S.init(NTOK, DM, C.G, C.bid);
        EpiResid<false> E{args.in[0], XB, mod0 + 2 * 1024};
        pg8::gemm_phase<EpiResid<false>, pg8::StaticOrder, true, true>(C.lds, g, S, E); } PROBE_T1(6) } SEAM(6);
    if (IN(7)) { PROBE_T0(7) { phase_rowpass<false, true, true>(C, args, XB, args.in[11], mod0, 3, 4, H8B, SA); } PROBE_T1(7) } SEAM(7);
    if (IN(8)) { PROBE_T0(8) { pg8::Gemm g{H8B, (const bf16*)(W8 + OUT_W8C0), NTOK, 2048, DM / 2}; pg8::StaticOrder S; S.init(NTOK, 2048, C.G, C.bid);
        EpiBf16I8 E{BIG, 2048, SA, SW + SW_C0};
        pg8::gemm_phase<EpiBf16I8, pg8::StaticOrder, true, true, true>(C.lds, g, S, E); } PROBE_T1(8) } SEAM(8);
    if (IN(9)) { PROBE_T0(9) { phase_peer<true>(C, args, TAB, TAB + TAB_BYTES, TSC, TSC + 16384, mod0 + 5 * 1024, args.in[19], mod1, bar); } PROBE_T1(9) } SEAM(9);
    if (IN(10)) { PROBE_T0(10) { pg8::Gemm g{H8B, (const bf16*)(W8 + OUT_W8QKV), NTOK, 3072, DM / 2}; pg8::StaticOrder S; S.init(NTOK, 3072, C.G, C.bid);
        EpiQKV<true> E{BIG, (bf16*)(ws + WS_BIG + 64 * MiB), (bf16*)(ws + WS_BIG + 128 * MiB), args.in[21], args.in[22], SA, SW + SW_QKV};
        pg8::gemm_phase<EpiQKV<true>, pg8::StaticOrder, true, true, true>(C.lds, g, S, E); } PROBE_T1(10) } SEAM(10);
    if (IN(11)) { PROBE_T0(11) { phase_attn(C, args); } PROBE_T1(11) } SEAM(11);
    if (IN(12)) { PROBE_T0(12) { pg8::Gemm g{Hb, (const bf16*)(ws + WS_WOUT1), NTOK, DM, DM}; pg8::StaticOrder S; S.init(NTOK, DM, C.G, C.bid);
        EpiResid<true> E{XB, XB, mod1 + 2 * 1024};
        pg8::gemm_phase<EpiResid<true>, pg8::StaticOrder, true, true>(C.lds, g, S, E); } PROBE_T1(12) } SEAM(12);
    if (IN(13)) { PROBE_T0(13) { phase_rowpass<false, true, true>(C, args, XB, args.in[24], mod1, 3, 4, H8B, SA); } PROBE_T1(13) } SEAM(13);
    if (IN(14)) { PROBE_T0(14) { pg8::Gemm g{H8B, (const bf16*)(W8 + OUT_W8C1), NTOK, 2048, DM / 2}; pg8::StaticOrder S; S.init(NTOK, 2048, C.G, C.bid);
        EpiBf16I8 E{BIG, 2048, SA, SW + SW_C1};
        pg8::gemm_phase<EpiBf16I8, pg8::StaticOrder, true, true, true>(C.lds, g, S, E); } PROBE_T1(14) } SEAM(14);
#ifdef PROBE_DRY
    if (IN(15)) { phase_peer<false, PROBE_DRY>(C, args, TAB + 2 * TAB_BYTES, TAB + 3 * TAB_BYTES, TSC + 2 * 16384, TSC + 3 * 16384, mod1 + 5 * 1024, nullptr, nullptr, bar); GRID_BAR(); }
#endif
    if (IN(15)) { PROBE_T0(15) { phase_peer<false>(C, args, TAB + 2 * TAB_BYTES, TAB + 3 * TAB_BYTES, TSC + 2 * 16384, TSC + 3 * 16384, mod1 + 5 * 1024, nullptr, nullptr, bar); } PROBE_T1(15) }
#undef IN
#undef SEAM
}

extern "C" void kernel_launch(void* const* d_in, const int* in_sizes, int n_in, void* d_out, int out_size, void* d_ws, size_t ws_size, hipStream_t stream) {
    static int grid = 0;
    if (grid == 0) {
        if (n_in != 30 || out_size != NTOK * DM || ws_size < WS_END2) { fprintf(stderr, "kernel_launch: unexpected shapes (n_in %d out %d ws %zu)\n", n_in, out_size, ws_size); grid = -1; return; }
        int dev = 0, cus = 0;
        if (hipGetDevice(&dev) != hipSuccess || hipDeviceGetAttribute(&cus, hipDeviceAttributeMultiprocessorCount, dev) != hipSuccess) { grid = -1; return; }
        if (hipFuncSetAttribute((const void*)mk_fwd, hipFuncAttributeMaxDynamicSharedMemorySize, LDS_BYTES) != hipSuccess) { fprintf(stderr, "kernel_launch: hipFuncSetAttribute failed\n"); grid = -1; return; }
        int per_cu = 0;
        if (hipOccupancyMaxActiveBlocksPerMultiprocessor(&per_cu, (const void*)mk_fwd, NWAVES * 64, LDS_BYTES) != hipSuccess || per_cu < 1) fprintf(stderr, "kernel_launch: occupancy query reports %d\n", per_cu);
        (void)hipGetLastError();
        grid = cus;
    }
    if (grid < 0) return;
    (void)hipMemsetAsync((char*)d_ws + WS_CTL + CW_BAR * 4, 0, XCD_BAR_WORDS * 4, stream);
    Args a{};
    for (int i = 0; i < 30; ++i) a.in[i] = (const float*)d_in[i];
    a.out = (float*)d_out; a.ws = (unsigned char*)d_ws;
#if MK_ONE_LAUNCH
    a.ph_lo = 0; a.ph_hi = N_PHASES;
    hipLaunchKernelGGL(mk_fwd, dim3(grid), dim3(NWAVES * 64), LDS_BYTES, stream, a);
#else
    for (int p = 0; p < N_PHASES; ++p) { a.ph_lo = p; a.ph_hi = p + 1; hipLaunchKernelGGL(mk_fwd, dim3(grid), dim3(NWAVES * 64), LDS_BYTES, stream, a); }
#endif
}
```

```cpp
#include <hip/hip_runtime.h>
#include <cstdio>
#include <cstdint>
#include <cmath>
#define PROBE_MASK 0
namespace pg8 {
#define PG8_LAS __attribute__((address_space(3)))
typedef unsigned short bf16_t;
typedef short bf16x8 __attribute__((ext_vector_type(8)));
typedef float f32x4 __attribute__((ext_vector_type(4)));
typedef unsigned u32x4 __attribute__((ext_vector_type(4)));
constexpr int BM = 256, BK = 64, HALF = 128, HTB = HALF * BK * 2  , STAGE_BYTES = 8 * HTB, NXCD = 8, WGM = 8;

__host__ __device__ __forceinline__ int lds_byte(int r, int c) { const int st = (r >> 4) * 2 + (c >> 5), rr = r & 15, cc = c & 31, ob = rr * 64 + cc * 2; return st * 1024 + (ob ^ (((ob >> 9) & 1) << 5)); }
__host__ __device__ __forceinline__ void stage_rc(int b, int& R, int& C) { const int st = b / 1024, sb = b % 1024, swz = sb ^ (((sb >> 9) & 1) << 5); R = (st >> 1) * 16 + swz / 64; C = (st & 1) * 32 + (swz % 64) / 2; }
__host__ __device__ __forceinline__ int perm32(int rho) { const int n = rho >> 4, i = rho & 15; return 8 * (i >> 2) + 4 * n + (i & 3); }

struct Unit { int pm, pn; };
struct Gemm { const bf16_t* A; const bf16_t* Bt; int M, N, K; };

struct StaticOrder {
    int nM, nN, nwg, G, c;
    __host__ __device__ void init(int M, int N, int G_, int c_) { nM = M / BM; nN = N / BM; nwg = nM * nN; G = G_; c = c_; }
    __host__ __device__ bool next(int i, Unit& u) const {
        const long L = (long)i * G + c; if (L >= nwg) return false;
        int wgid = (int)L; { const int q = nwg / NXCD, r = nwg % NXCD, xcd = wgid % NXCD, off = wgid / NXCD; wgid = (xcd < r ? xcd * (q + 1) : r * (q + 1) + (xcd - r) * q) + off; }
        const int nig = WGM * nN, gid = wgid / nig, fm = gid * WGM, gsz = (nM - fm) < WGM ? (nM - fm) : WGM;
        u.pm = fm + ((wgid % nig) % gsz); u.pn = (wgid % nig) / gsz; return true;
    }
    __device__ __forceinline__ void a_ready(const Unit&) const {}
    __device__ __forceinline__ void done(const Unit&) const {}
};

__device__ __forceinline__ unsigned cvt_pk_bf16(float lo, float hi) { unsigned r; asm volatile("v_cvt_pk_bf16_f32 %0, %1, %2" : "=v"(r) : "v"(lo), "v"(hi)); return r; }
typedef float f32x2 __attribute__((ext_vector_type(2)));
__device__ __forceinline__ f32x2 gelu_pk(f32x2 v) {
    const f32x2 av = __builtin_elementwise_abs(v), d = av * 0.2316418882f + 1.0f;
    f32x2 t; t.x = __builtin_amdgcn_rcpf(d.x); t.y = __builtin_amdgcn_rcpf(d.y);
    f32x2 q = t * 0.5307027145f + (-0.7265760135f); q = q * t + 0.7107068705f; q = q * t + (-0.142248368f); q = q * t + 0.127414796f; q = q * t;
    const f32x2 s = (v * v) * (-0.72134752044f);
    f32x2 e; e.x = __builtin_amdgcn_exp2f(s.x); e.y = __builtin_amdgcn_exp2f(s.y);
    const f32x2 m = v * (q * e), r = v - m;
    f32x2 o; o.x = v.x < 0.f ? m.x : r.x; o.y = v.y < 0.f ? m.y : r.y; return o;
}

template <int ACT  > struct EpiBf16 {
    static constexpr bool PERM = true, AFTER_DRAIN = false; static_assert(ACT == 0 || ACT == 1, "EpiBf16: ACT is 0 (none) or 1 (gelu_pk)");
    bf16_t* O; int ldc; const float* bias; int split_cols; size_t split_stride; float scale0;
    __device__ __forceinline__ void operator()(const f32x4 (&acc)[2][2][4][2], const Unit& u, int wr, int wc, int fr, int fq) const {
        const int row0 = u.pm * BM + wr * 64 + fr; int colt = u.pn * BM; bf16_t* base = O;
        float sc = 1.f; if (split_cols) { const int t = colt / split_cols; base += (size_t)t * split_stride; colt -= t * split_cols; if (t == 0) sc = scale0; }
        const int col0 = colt + wc * 32 + 8 * fq, bcol0 = u.pn * BM + wc * 32 + 8 * fq;
        f32x4 bv[2][2];
#pragma unroll
        for (int bj = 0; bj < 2; ++bj)
#pragma unroll
            for (int n = 0; n < 2; ++n) bv[bj][n] = bias ? *(const f32x4*)(bias + bcol0 + bj * HALF + 4 * n) : (f32x4){0.f, 0.f, 0.f, 0.f};
#pragma unroll
        for (int ai = 0; ai < 2; ++ai)
#pragma unroll
            for (int m = 0; m < 4; ++m) { bf16_t* rowp = base + (size_t)(row0 + ai * HALF + m * 16) * ldc + col0;
#pragma unroll
                for (int bj = 0; bj < 2; ++bj) { f32x4 v0 = acc[ai][bj][m][0] + bv[bj][0], v1 = acc[ai][bj][m][1] + bv[bj][1];
                    if (ACT == 1) { f32x2 a = gelu_pk((f32x2){v0[0], v0[1]}), b = gelu_pk((f32x2){v0[2], v0[3]}), c = gelu_pk((f32x2){v1[0], v1[1]}), d = gelu_pk((f32x2){v1[2], v1[3]});
                        v0 = (f32x4){a.x, a.y, b.x, b.y}; v1 = (f32x4){c.x, c.y, d.x, d.y}; }
                    v0 = v0 * sc; v1 = v1 * sc; u32x4 w; w.x = cvt_pk_bf16(v0[0], v0[1]); w.y = cvt_pk_bf16(v0[2], v0[3]); w.z = cvt_pk_bf16(v1[0], v1[1]); w.w = cvt_pk_bf16(v1[2], v1[3]);
                    *(u32x4*)(rowp + bj * HALF) = w; } }
    }
};
typedef int i32x4 __attribute__((ext_vector_type(4)));
template <bool I8> struct AccSel { typedef f32x4 type; };
template <> struct AccSel<true> { typedef i32x4 type; };
template <class Epi, class Sched, bool ALIGN_EPI = false, bool SP2 = false, bool I8 = false>
__device__ __forceinline__ void gemm_phase(PG8_LAS unsigned char* lds, const Gemm g, const Sched& S, const Epi& E) {
    const int tid = threadIdx.x, wid = __builtin_amdgcn_readfirstlane(tid >> 6), lane = tid & 63, wr = wid >> 2, wc = wid & 3, fr = lane & 15, fq = lane >> 4;
    const int K = g.K, nt = K / BK;
    unsigned voffA[2], voffB[2];
#pragma unroll
    for (int i = 0; i < 2; ++i) { int R, C; stage_rc(tid * 16 + i * 8192, R, C); const int Rb = Epi::PERM ? ((R & ~31) + perm32(R & 31)) : R;
        voffA[i] = (unsigned)(R * K + C) * 2u; voffB[i] = (unsigned)(Rb * K + C) * 2u; }
    const size_t kstep = (size_t)(BK * 2);
    const size_t hstep = (size_t)HALF * K * 2;
    const size_t tstep = 2 * hstep;
    const unsigned ldsw = (unsigned)wid * 1024u;
    const int aoff = lds_byte(wr * 64 + fr, fq * 8), boff = lds_byte(wc * 32 + fr, fq * 8);
#define PG8_SA(b, h) (((b) * 2 + (h)) * HTB)
#define PG8_SB(b, h) ((4 + (b) * 2 + (h)) * HTB)
#define PG8_STAGE(bufoff, gbase, voff) do { _Pragma("unroll") for (int _i = 0; _i < 2; ++_i) \
        __builtin_amdgcn_global_load_lds((const unsigned*)((const char*)(gbase) + (voff)[_i]), (PG8_LAS unsigned*)(lds + (bufoff) + ldsw + _i * 8192), 16, 0, 0); } while (0)
#define PG8_LDA(dst, b, h) do { _Pragma("unroll") for (int m = 0; m < 4; ++m) _Pragma("unroll") for (int k = 0; k < 2; ++k) dst[m][k] = *(const PG8_LAS bf16x8*)(lds + PG8_SA(b, h) + aoff + m * 2048 + k * 1024); } while (0)
#define PG8_LDB(dst, b, h) do { _Pragma("unroll") for (int n = 0; n < 2; ++n) _Pragma("unroll") for (int k = 0; k < 2; ++k) dst[n][k] = *(const PG8_LAS bf16x8*)(lds + PG8_SB(b, h) + boff + n * 2048 + k * 1024); } while (0)
#define PG8_MMA(ai, bj, At, Bt) do { __builtin_amdgcn_s_setprio(1); _Pragma("unroll") for (int m = 0; m < 4; ++m) _Pragma("unroll") for (int n = 0; n < 2; ++n) _Pragma("unroll") for (int k = 0; k < 2; ++k) \
        { if constexpr (I8) acc[ai][bj][m][n] = __builtin_bit_cast(acc_t, __builtin_amdgcn_mfma_i32_16x16x64_i8(__builtin_bit_cast(i32x4, Bt[n][k]), __builtin_bit_cast(i32x4, At[m][k]), __builtin_bit_cast(i32x4, acc[ai][bj][m][n]), 0, 0, 0)); \
          else acc[ai][bj][m][n] = __builtin_bit_cast(acc_t, __builtin_amdgcn_mfma_f32_16x16x32_bf16(Bt[n][k], At[m][k], __builtin_bit_cast(f32x4, acc[ai][bj][m][n]), 0, 0, 0)); } __builtin_amdgcn_s_setprio(0); } while (0)
#define PG8_WAIT_V(n) asm volatile("s_waitcnt vmcnt(" #n ")" ::: "memory")
#define PG8_WAIT_L(n) asm volatile("s_waitcnt lgkmcnt(" #n ")" ::: "memory")
#define PG8_BAR __builtin_amdgcn_s_barrier()
#define PG8_SCHED __builtin_amdgcn_sched_barrier(0)
    Unit cur, nxt; int ui = 0;
    if (!S.next(0, cur)) return;
    typedef typename AccSel<I8>::type acc_t; const acc_t acc_zero = {};
    acc_t acc[2][2][4][2];
#pragma unroll
    for (int a = 0; a < 2; ++a)
#pragma unroll
        for (int b = 0; b < 2; ++b)
#pragma unroll
            for (int m = 0; m < 4; ++m)
#pragma unroll
                for (int n = 0; n < 2; ++n) acc[a][b][m][n] = acc_zero;
    bf16x8 At[4][2], B0[2][2], B1[2][2];
    const char* cA = (const char*)g.A + (size_t)cur.pm * tstep; const char* cB = (const char*)g.Bt + (size_t)cur.pn * tstep;
    S.a_ready(cur);
    if constexpr (SP2) {
        PG8_STAGE(PG8_SB(0, 0), cB, voffB); PG8_STAGE(PG8_SB(0, 1), cB + hstep, voffB); PG8_STAGE(PG8_SA(0, 0), cA, voffA); PG8_STAGE(PG8_SA(0, 1), cA + hstep, voffA);
        if (wr == 1) PG8_BAR;
        PG8_WAIT_V(2); PG8_BAR;
        PG8_STAGE(PG8_SB(1, 0), cB + kstep, voffB); PG8_STAGE(PG8_SA(1, 0), cA + kstep, voffA); PG8_STAGE(PG8_SB(1, 1), cB + hstep + kstep, voffB);
        PG8_WAIT_V(6); PG8_BAR;
    } else {
        PG8_STAGE(PG8_SB(0, 0), cB, voffB); PG8_STAGE(PG8_SA(0, 0), cA, voffA); PG8_STAGE(PG8_SB(0, 1), cB + hstep, voffB); PG8_STAGE(PG8_SA(0, 1), cA + hstep, voffA);
        if (wr == 1) PG8_BAR;
        PG8_WAIT_V(4); PG8_BAR;
        PG8_STAGE(PG8_SB(1, 0), cB + kstep, voffB); PG8_STAGE(PG8_SA(1, 0), cA + kstep, voffA); PG8_STAGE(PG8_SB(1, 1), cB + hstep + kstep, voffB);
        PG8_WAIT_V(6); PG8_BAR;
    }
    for (;;) {
        const bool has_next = S.next(ui + 1, nxt);
        const char* nA = has_next ? (const char*)g.A + (size_t)nxt.pm * tstep : cA; const char* nB = has_next ? (const char*)g.Bt + (size_t)nxt.pn * tstep : cB;
        for (int t = 0; t < nt; t += 2) {
            const bool last = (t == nt - 2);
            const char* a1 = cA + (size_t)(t + 1) * kstep;
            const char* a2 = last ? nA : cA + (size_t)(t + 2) * kstep; const char* b2 = last ? nB : cB + (size_t)(t + 2) * kstep;
            const char* a3 = a2 + kstep; const char* b3 = b2 + kstep;
            if (last && has_next) S.a_ready(nxt);
            if constexpr (SP2) {
            PG8_LDB(B0, 0, 0); PG8_LDB(B1, 0, 1); PG8_SCHED; PG8_LDA(At, 0, 0); PG8_STAGE(PG8_SA(1, 1), a1 + hstep, voffA);
            PG8_WAIT_V(8); PG8_WAIT_L(0); PG8_BAR; PG8_MMA(0, 0, At, B0); PG8_MMA(0, 1, At, B1); PG8_BAR; PG8_SCHED;
            PG8_LDA(At, 0, 1); PG8_STAGE(PG8_SB(0, 0), b2, voffB); PG8_STAGE(PG8_SB(0, 1), b2 + hstep, voffB); PG8_STAGE(PG8_SA(0, 0), a2, voffA);
            PG8_WAIT_V(8); PG8_WAIT_L(0); PG8_BAR; PG8_MMA(1, 0, At, B0); PG8_MMA(1, 1, At, B1); PG8_BAR; PG8_SCHED;
            PG8_LDB(B0, 1, 0); PG8_LDB(B1, 1, 1); PG8_SCHED; PG8_LDA(At, 1, 0); PG8_STAGE(PG8_SA(0, 1), a2 + hstep, voffA);
            PG8_WAIT_V(8); PG8_WAIT_L(0); PG8_BAR; PG8_MMA(0, 0, At, B0); PG8_MMA(0, 1, At, B1); PG8_BAR; PG8_SCHED;
            PG8_LDA(At, 1, 1); PG8_STAGE(PG8_SB(1, 0), b3, voffB); PG8_STAGE(PG8_SB(1, 1), b3 + hstep, voffB); PG8_STAGE(PG8_SA(1, 0), a3, voffA);
            PG8_WAIT_V(8); PG8_WAIT_L(0); PG8_BAR; PG8_MMA(1, 0, At, B0); PG8_MMA(1, 1, At, B1); PG8_BAR; PG8_SCHED;
            } else {
            PG8_LDB(B0, 0, 0); PG8_SCHED; PG8_LDA(At, 0, 0); PG8_STAGE(PG8_SA(1, 1), a1 + hstep, voffA);
            PG8_WAIT_L(8); PG8_BAR; PG8_WAIT_L(0); PG8_MMA(0, 0, At, B0); PG8_BAR; PG8_SCHED;
            PG8_LDB(B1, 0, 1); PG8_STAGE(PG8_SB(0, 0), b2, voffB);
            PG8_BAR; PG8_WAIT_L(0); PG8_MMA(0, 1, At, B1); PG8_BAR;
            PG8_LDA(At, 0, 1); PG8_STAGE(PG8_SA(0, 0), a2, voffA);
            PG8_BAR; PG8_WAIT_L(0); PG8_MMA(1, 0, At, B0); PG8_BAR; PG8_SCHED;
            PG8_STAGE(PG8_SB(0, 1), b2 + hstep, voffB);
            PG8_WAIT_V(6); PG8_BAR; PG8_MMA(1, 1, At, B1); PG8_BAR;
            PG8_LDB(B0, 1, 0); PG8_SCHED; PG8_LDA(At, 1, 0); PG8_STAGE(PG8_SA(0, 1), a2 + hstep, voffA);
            PG8_WAIT_L(8); PG8_BAR; PG8_WAIT_L(0); PG8_MMA(0, 0, At, B0); PG8_BAR; PG8_SCHED;
            PG8_LDB(B1, 1, 1); PG8_STAGE(PG8_SB(1, 0), b3, voffB);
            PG8_BAR; PG8_WAIT_L(0); PG8_MMA(0, 1, At, B1); PG8_BAR;
            PG8_LDA(At, 1, 1); PG8_STAGE(PG8_SA(1, 0), a3, voffA);
            PG8_BAR; PG8_WAIT_L(0); PG8_MMA(1, 0, At, B0); PG8_BAR; PG8_SCHED;
            PG8_STAGE(PG8_SB(1, 1), b3 + hstep, voffB);
            PG8_WAIT_V(6); PG8_BAR; PG8_MMA(1, 1, At, B1); PG8_BAR;
            }
        }
        if constexpr (ALIGN_EPI) { if (wr == 0) PG8_BAR; }
        if constexpr (!Epi::AFTER_DRAIN) { E(acc, cur, wr, wc, fr, fq); S.done(cur); }
        if (!has_next) break;
#pragma unroll
        for (int a = 0; a < 2; ++a)
#pragma unroll
            for (int b = 0; b < 2; ++b)
#pragma unroll
                for (int m = 0; m < 4; ++m)
#pragma unroll
                    for (int n = 0; n < 2; ++n) acc[a][b][m][n] = acc_zero;
        cur = nxt; cA = nA; cB = nB; ++ui;
        if constexpr (ALIGN_EPI) { if (wr == 1) PG8_BAR; }
    }
    PG8_WAIT_V(0);
    if constexpr (!ALIGN_EPI) { if (wr == 0) PG8_BAR; }
    PG8_BAR;
    if constexpr (Epi::AFTER_DRAIN) { E.fused(acc, cur, wr, wc, fr, fq, lds, wid, lane); S.done(cur); }
#undef PG8_SA
#undef PG8_SB
#undef PG8_STAGE
#undef PG8_LDA
#undef PG8_LDB
#undef PG8_MMA
#undef PG8_WAIT_V
#undef PG8_WAIT_L
#undef PG8_BAR
#undef PG8_SCHED
}
}
#define GAS __attribute__((address_space(1)))
#define LAS __attribute__((address_space(3)))
typedef unsigned short bf16;
typedef unsigned v4u __attribute__((ext_vector_type(4)));
typedef float f32x4 __attribute__((ext_vector_type(4)));
typedef short bf16x8 __attribute__((ext_vector_type(8)));
typedef GAS unsigned gu32;
typedef GAS unsigned long long gu64;
#define RLX_AGENT __ATOMIC_RELAXED, __HIP_MEMORY_SCOPE_AGENT
#define LDS_WAIT() asm volatile("s_waitcnt lgkmcnt(0)" ::: "memory")
#define VM_WAIT() asm volatile("s_waitcnt vmcnt(0)" ::: "memory")
__device__ __forceinline__ unsigned long long rt() { return __builtin_amdgcn_s_memrealtime(); }
__device__ __forceinline__ unsigned f2bf(float f) { unsigned u = __builtin_bit_cast(unsigned, f); return (u + 0x7fffu + ((u >> 16) & 1u)) >> 16; }
typedef float pk2_f32x2 __attribute__((ext_vector_type(2))); typedef __bf16 pk2_bf16x2 __attribute__((ext_vector_type(2)));
__device__ __forceinline__ unsigned pk2(float lo, float hi) { const pk2_f32x2 v = {lo, hi}; return __builtin_bit_cast(unsigned, __builtin_convertvector(v, pk2_bf16x2)); }

#define XB_TMO      128
#define XB_XCNT(j)  (256  + 64 * (j))
#define XB_XSUB(j)  (1280 + 64 * (j))
#define XB_XGEN(j)  (2304 + 64 * (j))
#define XB_TOP      3328
#define XB_TOPGEN   3392
#define XCD_BAR_WORDS 3456
#define XB_SPIN_CAP (1u << 18)

__device__ __forceinline__ unsigned xb_ld(unsigned* p)              { return __hip_atomic_load(p, __ATOMIC_RELAXED, __HIP_MEMORY_SCOPE_AGENT); }
__device__ __forceinline__ unsigned xb_add(unsigned* p, unsigned v) { return __hip_atomic_fetch_add(p, v, __ATOMIC_RELAXED, __HIP_MEMORY_SCOPE_AGENT); }
__device__ __forceinline__ unsigned xb_xcc_id() { return (unsigned)__builtin_amdgcn_s_getreg((3 << 11) | 20) & 0xFu; }
#define XB_SPIN(cond, bar) do { unsigned _sp = 0; while (cond) { __builtin_amdgcn_s_sleep(1); \
    if ((++_sp & 255u) == 0u) { if (xb_ld(&(bar)[XB_TMO])) break; if (_sp > XB_SPIN_CAP) { atomicAdd(&(bar)[XB_TMO], 1u); break; } } } } while (0)

struct XcdBarrier {
    unsigned* bar; unsigned x;
    volatile LAS unsigned* st;
};

__device__ __forceinline__ XcdBarrier xcd_barrier_post(unsigned* bar, volatile LAS unsigned* st) {
    XcdBarrier b; b.bar = bar; b.x = xb_xcc_id(); b.st = st;
    if (threadIdx.x == 0) (void)xb_add(&bar[XB_XCNT(b.x)], 1u);
    return b;
}
__device__ __forceinline__ void xcd_barrier_complete(unsigned* bar, unsigned x, unsigned& nloc, unsigned& nx) {
    const unsigned G = gridDim.x * gridDim.y * gridDim.z;
    unsigned sum, cnt, mine, sp = 0u;
    for (;;) {
        sum = 0u; cnt = 0u; mine = 0u;
#pragma unroll
        for (unsigned j = 0; j < 16; ++j) { const unsigned c = xb_ld(&bar[XB_XCNT(j)]); sum += c; cnt += (c > 0u) ? 1u : 0u; mine = (j == x) ? c : mine; }
        if (sum == G) break;
        __builtin_amdgcn_s_sleep(1);
        if ((++sp & 255u) == 0u) { if (xb_ld(&bar[XB_TMO])) break; if (sp > XB_SPIN_CAP) { atomicAdd(&bar[XB_TMO], 1u); break; } }
    }
    nloc = mine > 0u ? mine : 1u; nx = cnt > 0u ? cnt : 1u;
}

__device__ __forceinline__ void xcd_barrier(const XcdBarrier& b) {
    asm volatile("s_waitcnt vmcnt(0)" ::: "memory");
    __syncthreads();
    if (threadIdx.x == 0) {
        unsigned* bar = b.bar;
        __builtin_amdgcn_s_waitcnt(0);
        unsigned nloc = b.st[0], nx = b.st[1];
        if (nloc == 0u) { xcd_barrier_complete(bar, b.x, nloc, nx); b.st[0] = nloc; b.st[1] = nx; }
        const unsigned old = xb_add(&bar[XB_XSUB(b.x)], 1u);
        const unsigned gen = old / nloc;
        if (old + 1u == (gen + 1u) * nloc) {
            __builtin_amdgcn_fence(__ATOMIC_RELEASE, "agent");
            asm volatile("s_waitcnt vmcnt(0)" ::: "memory");
            const unsigned og = xb_add(&bar[XB_TOP], 1u);
            const unsigned tg = og / nx;
            if (og + 1u == (tg + 1u) * nx) xb_add(&bar[XB_TOPGEN], 1u);
            else XB_SPIN(xb_ld(&bar[XB_TOPGEN]) == tg, bar);
            __builtin_amdgcn_fence(__ATOMIC_ACQUIRE, "agent");
            xb_add(&bar[XB_XGEN(b.x)], 1u);
            asm volatile("s_waitcnt vmcnt(0)" ::: "memory");
        } else {
            XB_SPIN(xb_ld(&bar[XB_XGEN(b.x)]) == gen, bar);
            __builtin_amdgcn_fence(__ATOMIC_ACQUIRE, "agent");
            asm volatile("s_waitcnt vmcnt(0)" ::: "memory");
        }
    }
    __syncthreads();
}
#ifndef MK_ONE_LAUNCH
#define MK_ONE_LAUNCH 1
#endif
constexpr int NWAVES = 8;
constexpr int NB = 8, SEQ = 4096, DM = 1024, NTOK = NB * SEQ;
constexpr int INW = 3592, INP = 3584;
constexpr float EPS = 1e-6f;
constexpr size_t MiB = 1u << 20;
constexpr size_t WS_CTL = 0, CTL_ZERO_BYTES = 1 * MiB;
constexpr size_t WS_MOD = 1 * MiB;
constexpr size_t WS_LF = 2 * MiB, WS_LI = WS_LF + 512 * 1024;
constexpr size_t WS_FC = 3 * MiB;
constexpr size_t WS_WIN = 4 * MiB, WS_WOUT0 = 11 * MiB, WS_WC0 = 13 * MiB, WS_WQKV = 17 * MiB, WS_WOUT1 = 23 * MiB, WS_WC1 = 25 * MiB;
constexpr size_t WS_H = 32 * MiB;
constexpr size_t WS_BIG = 96 * MiB;
constexpr size_t WS_IDS = 320 * MiB, WS_GATES = 336 * MiB;
constexpr size_t WS_END = 352 * MiB;
constexpr int CW_BAR = 4096;
constexpr int RING_BYTES = 131072, LDSCTL_OFF = RING_BYTES, MISC_OFF = LDSCTL_OFF + 320, LDS_BYTES = 147456;

__device__ __forceinline__ float wave_sum(float v) {
#pragma unroll
    for (int o = 1; o < 64; o <<= 1) v += __shfl_xor(v, o);
    return v;
}
__device__ __forceinline__ float wave_max(float v) {
#pragma unroll
    for (int o = 1; o < 64; o <<= 1) v = fmaxf(v, __shfl_xor(v, o));
    return v;
}
__device__ __forceinline__ float bf2f(unsigned short b) { return __uint_as_float((unsigned)b << 16); }
__device__ __forceinline__ float bflo(unsigned w) { return __uint_as_float(w << 16); }
__device__ __forceinline__ float bfhi(unsigned w) { return __uint_as_float(w & 0xffff0000u); }
__device__ __forceinline__ float sigmoidf_(float x) { return 1.f / (1.f + __expf(-x)); }
__device__ __forceinline__ float softplusf_(float x) { return fmaxf(x, 0.f) + __logf(1.f + __expf(-fabsf(x))); }
__device__ __forceinline__ float logsigmoidf_(float x) { return fminf(x, 0.f) - __logf(1.f + __expf(-fabsf(x))); }
__device__ __forceinline__ float gelu_exact(float x) { return 0.5f * x * (1.f + erff(x * 0.70710678118654752f)); }
__device__ __forceinline__ float gelu_as(float v) {
    const float av = fabsf(v), t = __builtin_amdgcn_rcpf(av * 0.2316418882f + 1.0f);
    float q = t * 0.5307027145f + (-0.7265760135f); q = q * t + 0.7107068705f; q = q * t + (-0.142248368f); q = q * t + 0.127414796f; q = q * t;
    const float e = __builtin_amdgcn_exp2f((v * v) * (-0.72134752044f));
    const float m = v * (q * e);
    return v < 0.f ? m : v - m;
}

struct Args { const float* in[30]; float* out; unsigned char* ws; int ph_lo, ph_hi; };

struct Ctx {
    LAS unsigned char* lds;
    int tid, lane, wave, G, bid;
    int gw, NGW;
    long gt, NGT;
};
template <bool BASE_BF16>
struct EpiResid {
    static constexpr bool PERM = true, AFTER_DRAIN = false;
    const void* base; bf16* out; const float* gate;
    __device__ __forceinline__ void operator()(const pg8::f32x4 (&acc)[2][2][4][2], const pg8::Unit& u, int wr, int wc, int fr, int fq) const {
        using pg8::f32x4;
        const int col0 = u.pn * 256 + wc * 32 + 8 * fq;
        const float* gp = gate + (size_t)((u.pm * 256) / SEQ) * 6144 + col0;
        f32x4 gv[2][2];
#pragma unroll
        for (int bj = 0; bj < 2; ++bj)
#pragma unroll
            for (int n = 0; n < 2; ++n) { gv[bj][n] = *(const f32x4*)(gp + bj * 128 + 4 * n); gv[bj][n] = gv[bj][n] + 1.0f; }
#pragma unroll
        for (int ai = 0; ai < 2; ++ai)
#pragma unroll
            for (int m = 0; m < 4; ++m) {
                const int r = ai * 128 + wr * 64 + m * 16 + fr; const size_t off = (size_t)(u.pm * 256 + r) * DM + col0;
#pragma unroll
                for (int bj = 0; bj < 2; ++bj) {
                    f32x4 b0, b1;
                    if (BASE_BF16) { const v4u w = *(const v4u*)((const bf16*)base + off + bj * 128); b0 = (f32x4){bflo(w.x), bfhi(w.x), bflo(w.y), bfhi(w.y)}; b1 = (f32x4){bflo(w.z), bfhi(w.z), bflo(w.w), bfhi(w.w)}; }
                    else { b0 = *(const f32x4*)((const float*)base + off + bj * 128); b1 = *(const f32x4*)((const float*)base + off + bj * 128 + 4); }
                    const f32x4 v0 = b0 + gv[bj][0] * acc[ai][bj][m][0], v1 = b1 + gv[bj][1] * acc[ai][bj][m][1];
                    v4u o; o.x = pk2(v0[0], v0[1]); o.y = pk2(v0[2], v0[3]); o.z = pk2(v1[0], v1[1]); o.w = pk2(v1[2], v1[3]);
                    *(v4u*)(out + off + bj * 128) = o;
                }
            }
    }
};

constexpr size_t WS_SA = WS_MOD + 768 * 1024;
constexpr size_t OUT_W8 = 96 * MiB;
constexpr size_t OUT_W8IN = OUT_W8, OUT_W8C0 = OUT_W8 + 4 * MiB, OUT_W8QKV = OUT_W8 + 6 * MiB, OUT_W8C1 = OUT_W8 + 9 * MiB, OUT_SW = OUT_W8 + 11 * MiB;
constexpr int SW_IN = 0, SW_C0 = 4096, SW_QKV = 8192, SW_C1 = 12288;
__device__ __forceinline__ void quantize_rows(const Ctx& C, const bf16* W, int N, unsigned char* W8, float* SW) {
    for (int n = C.gw; n < N; n += C.NGW) {
        const v4u w0 = *(const v4u*)(W + (size_t)n * DM + 16 * C.lane), w1 = *(const v4u*)(W + (size_t)n * DM + 16 * C.lane + 8);
        float x[16] = {bflo(w0.x), bfhi(w0.x), bflo(w0.y), bfhi(w0.y), bflo(w0.z), bfhi(w0.z), bflo(w0.w), bfhi(w0.w), bflo(w1.x), bfhi(w1.x), bflo(w1.y), bfhi(w1.y), bflo(w1.z), bfhi(w1.z), bflo(w1.w), bfhi(w1.w)};
        float am = 0.f;
#pragma unroll
        for (int i = 0; i < 16; ++i) am = fmaxf(am, fabsf(x[i]));
        am = fmaxf(wave_max(am), 1e-30f); const float qi = 127.f / am;
        v4u o;
#pragma unroll
        for (int q = 0; q < 4; ++q) { const int q0 = (int)rintf(x[4 * q] * qi), q1 = (int)rintf(x[4 * q + 1] * qi), q2 = (int)rintf(x[4 * q + 2] * qi), q3 = (int)rintf(x[4 * q + 3] * qi);
            o[q] = ((unsigned)q0 & 255u) | (((unsigned)q1 & 255u) << 8) | (((unsigned)q2 & 255u) << 16) | ((unsigned)q3 << 24); }
        *(v4u*)(W8 + (size_t)n * DM + 16 * C.lane) = o;
        if (C.lane == 0) SW[n] = am * (1.f / 127.f);
    }
}
struct EpiBf16I8 {
    static constexpr bool PERM = true, AFTER_DRAIN = false;
    bf16* O; int ldc; const float* sa; const float* sw;
    __device__ __forceinline__ void operator()(const pg8::i32x4 (&acc)[2][2][4][2], const pg8::Unit& u, int wr, int wc, int fr, int fq) const {
        using pg8::f32x4;
        const int col0 = u.pn * 256 + wc * 32 + 8 * fq;
        f32x4 cs[2][2];
#pragma unroll
        for (int bj = 0; bj < 2; ++bj)
#pragma unroll
            for (int n = 0; n < 2; ++n) cs[bj][n] = *(const f32x4*)(sw + col0 + bj * 128 + 4 * n);
#pragma unroll
        for (int ai = 0; ai < 2; ++ai)
#pragma unroll
            for (int m = 0; m < 4; ++m) { const int row = u.pm * 256 + ai * 128 + wr * 64 + m * 16 + fr; const float rs = sa[row];
                bf16* rowp = O + (size_t)row * ldc + col0;
#pragma unroll
                for (int bj = 0; bj < 2; ++bj) { const pg8::i32x4 a0 = acc[ai][bj][m][0], a1 = acc[ai][bj][m][1];
                    v4u w; w.x = pk2((float)a0[0] * rs * cs[bj][0][0], (float)a0[1] * rs * cs[bj][0][1]); w.y = pk2((float)a0[2] * rs * cs[bj][0][2], (float)a0[3] * rs * cs[bj][0][3]);
                    w.z = pk2((float)a1[0] * rs * cs[bj][1][0], (float)a1[1] * rs * cs[bj][1][1]); w.w = pk2((float)a1[2] * rs * cs[bj][1][2], (float)a1[3] * rs * cs[bj][1][3]);
                    *(v4u*)(rowp + bj * 128) = w; } }
    }
};

__device__ __forceinline__ void transpose_item(const float* W, int ldw, int src_col0, bf16* WT, int K, int dst_row0, int k0, LAS float* scr, int lane) {
#pragma unroll 8
    for (int i = 0; i < 32; ++i) { const int kk = 2 * i + (lane >> 5); scr[kk * 33 + (lane & 31)] = W[(size_t)(k0 + kk) * ldw + src_col0 + (lane & 31)]; }
    LDS_WAIT(); asm volatile("" ::: "memory");
    const int c = lane & 7;
#pragma unroll
    for (int j = 0; j < 4; ++j) { const int n = (lane >> 3) + 8 * j; const LAS float* s = scr + (8 * c) * 33 + n;
        v4u o; o.x = pk2(s[0 * 33], s[1 * 33]); o.y = pk2(s[2 * 33], s[3 * 33]); o.z = pk2(s[4 * 33], s[5 * 33]); o.w = pk2(s[6 * 33], s[7 * 33]);
        *(GAS v4u*)(WT + (size_t)(dst_row0 + n) * K + k0 + 8 * c) = o; }
    LDS_WAIT(); asm volatile("" ::: "memory");
}

__device__ __forceinline__ void phase_prep(const Ctx& C, const Args& A) {
    unsigned char* ws = A.ws;
    {
        LAS float* scr = (LAS float*)(C.lds + C.wave * 16384);
        constexpr int I_IN = 16 * (INP / 32), I_O = 16 * 32, I_QKV = 16 * 96;
        constexpr int NIT = I_IN + I_O + I_QKV + I_O;
        for (int it = C.gw; it < NIT; it += C.NGW) {
            int r = it;
            if (r < I_IN) { const int kb = r / (INP / 32), nb = r % (INP / 32); const int dst = nb * 32, src = dst + (dst >= 2048 ? 8 : 0);
                transpose_item(A.in[5], INW, src, (bf16*)(ws + WS_WIN), 1024, dst, kb * 64, scr, C.lane); continue; } r -= I_IN;
            if (r < I_O) { const int kb = r / 32, nb = r % 32; transpose_item(A.in[10], 1024, nb * 32, (bf16*)(ws + WS_WOUT0), 1024, nb * 32, kb * 64, scr, C.lane); continue; } r -= I_O;
            if (r < I_QKV) { const int kb = r / 96, nb = r % 96; const int src = (nb >> 3) * 256 + 64 * (nb & 3) + 32 * ((nb >> 2) & 1);
                transpose_item(A.in[20], 3072, src, (bf16*)(ws + WS_WQKV), 1024, nb * 32, kb * 64, scr, C.lane); continue; } r -= I_QKV;
            { const int kb = r / 32, nb = r % 32; transpose_item(A.in[23], 1024, nb * 32, (bf16*)(ws + WS_WOUT1), 1024, nb * 32, kb * 64, scr, C.lane); }
        }
    }
    {
        LAS float* sc = (LAS float*)C.lds;
        LAS float* red = (LAS float*)(C.lds + 32768);
        if (C.bid < 96) {
            __syncthreads();
            for (int i = C.tid; i < NB * DM; i += NWAVES * 64) { const float v = A.in[1][i]; sc[i] = v / (1.f + __expf(-v)); }
            __syncthreads();
            for (int item = C.bid; item < 96; item += C.G) {
                const int l = item / 48, jc = item % 48;
                const float* W = A.in[l ? 17 : 2] + 128 * jc + 2 * C.lane;
                float a0[NB], a1[NB];
#pragma unroll
                for (int b = 0; b < NB; ++b) a0[b] = a1[b] = 0.f;
#pragma unroll 32
                for (int kk = 0; kk < 128; ++kk) { const int k = 128 * C.wave + kk; const float2 w = *(const float2*)(W + (size_t)k * 6144);
#pragma unroll
                    for (int b = 0; b < NB; ++b) { const float s = sc[b * DM + k]; a0[b] += s * w.x; a1[b] += s * w.y; } }
#pragma unroll
                for (int b = 0; b < NB; ++b) { red[(C.wave * NB + b) * 128 + 2 * C.lane] = a0[b]; red[(C.wave * NB + b) * 128 + 2 * C.lane + 1] = a1[b]; }
                __syncthreads();
                float* mod = (float*)(ws + WS_MOD);
                for (int o = C.tid; o < NB * 128; o += NWAVES * 64) { const int b = o >> 7, j = o & 127; float s = A.in[l ? 18 : 3][128 * jc + j];
#pragma unroll
                    for (int w = 0; w < NWAVES; ++w) s += red[(w * NB + b) * 128 + j];
                    mod[(size_t)(l * NB + b) * 6144 + 128 * jc + j] = s; }
                __syncthreads();
            }
        }
    }
    {
        LAS float* kt = (LAS float*)C.lds;
        LAS float* wt = (LAS float*)(C.lds + 128 * 132 * 4);
        for (int item = C.bid; item < 512; item += C.G) {
            const int l = item >> 8, hh = (item >> 4) & 15, kb = item & 15;
            const float* Wq = A.in[l ? 25 : 12]; const float* Kh = A.in[l ? ((hh & 1) ? 27 : 26) : ((hh & 1) ? 14 : 13)];
            bf16* Wc = (bf16*)(ws + (l ? WS_WC1 : WS_WC0));
            __syncthreads();
#pragma unroll
            for (int i = 0; i < 8; ++i) { const int id = C.tid + 512 * i, row = id >> 5, c4 = id & 31; *(LAS f32x4*)(kt + row * 132 + 4 * c4) = *(const f32x4*)(Kh + row * 128 + 4 * c4); }
#pragma unroll
            for (int i = 0; i < 4; ++i) { const int id = C.tid + 512 * i, row = id >> 5, c4 = id & 31; *(LAS f32x4*)(wt + row * 132 + 4 * c4) = *(const f32x4*)(Wq + (size_t)(kb * 64 + row) * 2048 + hh * 128 + 4 * c4); }
            __syncthreads();
            const int key = C.tid & 127, kg = C.tid >> 7;
            float acc[16];
#pragma unroll
            for (int i = 0; i < 16; ++i) acc[i] = 0.f;
#pragma unroll 2
            for (int d4 = 0; d4 < 32; ++d4) { const f32x4 kv = *(const LAS f32x4*)(kt + key * 132 + 4 * d4);
#pragma unroll
                for (int i = 0; i < 16; ++i) { const f32x4 wv = *(const LAS f32x4*)(wt + (kg * 16 + i) * 132 + 4 * d4); acc[i] += (kv.x * wv.x + kv.y * wv.y) + (kv.z * wv.z + kv.w * wv.w); } }
            v4u o0, o1; o0.x = pk2(acc[0], acc[1]); o0.y = pk2(acc[2], acc[3]); o0.z = pk2(acc[4], acc[5]); o0.w = pk2(acc[6], acc[7]);
            o1.x = pk2(acc[8], acc[9]); o1.y = pk2(acc[10], acc[11]); o1.z = pk2(acc[12], acc[13]); o1.w = pk2(acc[14], acc[15]);
            bf16* dst = Wc + (size_t)(hh * 128 + key) * 1024 + kb * 64 + kg * 16;
            *(v4u*)dst = o0; *(v4u*)(dst + 8) = o1;
        }
        __syncthreads();
    }
}

template <bool GATES, bool IN_BF16, bool OUT_I8 = false>
__device__ __forceinline__ void phase_rowpass(const Ctx& C, const Args& A, const void* xin, const float* gain, const float* modl  , int ch_shift, int ch_scale, bf16* hout, float* sa = nullptr) {
    f32x4 wg0[GATES ? 16 : 1], wg1[GATES ? 16 : 1];
    if (GATES) {
        const float* Wg = A.in[5] + 2048;
#pragma unroll
        for (int j = 0; j < 4; ++j)
#pragma unroll
            for (int e = 0; e < 4; ++e) { const int k = 4 * C.lane + 256 * j + e; wg0[4 * j + e] = *(const f32x4*)(Wg + (size_t)k * INW); wg1[4 * j + e] = *(const f32x4*)(Wg + (size_t)k * INW + 4); }
    }
    for (int row = C.gw; row < NTOK; row += C.NGW) {
        const int b = row >> 12;
        f32x4 v[4]; float ss = 0.f;
#pragma unroll
        for (int j = 0; j < 4; ++j) {
            if (IN_BF16) { const uint2 w = *(const uint2*)((const bf16*)xin + (size_t)row * DM + 4 * C.lane + 256 * j); v[j] = (f32x4){bflo(w.x), bfhi(w.x), bflo(w.y), bfhi(w.y)}; }
            else v[j] = *(const f32x4*)((const float*)xin + (size_t)row * DM + 4 * C.lane + 256 * j);
            ss += v[j].x * v[j].x + v[j].y * v[j].y + v[j].z * v[j].z + v[j].w * v[j].w; }
        const float rstd = rsqrtf(wave_sum(ss) * (1.f / DM) + EPS);
        const float* shp = modl + (size_t)b * 6144 + ch_shift * 1024 + 4 * C.lane; const float* scp = modl + (size_t)b * 6144 + ch_scale * 1024 + 4 * C.lane;
        f32x4 h[4];
#pragma unroll
        for (int j = 0; j < 4; ++j) { const f32x4 g = *(const f32x4*)(gain + 4 * C.lane + 256 * j), sc = *(const f32x4*)(scp + 256 * j), sh = *(const f32x4*)(shp + 256 * j);
            h[j] = v[j] * rstd * g * (sc + 1.0f) + sh;
            if (!OUT_I8) { uint2 o; o.x = pk2(h[j].x, h[j].y); o.y = pk2(h[j].z, h[j].w);
                *(uint2*)(hout + (size_t)row * DM + 4 * C.lane + 256 * j) = o; } }
        if (OUT_I8) {
            float am = 0.f;
#pragma unroll
            for (int j = 0; j < 4; ++j) am = fmaxf(am, fmaxf(fmaxf(fabsf(h[j].x), fabsf(h[j].y)), fmaxf(fabsf(h[j].z), fabsf(h[j].w))));
            am = fmaxf(wave_max(am), 1e-20f); const float qi = 127.f / am;
            unsigned char* h8 = (unsigned char*)hout + (size_t)row * DM + 4 * C.lane;
#pragma unroll
            for (int j = 0; j < 4; ++j) { const int q0 = (int)rintf(h[j].x * qi), q1 = (int)rintf(h[j].y * qi), q2 = (int)rintf(h[j].z * qi), q3 = (int)rintf(h[j].w * qi);
                *(unsigned*)(h8 + 256 * j) = ((unsigned)q0 & 255u) | (((unsigned)q1 & 255u) << 8) | (((unsigned)q2 & 255u) << 16) | ((unsigned)q3 << 24); }
            if (C.lane == 0) sa[row] = am * (1.f / 127.f);
        }
        if (GATES) {
            f32x4 d0 = {0.f, 0.f, 0.f, 0.f}, d1 = {0.f, 0.f, 0.f, 0.f};
#pragma unroll
            for (int j = 0; j < 4; ++j)
#pragma unroll
                for (int e = 0; e < 4; ++e) { const float hv = h[j][e]; d0 += wg0[4 * j + e] * hv; d1 += wg1[4 * j + e] * hv; }
            float d[8] = {d0.x, d0.y, d0.z, d0.w, d1.x, d1.y, d1.z, d1.w};
#pragma unroll
            for (int q = 0; q < 8; ++q) d[q] = wave_sum(d[q]);
            if (C.lane == 0) {
                const int s = row & (SEQ - 1); float* LF = (float*)(A.ws + WS_LF); float* LI = (float*)(A.ws + WS_LI);
#pragma unroll
                for (int hh = 0; hh < 4; ++hh) { LI[(size_t)(b * 4 + hh) * SEQ + s] = d[hh] + A.in[6][hh]; LF[(size_t)(b * 4 + hh) * SEQ + s] = logsigmoidf_(d[4 + hh] + A.in[7][hh]); }
            }
        }
    }
}

__device__ __forceinline__ void phase_conv(const Ctx& C, const Args& A) {
    const bf16* P = (const bf16*)(A.ws + WS_BIG); bf16* mix = (bf16*)(A.ws + WS_H); const float* cw = A.in[8];
    for (long it = C.gt; it < (long)NTOK * 64; it += C.NGT) {
        const int cg = (int)(it & 63), tok = (int)(it >> 6), t = tok & (SEQ - 1), c0 = cg * 8;
        float conv[8];
#pragma unroll
        for (int e = 0; e < 8; ++e) conv[e] = 0.f;
#pragma unroll
        for (int k = 0; k < 3; ++k) {
            const int dt = 2 - k;
            if (t - dt >= 0) {
                const bf16* r = P + (size_t)(tok - dt) * INP;
                const v4u cc = *(const v4u*)(r + 2560 + c0), chv = *(const v4u*)(r + 3072 + c0);
                const f32x4 w0 = *(const f32x4*)(cw + k * 512 + c0), w1 = *(const f32x4*)(cw + k * 512 + c0 + 4);
                conv[0] += w0.x * bflo(cc.x) * bflo(chv.x); conv[1] += w0.y * bfhi(cc.x) * bfhi(chv.x);
                conv[2] += w0.z * bflo(cc.y) * bflo(chv.y); conv[3] += w0.w * bfhi(cc.y) * bfhi(chv.y);
                conv[4] += w1.x * bflo(cc.z) * bflo(chv.z); conv[5] += w1.y * bfhi(cc.z) * bfhi(chv.z);
                conv[6] += w1.z * bflo(cc.w) * bflo(chv.w); conv[7] += w1.w * bfhi(cc.w) * bfhi(chv.w);
            }
        }
        const v4u cb = *(const v4u*)(P + (size_t)tok * INP + 2048 + c0);
        v4u o; o.x = pk2(conv[0] * bflo(cb.x), conv[1] * bfhi(cb.x)); o.y = pk2(conv[2] * bflo(cb.y), conv[3] * bfhi(cb.y));
        o.z = pk2(conv[4] * bflo(cb.z), conv[5] * bfhi(cb.z)); o.w = pk2(conv[6] * bflo(cb.w), conv[7] * bfhi(cb.w));
        *(v4u*)(mix + (size_t)tok * DM + 512 + c0) = o;
    }
}
constexpr size_t WS_TAB = 352 * MiB;
constexpr size_t TAB_BYTES = (size_t)16384 * 1024;
constexpr size_t WS_TSC = WS_TAB + 4 * TAB_BYTES;
constexpr size_t WS_XB = 420 * MiB;
constexpr size_t WS_END2 = WS_XB + 64 * MiB;
typedef float f32x2 __attribute__((ext_vector_type(2)));
typedef __bf16 bf16x2_t __attribute__((ext_vector_type(2)));
typedef unsigned u32x2 __attribute__((ext_vector_type(2)));
__device__ __forceinline__ float dot2bf(unsigned a, unsigned b, float c) { return __builtin_amdgcn_fdot2_f32_bf16(__builtin_bit_cast(bf16x2_t, a), __builtin_bit_cast(bf16x2_t, b), c, false); }
template <int CTRL> __device__ __forceinline__ unsigned dppu(unsigned v) { return (unsigned)__builtin_amdgcn_update_dpp(0, (int)v, CTRL, 0xF, 0xF, true); }
__device__ __forceinline__ float wave_sum_dpp(float v) {
    v += __uint_as_float(dppu<0xB1>(__float_as_uint(v)));
    v += __uint_as_float(dppu<0x4E>(__float_as_uint(v)));
    v += __uint_as_float(dppu<0x124>(__float_as_uint(v)));
    v += __uint_as_float(dppu<0x128>(__float_as_uint(v)));
    const unsigned u = __float_as_uint(v);
    return (__uint_as_float(__builtin_amdgcn_readlane(u, 0)) + __uint_as_float(__builtin_amdgcn_readlane(u, 16))) + (__uint_as_float(__builtin_amdgcn_readlane(u, 32)) + __uint_as_float(__builtin_amdgcn_readlane(u, 48)));
}
__device__ __forceinline__ void ins16(unsigned (&val)[16], unsigned k) {
#pragma unroll
    for (int j = 0; j < 16; ++j) { const unsigned t = val[j] < k ? val[j] : k; val[j] = val[j] < k ? k : val[j]; k = t; }
}
#define PEER_CE(x, i, l) { const unsigned a_ = x[i] < x[l] ? x[l] : x[i], b_ = x[i] < x[l] ? x[i] : x[l]; x[i] = a_; x[l] = b_; }
__device__ __forceinline__ void sort16_desc(unsigned (&x)[16]) {
#pragma unroll
    for (int k = 2; k <= 16; k <<= 1)
#pragma unroll
        for (int j = k >> 1; j > 0; j >>= 1)
#pragma unroll
            for (int i = 0; i < 16; ++i) { const int l = i ^ j; if (l > i) { if ((i & k) == 0) { PEER_CE(x, i, l) } else { PEER_CE(x, l, i) } } }
}
__device__ __forceinline__ void merge16_desc(unsigned (&v)[16], const unsigned (&s)[16]) {
#pragma unroll
    for (int i = 0; i < 16; ++i) v[i] = v[i] < s[15 - i] ? s[15 - i] : v[i];
#pragma unroll
    for (int j = 8; j > 0; j >>= 1)
#pragma unroll
        for (int i = 0; i < 16; ++i) { const int l = i ^ j; if (l > i) PEER_CE(v, i, l) }
}
__device__ __forceinline__ unsigned ord32(unsigned b) { return b ^ ((unsigned)((int)b >> 31) | 0x80000000u); }
__device__ __forceinline__ float unord(unsigned o, unsigned mask) { o &= mask; return __uint_as_float((o & 0x80000000u) ? (o ^ 0x80000000u) : (~o & mask)); }

template <bool NEXT, int DRY = 0>
__device__ __forceinline__ void phase_peer(const Ctx& C, const Args& A, const unsigned char* Utab, const unsigned char* Vtab, const float* SU, const float* SV, const float* g2  ,
                                           const float* ngain, const float* nmod  , const XcdBarrier& bar) {
    const bf16* SC = (const bf16*)(A.ws + WS_BIG); bf16* Hb = (bf16*)(A.ws + WS_H);
#ifndef PEER_NBK
#define PEER_NBK 32
#endif
    constexpr int NBK = PEER_NBK, BSH = (NBK == 32 ? 9 : NBK == 64 ? 8 : 7), BPL = NBK / 16;
    LAS unsigned char* wb = C.lds + C.wave * (1024 + 32 * NBK + 8192);
    LAS unsigned char* IDXB = wb; LAS unsigned* CNT = (LAS unsigned*)(wb + 1024); LAS unsigned* PRE = (LAS unsigned*)(wb + 1024 + 16 * NBK); LAS v4u* ENT = (LAS v4u*)(wb + 1024 + 32 * NBK);
#ifndef PEER_SYNC_EVERY
#define PEER_SYNC_EVERY 32
#endif
    const bool wg_uniform = (DRY != 6) && ((NTOK / 4) % C.NGW == 0);
    unsigned flip = 0u;
#ifdef PEER_STAGGER
    if (C.wave >= 4) { const unsigned long long t0_ = __builtin_amdgcn_s_memrealtime(); while (__builtin_amdgcn_s_memrealtime() - t0_ < (unsigned long long)PEER_STAGGER) __builtin_amdgcn_s_sleep(16); }
#endif
    const int gw_ = (DRY == 6) ? ((C.bid >> 1) * NWAVES + C.wave) : C.gw, ngw_ = (DRY == 6) ? (C.NGW >> 1) : C.NGW;
    if (DRY == 6 && (C.bid & 1)) return;
    for (int tb = gw_; tb < NTOK / 4; tb += ngw_) {
        const int tok0 = tb * 4;
#if MK_ONE_LAUNCH && defined(PEER_SYNC)
        if (tb >= C.NGW) xcd_barrier(bar);
#endif
        int lane = C.lane; asm volatile("" : "+v"(lane));
        const int par = lane & 1, tl = lane >> 4, grp = lane & 15, head = grp >> 1, i16 = lane & 15;
        {
            unsigned val[16];
            const v4u* sp = (const v4u*)(SC + (size_t)(tok0 + tl) * 2048 + grp * 128);
            v4u raw[16];
#pragma unroll
            for (int c = 0; c < 16; ++c) raw[c] = sp[c];
#pragma unroll
            for (int c = 0; c < 16; c += 2) {
                const v4u c0 = raw[c], c1 = raw[c + 1];
                const unsigned ib = 127u - 8u * (unsigned)c;
                unsigned ks[16];
#pragma unroll
                for (int e = 0; e < 4; ++e) { ks[2 * e] = (ord32(c0[e] << 16) & 0xFFFF0000u) | (ib - 2u * e); ks[2 * e + 1] = (ord32(c0[e] & 0xFFFF0000u) & 0xFFFF0000u) | (ib - 2u * e - 1u);
                    ks[8 + 2 * e] = (ord32(c1[e] << 16) & 0xFFFF0000u) | (ib - 8u - 2u * e); ks[9 + 2 * e] = (ord32(c1[e] & 0xFFFF0000u) & 0xFFFF0000u) | (ib - 9u - 2u * e); }
                sort16_desc(ks);
                if (c == 0) {
#pragma unroll
                    for (int j = 0; j < 16; ++j) val[j] = ks[j];
                } else merge16_desc(val, ks);
            }
#pragma unroll
            for (int z = 0; z < NBK / 16; ++z) CNT[lane + 64 * z] = 0u;
            float X[16], Y[16];
            v4u ib4 = {0u, 0u, 0u, 0u};
#pragma unroll
            for (int j = 0; j < 16; ++j) { X[j] = unord(val[j], 0xFFFF0000u); Y[j] = unord(dppu<0xB1>(val[j]), 0xFFFF0000u); ib4[j >> 2] |= (127u - (val[j] & 127u)) << (8 * (j & 3)); }
            *(LAS v4u*)(IDXB + lane * 16) = ib4;
            unsigned cand[16], cb2[16];
            unsigned parv = (unsigned)par; asm volatile("" : "+v"(parv));
#define PEER_CKEY(p, q) ((((p) == (q)) && parv) ? 0u : ((ord32(__float_as_uint(X[p] + Y[q])) & 0xFFFFFF00u) | (255u - ((unsigned)((p) * 16 + (q)) + parv * (unsigned)(15 * ((q) - (p)))))))
            cand[0] = PEER_CKEY(0, 0); cand[1] = PEER_CKEY(0, 1); cand[2] = PEER_CKEY(0, 2); cand[3] = PEER_CKEY(0, 3); cand[4] = PEER_CKEY(0, 4); cand[5] = PEER_CKEY(0, 5); cand[6] = PEER_CKEY(0, 6); cand[7] = PEER_CKEY(0, 7);
            cand[8] = PEER_CKEY(0, 8); cand[9] = PEER_CKEY(0, 9); cand[10] = PEER_CKEY(0, 10); cand[11] = PEER_CKEY(0, 11); cand[12] = PEER_CKEY(0, 12); cand[13] = PEER_CKEY(0, 13); cand[14] = PEER_CKEY(0, 14); cand[15] = PEER_CKEY(0, 15);
            cb2[0] = PEER_CKEY(1, 1); cb2[1] = PEER_CKEY(1, 2); cb2[2] = PEER_CKEY(1, 3); cb2[3] = PEER_CKEY(1, 4); cb2[4] = PEER_CKEY(1, 5); cb2[5] = PEER_CKEY(1, 6); cb2[6] = PEER_CKEY(1, 7);
            cb2[7] = PEER_CKEY(2, 2); cb2[8] = PEER_CKEY(2, 3); cb2[9] = PEER_CKEY(2, 4); cb2[10] = PEER_CKEY(3, 3); cb2[11] = 0u; cb2[12] = 0u; cb2[13] = 0u; cb2[14] = 0u; cb2[15] = 0u;
#undef PEER_CKEY
            sort16_desc(cand); sort16_desc(cb2); merge16_desc(cand, cb2);
            unsigned mg[16]; float fv[16]; float mx = -INFINITY;
#pragma unroll
            for (int k = 0; k < 16; ++k) { const unsigned o = dppu<0xB1>(cand[15 - k]); mg[k] = cand[k] < o ? o : cand[k]; fv[k] = unord(mg[k], 0xFFFFFF00u); mx = fmaxf(mx, fv[k]); }
            float ssum = 0.f;
#pragma unroll
            for (int k = 0; k < 16; ++k) { fv[k] = __expf(fv[k] - mx); ssum += fv[k]; }
            const float inv = 1.f / ssum;
            asm volatile("s_waitcnt lgkmcnt(0)" ::: "memory");
            unsigned eid[8], rk[8]; float esu[8], egv[8];
#pragma unroll
            for (int k = 0; k < 8; ++k) { const unsigned fi = 255u - (mg[k] & 255u);
                const unsigned e1 = IDXB[(lane & ~1) * 16 + (fi >> 4)], e2 = IDXB[(lane | 1) * 16 + (fi & 15u)];
                eid[k] = e1 * 128u + e2;
                rk[k] = __hip_atomic_fetch_add(CNT + tl * NBK + (eid[k] >> BSH), 1u, __ATOMIC_RELAXED, __HIP_MEMORY_SCOPE_WORKGROUP);
                esu[k] = SU[eid[k]]; egv[k] = fv[k] * inv * SV[eid[k]]; }
            asm volatile("s_waitcnt lgkmcnt(0)" ::: "memory");
            { unsigned cb[BPL]; unsigned s = 0u;
#pragma unroll
              for (int z = 0; z < BPL; ++z) { cb[z] = CNT[tl * NBK + BPL * i16 + z]; s += cb[z]; }
              const unsigned tot = s;
              s += dppu<0x111>(s); s += dppu<0x112>(s); s += dppu<0x114>(s); s += dppu<0x118>(s);
              unsigned ex = s - tot;
#pragma unroll
              for (int z = 0; z < BPL; ++z) { PRE[tl * NBK + BPL * i16 + z] = ex; ex += cb[z]; } }
            asm volatile("s_waitcnt lgkmcnt(0)" ::: "memory");
#pragma unroll
            for (int k = 0; k < 8; ++k) { unsigned pos = PRE[tl * NBK + (eid[k] >> BSH)] + rk[k]; pos = flip ? 127u - pos : pos;
                ENT[tl * 128 + pos] = (v4u){eid[k], __float_as_uint(esu[k]), __float_as_uint(egv[k]), 0u}; }
            asm volatile("s_waitcnt lgkmcnt(0)" ::: "memory");
            flip ^= 1u;
        }
        if (wg_uniform) __syncthreads();
        if (DRY != 3) {
            const int tok = tok0 + tl; const int b = tok >> 12;
            LAS v4u* E = ENT + tl * 128;
            float cmax = 0.f;
            {
                unsigned hq[16]; const float hs = ((const float*)(A.ws + WS_SA))[tok];
#pragma unroll
                for (int j = 0; j < 4; ++j) { const v4u hw = *(const v4u*)(A.ws + WS_IDS + (size_t)tok * DM + 256 * j + 16 * i16); hq[4 * j] = hw.x; hq[4 * j + 1] = hw.y; hq[4 * j + 2] = hw.z; hq[4 * j + 3] = hw.w; }
                v4u B[8][4]; unsigned idr[8]; float mine = 0.f;
#define PEER_LOADI(R_, tab, id_) { const unsigned off = ((id_) & (DRY == 2 ? 1023u : 16383u)) * 1024u + 16u * (unsigned)i16; \
                _Pragma("unroll") for (int j = 0; j < 4; ++j) R_[j] = (DRY == 5 && j >= 2) ? R_[j - 2] : *(const v4u*)((tab) + off + 256 * j); }
#define PEER_DOTS(U_, t_) { int d0 = 0, d1 = 0, d2 = 0, d3 = 0; \
                _Pragma("unroll") for (int e = 0; e < 4; ++e) { d0 = __builtin_amdgcn_sdot4((int)U_[0][e], (int)hq[e], d0, false); d1 = __builtin_amdgcn_sdot4((int)U_[1][e], (int)hq[4 + e], d1, false); \
                    d2 = __builtin_amdgcn_sdot4((int)U_[2][e], (int)hq[8 + e], d2, false); d3 = __builtin_amdgcn_sdot4((int)U_[3][e], (int)hq[12 + e], d3, false); } \
                unsigned ds_ = (unsigned)((d0 + d1) + (d2 + d3)); ds_ += dppu<0xB1>(ds_); ds_ += dppu<0x4E>(ds_); ds_ += dppu<0x124>(ds_); ds_ += dppu<0x128>(ds_); \
                mine = (i16 == ((t_) & 15)) ? (float)(int)ds_ : mine; }
#pragma unroll
                for (int k = 0; k < 8; ++k) idr[k] = E[k].x;
#pragma unroll
                for (int k = 0; k < 8; ++k) PEER_LOADI(B[k], Utab, idr[k])
#pragma unroll 1
                for (int r = 0; r < 128; r += 8) {
                    if (wg_uniform && (r & (PEER_SYNC_EVERY - 1)) == 0 && r) __syncthreads();
                    if (r + 8 < 128) {
#pragma unroll
                        for (int k = 0; k < 8; ++k) idr[k] = E[r + 8 + k].x;
                    }
#pragma unroll
                    for (int k = 0; k < 8; ++k) { PEER_DOTS(B[k], r + k) if (r + 8 < 128) PEER_LOADI(B[k], Utab, idr[k]) }
                    if (r & 8) {
                        const int t = (r & ~15) + i16; const v4u en = E[t];
                        const float cf = gelu_as(mine * (__uint_as_float(en.y) * hs)) * __uint_as_float(en.z);
                        ((LAS float*)(E + t))[3] = cf; cmax = fmaxf(cmax, fabsf(cf));
                    }
                }
#undef PEER_DOTS
            }
            if (wg_uniform) __syncthreads();
            cmax = fmaxf(cmax, __uint_as_float(dppu<0xB1>(__float_as_uint(cmax)))); cmax = fmaxf(cmax, __uint_as_float(dppu<0x4E>(__float_as_uint(cmax))));
            cmax = fmaxf(cmax, __uint_as_float(dppu<0x124>(__float_as_uint(cmax)))); cmax = fmaxf(cmax, __uint_as_float(dppu<0x128>(__float_as_uint(cmax))));
            cmax = fmaxf(cmax, 1e-30f);
            int acci[4][16];
#pragma unroll
            for (int j = 0; j < 4; ++j)
#pragma unroll
                for (int e = 0; e < 16; ++e) acci[j][e] = 0;
            if (DRY != 4) {
                const float cq = 127.f / cmax;
                asm volatile("s_waitcnt lgkmcnt(0)" ::: "memory");
                unsigned pk0, pk1;
                { int q[8];
#pragma unroll
                  for (int k = 0; k < 8; ++k) q[k] = (int)rintf(((const LAS float*)(E + 8 * i16 + k))[3] * cq);
                  pk0 = ((unsigned)q[0] & 255u) | (((unsigned)q[1] & 255u) << 8) | (((unsigned)q[2] & 255u) << 16) | ((unsigned)q[3] << 24);
                  pk1 = ((unsigned)q[4] & 255u) | (((unsigned)q[5] & 255u) << 8) | (((unsigned)q[6] & 255u) << 16) | ((unsigned)q[7] << 24); }
                asm volatile("s_waitcnt lgkmcnt(0)" ::: "memory");
                ((LAS unsigned*)(E + 2 * i16))[1] = pk0; ((LAS unsigned*)(E + 2 * i16 + 1))[1] = pk1;
                asm volatile("s_waitcnt lgkmcnt(0)" ::: "memory");
                v4u Ba[4][2], Bb[4][2];
#define PEER_LOADG(B_, g_, hf_) { _Pragma("unroll") for (int n = 0; n < 4; ++n) { const unsigned id_ = E[4 * (g_) + n].x; const unsigned off = (id_ & (DRY == 2 ? 1023u : 16383u)) * 1024u + 16u * (unsigned)i16 + 512u * (hf_); \
                    _Pragma("unroll") for (int jj = 0; jj < 2; ++jj) B_[n][jj] = *(const v4u*)(Vtab + off + 256 * jj); } }
#define PEER_GROUP(B_, g_, hf_) { const unsigned a4 = ((const LAS unsigned*)(E + (g_)))[1]; \
                    _Pragma("unroll") for (int jj = 0; jj < 2; ++jj) _Pragma("unroll") for (int e = 0; e < 4; ++e) { \
                        const unsigned p01l = __builtin_amdgcn_perm(B_[1][jj][e], B_[0][jj][e], 0x05010400u), p01h = __builtin_amdgcn_perm(B_[1][jj][e], B_[0][jj][e], 0x07030602u); \
                        const unsigned p23l = __builtin_amdgcn_perm(B_[3][jj][e], B_[2][jj][e], 0x05010400u), p23h = __builtin_amdgcn_perm(B_[3][jj][e], B_[2][jj][e], 0x07030602u); \
                        acci[2 * (hf_) + jj][4 * e + 0] = __builtin_amdgcn_sdot4((int)__builtin_amdgcn_perm(p23l, p01l, 0x05040100u), (int)a4, acci[2 * (hf_) + jj][4 * e + 0], false); \
                        acci[2 * (hf_) + jj][4 * e + 1] = __builtin_amdgcn_sdot4((int)__builtin_amdgcn_perm(p23l, p01l, 0x07060302u), (int)a4, acci[2 * (hf_) + jj][4 * e + 1], false); \
                        acci[2 * (hf_) + jj][4 * e + 2] = __builtin_amdgcn_sdot4((int)__builtin_amdgcn_perm(p23h, p01h, 0x05040100u), (int)a4, acci[2 * (hf_) + jj][4 * e + 2], false); \
                        acci[2 * (hf_) + jj][4 * e + 3] = __builtin_amdgcn_sdot4((int)__builtin_amdgcn_perm(p23h, p01h, 0x07060302u), (int)a4, acci[2 * (hf_) + jj][4 * e + 3], false); } }
                PEER_LOADG(Ba, 0, 0)
#pragma unroll 1
                for (int g = 0; g < 32; ++g) {
                    if (wg_uniform && (g & (PEER_SYNC_EVERY / 4 - 1)) == 0 && g) __syncthreads();
                    PEER_LOADG(Bb, g, 1)
                    PEER_GROUP(Ba, g, 0)
                    if (g + 1 < 32) PEER_LOADG(Ba, g + 1, 0)
                    PEER_GROUP(Bb, g, 1)
                }
#undef PEER_LOADG
#undef PEER_GROUP
            }
            const float osc = cmax * (1.f / 127.f);
            f32x2 acc[4][8];
#pragma unroll
            for (int j = 0; j < 4; ++j)
#pragma unroll
                for (int e = 0; e < 8; ++e) acc[j][e] = (f32x2){(float)acci[j][2 * e] * osc, (float)acci[j][2 * e + 1] * osc};
#undef PEER_LOADI
            float ss = 0.f;
#pragma unroll
            for (int j = 0; j < 4; ++j) { const size_t eo = (size_t)tok * DM + 256 * j + 16 * i16; const float* gp = g2 + (size_t)b * 6144 + 256 * j + 16 * i16;
                bf16* XBp = (bf16*)(A.ws + WS_XB) + eo; const v4u xw0 = *(const v4u*)XBp, xw1 = *(const v4u*)(XBp + 8);
                unsigned ow[8];
#pragma unroll
                for (int q = 0; q < 4; ++q) { const unsigned w0 = q < 2 ? xw0[2 * q] : xw1[2 * q - 4], w1 = q < 2 ? xw0[2 * q + 1] : xw1[2 * q - 3]; const f32x4 g0 = *(const f32x4*)(gp + 4 * q);
                    const f32x4 xn = {bflo(w0) + (1.f + g0[0]) * acc[j][2 * q].x, bfhi(w0) + (1.f + g0[1]) * acc[j][2 * q].y, bflo(w1) + (1.f + g0[2]) * acc[j][2 * q + 1].x, bfhi(w1) + (1.f + g0[3]) * acc[j][2 * q + 1].y};
                    if (NEXT) { ow[2 * q] = pk2(xn[0], xn[1]); ow[2 * q + 1] = pk2(xn[2], xn[3]); }
                    else if (DRY == 0 || xn[0] == 1234.5678f) *(f32x4*)(A.out + eo + 4 * q) = xn;
                    acc[j][2 * q] = (f32x2){xn[0], xn[1]}; acc[j][2 * q + 1] = (f32x2){xn[2], xn[3]};
                    ss += (xn[0] * xn[0] + xn[1] * xn[1]) + (xn[2] * xn[2] + xn[3] * xn[3]); }
                if (NEXT && (DRY == 0 || ss == 1234.5678f)) { *(v4u*)XBp = (v4u){ow[0], ow[1], ow[2], ow[3]}; *(v4u*)(XBp + 8) = (v4u){ow[4], ow[5], ow[6], ow[7]}; } }
            if (DRY != 0) { if (ss == 1234.5678f) A.out[tok] = ss; }
            if (NEXT && DRY == 0) {
                ss += __uint_as_float(dppu<0xB1>(__float_as_uint(ss))); ss += __uint_as_float(dppu<0x4E>(__float_as_uint(ss)));
                ss += __uint_as_float(dppu<0x124>(__float_as_uint(ss))); ss += __uint_as_float(dppu<0x128>(__float_as_uint(ss)));
                const float rstd = rsqrtf(ss * (1.f / DM) + EPS);
                float am = 0.f;
#pragma unroll
                for (int j = 0; j < 4; ++j) { const int c0 = 256 * j + 16 * i16; const float* shp = nmod + (size_t)b * 6144 + c0; const float* scp = shp + 1024;
#pragma unroll
                    for (int q = 0; q < 4; ++q) { const f32x4 gn = *(const f32x4*)(ngain + c0 + 4 * q), sc = *(const f32x4*)(scp + 4 * q), sh = *(const f32x4*)(shp + 4 * q);
                        const f32x2 h0 = {acc[j][2 * q].x * rstd * gn[0] * (1.f + sc[0]) + sh[0], acc[j][2 * q].y * rstd * gn[1] * (1.f + sc[1]) + sh[1]};
                        const f32x2 h1 = {acc[j][2 * q + 1].x * rstd * gn[2] * (1.f + sc[2]) + sh[2], acc[j][2 * q + 1].y * rstd * gn[3] * (1.f + sc[3]) + sh[3]};
                        acc[j][2 * q] = h0; acc[j][2 * q + 1] = h1; am = fmaxf(am, fmaxf(fmaxf(fabsf(h0.x), fabsf(h0.y)), fmaxf(fabsf(h1.x), fabsf(h1.y)))); } }
                am = fmaxf(am, __uint_as_float(dppu<0xB1>(__float_as_uint(am)))); am = fmaxf(am, __uint_as_float(dppu<0x4E>(__float_as_uint(am))));
                am = fmaxf(am, __uint_as_float(dppu<0x124>(__float_as_uint(am)))); am = fmaxf(am, __uint_as_float(dppu<0x128>(__float_as_uint(am))));
                am = fmaxf(am, 1e-20f); const float qi = 127.f / am;
#pragma unroll
                for (int j = 0; j < 4; ++j) { v4u o;
#pragma unroll
                    for (int q = 0; q < 4; ++q) { const int q0 = (int)rintf(acc[j][2 * q].x * qi), q1 = (int)rintf(acc[j][2 * q].y * qi), q2 = (int)rintf(acc[j][2 * q + 1].x * qi), q3 = (int)rintf(acc[j][2 * q + 1].y * qi);
                        o[q] = ((unsigned)q0 & 255u) | (((unsigned)q1 & 255u) << 8) | (((unsigned)q2 & 255u) << 16) | ((unsigned)q3 << 24); }
                    *(v4u*)(A.ws + WS_IDS + (size_t)tok * DM + 256 * j + 16 * i16) = o; }
                if (i16 == 0) ((float*)(A.ws + WS_SA))[tok] = am * (1.f / 127.f);
            }
        }
    }
}
__device__ __forceinline__ void convert_tables_int8(const Ctx& C, const Args& A) {
    unsigned char* T8 = A.ws + WS_TAB; float* TS = (float*)(A.ws + WS_TSC);
    for (int R0 = C.gw * 4; R0 < 4 * 16384; R0 += C.NGW * 4) {
        const int t = R0 >> 14;
        const float* src = A.in[t == 0 ? 15 : t == 1 ? 16 : t == 2 ? 28 : 29] + (size_t)(R0 & 16383) * DM + 16 * C.lane;
        f32x4 x[4][4]; float am[4];
#pragma unroll
        for (int r = 0; r < 4; ++r) { am[r] = 0.f;
#pragma unroll
            for (int q = 0; q < 4; ++q) x[r][q] = *(const f32x4*)(src + (size_t)r * DM + 4 * q); }
#pragma unroll
        for (int r = 0; r < 4; ++r) {
#pragma unroll
            for (int q = 0; q < 4; ++q) am[r] = fmaxf(am[r], fmaxf(fmaxf(fabsf(x[r][q].x), fabsf(x[r][q].y)), fmaxf(fabsf(x[r][q].z), fabsf(x[r][q].w))));
            am[r] = wave_max(am[r]);
            const float sc = (am[r] > 0.f) ? 127.f / am[r] : 1.f, inv = (am[r] > 0.f) ? am[r] * (1.f / 127.f) : 1.f;
            v4u o;
#pragma unroll
            for (int q = 0; q < 4; ++q) { const int q0 = (int)rintf(x[r][q].x * sc), q1 = (int)rintf(x[r][q].y * sc), q2 = (int)rintf(x[r][q].z * sc), q3 = (int)rintf(x[r][q].w * sc);
                o[q] = ((unsigned)q0 & 255u) | (((unsigned)q1 & 255u) << 8) | (((unsigned)q2 & 255u) << 16) | ((unsigned)q3 << 24); }
            *(v4u*)(T8 + (size_t)(R0 + r) * DM + 16 * C.lane) = o;
            if (C.lane == 0) TS[R0 + r] = inv;
        }
    }
}
constexpr size_t WS_NL = 3 * MiB, WS_NP = WS_NL + 512 * 1024;
constexpr size_t WS_GC = WS_MOD + 512 * 1024, WS_ML = WS_GC + 4096, WS_MP = WS_ML + 4096;
constexpr size_t OUT_SL = 0, OUT_SP = 64 * MiB;
typedef float f32x16 __attribute__((ext_vector_type(16)));
typedef short s16x4 __attribute__((ext_vector_type(4)));
__device__ __forceinline__ unsigned offb(unsigned row, unsigned ch) { return 256u * row + 16u * (ch ^ (((row & 3u) << 2) | ((row >> 2) & 3u))); }
__device__ __forceinline__ s16x4 tr_read4(unsigned lds_addr) { s16x4 r; asm volatile("ds_read_b64_tr_b16 %0, %1\n\ts_waitcnt lgkmcnt(0)" : "=&v"(r) : "v"(lds_addr) : "memory"); return r; }
__device__ __forceinline__ void tr_read4x2(s16x4& r0, s16x4& r1, unsigned a0, unsigned a1) {
    asm volatile("ds_read_b64_tr_b16 %0, %2\n\tds_read_b64_tr_b16 %1, %3\n\ts_waitcnt lgkmcnt(0)" : "=&v"(r0), "=&v"(r1) : "v"(a0), "v"(a1) : "memory"); }
__device__ __forceinline__ void tr_read4x6(s16x4 (&r)[6], unsigned a0, unsigned a1, unsigned a2, unsigned a3, unsigned a4, unsigned a5) {
    asm volatile("ds_read_b64_tr_b16 %0, %6\n\tds_read_b64_tr_b16 %1, %7\n\tds_read_b64_tr_b16 %2, %8\n\tds_read_b64_tr_b16 %3, %9\n\tds_read_b64_tr_b16 %4, %10\n\tds_read_b64_tr_b16 %5, %11\n\ts_waitcnt lgkmcnt(0)"
                 : "=&v"(r[0]), "=&v"(r[1]), "=&v"(r[2]), "=&v"(r[3]), "=&v"(r[4]), "=&v"(r[5]) : "v"(a0), "v"(a1), "v"(a2), "v"(a3), "v"(a4), "v"(a5) : "memory"); }
__device__ __forceinline__ void tr_read4x8(s16x4 (&r)[8], unsigned a0, unsigned a1, unsigned a2, unsigned a3, unsigned a4, unsigned a5, unsigned a6, unsigned a7) {
    asm volatile("ds_read_b64_tr_b16 %0, %8\n\tds_read_b64_tr_b16 %1, %9\n\tds_read_b64_tr_b16 %2, %10\n\tds_read_b64_tr_b16 %3, %11\n\tds_read_b64_tr_b16 %4, %12\n\tds_read_b64_tr_b16 %5, %13\n\tds_read_b64_tr_b16 %6, %14\n\tds_read_b64_tr_b16 %7, %15\n\ts_waitcnt lgkmcnt(0)"
                 : "=&v"(r[0]), "=&v"(r[1]), "=&v"(r[2]), "=&v"(r[3]), "=&v"(r[4]), "=&v"(r[5]), "=&v"(r[6]), "=&v"(r[7]) : "v"(a0), "v"(a1), "v"(a2), "v"(a3), "v"(a4), "v"(a5), "v"(a6), "v"(a7) : "memory"); }
__device__ __forceinline__ float scan_sum64(float v, int lane) {
#pragma unroll
    for (int o = 1; o < 64; o <<= 1) { const float t = __shfl_up(v, o); if (lane >= o) v += t; }
    return v;
}
__device__ __forceinline__ float scan_max64(float v, int lane) {
#pragma unroll
    for (int o = 1; o < 64; o <<= 1) { const float t = __shfl_up(v, o); if (lane >= o) v = fmaxf(v, t); }
    return v;
}
__device__ __forceinline__ pg8::bf16x8 mk_frag(s16x4 a, s16x4 b) { return (pg8::bf16x8){a[0], a[1], a[2], a[3], b[0], b[1], b[2], b[3]}; }

__device__ __forceinline__ void phase_mlstm_local(const Ctx& C, const Args& A) {
    const bf16* P = (const bf16*)(A.ws + WS_BIG);
    const float* LF = (const float*)(A.ws + WS_LF); const float* LI = (const float*)(A.ws + WS_LI);
    bf16* SL = (bf16*)((unsigned char*)A.out + OUT_SL); float* NL = (float*)(A.ws + WS_NL);
    float* GC = (float*)(A.ws + WS_GC); float* ML = (float*)(A.ws + WS_ML);
    LAS unsigned char* tK = C.lds; LAS unsigned char* tV = C.lds + 32768; LAS float* wtab = (LAS float*)(C.lds + 65536);
    const unsigned ldsK = (unsigned)(uintptr_t)tK, ldsV = (unsigned)(uintptr_t)tV;
    const int lane = C.lane, wid = C.wave, tid = C.tid;
    for (int unit = C.bid; unit < 1024; unit += C.G) {
        const int bh = unit >> 5, c = unit & 31, b = bh >> 2, hh = bh & 3;
        const size_t tok0 = (size_t)b * SEQ + c * 128;
        if (wid == 0) {
            const float2 lf = *(const float2*)(LF + (size_t)bh * SEQ + c * 128 + 2 * lane), li = *(const float2*)(LI + (size_t)bh * SEQ + c * 128 + 2 * lane);
            const float pr = lf.x + lf.y, inc = scan_sum64(pr, lane), ex = inc - pr;
            const float b0 = ex + lf.x, b1 = b0 + lf.y;
            const float g = __shfl(inc, 63);
            const float a0 = g - b0 + li.x, a1 = g - b1 + li.y;
            const float mloc = wave_max(fmaxf(a0, a1));
            wtab[2 * lane] = __expf(a0 - mloc); wtab[2 * lane + 1] = __expf(a1 - mloc);
            if (lane == 0) { GC[unit] = g; ML[unit] = mloc; }
        }
        __syncthreads();
#pragma unroll
        for (int i = 0; i < 4; ++i) { const int id = tid + 512 * i, row = id >> 4, ch = id & 15;
            const bf16* src = P + (tok0 + row) * INP + hh * 128 + ch * 8;
            const v4u kv = *(const v4u*)(src + 512), vv = *(const v4u*)(src + 1024);
            const float w = wtab[row];
            v4u ko; ko.x = pk2(bflo(kv.x) * w, bfhi(kv.x) * w); ko.y = pk2(bflo(kv.y) * w, bfhi(kv.y) * w); ko.z = pk2(bflo(kv.z) * w, bfhi(kv.z) * w); ko.w = pk2(bflo(kv.w) * w, bfhi(kv.w) * w);
            *(LAS v4u*)(tK + offb(row, ch)) = ko; *(LAS v4u*)(tV + offb(row, ch)) = vv; }
        __syncthreads();
        if (tid < 128) { const int d = tid; float s = 0.f;
#pragma unroll 8
            for (int l = 0; l < 128; ++l) s += bf2f(*(const LAS unsigned short*)(tK + offb(l, d >> 3) + (d & 7) * 2));
            NL[(size_t)unit * 128 + d] = s; }
        {
            const int db = wid & 3, eh = wid >> 2;
            const unsigned h = lane >> 5, blk = (lane >> 4) & 1, q = (lane & 15) >> 2, p = lane & 3;
            f32x16 acc[2];
#pragma unroll
            for (int eb = 0; eb < 2; ++eb)
#pragma unroll
                for (int r = 0; r < 16; ++r) acc[eb][r] = 0.f;
#pragma unroll
            for (int ks = 0; ks < 8; ++ks) {
                const unsigned r0 = 16 * ks + 8 * h + q, cA = 4 * db + 2 * blk + (p >> 1), cB0 = 4 * (2 * eh) + 2 * blk + (p >> 1), cB1 = cB0 + 4, po = 8 * (p & 1);
                s16x4 t[6];
                tr_read4x6(t, ldsK + offb(r0, cA) + po, ldsK + offb(r0 + 4, cA) + po, ldsV + offb(r0, cB0) + po, ldsV + offb(r0 + 4, cB0) + po, ldsV + offb(r0, cB1) + po, ldsV + offb(r0 + 4, cB1) + po);
                const pg8::bf16x8 af = mk_frag(t[0], t[1]);
                acc[0] = __builtin_amdgcn_mfma_f32_32x32x16_bf16(af, mk_frag(t[2], t[3]), acc[0], 0, 0, 0);
                acc[1] = __builtin_amdgcn_mfma_f32_32x32x16_bf16(af, mk_frag(t[4], t[5]), acc[1], 0, 0, 0);
            }
            const int hi = lane >> 5;
#pragma unroll
            for (int eb = 0; eb < 2; ++eb) { const int e = 32 * (2 * eh + eb) + (lane & 31);
#pragma unroll
                for (int g4 = 0; g4 < 4; ++g4) { uint2 o; o.x = pk2(acc[eb][4 * g4], acc[eb][4 * g4 + 1]); o.y = pk2(acc[eb][4 * g4 + 2], acc[eb][4 * g4 + 3]);
                    *(uint2*)(SL + ((size_t)unit * 128 + e) * 128 + 32 * db + 8 * g4 + 4 * hi) = o; } }
        }
        __syncthreads();
    }
}

__device__ __forceinline__ void phase_mlstm_scan(const Ctx& C, const Args& A) {
    const bf16* SL = (const bf16*)((unsigned char*)A.out + OUT_SL); bf16* SP = (bf16*)((unsigned char*)A.out + OUT_SP);
    const float* NL = (const float*)(A.ws + WS_NL); float* NP = (float*)(A.ws + WS_NP);
    const float* GC = (const float*)(A.ws + WS_GC); const float* ML = (const float*)(A.ws + WS_ML); float* MP = (float*)(A.ws + WS_MP);
    for (long it = C.gt; it < 32L * 128 * 32; it += C.NGT) {
        const int d4 = (int)(it & 31), e = (int)((it >> 5) & 127), bh = (int)(it >> 12);
        f32x4 s = {0.f, 0.f, 0.f, 0.f}, n = {0.f, 0.f, 0.f, 0.f}; float m = 0.f;
        const bool do_n = (e == 0);
#pragma unroll 4
        for (int c = 0; c < 32; ++c) {
            const size_t unit = (size_t)bh * 32 + c;
            uint2 o; o.x = pk2(s.x, s.y); o.y = pk2(s.z, s.w);
            *(uint2*)(SP + (unit * 128 + e) * 128 + 4 * d4) = o;
            if (do_n) { *(f32x4*)(NP + unit * 128 + 4 * d4) = n; if (d4 == 0) MP[unit] = m; }
            const float g = GC[unit], ml = ML[unit];
            const float mn = fmaxf(g + m, ml), dec = __expf(g + m - mn), sc = __expf(ml - mn);
            const uint2 xw = *(const uint2*)(SL + (unit * 128 + e) * 128 + 4 * d4); const f32x4 x = {bflo(xw.x), bfhi(xw.x), bflo(xw.y), bfhi(xw.y)};
            s = s * dec + x * sc;
            if (do_n) { const f32x4 y = *(const f32x4*)(NL + unit * 128 + 4 * d4); n = n * dec + y * sc; }
            m = mn;
        }
    }
}

__device__ __forceinline__ void phase_mlstm_out(const Ctx& C, const Args& A) {
    const bf16* P = (const bf16*)(A.ws + WS_BIG); bf16* mix = (bf16*)(A.ws + WS_H);
    const float* LF = (const float*)(A.ws + WS_LF); const float* LI = (const float*)(A.ws + WS_LI);
    const bf16* SP = (const bf16*)((unsigned char*)A.out + OUT_SP); const float* NP = (const float*)(A.ws + WS_NP); const float* MP = (const float*)(A.ws + WS_MP);
    const float* gain = A.in[9];
    LAS unsigned char* tV = C.lds; LAS float* abt = (LAS float*)(C.lds + 65536); LAS float* Mt = abt + 128; LAS float* bt = abt + 256; LAS float* npt = abt + 384; LAS float* ssq = abt + 512;
    const unsigned ldsV = (unsigned)(uintptr_t)tV;
    const int lane = C.lane, wid = C.wave, tid = C.tid, hi = lane >> 5, l31 = lane & 31;
    constexpr float QS = 0.08838834764831845f;
    for (int unit = C.bid; unit < 1024; unit += C.G) {
        const int bh = unit >> 5, c = unit & 31, b = bh >> 2, hh = bh & 3;
        const size_t tok0 = (size_t)b * SEQ + c * 128;
        const float mprev = MP[unit];
        if (wid == 0) {
            const float2 lf = *(const float2*)(LF + (size_t)bh * SEQ + c * 128 + 2 * lane), li = *(const float2*)(LI + (size_t)bh * SEQ + c * 128 + 2 * lane);
            const float pr = lf.x + lf.y, inc = scan_sum64(pr, lane), ex = inc - pr;
            const float b0 = ex + lf.x, b1 = b0 + lf.y;
            const float ab0 = li.x - b0, ab1 = li.y - b1;
            const float pmx = scan_max64(fmaxf(ab0, ab1), lane);
            float pme = __shfl_up(pmx, 1); if (lane == 0) pme = -INFINITY;
            const float pm0 = fmaxf(pme, ab0), pm1 = fmaxf(pm0, ab1);
            abt[2 * lane] = ab0; abt[2 * lane + 1] = ab1; bt[2 * lane] = b0; bt[2 * lane + 1] = b1;
            Mt[2 * lane] = fmaxf(mprev, pm0); Mt[2 * lane + 1] = fmaxf(mprev, pm1);
        }
        if (wid == 1) { npt[2 * lane] = NP[(size_t)unit * 128 + 2 * lane]; npt[2 * lane + 1] = NP[(size_t)unit * 128 + 2 * lane + 1]; }
#pragma unroll
        for (int i = 0; i < 4; ++i) { const int id = tid + 512 * i, row = id >> 4, ch = id & 15;
            *(LAS v4u*)(tV + offb(row, ch)) = *(const v4u*)(P + (tok0 + row) * INP + 1024 + hh * 128 + ch * 8); }
        __syncthreads();
        const int lb = wid & 3, eh = wid >> 2;
        const int l = 32 * lb + l31;
        const float Ml = Mt[l], iw = __expf(mprev - Ml) * QS;
        pg8::bf16x8 qf[8];
#pragma unroll
        for (int ks = 0; ks < 8; ++ks) qf[ks] = *(const pg8::bf16x8*)(P + (tok0 + l) * INP + hh * 128 + 16 * ks + 8 * hi);
        float qn = 0.f;
#pragma unroll
        for (int ks = 0; ks < 8; ++ks)
#pragma unroll
            for (int j = 0; j < 8; ++j) qn += bf2f((unsigned short)qf[ks][j]) * npt[16 * ks + 8 * hi + j];
        qn += __shfl_xor(qn, 32);
        f32x16 acc[2];
#pragma unroll
        for (int eb = 0; eb < 2; ++eb) {
#pragma unroll
            for (int r = 0; r < 16; ++r) acc[eb][r] = 0.f;
            const bf16* sp = SP + ((size_t)unit * 128 + 32 * (2 * eh + eb) + l31) * 128 + 8 * hi;
#pragma unroll
            for (int ks = 0; ks < 8; ++ks) acc[eb] = __builtin_amdgcn_mfma_f32_32x32x16_bf16(*(const pg8::bf16x8*)(sp + 16 * ks), qf[ks], acc[eb], 0, 0, 0);
#pragma unroll
            for (int r = 0; r < 16; ++r) acc[eb][r] *= iw;
        }
        float den = 0.f;
        const unsigned g16 = lane >> 4, blk = g16 & 1, q = (lane & 15) >> 2, p = lane & 3;
        for (int sb = 0; sb <= lb; ++sb) {
            f32x16 X;
#pragma unroll
            for (int r = 0; r < 16; ++r) X[r] = 0.f;
            const bf16* kp = P + (tok0 + 32 * sb + l31) * INP + 512 + hh * 128 + 8 * hi;
#pragma unroll
            for (int ks = 0; ks < 8; ++ks) X = __builtin_amdgcn_mfma_f32_32x32x16_bf16(*(const pg8::bf16x8*)(kp + 16 * ks), qf[ks], X, 0, 0, 0);
            float pv[16];
#pragma unroll
            for (int r = 0; r < 16; ++r) { const int s = 32 * sb + (r & 3) + 8 * (r >> 2) + 4 * hi;
                const float v = X[r] * QS * __expf(abt[s] - Ml);
                pv[r] = (s <= l) ? v : 0.f; den += pv[r]; }
            pg8::bf16x8 pf[2];
#pragma unroll
            for (int st = 0; st < 2; ++st) { v4u t; t.x = pk2(pv[8 * st], pv[8 * st + 1]); t.y = pk2(pv[8 * st + 2], pv[8 * st + 3]); t.z = pk2(pv[8 * st + 4], pv[8 * st + 5]); t.w = pk2(pv[8 * st + 6], pv[8 * st + 7]);
                pf[st] = __builtin_bit_cast(pg8::bf16x8, t); }
            { const unsigned c0 = 4 * (2 * eh) + 2 * blk + (p >> 1), c1 = c0 + 4, ra = 32 * sb + 4 * hi + q, po = 8 * (p & 1);
              s16x4 t[8];
              tr_read4x8(t, ldsV + offb(ra, c0) + po, ldsV + offb(ra + 8, c0) + po, ldsV + offb(ra + 16, c0) + po, ldsV + offb(ra + 24, c0) + po,
                            ldsV + offb(ra, c1) + po, ldsV + offb(ra + 8, c1) + po, ldsV + offb(ra + 16, c1) + po, ldsV + offb(ra + 24, c1) + po);
#pragma unroll
              for (int eb = 0; eb < 2; ++eb)
#pragma unroll
                  for (int st = 0; st < 2; ++st) acc[eb] = __builtin_amdgcn_mfma_f32_32x32x16_bf16(mk_frag(t[4 * eb + 2 * st], t[4 * eb + 2 * st + 1]), pf[st], acc[eb], 0, 0, 0); }
        }
        den += __shfl_xor(den, 32);
        den += iw * qn;
        const float dn = 1.f / fmaxf(fabsf(den), __expf(-(bt[l] + Ml)));
        float ss = 0.f;
#pragma unroll
        for (int eb = 0; eb < 2; ++eb)
#pragma unroll
            for (int r = 0; r < 16; ++r) { acc[eb][r] *= dn; ss += acc[eb][r] * acc[eb][r]; }
        ss += __shfl_xor(ss, 32);
        if (hi == 0) ssq[eh * 128 + l] = ss;
        __syncthreads();
        const float rstd = rsqrtf((ssq[l] + ssq[128 + l]) * (1.f / 128.f) + EPS);
#pragma unroll
        for (int eb = 0; eb < 2; ++eb)
#pragma unroll
            for (int g4 = 0; g4 < 4; ++g4) { const int e = 32 * (2 * eh + eb) + 8 * g4 + 4 * hi;
                const uint2 ow = *(const uint2*)(P + (tok0 + l) * INP + 1536 + hh * 128 + e);
                const f32x4 gn = *(const f32x4*)(gain + hh * 128 + e);
                uint2 o; o.x = pk2(acc[eb][4 * g4] * rstd * gn.x * sigmoidf_(bflo(ow.x)), acc[eb][4 * g4 + 1] * rstd * gn.y * sigmoidf_(bfhi(ow.x)));
                o.y = pk2(acc[eb][4 * g4 + 2] * rstd * gn.z * sigmoidf_(bflo(ow.y)), acc[eb][4 * g4 + 3] * rstd * gn.w * sigmoidf_(bfhi(ow.y)));
                *(uint2*)(mix + (tok0 + l) * DM + hh * 128 + e) = o; }
        __syncthreads();
    }
}
template <bool I8>
struct EpiQKV {
    static constexpr bool PERM = true, AFTER_DRAIN = false;
    bf16* O; bf16* KF; bf16* VH; const float* qg; const float* kg; const float* sa; const float* sw;
    __device__ __forceinline__ void operator()(const typename pg8::AccSel<I8>::type (&acc)[2][2][4][2], const pg8::Unit& u, int wr, int wc, int fr, int fq) const {
        using pg8::f32x4;
        f32x4 cs[2][2];
#pragma unroll
        for (int bj = 0; bj < 2; ++bj)
#pragma unroll
            for (int n = 0; n < 2; ++n) cs[bj][n] = I8 ? *(const f32x4*)(sw + u.pn * 256 + 128 * bj + 32 * wc + 8 * fq + 4 * n) : (f32x4){1.f, 1.f, 1.f, 1.f};
        const int kind = u.pn >> 2;
        const float* gp = (kind == 0) ? qg : kg;
        const float post = (kind == 0) ? 0.125f * 1.4426950408889634f : 1.0f;
        f32x4 gv[2][2];
#pragma unroll
        for (int bj = 0; bj < 2; ++bj)
#pragma unroll
            for (int n = 0; n < 2; ++n) gv[bj][n] = (kind < 2) ? *(const f32x4*)(gp + 32 * bj + 8 * fq + 4 * n) * post : (f32x4){1.f, 1.f, 1.f, 1.f};
#pragma unroll
        for (int ai = 0; ai < 2; ++ai)
#pragma unroll
            for (int m = 0; m < 4; ++m) {
                const int row = u.pm * 256 + ai * 128 + wr * 64 + m * 16 + fr;
                f32x4 xv[2][2]; float ss = 0.f;
                { const float rsc = I8 ? sa[row] : 1.f;
#pragma unroll
                  for (int bj = 0; bj < 2; ++bj)
#pragma unroll
                      for (int n = 0; n < 2; ++n) { const auto a = acc[ai][bj][m][n]; const f32x4 x = (f32x4){(float)a[0], (float)a[1], (float)a[2], (float)a[3]} * cs[bj][n] * rsc; xv[bj][n] = x;
                          ss += (x[0] * x[0] + x[1] * x[1]) + (x[2] * x[2] + x[3] * x[3]); } }
                ss += __shfl_xor(ss, 16); ss += __shfl_xor(ss, 32);
                const float rs = (kind < 2) ? rsqrtf(ss * (1.f / 64.f) + EPS) : 1.0f;
                bf16* dst = (kind == 1) ? KF + ((size_t)(((row >> 12) * 16 + (u.pn - 4) * 4 + wc) * 128 + ((row & 4095) >> 5)) * 2048 + (size_t)((fq >> 1) * 512 + ((fq & 1) * 32 + (row & 31)) * 8))
                                        : (kind == 2) ? VH + ((size_t)(((row >> 12) * 16 + (u.pn & 3) * 4 + wc) * 4096 + (row & 4095)) * 64 + 8 * fq)
                                        : O + (size_t)row * 1024 + (u.pn & 3) * 256 + 64 * wc + 8 * fq;
                const int bjstep = (kind == 1) ? 1024 : 32;
#pragma unroll
                for (int bj = 0; bj < 2; ++bj) { const f32x4 v0 = xv[bj][0] * gv[bj][0] * rs, v1 = xv[bj][1] * gv[bj][1] * rs;
                    v4u w; w.x = pk2(v0[0], v0[1]); w.y = pk2(v0[2], v0[3]); w.z = pk2(v1[0], v1[1]); w.w = pk2(v1[2], v1[3]);
                    *(v4u*)(dst + bjstep * bj) = w; }
            }
    }
};

__device__ __forceinline__ unsigned voff(unsigned row, unsigned ch) { return row * 128u + 16u * (ch ^ (row & 7u)); }
__device__ __forceinline__ void phase_attn(const Ctx& C, const Args& A) {
    const bf16* QV = (const bf16*)(A.ws + WS_BIG); const bf16* KF = (const bf16*)(A.ws + WS_BIG + 64 * MiB); const bf16* VH = (const bf16*)(A.ws + WS_BIG + 128 * MiB); bf16* O = (bf16*)(A.ws + WS_H);
    LAS unsigned char* tV = C.lds + C.wave * 4096;
    const unsigned ldsV = (unsigned)(uintptr_t)tV;
    const int lane = C.lane, hi = lane >> 5, l31 = lane & 31;
    const unsigned blk = (lane >> 4) & 1, q4 = (lane & 15) >> 2, p = lane & 3;
    const int per_wave = (16384 + C.NGW - 1) / C.NGW;
    for (int u = C.gw * per_wave; u < C.gw * per_wave + per_wave; ++u) {
        if (u >= 16384) break;
        const int bh = u >> 7, qt = u & 127, b = bh >> 4, hd = bh & 15;
        const size_t tokb = (size_t)b * SEQ;
        const int l = qt * 32 + l31;
        pg8::bf16x8 qf[4];
#pragma unroll
        for (int ks = 0; ks < 4; ++ks) qf[ks] = *(const pg8::bf16x8*)(QV + (tokb + l) * 1024 + hd * 64 + 16 * ks + 8 * hi);
        f32x16 acc[2];
#pragma unroll
        for (int eb = 0; eb < 2; ++eb)
#pragma unroll
            for (int r = 0; r < 16; ++r) acc[eb][r] = 0.f;
        float carry = 1.f;
        pg8::bf16x8 kf[4]; v4u vv[4];
#define ATT_LOAD(kt_) { const size_t s0_ = tokb + (size_t)(kt_) * 32; const bf16* kp_ = KF + ((size_t)(bh * 128 + (kt_)) * 2048 + lane * 8); \
            _Pragma("unroll") for (int ks = 0; ks < 4; ++ks) kf[ks] = *(const pg8::bf16x8*)(kp_ + ks * 512); \
            _Pragma("unroll") for (int i = 0; i < 4; ++i) { const int id = lane + 64 * i; vv[i] = *(const v4u*)(VH + ((size_t)bh * 4096 + (size_t)(kt_) * 32) * 64 + id * 8); } }
        ATT_LOAD(qt)
        for (int kt = qt; kt >= 0; --kt) {
            f32x16 X;
#pragma unroll
            for (int r = 0; r < 16; ++r) X[r] = 0.f;
#pragma unroll
            for (int ks = 0; ks < 4; ++ks) X = __builtin_amdgcn_mfma_f32_32x32x16_bf16(kf[ks], qf[ks], X, 0, 0, 0);
#pragma unroll
            for (int i = 0; i < 4; ++i) { const int id = lane + 64 * i; *(LAS v4u*)(tV + voff(id >> 3, id & 7)) = vv[i]; }
            if (kt > 0) ATT_LOAD(kt - 1)
            const int sbase = kt * 32 + 4 * hi;
            float rr[16];
#pragma unroll
            for (int r = 0; r < 16; ++r) rr[r] = __builtin_amdgcn_rcpf(1.f + __builtin_amdgcn_exp2f(X[r]));
            if (kt == qt) {
#pragma unroll
                for (int r = 0; r < 16; ++r) { const int s = sbase + (r & 3) + 8 * (r >> 2); rr[r] = (s < l) ? rr[r] : 1.f; }
            }
            float To[4], Tp[4];
#pragma unroll
            for (int g = 0; g < 4; ++g) { To[g] = (rr[4 * g] * rr[4 * g + 1]) * (rr[4 * g + 2] * rr[4 * g + 3]); Tp[g] = __shfl_xor(To[g], 32); }
            float base[4]; float run = 1.f;
#pragma unroll
            for (int g = 3; g >= 0; --g) { base[g] = carry * run * (hi == 0 ? Tp[g] : 1.f); run *= To[g] * Tp[g]; }
            float att[16];
#pragma unroll
            for (int g = 0; g < 4; ++g) { float w = base[g];
#pragma unroll
                for (int i = 3; i >= 0; --i) { const int r = 4 * g + i; att[r] = (1.f - rr[r]) * w; w *= rr[r]; } }
            carry *= run;
            pg8::bf16x8 pf[2];
#pragma unroll
            for (int st = 0; st < 2; ++st) { v4u t; t.x = pg8::cvt_pk_bf16(att[8 * st], att[8 * st + 1]); t.y = pg8::cvt_pk_bf16(att[8 * st + 2], att[8 * st + 3]); t.z = pg8::cvt_pk_bf16(att[8 * st + 4], att[8 * st + 5]); t.w = pg8::cvt_pk_bf16(att[8 * st + 6], att[8 * st + 7]);
                pf[st] = __builtin_bit_cast(pg8::bf16x8, t); }
            s16x4 vf[8];
            { const unsigned a0 = ldsV + voff(4 * hi + q4, 2 * blk + (p >> 1)) + 8 * (p & 1), a1 = ldsV + voff(4 * hi + q4 + 8, 2 * blk + (p >> 1)) + 8 * (p & 1);
              const unsigned a2 = ldsV + voff(16 + 4 * hi + q4, 2 * blk + (p >> 1)) + 8 * (p & 1), a3 = ldsV + voff(24 + 4 * hi + q4, 2 * blk + (p >> 1)) + 8 * (p & 1);
              const unsigned a4 = ldsV + voff(4 * hi + q4, 4 + 2 * blk + (p >> 1)) + 8 * (p & 1), a5 = ldsV + voff(4 * hi + q4 + 8, 4 + 2 * blk + (p >> 1)) + 8 * (p & 1);
              const unsigned a6 = ldsV + voff(16 + 4 * hi + q4, 4 + 2 * blk + (p >> 1)) + 8 * (p & 1), a7 = ldsV + voff(24 + 4 * hi + q4, 4 + 2 * blk + (p >> 1)) + 8 * (p & 1);
              asm volatile("ds_read_b64_tr_b16 %0, %8\n\tds_read_b64_tr_b16 %1, %9\n\tds_read_b64_tr_b16 %2, %10\n\tds_read_b64_tr_b16 %3, %11\n\t"
                           "ds_read_b64_tr_b16 %4, %12\n\tds_read_b64_tr_b16 %5, %13\n\tds_read_b64_tr_b16 %6, %14\n\tds_read_b64_tr_b16 %7, %15\n\ts_waitcnt lgkmcnt(0)"
                           : "=&v"(vf[0]), "=&v"(vf[1]), "=&v"(vf[2]), "=&v"(vf[3]), "=&v"(vf[4]), "=&v"(vf[5]), "=&v"(vf[6]), "=&v"(vf[7])
                           : "v"(a0), "v"(a1), "v"(a2), "v"(a3), "v"(a4), "v"(a5), "v"(a6), "v"(a7) : "memory"); }
#pragma unroll
            for (int eb = 0; eb < 2; ++eb)
#pragma unroll
                for (int st = 0; st < 2; ++st) acc[eb] = __builtin_amdgcn_mfma_f32_32x32x16_bf16(mk_frag(vf[4 * eb + 2 * st], vf[4 * eb + 2 * st + 1]), pf[st], acc[eb], 0, 0, 0);
            if (__all(carry == 0.f)) break;
        }
#undef ATT_LOAD
#pragma unroll
        for (int eb = 0; eb < 2; ++eb)
#pragma unroll
            for (int g4 = 0; g4 < 4; ++g4) { const u32x2 o = {pk2(acc[eb][4 * g4], acc[eb][4 * g4 + 1]), pk2(acc[eb][4 * g4 + 2], acc[eb][4 * g4 + 3])};
                const unsigned c8 = (unsigned)(8 * eb + 2 * g4 + hi);
                *(LAS u32x2*)(tV + l31 * 128 + ((c8 ^ ((unsigned)(l31 & 7) << 1)) << 3)) = o; }
        asm volatile("s_waitcnt lgkmcnt(0)" ::: "memory");
#pragma unroll
        for (int i = 0; i < 4; ++i) { const int id = lane + 64 * i, rr = id >> 3, q = id & 7;
            const v4u w = *(const LAS v4u*)(tV + rr * 128 + (((unsigned)(2 * q) ^ ((unsigned)(rr & 7) << 1)) << 3));
            *(v4u*)(O + (tokb + qt * 32 + rr) * DM + hd * 64 + 8 * q) = w; }
        asm volatile("s_waitcnt lgkmcnt(0)" ::: "memory");
    }
}
constexpr int N_PHASES = 16;
#ifndef MK_ONE_LAUNCH
#define MK_ONE_LAUNCH 1
#endif

__global__ void __launch_bounds__(NWAVES * 64, 2) mk_fwd(Args args) {
    extern __shared__ __attribute__((aligned(16))) unsigned char lds_raw[];
    Ctx C;
    C.lds = (LAS unsigned char*)lds_raw;
    C.tid = threadIdx.x; C.lane = C.tid & 63; C.wave = __builtin_amdgcn_readfirstlane(C.tid >> 6);
    C.G = gridDim.x; C.bid = blockIdx.x;
    C.gw = C.bid * NWAVES + C.wave; C.NGW = C.G * NWAVES;
    C.gt = (long)C.bid * (NWAVES * 64) + C.tid; C.NGT = (long)C.G * (NWAVES * 64);
    unsigned char* ws = args.ws;
    volatile LAS unsigned* MISC = (volatile LAS unsigned*)(C.lds + MISC_OFF);
    for (int u = C.tid; u < (LDS_BYTES - LDSCTL_OFF) / 4; u += NWAVES * 64) ((LAS unsigned*)(C.lds + LDSCTL_OFF))[u] = 0u;
    __syncthreads();
#if MK_ONE_LAUNCH
    XcdBarrier bar = xcd_barrier_post((unsigned*)((gu32*)(ws + WS_CTL) + CW_BAR), MISC + 8);
#ifdef PROBE_DBLBAR
#define GRID_BAR() do { xcd_barrier(bar); xcd_barrier(bar); } while (0)
#else
#define GRID_BAR() xcd_barrier(bar)
#endif
#else
    (void)MISC; XcdBarrier bar; bar.bar = nullptr; bar.x = 0; bar.st = nullptr;
#define GRID_BAR() do {} while (0)
#endif
    const int lo = args.ph_lo, hi = args.ph_hi;
#define IN(k) (lo <= (k) && (k) < hi)
#ifndef PROBE_MASK
#define PROBE_MASK 0
#endif
#define PROBE_T0(k) unsigned long long pt0_ = 0; if ((PROBE_MASK >> (k)) & 1) pt0_ = __builtin_amdgcn_s_memrealtime();
#define PROBE_T1(k) if ((PROBE_MASK >> (k)) & 1) { const unsigned long long t1_ = __builtin_amdgcn_s_memrealtime(); const unsigned long long d_ = t1_ - pt0_; while (__builtin_amdgcn_s_memrealtime() - t1_ < d_) __builtin_amdgcn_s_sleep(8); }
#define SEAM(k) do { if (IN(k) && IN((k) + 1)) GRID_BAR(); } while (0)
    float* mod0 = (float*)(ws + WS_MOD); float* mod1 = mod0 + (size_t)NB * 6144;
    bf16* Hb = (bf16*)(ws + WS_H); bf16* BIG = (bf16*)(ws + WS_BIG); bf16* XB = (bf16*)(ws + WS_XB);

    const unsigned char* TAB = ws + WS_TAB; const float* TSC = (const float*)(ws + WS_TSC);
#ifdef PROBE_INSTR
    {
        unsigned xs[16]; float fs[16];
#pragma unroll
        for (int i = 0; i < 16; ++i) { xs[i] = (unsigned)(C.tid * 2654435761u + i * 40503u); fs[i] = (float)(C.tid * 7 + i) * 0.37f; }
#pragma unroll 1
        for (int it = 0; it < 4096; ++it) {
#pragma unroll
            for (int rep = 0; rep < 2; ++rep) {
#pragma unroll
                for (int i = 0; i < 16; i += 2) {
#if PROBE_INSTR == 10
                    { const unsigned a = xs[i], b = xs[i + 1]; xs[i] = a < b ? b : a; xs[i + 1] = (a < b ? a : b) + (unsigned)it; }
#elif PROBE_INSTR == 11
                    { const float a = fs[i], b = fs[i + 1]; fs[i] = fmaxf(a, b); fs[i + 1] = fminf(a, b) + 1.0f; }
#elif PROBE_INSTR == 12
                    { const unsigned a = xs[i], b = xs[i + 1]; xs[i] = a + b; xs[i + 1] = (a ^ b) + (unsigned)it; }
#endif
                }
            }
        }
        float sm = 0.f;
#pragma unroll
        for (int i = 0; i < 16; ++i) sm += fs[i] + __uint_as_float(xs[i] & 0x3fffffffu);
        if (sm == 1234.5678f) args.out[C.tid] = sm;
    }
#endif
    if (IN(0)) { PROBE_T0(0) { phase_prep(C, args); convert_tables_int8(C, args); } PROBE_T1(0) } SEAM(0);
    bf16* H8B = (bf16*)(ws + WS_IDS);
    unsigned char* W8 = (unsigned char*)args.out; float* SW = (float*)((unsigned char*)args.out + OUT_SW); float* SA = (float*)(ws + WS_SA);
    if (IN(1)) { PROBE_T0(1) { phase_rowpass<true, false, true>(C, args, args.in[0], args.in[4], mod0, 0, 1, Hb, SA);
        quantize_rows(C, (const bf16*)(ws + WS_WIN), INP, W8 + OUT_W8IN, SW + SW_IN);
        quantize_rows(C, (const bf16*)(ws + WS_WC0), 2048, W8 + OUT_W8C0, SW + SW_C0); quantize_rows(C, (const bf16*)(ws + WS_WC1), 2048, W8 + OUT_W8C1, SW + SW_C1);
        quantize_rows(C, (const bf16*)(ws + WS_WQKV), 3072, W8 + OUT_W8QKV, SW + SW_QKV); } PROBE_T1(1) } SEAM(1);
    if (IN(2)) { PROBE_T0(2) { pg8::Gemm g{Hb, (const bf16*)(W8 + OUT_W8IN), NTOK, INP, DM / 2}; pg8::StaticOrder S; S.init(NTOK, INP, C.G, C.bid);
        EpiBf16I8 E{BIG, INP, SA, SW + SW_IN};
        pg8::gemm_phase<EpiBf16I8, pg8::StaticOrder, true, true, true>(C.lds, g, S, E); } PROBE_T1(2) } SEAM(2);
    if (IN(3)) { PROBE_T0(3) { phase_mlstm_local(C, args); phase_conv(C, args); } PROBE_T1(3) } SEAM(3);
    if (IN(4)) { PROBE_T0(4) { phase_mlstm_scan(C, args); } PROBE_T1(4) } SEAM(4);
    if (IN(5)) { PROBE_T0(5) { phase_mlstm_out(C, args); } PROBE_T1(5) } SEAM(5);
    if (IN(6)) { PROBE_T0(6) { pg8::Gemm g{Hb, (const bf16*)(ws + WS_WOUT0), NTOK, DM, DM}; pg8::StaticOrder S; S.init(NTOK, DM, C.G, C.bid);
        EpiResid<false> E{args.in[0], XB, mod0 + 2 * 1024};
        pg8::gemm_phase<EpiResid<false>, pg8::StaticOrder, true, true>(C.lds, g, S, E); } PROBE_T1(6) } SEAM(6);
    if (IN(7)) { PROBE_T0(7) { phase_rowpass<false, true, true>(C, args, XB, args.in[11], mod0, 3, 4, H8B, SA); } PROBE_T1(7) } SEAM(7);
    if (IN(8)) { PROBE_T0(8) { pg8::Gemm g{H8B, (const bf16*)(W8 + OUT_W8C0), NTOK, 2048, DM / 2}; pg8::StaticOrder S; S.init(NTOK, 2048, C.G, C.bid);
        EpiBf16I8 E{BIG, 2048, SA, SW + SW_C0};
        pg8::gemm_phase<EpiBf16I8, pg8::StaticOrder, true, true, true>(C.lds, g, S, E); } PROBE_T1(8) } SEAM(8);
    if (IN(9)) { PROBE_T0(9) { phase_peer<true>(C, args, TAB, TAB + TAB_BYTES, TSC, TSC + 16384, mod0 + 5 * 1024, args.in[19], mod1, bar); } PROBE_T1(9) } SEAM(9);
    if (IN(10)) { PROBE_T0(10) { pg8::Gemm g{H8B, (const bf16*)(W8 + OUT_W8QKV), NTOK, 3072, DM / 2}; pg8::StaticOrder S; S.init(NTOK, 3072, C.G, C.bid);
        EpiQKV<true> E{BIG, (bf16*)(ws + WS_BIG + 64 * MiB), (bf16*)(ws + WS_BIG + 128 * MiB), args.in[21], args.in[22], SA, SW + SW_QKV};
        pg8::gemm_phase<EpiQKV<true>, pg8::StaticOrder, true, true, true>(C.lds, g, S, E); } PROBE_T1(10) } SEAM(10);
    if (IN(11)) { PROBE_T0(11) { phase_attn(C, args); } PROBE_T1(11) } SEAM(11);
    if (IN(12)) { PROBE_T0(12) { pg8::Gemm g{Hb, (const bf16*)(ws + WS_WOUT1), NTOK, DM, DM}; pg8::StaticOrder S; S.init(NTOK, DM, C.G, C.bid);
        EpiResid<true> E{XB, XB, mod1 + 2 * 1024};
        pg8::gemm_phase<EpiResid<true>, pg8::StaticOrder, true, true>(C.lds, g, S, E); } PROBE_T1(12) } SEAM(12);
    if (IN(13)) { PROBE_T0(13) { phase_rowpass<false, true, true>(C, args, XB, args.in[24], mod1, 3, 4, H8B, SA); } PROBE_T1(13) } SEAM(13);
    if (IN(14)) { PROBE_T0(14) { pg8::Gemm g{H8B, (const bf16*)(W8 + OUT_W8C1), NTOK, 2048, DM / 2}; pg8::StaticOrder S; S.init(NTOK, 2048, C.G, C.bid);
        EpiBf16I8 E{BIG, 2048, SA, SW + SW_C1};
        pg8::gemm_phase<EpiBf16I8, pg8::StaticOrder, true, true, true>(C.lds, g, S, E); } PROBE_T1(14) } SEAM(14);
#ifdef PROBE_DRY
    if (IN(15)) { phase_peer<false, PROBE_DRY>(C, args, TAB + 2 * TAB_BYTES, TAB + 3 * TAB_BYTES, TSC + 2 * 16384, TSC + 3 * 16384, mod1 + 5 * 1024, nullptr, nullptr, bar); GRID_BAR(); }
#endif
    if (IN(15)) { PROBE_T0(15) { phase_peer<false>(C, args, TAB + 2 * TAB_BYTES, TAB + 3 * TAB_BYTES, TSC + 2 * 16384, TSC + 3 * 16384, mod1 + 5 * 1024, nullptr, nullptr, bar); } PROBE_T1(15) }
#undef IN
#undef SEAM
}

extern "C" void kernel_launch(void* const* d_in, const int* in_sizes, int n_in, void* d_out, int out_size, void* d_ws, size_t ws_size, hipStream_t stream) {
    static int grid = 0;
    if (grid == 0) {
        if (n_in != 30 || out_size != NTOK * DM || ws_size < WS_END2) { fprintf(stderr, "kernel_launch: unexpected shapes (n_in %d out %d ws %zu)\n", n_in, out_size, ws_size); grid = -1; return; }
        int dev = 0, cus = 0;
        if (hipGetDevice(&dev) != hipSuccess || hipDeviceGetAttribute(&cus, hipDeviceAttributeMultiprocessorCount, dev) != hipSuccess) { grid = -1; return; }
        if (hipFuncSetAttribute((const void*)mk_fwd, hipFuncAttributeMaxDynamicSharedMemorySize, LDS_BYTES) != hipSuccess) { fprintf(stderr, "kernel_launch: hipFuncSetAttribute failed\n"); grid = -1; return; }
        int per_cu = 0;
        if (hipOccupancyMaxActiveBlocksPerMultiprocessor(&per_cu, (const void*)mk_fwd, NWAVES * 64, LDS_BYTES) != hipSuccess || per_cu < 1) fprintf(stderr, "kernel_launch: occupancy query reports %d\n", per_cu);
        (void)hipGetLastError();
        grid = cus;
    }
    if (grid < 0) return;
    (void)hipMemsetAsync((char*)d_ws + WS_CTL + CW_BAR * 4, 0, XCD_BAR_WORDS * 4, stream);
    Args a{};
    for (int i = 0; i < 30; ++i) a.in[i] = (const float*)d_in[i];
    a.out = (float*)d_out; a.ws = (unsigned char*)d_ws;
#if MK_ONE_LAUNCH
    a.ph_lo = 0; a.ph_hi = N_PHASES;
    hipLaunchKernelGGL(mk_fwd, dim3(grid), dim3(NWAVES * 64), LDS_BYTES, stream, a);
#else
    for (int p = 0; p < N_PHASES; ++p) { a.ph_lo = p; a.ph_hi = p + 1; hipLaunchKernelGGL(mk_fwd, dim3(grid), dim3(NWAVES * 64), LDS_BYTES, stream, a); }
#endif
}
```

```cpp
#include <hip/hip_runtime.h>
#include <cstdio>
#include <cstdint>
#include <cmath>
#define PROBE_MASK 0
namespace pg8 {
#define PG8_LAS __attribute__((address_space(3)))
typedef unsigned short bf16_t;
typedef short bf16x8 __attribute__((ext_vector_type(8)));
typedef float f32x4 __attribute__((ext_vector_type(4)));
typedef unsigned u32x4 __attribute__((ext_vector_type(4)));
constexpr int BM = 256, BK = 64, HALF = 128, HTB = HALF * BK * 2  , STAGE_BYTES = 8 * HTB, NXCD = 8, WGM = 8;

__host__ __device__ __forceinline__ int lds_byte(int r, int c) { const int st = (r >> 4) * 2 + (c >> 5), rr = r & 15, cc = c & 31, ob = rr * 64 + cc * 2; return st * 1024 + (ob ^ (((ob >> 9) & 1) << 5)); }
__host__ __device__ __forceinline__ void stage_rc(int b, int& R, int& C) { const int st = b / 1024, sb = b % 1024, swz = sb ^ (((sb >> 9) & 1) << 5); R = (st >> 1) * 16 + swz / 64; C = (st & 1) * 32 + (swz % 64) / 2; }
__host__ __device__ __forceinline__ int perm32(int rho) { const int n = rho >> 4, i = rho & 15; return 8 * (i >> 2) + 4 * n + (i & 3); }

struct Unit { int pm, pn; };
struct Gemm { const bf16_t* A; const bf16_t* Bt; int M, N, K; };

struct StaticOrder {
    int nM, nN, nwg, G, c;
    __host__ __device__ void init(int M, int N, int G_, int c_) { nM = M / BM; nN = N / BM; nwg = nM * nN; G = G_; c = c_; }
    __host__ __device__ bool next(int i, Unit& u) const {
        const long L = (long)i * G + c; if (L >= nwg) return false;
        int wgid = (int)L; { const int q = nwg / NXCD, r = nwg % NXCD, xcd = wgid % NXCD, off = wgid / NXCD; wgid = (xcd < r ? xcd * (q + 1) : r * (q + 1) + (xcd - r) * q) + off; }
        const int nig = WGM * nN, gid = wgid / nig, fm = gid * WGM, gsz = (nM - fm) < WGM ? (nM - fm) : WGM;
        u.pm = fm + ((wgid % nig) % gsz); u.pn = (wgid % nig) / gsz; return true;
    }
    __device__ __forceinline__ void a_ready(const Unit&) const {}
    __device__ __forceinline__ void done(const Unit&) const {}
};

__device__ __forceinline__ unsigned cvt_pk_bf16(float lo, float hi) { unsigned r; asm volatile("v_cvt_pk_bf16_f32 %0, %1, %2" : "=v"(r) : "v"(lo), "v"(hi)); return r; }
typedef float f32x2 __attribute__((ext_vector_type(2)));
__device__ __forceinline__ f32x2 gelu_pk(f32x2 v) {
    const f32x2 av = __builtin_elementwise_abs(v), d = av * 0.2316418882f + 1.0f;
    f32x2 t; t.x = __builtin_amdgcn_rcpf(d.x); t.y = __builtin_amdgcn_rcpf(d.y);
    f32x2 q = t * 0.5307027145f + (-0.7265760135f); q = q * t + 0.7107068705f; q = q * t + (-0.142248368f); q = q * t + 0.127414796f; q = q * t;
    const f32x2 s = (v * v) * (-0.72134752044f);
    f32x2 e; e.x = __builtin_amdgcn_exp2f(s.x); e.y = __builtin_amdgcn_exp2f(s.y);
    const f32x2 m = v * (q * e), r = v - m;
    f32x2 o; o.x = v.x < 0.f ? m.x : r.x; o.y = v.y < 0.f ? m.y : r.y; return o;
}

template <int ACT  > struct EpiBf16 {
    static constexpr bool PERM = true, AFTER_DRAIN = false; static_assert(ACT == 0 || ACT == 1, "EpiBf16: ACT is 0 (none) or 1 (gelu_pk)");
    bf16_t* O; int ldc; const float* bias; int split_cols; size_t split_stride; float scale0;
    __device__ __forceinline__ void operator()(const f32x4 (&acc)[2][2][4][2], const Unit& u, int wr, int wc, int fr, int fq) const {
        const int row0 = u.pm * BM + wr * 64 + fr; int colt = u.pn * BM; bf16_t* base = O;
        float sc = 1.f; if (split_cols) { const int t = colt / split_cols; base += (size_t)t * split_stride; colt -= t * split_cols; if (t == 0) sc = scale0; }
        const int col0 = colt + wc * 32 + 8 * fq, bcol0 = u.pn * BM + wc * 32 + 8 * fq;
        f32x4 bv[2][2];
#pragma unroll
        for (int bj = 0; bj < 2; ++bj)
#pragma unroll
            for (int n = 0; n < 2; ++n) bv[bj][n] = bias ? *(const f32x4*)(bias + bcol0 + bj * HALF + 4 * n) : (f32x4){0.f, 0.f, 0.f, 0.f};
#pragma unroll
        for (int ai = 0; ai < 2; ++ai)
#pragma unroll
            for (int m = 0; m < 4; ++m) { bf16_t* rowp = base + (size_t)(row0 + ai * HALF + m * 16) * ldc + col0;
#pragma unroll
                for (int bj = 0; bj < 2; ++bj) { f32x4 v0 = acc[ai][bj][m][0] + bv[bj][0], v1 = acc[ai][bj][m][1] + bv[bj][1];
                    if (ACT == 1) { f32x2 a = gelu_pk((f32x2){v0[0], v0[1]}), b = gelu_pk((f32x2){v0[2], v0[3]}), c = gelu_pk((f32x2){v1[0], v1[1]}), d = gelu_pk((f32x2){v1[2], v1[3]});
                        v0 = (f32x4){a.x, a.y, b.x, b.y}; v1 = (f32x4){c.x, c.y, d.x, d.y}; }
                    v0 = v0 * sc; v1 = v1 * sc; u32x4 w; w.x = cvt_pk_bf16(v0[0], v0[1]); w.y = cvt_pk_bf16(v0[2], v0[3]); w.z = cvt_pk_bf16(v1[0], v1[1]); w.w = cvt_pk_bf16(v1[2], v1[3]);
                    *(u32x4*)(rowp + bj * HALF) = w; } }
    }
};
typedef int i32x4 __attribute__((ext_vector_type(4)));
template <bool I8> struct AccSel { typedef f32x4 type; };
template <> struct AccSel<true> { typedef i32x4 type; };
template <class Epi, class Sched, bool ALIGN_EPI = false, bool SP2 = false, bool I8 = false>
__device__ __forceinline__ void gemm_phase(PG8_LAS unsigned char* lds, const Gemm g, const Sched& S, const Epi& E) {
    const int tid = threadIdx.x, wid = __builtin_amdgcn_readfirstlane(tid >> 6), lane = tid & 63, wr = wid >> 2, wc = wid & 3, fr = lane & 15, fq = lane >> 4;
    const int K = g.K, nt = K / BK;
    unsigned voffA[2], voffB[2];
#pragma unroll
    for (int i = 0; i < 2; ++i) { int R, C; stage_rc(tid * 16 + i * 8192, R, C); const int Rb = Epi::PERM ? ((R & ~31) + perm32(R & 31)) : R;
        voffA[i] = (unsigned)(R * K + C) * 2u; voffB[i] = (unsigned)(Rb * K + C) * 2u; }
    const size_t kstep = (size_t)(BK * 2);
    const size_t hstep = (size_t)HALF * K * 2;
    const size_t tstep = 2 * hstep;
    const unsigned ldsw = (unsigned)wid * 1024u;
    const int aoff = lds_byte(wr * 64 + fr, fq * 8), boff = lds_byte(wc * 32 + fr, fq * 8);
#define PG8_SA(b, h) (((b) * 2 + (h)) * HTB)
#define PG8_SB(b, h) ((4 + (b) * 2 + (h)) * HTB)
#define PG8_STAGE(bufoff, gbase, voff) do { _Pragma("unroll") for (int _i = 0; _i < 2; ++_i) \
        __builtin_amdgcn_global_load_lds((const unsigned*)((const char*)(gbase) + (voff)[_i]), (PG8_LAS unsigned*)(lds + (bufoff) + ldsw + _i * 8192), 16, 0, 0); } while (0)
#define PG8_LDA(dst, b, h) do { _Pragma("unroll") for (int m = 0; m < 4; ++m) _Pragma("unroll") for (int k = 0; k < 2; ++k) dst[m][k] = *(const PG8_LAS bf16x8*)(lds + PG8_SA(b, h) + aoff + m * 2048 + k * 1024); } while (0)
#define PG8_LDB(dst, b, h) do { _Pragma("unroll") for (int n = 0; n < 2; ++n) _Pragma("unroll") for (int k = 0; k < 2; ++k) dst[n][k] = *(const PG8_LAS bf16x8*)(lds + PG8_SB(b, h) + boff + n * 2048 + k * 1024); } while (0)
#define PG8_MMA(ai, bj, At, Bt) do { __builtin_amdgcn_s_setprio(1); _Pragma("unroll") for (int m = 0; m < 4; ++m) _Pragma("unroll") for (int n = 0; n < 2; ++n) _Pragma("unroll") for (int k = 0; k < 2; ++k) \
        { if constexpr (I8) acc[ai][bj][m][n] = __builtin_bit_cast(acc_t, __builtin_amdgcn_mfma_i32_16x16x64_i8(__builtin_bit_cast(i32x4, Bt[n][k]), __builtin_bit_cast(i32x4, At[m][k]), __builtin_bit_cast(i32x4, acc[ai][bj][m][n]), 0, 0, 0)); \
          else acc[ai][bj][m][n] = __builtin_bit_cast(acc_t, __builtin_amdgcn_mfma_f32_16x16x32_bf16(Bt[n][k], At[m][k], __builtin_bit_cast(f32x4, acc[ai][bj][m][n]), 0, 0, 0)); } __builtin_amdgcn_s_setprio(0); } while (0)
#define PG8_WAIT_V(n) asm volatile("s_waitcnt vmcnt(" #n ")" ::: "memory")
#define PG8_WAIT_L(n) asm volatile("s_waitcnt lgkmcnt(" #n ")" ::: "memory")
#define PG8_BAR __builtin_amdgcn_s_barrier()
#define PG8_SCHED __builtin_amdgcn_sched_barrier(0)
    Unit cur, nxt; int ui = 0;
    if (!S.next(0, cur)) return;
    typedef typename AccSel<I8>::type acc_t; const acc_t acc_zero = {};
    acc_t acc[2][2][4][2];
#pragma unroll
    for (int a = 0; a < 2; ++a)
#pragma unroll
        for (int b = 0; b < 2; ++b)
#pragma unroll
            for (int m = 0; m < 4; ++m)
#pragma unroll
                for (int n = 0; n < 2; ++n) acc[a][b][m][n] = acc_zero;
    bf16x8 At[4][2], B0[2][2], B1[2][2];
    const char* cA = (const char*)g.A + (size_t)cur.pm * tstep; const char* cB = (const char*)g.Bt + (size_t)cur.pn * tstep;
    S.a_ready(cur);
    if constexpr (SP2) {
        PG8_STAGE(PG8_SB(0, 0), cB, voffB); PG8_STAGE(PG8_SB(0, 1), cB + hstep, voffB); PG8_STAGE(PG8_SA(0, 0), cA, voffA); PG8_STAGE(PG8_SA(0, 1), cA + hstep, voffA);
        if (wr == 1) PG8_BAR;
        PG8_WAIT_V(2); PG8_BAR;
        PG8_STAGE(PG8_SB(1, 0), cB + kstep, voffB); PG8_STAGE(PG8_SA(1, 0), cA + kstep, voffA); PG8_STAGE(PG8_SB(1, 1), cB + hstep + kstep, voffB);
        PG8_WAIT_V(6); PG8_BAR;
    } else {
        PG8_STAGE(PG8_SB(0, 0), cB, voffB); PG8_STAGE(PG8_SA(0, 0), cA, voffA); PG8_STAGE(PG8_SB(0, 1), cB + hstep, voffB); PG8_STAGE(PG8_SA(0, 1), cA + hstep, voffA);
        if (wr == 1) PG8_BAR;
        PG8_WAIT_V(4); PG8_BAR;
        PG8_STAGE(PG8_SB(1, 0), cB + kstep, voffB); PG8_STAGE(PG8_SA(1, 0), cA + kstep, voffA); PG8_STAGE(PG8_SB(1, 1), cB + hstep + kstep, voffB);
        PG8_WAIT_V(6); PG8_BAR;
    }
    for (;;) {
        const bool has_next = S.next(ui + 1, nxt);
        const char* nA = has_next ? (const char*)g.A + (size_t)nxt.pm * tstep : cA; const char* nB = has_next ? (const char*)g.Bt + (size_t)nxt.pn * tstep : cB;
        for (int t = 0; t < nt; t += 2) {
            const bool last = (t == nt - 2);
            const char* a1 = cA + (size_t)(t + 1) * kstep;
            const char* a2 = last ? nA : cA + (size_t)(t + 2) * kstep; const char* b2 = last ? nB : cB + (size_t)(t + 2) * kstep;
            const char* a3 = a2 + kstep; const char* b3 = b2 + kstep;
            if (last && has_next) S.a_ready(nxt);
            if constexpr (SP2) {
            PG8_LDB(B0, 0, 0); PG8_LDB(B1, 0, 1); PG8_SCHED; PG8_LDA(At, 0, 0); PG8_STAGE(PG8_SA(1, 1), a1 + hstep, voffA);
            PG8_WAIT_V(8); PG8_WAIT_L(0); PG8_BAR; PG8_MMA(0, 0, At, B0); PG8_MMA(0, 1, At, B1); PG8_BAR; PG8_SCHED;
            PG8_LDA(At, 0, 1); PG8_STAGE(PG8_SB(0, 0), b2, voffB); PG8_STAGE(PG8_SB(0, 1), b2 + hstep, voffB); PG8_STAGE(PG8_SA(0, 0), a2, voffA);
            PG8_WAIT_V(8); PG8_WAIT_L(0); PG8_BAR; PG8_MMA(1, 0, At, B0); PG8_MMA(1, 1, At, B1); PG8_BAR; PG8_SCHED;
            PG8_LDB(B0, 1, 0); PG8_LDB(B1, 1, 1); PG8_SCHED; PG8_LDA(At, 1, 0); PG8_STAGE(PG8_SA(0, 1), a2 + hstep, voffA);
            PG8_WAIT_V(8); PG8_WAIT_L(0); PG8_BAR; PG8_MMA(0, 0, At, B0); PG8_MMA(0, 1, At, B1); PG8_BAR; PG8_SCHED;
            PG8_LDA(At, 1, 1); PG8_STAGE(PG8_SB(1, 0), b3, voffB); PG8_STAGE(PG8_SB(1, 1), b3 + hstep, voffB); PG8_STAGE(PG8_SA(1, 0), a3, voffA);
            PG8_WAIT_V(8); PG8_WAIT_L(0); PG8_BAR; PG8_MMA(1, 0, At, B0); PG8_MMA(1, 1, At, B1); PG8_BAR; PG8_SCHED;
            } else {
            PG8_LDB(B0, 0, 0); PG8_SCHED; PG8_LDA(At, 0, 0); PG8_STAGE(PG8_SA(1, 1), a1 + hstep, voffA);
            PG8_WAIT_L(8); PG8_BAR; PG8_WAIT_L(0); PG8_MMA(0, 0, At, B0); PG8_BAR; PG8_SCHED;
            PG8_LDB(B1, 0, 1); PG8_STAGE(PG8_SB(0, 0), b2, voffB);
            PG8_BAR; PG8_WAIT_L(0); PG8_MMA(0, 1, At, B1); PG8_BAR;
            PG8_LDA(At, 0, 1); PG8_STAGE(PG8_SA(0, 0), a2, voffA);
            PG8_BAR; PG8_WAIT_L(0); PG8_MMA(1, 0, At, B0); PG8_BAR; PG8_SCHED;
            PG8_STAGE(PG8_SB(0, 1), b2 + hstep, voffB);
            PG8_WAIT_V(6); PG8_BAR; PG8_MMA(1, 1, At, B1); PG8_BAR;
            PG8_LDB(B0, 1, 0); PG8_SCHED; PG8_LDA(At, 1, 0); PG8_STAGE(PG8_SA(0, 1), a2 + hstep, voffA);
            PG8_WAIT_L(8); PG8_BAR; PG8_WAIT_L(0); PG8_MMA(0, 0, At, B0); PG8_BAR; PG8_SCHED;
            PG8_LDB(B1, 1, 1); PG8_STAGE(PG8_SB(1, 0), b3, voffB);
            PG8_BAR; PG8_WAIT_L(0); PG8_MMA(0, 1, At, B1); PG8_BAR;
            PG8_LDA(At, 1, 1); PG8_STAGE(PG8_SA(1, 0), a3, voffA);
            PG8_BAR; PG8_WAIT_L(0); PG8_MMA(1, 0, At, B0); PG8_BAR; PG8_SCHED;
            PG8_STAGE(PG8_SB(1, 1), b3 + hstep, voffB);
            PG8_WAIT_V(6); PG8_BAR; PG8_MMA(1, 1, At, B1); PG8_BAR;
            }
        }
        if constexpr (ALIGN_EPI) { if (wr == 0) PG8_BAR; }
        if constexpr (!Epi::AFTER_DRAIN) { E(acc, cur, wr, wc, fr, fq); S.done(cur); }
        if (!has_next) break;
#pragma unroll
        for (int a = 0; a < 2; ++a)
#pragma unroll
            for (int b = 0; b < 2; ++b)
#pragma unroll
                for (int m = 0; m < 4; ++m)
#pragma unroll
                    for (int n = 0; n < 2; ++n) acc[a][b][m][n] = acc_zero;
        cur = nxt; cA = nA; cB = nB; ++ui;
        if constexpr (ALIGN_EPI) { if (wr == 1) PG8_BAR; }
    }
    PG8_WAIT_V(0);
    if constexpr (!ALIGN_EPI) { if (wr == 0) PG8_BAR; }
    PG8_BAR;
    if constexpr (Epi::AFTER_DRAIN) { E.fused(acc, cur, wr, wc, fr, fq, lds, wid, lane); S.done(cur); }
#undef PG8_SA
#undef PG8_SB
#undef PG8_STAGE
#undef PG8_LDA
#undef PG8_LDB
#undef PG8_MMA
#undef PG8_WAIT_V
#undef PG8_WAIT_L
#undef PG8_BAR
#undef PG8_SCHED
}
}
#define GAS __attribute__((address_space(1)))
#define LAS __attribute__((address_space(3)))
typedef unsigned short bf16;
typedef unsigned v4u __attribute__((ext_vector_type(4)));
typedef float f32x4 __attribute__((ext_vector_type(4)));
typedef short bf16x8 __attribute__((ext_vector_type(8)));
typedef GAS unsigned gu32;
typedef GAS unsigned long long gu64;
#define RLX_AGENT __ATOMIC_RELAXED, __HIP_MEMORY_SCOPE_AGENT
#define LDS_WAIT() asm volatile("s_waitcnt lgkmcnt(0)" ::: "memory")
#define VM_WAIT() asm volatile("s_waitcnt vmcnt(0)" ::: "memory")
__device__ __forceinline__ unsigned long long rt() { return __builtin_amdgcn_s_memrealtime(); }
__device__ __forceinline__ unsigned f2bf(float f) { unsigned u = __builtin_bit_cast(unsigned, f); return (u + 0x7fffu + ((u >> 16) & 1u)) >> 16; }
typedef float pk2_f32x2 __attribute__((ext_vector_type(2))); typedef __bf16 pk2_bf16x2 __attribute__((ext_vector_type(2)));
__device__ __forceinline__ unsigned pk2(float lo, float hi) { const pk2_f32x2 v = {lo, hi}; return __builtin_bit_cast(unsigned, __builtin_convertvector(v, pk2_bf16x2)); }

#define XB_TMO      128
#define XB_XCNT(j)  (256  + 64 * (j))
#define XB_XSUB(j)  (1280 + 64 * (j))
#define XB_XGEN(j)  (2304 + 64 * (j))
#define XB_TOP      3328
#define XB_TOPGEN   3392
#define XCD_BAR_WORDS 3456
#define XB_SPIN_CAP (1u << 18)

__device__ __forceinline__ unsigned xb_ld(unsigned* p)              { return __hip_atomic_load(p, __ATOMIC_RELAXED, __HIP_MEMORY_SCOPE_AGENT); }
__device__ __forceinline__ unsigned xb_add(unsigned* p, unsigned v) { return __hip_atomic_fetch_add(p, v, __ATOMIC_RELAXED, __HIP_MEMORY_SCOPE_AGENT); }
__device__ __forceinline__ unsigned xb_xcc_id() { return (unsigned)__builtin_amdgcn_s_getreg((3 << 11) | 20) & 0xFu; }
#define XB_SPIN(cond, bar) do { unsigned _sp = 0; while (cond) { __builtin_amdgcn_s_sleep(1); \
    if ((++_sp & 255u) == 0u) { if (xb_ld(&(bar)[XB_TMO])) break; if (_sp > XB_SPIN_CAP) { atomicAdd(&(bar)[XB_TMO], 1u); break; } } } } while (0)

struct XcdBarrier {
    unsigned* bar; unsigned x;
    volatile LAS unsigned* st;
};

__device__ __forceinline__ XcdBarrier xcd_barrier_post(unsigned* bar, volatile LAS unsigned* st) {
    XcdBarrier b; b.bar = bar; b.x = xb_xcc_id(); b.st = st;
    if (threadIdx.x == 0) (void)xb_add(&bar[XB_XCNT(b.x)], 1u);
    return b;
}
__device__ __forceinline__ void xcd_barrier_complete(unsigned* bar, unsigned x, unsigned& nloc, unsigned& nx) {
    const unsigned G = gridDim.x * gridDim.y * gridDim.z;
    unsigned sum, cnt, mine, sp = 0u;
    for (;;) {
        sum = 0u; cnt = 0u; mine = 0u;
#pragma unroll
        for (unsigned j = 0; j < 16; ++j) { const unsigned c = xb_ld(&bar[XB_XCNT(j)]); sum += c; cnt += (c > 0u) ? 1u : 0u; mine = (j == x) ? c : mine; }
        if (sum == G) break;
        __builtin_amdgcn_s_sleep(1);
        if ((++sp & 255u) == 0u) { if (xb_ld(&bar[XB_TMO])) break; if (sp > XB_SPIN_CAP) { atomicAdd(&bar[XB_TMO], 1u); break; } }
    }
    nloc = mine > 0u ? mine : 1u; nx = cnt > 0u ? cnt : 1u;
}

__device__ __forceinline__ void xcd_barrier(const XcdBarrier& b) {
    asm volatile("s_waitcnt vmcnt(0)" ::: "memory");
    __syncthreads();
    if (threadIdx.x == 0) {
        unsigned* bar = b.bar;
        __builtin_amdgcn_s_waitcnt(0);
        unsigned nloc = b.st[0], nx = b.st[1];
        if (nloc == 0u) { xcd_barrier_complete(bar, b.x, nloc, nx); b.st[0] = nloc; b.st[1] = nx; }
        const unsigned old = xb_add(&bar[XB_XSUB(b.x)], 1u);
        const unsigned gen = old / nloc;
        if (old + 1u == (gen + 1u) * nloc) {
            __builtin_amdgcn_fence(__ATOMIC_RELEASE, "agent");
            asm volatile("s_waitcnt vmcnt(0)" ::: "memory");
            const unsigned og = xb_add(&bar[XB_TOP], 1u);
            const unsigned tg = og / nx;
            if (og + 1u == (tg + 1u) * nx) xb_add(&bar[XB_TOPGEN], 1u);
            else XB_SPIN(xb_ld(&bar[XB_TOPGEN]) == tg, bar);
            __builtin_amdgcn_fence(__ATOMIC_ACQUIRE, "agent");
            xb_add(&bar[XB_XGEN(b.x)], 1u);
            asm volatile("s_waitcnt vmcnt(0)" ::: "memory");
        } else {
            XB_SPIN(xb_ld(&bar[XB_XGEN(b.x)]) == gen, bar);
            __builtin_amdgcn_fence(__ATOMIC_ACQUIRE, "agent");
            asm volatile("s_waitcnt vmcnt(0)" ::: "memory");
        }
    }
    __syncthreads();
}
#ifndef MK_ONE_LAUNCH
#define MK_ONE_LAUNCH 1
#endif
constexpr int NWAVES = 8;
constexpr int NB = 8, SEQ = 4096, DM = 1024, NTOK = NB * SEQ;
constexpr int INW = 3592, INP = 3584;
constexpr float EPS = 1e-6f;
constexpr size_t MiB = 1u << 20;
constexpr size_t WS_CTL = 0, CTL_ZERO_BYTES = 1 * MiB;
constexpr size_t WS_MOD = 1 * MiB;
constexpr size_t WS_LF = 2 * MiB, WS_LI = WS_LF + 512 * 1024;
constexpr size_t WS_FC = 3 * MiB;
constexpr size_t WS_WIN = 4 * MiB, WS_WOUT0 = 11 * MiB, WS_WC0 = 13 * MiB, WS_WQKV = 17 * MiB, WS_WOUT1 = 23 * MiB, WS_WC1 = 25 * MiB;
constexpr size_t WS_H = 32 * MiB;
constexpr size_t WS_BIG = 96 * MiB;
constexpr size_t WS_IDS = 320 * MiB, WS_GATES = 336 * MiB;
constexpr size_t WS_END = 352 * MiB;
constexpr int CW_BAR = 4096;
constexpr int RING_BYTES = 131072, LDSCTL_OFF = RING_BYTES, MISC_OFF = LDSCTL_OFF + 320, LDS_BYTES = 163840;

__device__ __forceinline__ float wave_sum(float v) {
#pragma unroll
    for (int o = 1; o < 64; o <<= 1) v += __shfl_xor(v, o);
    return v;
}
__device__ __forceinline__ float wave_max(float v) {
#pragma unroll
    for (int o = 1; o < 64; o <<= 1) v = fmaxf(v, __shfl_xor(v, o));
    return v;
}
__device__ __forceinline__ float bf2f(unsigned short b) { return __uint_as_float((unsigned)b << 16); }
__device__ __forceinline__ float bflo(unsigned w) { return __uint_as_float(w << 16); }
__device__ __forceinline__ float bfhi(unsigned w) { return __uint_as_float(w & 0xffff0000u); }
__device__ __forceinline__ float sigmoidf_(float x) { return 1.f / (1.f + __expf(-x)); }
__device__ __forceinline__ float softplusf_(float x) { return fmaxf(x, 0.f) + __logf(1.f + __expf(-fabsf(x))); }
__device__ __forceinline__ float logsigmoidf_(float x) { return fminf(x, 0.f) - __logf(1.f + __expf(-fabsf(x))); }
__device__ __forceinline__ float gelu_exact(float x) { return 0.5f * x * (1.f + erff(x * 0.70710678118654752f)); }
__device__ __forceinline__ float gelu_as(float v) {
    const float av = fabsf(v), t = __builtin_amdgcn_rcpf(av * 0.2316418882f + 1.0f);
    float q = t * 0.5307027145f + (-0.7265760135f); q = q * t + 0.7107068705f; q = q * t + (-0.142248368f); q = q * t + 0.127414796f; q = q * t;
    const float e = __builtin_amdgcn_exp2f((v * v) * (-0.72134752044f));
    const float m = v * (q * e);
    return v < 0.f ? m : v - m;
}

struct Args { const float* in[30]; float* out; unsigned char* ws; int ph_lo, ph_hi; };

struct Ctx {
    LAS unsigned char* lds;
    int tid, lane, wave, G, bid;
    int gw, NGW;
    long gt, NGT;
};
template <bool BASE_BF16>
struct EpiResid {
    static constexpr bool PERM = true, AFTER_DRAIN = false;
    const void* base; bf16* out; const float* gate;
    __device__ __forceinline__ void operator()(const pg8::f32x4 (&acc)[2][2][4][2], const pg8::Unit& u, int wr, int wc, int fr, int fq) const {
        using pg8::f32x4;
        const int col0 = u.pn * 256 + wc * 32 + 8 * fq;
        const float* gp = gate + (size_t)((u.pm * 256) / SEQ) * 6144 + col0;
        f32x4 gv[2][2];
#pragma unroll
        for (int bj = 0; bj < 2; ++bj)
#pragma unroll
            for (int n = 0; n < 2; ++n) { gv[bj][n] = *(const f32x4*)(gp + bj * 128 + 4 * n); gv[bj][n] = gv[bj][n] + 1.0f; }
#pragma unroll
        for (int ai = 0; ai < 2; ++ai)
#pragma unroll
            for (int m = 0; m < 4; ++m) {
                const int r = ai * 128 + wr * 64 + m * 16 + fr; const size_t off = (size_t)(u.pm * 256 + r) * DM + col0;
#pragma unroll
                for (int bj = 0; bj < 2; ++bj) {
                    f32x4 b0, b1;
                    if (BASE_BF16) { const v4u w = *(const v4u*)((const bf16*)base + off + bj * 128); b0 = (f32x4){bflo(w.x), bfhi(w.x), bflo(w.y), bfhi(w.y)}; b1 = (f32x4){bflo(w.z), bfhi(w.z), bflo(w.w), bfhi(w.w)}; }
                    else { b0 = *(const f32x4*)((const float*)base + off + bj * 128); b1 = *(const f32x4*)((const float*)base + off + bj * 128 + 4); }
                    const f32x4 v0 = b0 + gv[bj][0] * acc[ai][bj][m][0], v1 = b1 + gv[bj][1] * acc[ai][bj][m][1];
                    v4u o; o.x = pk2(v0[0], v0[1]); o.y = pk2(v0[2], v0[3]); o.z = pk2(v1[0], v1[1]); o.w = pk2(v1[2], v1[3]);
                    *(v4u*)(out + off + bj * 128) = o;
                }
            }
    }
};

constexpr size_t WS_SA = WS_MOD + 768 * 1024;
constexpr size_t OUT_W8 = 96 * MiB;
constexpr size_t OUT_W8IN = OUT_W8, OUT_W8C0 = OUT_W8 + 4 * MiB, OUT_W8QKV = OUT_W8 + 6 * MiB, OUT_W8C1 = OUT_W8 + 9 * MiB, OUT_SW = OUT_W8 + 11 * MiB;
constexpr int SW_IN = 0, SW_C0 = 4096, SW_QKV = 8192, SW_C1 = 12288;
__device__ __forceinline__ void quantize_rows(const Ctx& C, const bf16* W, int N, unsigned char* W8, float* SW) {
    for (int n = C.gw; n < N; n += C.NGW) {
        const v4u w0 = *(const v4u*)(W + (size_t)n * DM + 16 * C.lane), w1 = *(const v4u*)(W + (size_t)n * DM + 16 * C.lane + 8);
        float x[16] = {bflo(w0.x), bfhi(w0.x), bflo(w0.y), bfhi(w0.y), bflo(w0.z), bfhi(w0.z), bflo(w0.w), bfhi(w0.w), bflo(w1.x), bfhi(w1.x), bflo(w1.y), bfhi(w1.y), bflo(w1.z), bfhi(w1.z), bflo(w1.w), bfhi(w1.w)};
        float am = 0.f;
#pragma unroll
        for (int i = 0; i < 16; ++i) am = fmaxf(am, fabsf(x[i]));
        am = fmaxf(wave_max(am), 1e-30f); const float qi = 127.f / am;
        v4u o;
#pragma unroll
        for (int q = 0; q < 4; ++q) { const int q0 = (int)rintf(x[4 * q] * qi), q1 = (int)rintf(x[4 * q + 1] * qi), q2 = (int)rintf(x[4 * q + 2] * qi), q3 = (int)rintf(x[4 * q + 3] * qi);
            o[q] = ((unsigned)q0 & 255u) | (((unsigned)q1 & 255u) << 8) | (((unsigned)q2 & 255u) << 16) | ((unsigned)q3 << 24); }
        *(v4u*)(W8 + (size_t)n * DM + 16 * C.lane) = o;
        if (C.lane == 0) SW[n] = am * (1.f / 127.f);
    }
}
struct EpiBf16I8 {
    static constexpr bool PERM = true, AFTER_DRAIN = false;
    bf16* O; int ldc; const float* sa; const float* sw;
    __device__ __forceinline__ void operator()(const pg8::i32x4 (&acc)[2][2][4][2], const pg8::Unit& u, int wr, int wc, int fr, int fq) const {
        using pg8::f32x4;
        const int col0 = u.pn * 256 + wc * 32 + 8 * fq;
        f32x4 cs[2][2];
#pragma unroll
        for (int bj = 0; bj < 2; ++bj)
#pragma unroll
            for (int n = 0; n < 2; ++n) cs[bj][n] = *(const f32x4*)(sw + col0 + bj * 128 + 4 * n);
#pragma unroll
        for (int ai = 0; ai < 2; ++ai)
#pragma unroll
            for (int m = 0; m < 4; ++m) { const int row = u.pm * 256 + ai * 128 + wr * 64 + m * 16 + fr; const float rs = sa[row];
                bf16* rowp = O + (size_t)row * ldc + col0;
#pragma unroll
                for (int bj = 0; bj < 2; ++bj) { const pg8::i32x4 a0 = acc[ai][bj][m][0], a1 = acc[ai][bj][m][1];
                    v4u w; w.x = pk2((float)a0[0] * rs * cs[bj][0][0], (float)a0[1] * rs * cs[bj][0][1]); w.y = pk2((float)a0[2] * rs * cs[bj][0][2], (float)a0[3] * rs * cs[bj][0][3]);
                    w.z = pk2((float)a1[0] * rs * cs[bj][1][0], (float)a1[1] * rs * cs[bj][1][1]); w.w = pk2((float)a1[2] * rs * cs[bj][1][2], (float)a1[3] * rs * cs[bj][1][3]);
                    *(v4u*)(rowp + bj * 128) = w; } }
    }
};

__device__ __forceinline__ void transpose_item(const float* W, int ldw, int src_col0, bf16* WT, int K, int dst_row0, int k0, LAS float* scr, int lane) {
#pragma unroll 8
    for (int i = 0; i < 32; ++i) { const int kk = 2 * i + (lane >> 5); scr[kk * 33 + (lane & 31)] = W[(size_t)(k0 + kk) * ldw + src_col0 + (lane & 31)]; }
    LDS_WAIT(); asm volatile("" ::: "memory");
    const int c = lane & 7;
#pragma unroll
    for (int j = 0; j < 4; ++j) { const int n = (lane >> 3) + 8 * j; const LAS float* s = scr + (8 * c) * 33 + n;
        v4u o; o.x = pk2(s[0 * 33], s[1 * 33]); o.y = pk2(s[2 * 33], s[3 * 33]); o.z = pk2(s[4 * 33], s[5 * 33]); o.w = pk2(s[6 * 33], s[7 * 33]);
        *(GAS v4u*)(WT + (size_t)(dst_row0 + n) * K + k0 + 8 * c) = o; }
    LDS_WAIT(); asm volatile("" ::: "memory");
}

__device__ __forceinline__ void phase_prep(const Ctx& C, const Args& A) {
    unsigned char* ws = A.ws;
    {
        LAS float* scr = (LAS float*)(C.lds + C.wave * 16384);
        constexpr int I_IN = 16 * (INP / 32), I_O = 16 * 32, I_QKV = 16 * 96;
        constexpr int NIT = I_IN + I_O + I_QKV + I_O;
        for (int it = C.gw; it < NIT; it += C.NGW) {
            int r = it;
            if (r < I_IN) { const int kb = r / (INP / 32), nb = r % (INP / 32); const int dst = nb * 32, src = dst + (dst >= 2048 ? 8 : 0);
                transpose_item(A.in[5], INW, src, (bf16*)(ws + WS_WIN), 1024, dst, kb * 64, scr, C.lane); continue; } r -= I_IN;
            if (r < I_O) { const int kb = r / 32, nb = r % 32; transpose_item(A.in[10], 1024, nb * 32, (bf16*)(ws + WS_WOUT0), 1024, nb * 32, kb * 64, scr, C.lane); continue; } r -= I_O;
            if (r < I_QKV) { const int kb = r / 96, nb = r % 96; const int src = (nb >> 3) * 256 + 64 * (nb & 3) + 32 * ((nb >> 2) & 1);
                transpose_item(A.in[20], 3072, src, (bf16*)(ws + WS_WQKV), 1024, nb * 32, kb * 64, scr, C.lane); continue; } r -= I_QKV;
            { const int kb = r / 32, nb = r % 32; transpose_item(A.in[23], 1024, nb * 32, (bf16*)(ws + WS_WOUT1), 1024, nb * 32, kb * 64, scr, C.lane); }
        }
    }
    {
        LAS float* sc = (LAS float*)C.lds;
        LAS float* red = (LAS float*)(C.lds + 32768);
        if (C.bid < 96) {
            __syncthreads();
            for (int i = C.tid; i < NB * DM; i += NWAVES * 64) { const float v = A.in[1][i]; sc[i] = v / (1.f + __expf(-v)); }
            __syncthreads();
            for (int item = C.bid; item < 96; item += C.G) {
                const int l = item / 48, jc = item % 48;
                const float* W = A.in[l ? 17 : 2] + 128 * jc + 2 * C.lane;
                float a0[NB], a1[NB];
#pragma unroll
                for (int b = 0; b < NB; ++b) a0[b] = a1[b] = 0.f;
#pragma unroll 32
                for (int kk = 0; kk < 128; ++kk) { const int k = 128 * C.wave + kk; const float2 w = *(const float2*)(W + (size_t)k * 6144);
#pragma unroll
                    for (int b = 0; b < NB; ++b) { const float s = sc[b * DM + k]; a0[b] += s * w.x; a1[b] += s * w.y; } }
#pragma unroll
                for (int b = 0; b < NB; ++b) { red[(C.wave * NB + b) * 128 + 2 * C.lane] = a0[b]; red[(C.wave * NB + b) * 128 + 2 * C.lane + 1] = a1[b]; }
                __syncthreads();
                float* mod = (float*)(ws + WS_MOD);
                for (int o = C.tid; o < NB * 128; o += NWAVES * 64) { const int b = o >> 7, j = o & 127; float s = A.in[l ? 18 : 3][128 * jc + j];
#pragma unroll
                    for (int w = 0; w < NWAVES; ++w) s += red[(w * NB + b) * 128 + j];
                    mod[(size_t)(l * NB + b) * 6144 + 128 * jc + j] = s; }
                __syncthreads();
            }
        }
    }
    {
        LAS float* kt = (LAS float*)C.lds;
        LAS float* wt = (LAS float*)(C.lds + 128 * 132 * 4);
        for (int item = C.bid; item < 512; item += C.G) {
            const int l = item >> 8, hh = (item >> 4) & 15, kb = item & 15;
            const float* Wq = A.in[l ? 25 : 12]; const float* Kh = A.in[l ? ((hh & 1) ? 27 : 26) : ((hh & 1) ? 14 : 13)];
            bf16* Wc = (bf16*)(ws + (l ? WS_WC1 : WS_WC0));
            __syncthreads();
#pragma unroll
            for (int i = 0; i < 8; ++i) { const int id = C.tid + 512 * i, row = id >> 5, c4 = id & 31; *(LAS f32x4*)(kt + row * 132 + 4 * c4) = *(const f32x4*)(Kh + row * 128 + 4 * c4); }
#pragma unroll
            for (int i = 0; i < 4; ++i) { const int id = C.tid + 512 * i, row = id >> 5, c4 = id & 31; *(LAS f32x4*)(wt + row * 132 + 4 * c4) = *(const f32x4*)(Wq + (size_t)(kb * 64 + row) * 2048 + hh * 128 + 4 * c4); }
            __syncthreads();
            const int key = C.tid & 127, kg = C.tid >> 7;
            float acc[16];
#pragma unroll
            for (int i = 0; i < 16; ++i) acc[i] = 0.f;
#pragma unroll 2
            for (int d4 = 0; d4 < 32; ++d4) { const f32x4 kv = *(const LAS f32x4*)(kt + key * 132 + 4 * d4);
#pragma unroll
                for (int i = 0; i < 16; ++i) { const f32x4 wv = *(const LAS f32x4*)(wt + (kg * 16 + i) * 132 + 4 * d4); acc[i] += (kv.x * wv.x + kv.y * wv.y) + (kv.z * wv.z + kv.w * wv.w); } }
            v4u o0, o1; o0.x = pk2(acc[0], acc[1]); o0.y = pk2(acc[2], acc[3]); o0.z = pk2(acc[4], acc[5]); o0.w = pk2(acc[6], acc[7]);
            o1.x = pk2(acc[8], acc[9]); o1.y = pk2(acc[10], acc[11]); o1.z = pk2(acc[12], acc[13]); o1.w = pk2(acc[14], acc[15]);
            bf16* dst = Wc + (size_t)(hh * 128 + key) * 1024 + kb * 64 + kg * 16;
            *(v4u*)dst = o0; *(v4u*)(dst + 8) = o1;
        }
        __syncthreads();
    }
}

template <bool GATES, bool IN_BF16, bool OUT_I8 = false>
__device__ __forceinline__ void phase_rowpass(const Ctx& C, const Args& A, const void* xin, const float* gain, const float* modl  , int ch_shift, int ch_scale, bf16* hout, float* sa = nullptr) {
    f32x4 wg0[GATES ? 16 : 1], wg1[GATES ? 16 : 1];
    if (GATES) {
        const float* Wg = A.in[5] + 2048;
#pragma unroll
        for (int j = 0; j < 4; ++j)
#pragma unroll
            for (int e = 0; e < 4; ++e) { const int k = 4 * C.lane + 256 * j + e; wg0[4 * j + e] = *(const f32x4*)(Wg + (size_t)k * INW); wg1[4 * j + e] = *(const f32x4*)(Wg + (size_t)k * INW + 4); }
    }
    for (int row = C.gw; row < NTOK; row += C.NGW) {
        const int b = row >> 12;
        f32x4 v[4]; float ss = 0.f;
#pragma unroll
        for (int j = 0; j < 4; ++j) {
            if (IN_BF16) { const uint2 w = *(const uint2*)((const bf16*)xin + (size_t)row * DM + 4 * C.lane + 256 * j); v[j] = (f32x4){bflo(w.x), bfhi(w.x), bflo(w.y), bfhi(w.y)}; }
            else v[j] = *(const f32x4*)((const float*)xin + (size_t)row * DM + 4 * C.lane + 256 * j);
            ss += v[j].x * v[j].x + v[j].y * v[j].y + v[j].z * v[j].z + v[j].w * v[j].w; }
        const float rstd = rsqrtf(wave_sum(ss) * (1.f / DM) + EPS);
        const float* shp = modl + (size_t)b * 6144 + ch_shift * 1024 + 4 * C.lane; const float* scp = modl + (size_t)b * 6144 + ch_scale * 1024 + 4 * C.lane;
        f32x4 h[4];
#pragma unroll
        for (int j = 0; j < 4; ++j) { const f32x4 g = *(const f32x4*)(gain + 4 * C.lane + 256 * j), sc = *(const f32x4*)(scp + 256 * j), sh = *(const f32x4*)(shp + 256 * j);
            h[j] = v[j] * rstd * g * (sc + 1.0f) + sh;
            if (!OUT_I8) { uint2 o; o.x = pk2(h[j].x, h[j].y); o.y = pk2(h[j].z, h[j].w);
                *(uint2*)(hout + (size_t)row * DM + 4 * C.lane + 256 * j) = o; } }
        if (OUT_I8) {
            float am = 0.f;
#pragma unroll
            for (int j = 0; j < 4; ++j) am = fmaxf(am, fmaxf(fmaxf(fabsf(h[j].x), fabsf(h[j].y)), fmaxf(fabsf(h[j].z), fabsf(h[j].w))));
            am = fmaxf(wave_max(am), 1e-20f); const float qi = 127.f / am;
            unsigned char* h8 = (unsigned char*)hout + (size_t)row * DM + 4 * C.lane;
#pragma unroll
            for (int j = 0; j < 4; ++j) { const int q0 = (int)rintf(h[j].x * qi), q1 = (int)rintf(h[j].y * qi), q2 = (int)rintf(h[j].z * qi), q3 = (int)rintf(h[j].w * qi);
                *(unsigned*)(h8 + 256 * j) = ((unsigned)q0 & 255u) | (((unsigned)q1 & 255u) << 8) | (((unsigned)q2 & 255u) << 16) | ((unsigned)q3 << 24); }
            if (C.lane == 0) sa[row] = am * (1.f / 127.f);
        }
        if (GATES) {
            f32x4 d0 = {0.f, 0.f, 0.f, 0.f}, d1 = {0.f, 0.f, 0.f, 0.f};
#pragma unroll
            for (int j = 0; j < 4; ++j)
#pragma unroll
                for (int e = 0; e < 4; ++e) { const float hv = h[j][e]; d0 += wg0[4 * j + e] * hv; d1 += wg1[4 * j + e] * hv; }
            float d[8] = {d0.x, d0.y, d0.z, d0.w, d1.x, d1.y, d1.z, d1.w};
#pragma unroll
            for (int q = 0; q < 8; ++q) d[q] = wave_sum(d[q]);
            if (C.lane == 0) {
                const int s = row & (SEQ - 1); float* LF = (float*)(A.ws + WS_LF); float* LI = (float*)(A.ws + WS_LI);
#pragma unroll
                for (int hh = 0; hh < 4; ++hh) { LI[(size_t)(b * 4 + hh) * SEQ + s] = d[hh] + A.in[6][hh]; LF[(size_t)(b * 4 + hh) * SEQ + s] = logsigmoidf_(d[4 + hh] + A.in[7][hh]); }
            }
        }
    }
}

__device__ __forceinline__ void phase_conv(const Ctx& C, const Args& A) {
    const bf16* P = (const bf16*)(A.ws + WS_BIG); bf16* mix = (bf16*)(A.ws + WS_H); const float* cw = A.in[8];
    for (long it = C.gt; it < (long)NTOK * 64; it += C.NGT) {
        const int cg = (int)(it & 63), tok = (int)(it >> 6), t = tok & (SEQ - 1), c0 = cg * 8;
        float conv[8];
#pragma unroll
        for (int e = 0; e < 8; ++e) conv[e] = 0.f;
#pragma unroll
        for (int k = 0; k < 3; ++k) {
            const int dt = 2 - k;
            if (t - dt >= 0) {
                const bf16* r = P + (size_t)(tok - dt) * INP;
                const v4u cc = *(const v4u*)(r + 2560 + c0), chv = *(const v4u*)(r + 3072 + c0);
                const f32x4 w0 = *(const f32x4*)(cw + k * 512 + c0), w1 = *(const f32x4*)(cw + k * 512 + c0 + 4);
                conv[0] += w0.x * bflo(cc.x) * bflo(chv.x); conv[1] += w0.y * bfhi(cc.x) * bfhi(chv.x);
                conv[2] += w0.z * bflo(cc.y) * bflo(chv.y); conv[3] += w0.w * bfhi(cc.y) * bfhi(chv.y);
                conv[4] += w1.x * bflo(cc.z) * bflo(chv.z); conv[5] += w1.y * bfhi(cc.z) * bfhi(chv.z);
                conv[6] += w1.z * bflo(cc.w) * bflo(chv.w); conv[7] += w1.w * bfhi(cc.w) * bfhi(chv.w);
            }
        }
        const v4u cb = *(const v4u*)(P + (size_t)tok * INP + 2048 + c0);
        v4u o; o.x = pk2(conv[0] * bflo(cb.x), conv[1] * bfhi(cb.x)); o.y = pk2(conv[2] * bflo(cb.y), conv[3] * bfhi(cb.y));
        o.z = pk2(conv[4] * bflo(cb.z), conv[5] * bfhi(cb.z)); o.w = pk2(conv[6] * bflo(cb.w), conv[7] * bfhi(cb.w));
        *(v4u*)(mix + (size_t)tok * DM + 512 + c0) = o;
    }
}
constexpr size_t WS_TAB = 352 * MiB;
constexpr size_t TAB_BYTES = (size_t)16384 * 1024;
constexpr size_t WS_TSC = WS_TAB + 4 * TAB_BYTES;
constexpr size_t WS_XB = 420 * MiB;
constexpr size_t WS_END2 = WS_XB + 64 * MiB;
typedef float f32x2 __attribute__((ext_vector_type(2)));
typedef __bf16 bf16x2_t __attribute__((ext_vector_type(2)));
typedef unsigned u32x2 __attribute__((ext_vector_type(2)));
__device__ __forceinline__ float dot2bf(unsigned a, unsigned b, float c) { return __builtin_amdgcn_fdot2_f32_bf16(__builtin_bit_cast(bf16x2_t, a), __builtin_bit_cast(bf16x2_t, b), c, false); }
template <int CTRL> __device__ __forceinline__ unsigned dppu(unsigned v) { return (unsigned)__builtin_amdgcn_update_dpp(0, (int)v, CTRL, 0xF, 0xF, true); }
__device__ __forceinline__ float wave_sum_dpp(float v) {
    v += __uint_as_float(dppu<0xB1>(__float_as_uint(v)));
    v += __uint_as_float(dppu<0x4E>(__float_as_uint(v)));
    v += __uint_as_float(dppu<0x124>(__float_as_uint(v)));
    v += __uint_as_float(dppu<0x128>(__float_as_uint(v)));
    const unsigned u = __float_as_uint(v);
    return (__uint_as_float(__builtin_amdgcn_readlane(u, 0)) + __uint_as_float(__builtin_amdgcn_readlane(u, 16))) + (__uint_as_float(__builtin_amdgcn_readlane(u, 32)) + __uint_as_float(__builtin_amdgcn_readlane(u, 48)));
}
__device__ __forceinline__ void ins16(unsigned (&val)[16], unsigned k) {
#pragma unroll
    for (int j = 0; j < 16; ++j) { const unsigned t = val[j] < k ? val[j] : k; val[j] = val[j] < k ? k : val[j]; k = t; }
}
#define PEER_CE(x, i, l) { const unsigned a_ = x[i] < x[l] ? x[l] : x[i], b_ = x[i] < x[l] ? x[i] : x[l]; x[i] = a_; x[l] = b_; }
__device__ __forceinline__ void sort16_desc(unsigned (&x)[16]) {
#pragma unroll
    for (int k = 2; k <= 16; k <<= 1)
#pragma unroll
        for (int j = k >> 1; j > 0; j >>= 1)
#pragma unroll
            for (int i = 0; i < 16; ++i) { const int l = i ^ j; if (l > i) { if ((i & k) == 0) { PEER_CE(x, i, l) } else { PEER_CE(x, l, i) } } }
}
__device__ __forceinline__ void merge16_desc(unsigned (&v)[16], const unsigned (&s)[16]) {
#pragma unroll
    for (int i = 0; i < 16; ++i) v[i] = v[i] < s[15 - i] ? s[15 - i] : v[i];
#pragma unroll
    for (int j = 8; j > 0; j >>= 1)
#pragma unroll
        for (int i = 0; i < 16; ++i) { const int l = i ^ j; if (l > i) PEER_CE(v, i, l) }
}
__device__ __forceinline__ unsigned ord32(unsigned b) { return b ^ ((unsigned)((int)b >> 31) | 0x80000000u); }
__device__ __forceinline__ float unord(unsigned o, unsigned mask) { o &= mask; return __uint_as_float((o & 0x80000000u) ? (o ^ 0x80000000u) : (~o & mask)); }

template <bool NEXT, int DRY = 0>
__device__ __forceinline__ void phase_peer(const Ctx& C, const Args& A, const unsigned char* Utab, const unsigned char* Vtab, const float* SU, const float* SV, const float* g2  ,
                                           const float* ngain, const float* nmod  , const XcdBarrier& bar) {
    const bf16* SC = (const bf16*)(A.ws + WS_BIG); bf16* Hb = (bf16*)(A.ws + WS_H);
#ifndef PEER_NBK
#define PEER_NBK 32
#endif
    constexpr int NBK = PEER_NBK, BSH = (NBK == 32 ? 9 : NBK == 64 ? 8 : 7), BPL = NBK / 16;
    LAS unsigned char* wb = C.lds + C.wave * (1024 + 32 * NBK + 8192);
    LAS unsigned char* IDXB = wb; LAS unsigned* CNT = (LAS unsigned*)(wb + 1024); LAS unsigned* PRE = (LAS unsigned*)(wb + 1024 + 16 * NBK); LAS v4u* ENT = (LAS v4u*)(wb + 1024 + 32 * NBK);
#ifndef PEER_SYNC_EVERY
#define PEER_SYNC_EVERY 32
#endif
    const bool wg_uniform = (DRY != 6) && ((NTOK / 4) % C.NGW == 0);
    unsigned flip = 0u;
#ifdef PEER_STAGGER
    if (C.wave >= 4) { const unsigned long long t0_ = __builtin_amdgcn_s_memrealtime(); while (__builtin_amdgcn_s_memrealtime() - t0_ < (unsigned long long)PEER_STAGGER) __builtin_amdgcn_s_sleep(16); }
#endif
    const int gw_ = (DRY == 6) ? ((C.bid >> 1) * NWAVES + C.wave) : C.gw, ngw_ = (DRY == 6) ? (C.NGW >> 1) : C.NGW;
    if (DRY == 6 && (C.bid & 1)) return;
    for (int tb = gw_; tb < NTOK / 4; tb += ngw_) {
        const int tok0 = tb * 4;
#if MK_ONE_LAUNCH && defined(PEER_SYNC)
        if (tb >= C.NGW) xcd_barrier(bar);
#endif
        int lane = C.lane; asm volatile("" : "+v"(lane));
        const int par = lane & 1, tl = lane >> 4, grp = lane & 15, head = grp >> 1, i16 = lane & 15;
        {
            unsigned val[16];
            const v4u* sp = (const v4u*)(SC + (size_t)(tok0 + tl) * 2048 + grp * 128);
            v4u raw[16];
#pragma unroll
            for (int c = 0; c < 16; ++c) raw[c] = sp[c];
#pragma unroll
            for (int c = 0; c < 16; c += 2) {
                const v4u c0 = raw[c], c1 = raw[c + 1];
                const unsigned ib = 127u - 8u * (unsigned)c;
                unsigned ks[16];
#pragma unroll
                for (int e = 0; e < 4; ++e) { ks[2 * e] = (ord32(c0[e] << 16) & 0xFFFF0000u) | (ib - 2u * e); ks[2 * e + 1] = (ord32(c0[e] & 0xFFFF0000u) & 0xFFFF0000u) | (ib - 2u * e - 1u);
                    ks[8 + 2 * e] = (ord32(c1[e] << 16) & 0xFFFF0000u) | (ib - 8u - 2u * e); ks[9 + 2 * e] = (ord32(c1[e] & 0xFFFF0000u) & 0xFFFF0000u) | (ib - 9u - 2u * e); }
                sort16_desc(ks);
                if (c == 0) {
#pragma unroll
                    for (int j = 0; j < 16; ++j) val[j] = ks[j];
                } else merge16_desc(val, ks);
            }
#pragma unroll
            for (int z = 0; z < NBK / 16; ++z) CNT[lane + 64 * z] = 0u;
            float X[16], Y[16];
            v4u ib4 = {0u, 0u, 0u, 0u};
#pragma unroll
            for (int j = 0; j < 16; ++j) { X[j] = unord(val[j], 0xFFFF0000u); Y[j] = unord(dppu<0xB1>(val[j]), 0xFFFF0000u); ib4[j >> 2] |= (127u - (val[j] & 127u)) << (8 * (j & 3)); }
            *(LAS v4u*)(IDXB + lane * 16) = ib4;
            unsigned cand[16], cb2[16];
            unsigned parv = (unsigned)par; asm volatile("" : "+v"(parv));
#define PEER_CKEY(p, q) ((((p) == (q)) && parv) ? 0u : ((ord32(__float_as_uint(X[p] + Y[q])) & 0xFFFFFF00u) | (255u - ((unsigned)((p) * 16 + (q)) + parv * (unsigned)(15 * ((q) - (p)))))))
            cand[0] = PEER_CKEY(0, 0); cand[1] = PEER_CKEY(0, 1); cand[2] = PEER_CKEY(0, 2); cand[3] = PEER_CKEY(0, 3); cand[4] = PEER_CKEY(0, 4); cand[5] = PEER_CKEY(0, 5); cand[6] = PEER_CKEY(0, 6); cand[7] = PEER_CKEY(0, 7);
            cand[8] = PEER_CKEY(0, 8); cand[9] = PEER_CKEY(0, 9); cand[10] = PEER_CKEY(0, 10); cand[11] = PEER_CKEY(0, 11); cand[12] = PEER_CKEY(0, 12); cand[13] = PEER_CKEY(0, 13); cand[14] = PEER_CKEY(0, 14); cand[15] = PEER_CKEY(0, 15);
            cb2[0] = PEER_CKEY(1, 1); cb2[1] = PEER_CKEY(1, 2); cb2[2] = PEER_CKEY(1, 3); cb2[3] = PEER_CKEY(1, 4); cb2[4] = PEER_CKEY(1, 5); cb2[5] = PEER_CKEY(1, 6); cb2[6] = PEER_CKEY(1, 7);
            cb2[7] = PEER_CKEY(2, 2); cb2[8] = PEER_CKEY(2, 3); cb2[9] = PEER_CKEY(2, 4); cb2[10] = PEER_CKEY(3, 3); cb2[11] = 0u; cb2[12] = 0u; cb2[13] = 0u; cb2[14] = 0u; cb2[15] = 0u;
#undef PEER_CKEY
            sort16_desc(cand); sort16_desc(cb2); merge16_desc(cand, cb2);
            unsigned mg[16]; float fv[16]; float mx = -INFINITY;
#pragma unroll
            for (int k = 0; k < 16; ++k) { const unsigned o = dppu<0xB1>(cand[15 - k]); mg[k] = cand[k] < o ? o : cand[k]; fv[k] = unord(mg[k], 0xFFFFFF00u); mx = fmaxf(mx, fv[k]); }
            float ssum = 0.f;
#pragma unroll
            for (int k = 0; k < 16; ++k) { fv[k] = __expf(fv[k] - mx); ssum += fv[k]; }
            const float inv = 1.f / ssum;
            asm volatile("s_waitcnt lgkmcnt(0)" ::: "memory");
            unsigned eid[8], rk[8]; float esu[8], egv[8];
#pragma unroll
            for (int k = 0; k < 8; ++k) { const unsigned fi = 255u - (mg[k] & 255u);
                const unsigned e1 = IDXB[(lane & ~1) * 16 + (fi >> 4)], e2 = IDXB[(lane | 1) * 16 + (fi & 15u)];
                eid[k] = e1 * 128u + e2;
                rk[k] = __hip_atomic_fetch_add(CNT + tl * NBK + (eid[k] >> BSH), 1u, __ATOMIC_RELAXED, __HIP_MEMORY_SCOPE_WORKGROUP);
                esu[k] = SU[eid[k]]; egv[k] = fv[k] * inv * SV[eid[k]]; }
            asm volatile("s_waitcnt lgkmcnt(0)" ::: "memory");
            { unsigned cb[BPL]; unsigned s = 0u;
#pragma unroll
              for (int z = 0; z < BPL; ++z) { cb[z] = CNT[tl * NBK + BPL * i16 + z]; s += cb[z]; }
              const unsigned tot = s;
              s += dppu<0x111>(s); s += dppu<0x112>(s); s += dppu<0x114>(s); s += dppu<0x118>(s);
              unsigned ex = s - tot;
#pragma unroll
              for (int z = 0; z < BPL; ++z) { PRE[tl * NBK + BPL * i16 + z] = ex; ex += cb[z]; } }
            asm volatile("s_waitcnt lgkmcnt(0)" ::: "memory");
#pragma unroll
            for (int k = 0; k < 8; ++k) { unsigned pos = PRE[tl * NBK + (eid[k] >> BSH)] + rk[k]; pos = flip ? 127u - pos : pos;
                ENT[tl * 128 + pos] = (v4u){eid[k], __float_as_uint(esu[k]), __float_as_uint(egv[k]), 0u}; }
            asm volatile("s_waitcnt lgkmcnt(0)" ::: "memory");
            flip ^= 1u;
        }
        if (wg_uniform) __syncthreads();
        if (DRY != 3) {
            const int tok = tok0 + tl; const int b = tok >> 12;
            LAS v4u* E = ENT + tl * 128;
            float cmax = 0.f;
            {
                unsigned hq[16]; const float hs = ((const float*)(A.ws + WS_SA))[tok];
#pragma unroll
                for (int j = 0; j < 4; ++j) { const v4u hw = *(const v4u*)(A.ws + WS_IDS + (size_t)tok * DM + 256 * j + 16 * i16); hq[4 * j] = hw.x; hq[4 * j + 1] = hw.y; hq[4 * j + 2] = hw.z; hq[4 * j + 3] = hw.w; }
                v4u B[8][4]; unsigned idr[8]; float mine = 0.f;
#define PEER_LOADI(R_, tab, id_) { const unsigned off = ((id_) & (DRY == 2 ? 1023u : 16383u)) * 1024u + 16u * (unsigned)i16; \
                _Pragma("unroll") for (int j = 0; j < 4; ++j) R_[j] = (DRY == 5 && j >= 2) ? R_[j - 2] : *(const v4u*)((tab) + off + 256 * j); }
#define PEER_DOTS(U_, t_) { int d0 = 0, d1 = 0, d2 = 0, d3 = 0; \
                _Pragma("unroll") for (int e = 0; e < 4; ++e) { d0 = __builtin_amdgcn_sdot4((int)U_[0][e], (int)hq[e], d0, false); d1 = __builtin_amdgcn_sdot4((int)U_[1][e], (int)hq[4 + e], d1, false); \
                    d2 = __builtin_amdgcn_sdot4((int)U_[2][e], (int)hq[8 + e], d2, false); d3 = __builtin_amdgcn_sdot4((int)U_[3][e], (int)hq[12 + e], d3, false); } \
                unsigned ds_ = (unsigned)((d0 + d1) + (d2 + d3)); ds_ += dppu<0xB1>(ds_); ds_ += dppu<0x4E>(ds_); ds_ += dppu<0x124>(ds_); ds_ += dppu<0x128>(ds_); \
                mine = (i16 == ((t_) & 15)) ? (float)(int)ds_ : mine; }
#pragma unroll
                for (int k = 0; k < 8; ++k) idr[k] = E[k].x;
#pragma unroll
                for (int k = 0; k < 8; ++k) PEER_LOADI(B[k], Utab, idr[k])
#pragma unroll 1
                for (int r = 0; r < 128; r += 8) {
                    if (wg_uniform && (r & (PEER_SYNC_EVERY - 1)) == 0 && r) __syncthreads();
                    if (r + 8 < 128) {
#pragma unroll
                        for (int k = 0; k < 8; ++k) idr[k] = E[r + 8 + k].x;
                    }
#pragma unroll
                    for (int k = 0; k < 8; ++k) { PEER_DOTS(B[k], r + k) if (r + 8 < 128) PEER_LOADI(B[k], Utab, idr[k]) }
                    if (r & 8) {
                        const int t = (r & ~15) + i16; const v4u en = E[t];
                        const float cf = gelu_as(mine * (__uint_as_float(en.y) * hs)) * __uint_as_float(en.z);
                        ((LAS float*)(E + t))[3] = cf; cmax = fmaxf(cmax, fabsf(cf));
                    }
                }
#undef PEER_DOTS
            }
            if (wg_uniform) __syncthreads();
            cmax = fmaxf(cmax, __uint_as_float(dppu<0xB1>(__float_as_uint(cmax)))); cmax = fmaxf(cmax, __uint_as_float(dppu<0x4E>(__float_as_uint(cmax))));
            cmax = fmaxf(cmax, __uint_as_float(dppu<0x124>(__float_as_uint(cmax)))); cmax = fmaxf(cmax, __uint_as_float(dppu<0x128>(__float_as_uint(cmax))));
            cmax = fmaxf(cmax, 1e-30f);
            int acci[4][16];
#pragma unroll
            for (int j = 0; j < 4; ++j)
#pragma unroll
                for (int e = 0; e < 16; ++e) acci[j][e] = 0;
            if (DRY != 4) {
                const float cq = 127.f / cmax;
                asm volatile("s_waitcnt lgkmcnt(0)" ::: "memory");
                unsigned pk0, pk1;
                { int q[8];
#pragma unroll
                  for (int k = 0; k < 8; ++k) q[k] = (int)rintf(((const LAS float*)(E + 8 * i16 + k))[3] * cq);
                  pk0 = ((unsigned)q[0] & 255u) | (((unsigned)q[1] & 255u) << 8) | (((unsigned)q[2] & 255u) << 16) | ((unsigned)q[3] << 24);
                  pk1 = ((unsigned)q[4] & 255u) | (((unsigned)q[5] & 255u) << 8) | (((unsigned)q[6] & 255u) << 16) | ((unsigned)q[7] << 24); }
                asm volatile("s_waitcnt lgkmcnt(0)" ::: "memory");
                ((LAS unsigned*)(E + 2 * i16))[1] = pk0; ((LAS unsigned*)(E + 2 * i16 + 1))[1] = pk1;
                asm volatile("s_waitcnt lgkmcnt(0)" ::: "memory");
                v4u Ba[4][2], Bb[4][2];
#define PEER_LOADG(B_, g_, hf_) { _Pragma("unroll") for (int n = 0; n < 4; ++n) { const unsigned id_ = E[4 * (g_) + n].x; const unsigned off = (id_ & (DRY == 2 ? 1023u : 16383u)) * 1024u + 16u * (unsigned)i16 + 512u * (hf_); \
                    _Pragma("unroll") for (int jj = 0; jj < 2; ++jj) B_[n][jj] = *(const v4u*)(Vtab + off + 256 * jj); } }
#define PEER_GROUP(B_, g_, hf_) { const unsigned a4 = ((const LAS unsigned*)(E + (g_)))[1]; \
                    _Pragma("unroll") for (int jj = 0; jj < 2; ++jj) _Pragma("unroll") for (int e = 0; e < 4; ++e) { \
                        const unsigned p01l = __builtin_amdgcn_perm(B_[1][jj][e], B_[0][jj][e], 0x05010400u), p01h = __builtin_amdgcn_perm(B_[1][jj][e], B_[0][jj][e], 0x07030602u); \
                        const unsigned p23l = __builtin_amdgcn_perm(B_[3][jj][e], B_[2][jj][e], 0x05010400u), p23h = __builtin_amdgcn_perm(B_[3][jj][e], B_[2][jj][e], 0x07030602u); \
                        acci[2 * (hf_) + jj][4 * e + 0] = __builtin_amdgcn_sdot4((int)__builtin_amdgcn_perm(p23l, p01l, 0x05040100u), (int)a4, acci[2 * (hf_) + jj][4 * e + 0], false); \
                        acci[2 * (hf_) + jj][4 * e + 1] = __builtin_amdgcn_sdot4((int)__builtin_amdgcn_perm(p23l, p01l, 0x07060302u), (int)a4, acci[2 * (hf_) + jj][4 * e + 1], false); \
                        acci[2 * (hf_) + jj][4 * e + 2] = __builtin_amdgcn_sdot4((int)__builtin_amdgcn_perm(p23h, p01h, 0x05040100u), (int)a4, acci[2 * (hf_) + jj][4 * e + 2], false); \
                        acci[2 * (hf_) + jj][4 * e + 3] = __builtin_amdgcn_sdot4((int)__builtin_amdgcn_perm(p23h, p01h, 0x07060302u), (int)a4, acci[2 * (hf_) + jj][4 * e + 3], false); } }
                PEER_LOADG(Ba, 0, 0)
#pragma unroll 1
                for (int g = 0; g < 32; ++g) {
                    if (wg_uniform && (g & (PEER_SYNC_EVERY / 4 - 1)) == 0 && g) __syncthreads();
                    PEER_LOADG(Bb, g, 1)
                    PEER_GROUP(Ba, g, 0)
                    if (g + 1 < 32) PEER_LOADG(Ba, g + 1, 0)
                    PEER_GROUP(Bb, g, 1)
                }
#undef PEER_LOADG
#undef PEER_GROUP
            }
            const float osc = cmax * (1.f / 127.f);
            f32x2 acc[4][8];
#pragma unroll
            for (int j = 0; j < 4; ++j)
#pragma unroll
                for (int e = 0; e < 8; ++e) acc[j][e] = (f32x2){(float)acci[j][2 * e] * osc, (float)acci[j][2 * e + 1] * osc};
#undef PEER_LOADI
            float ss = 0.f;
#pragma unroll
            for (int j = 0; j < 4; ++j) { const size_t eo = (size_t)tok * DM + 256 * j + 16 * i16; const float* gp = g2 + (size_t)b * 6144 + 256 * j + 16 * i16;
                bf16* XBp = (bf16*)(A.ws + WS_XB) + eo; const v4u xw0 = *(const v4u*)XBp, xw1 = *(const v4u*)(XBp + 8);
                unsigned ow[8];
#pragma unroll
                for (int q = 0; q < 4; ++q) { const unsigned w0 = q < 2 ? xw0[2 * q] : xw1[2 * q - 4], w1 = q < 2 ? xw0[2 * q + 1] : xw1[2 * q - 3]; const f32x4 g0 = *(const f32x4*)(gp + 4 * q);
                    const f32x4 xn = {bflo(w0) + (1.f + g0[0]) * acc[j][2 * q].x, bfhi(w0) + (1.f + g0[1]) * acc[j][2 * q].y, bflo(w1) + (1.f + g0[2]) * acc[j][2 * q + 1].x, bfhi(w1) + (1.f + g0[3]) * acc[j][2 * q + 1].y};
                    if (NEXT) { ow[2 * q] = pk2(xn[0], xn[1]); ow[2 * q + 1] = pk2(xn[2], xn[3]); }
                    else if (DRY == 0 || xn[0] == 1234.5678f) *(f32x4*)(A.out + eo + 4 * q) = xn;
                    acc[j][2 * q] = (f32x2){xn[0], xn[1]}; acc[j][2 * q + 1] = (f32x2){xn[2], xn[3]};
                    ss += (xn[0] * xn[0] + xn[1] * xn[1]) + (xn[2] * xn[2] + xn[3] * xn[3]); }
                if (NEXT && (DRY == 0 || ss == 1234.5678f)) { *(v4u*)XBp = (v4u){ow[0], ow[1], ow[2], ow[3]}; *(v4u*)(XBp + 8) = (v4u){ow[4], ow[5], ow[6], ow[7]}; } }
            if (DRY != 0) { if (ss == 1234.5678f) A.out[tok] = ss; }
            if (NEXT && DRY == 0) {
                ss += __uint_as_float(dppu<0xB1>(__float_as_uint(ss))); ss += __uint_as_float(dppu<0x4E>(__float_as_uint(ss)));
                ss += __uint_as_float(dppu<0x124>(__float_as_uint(ss))); ss += __uint_as_float(dppu<0x128>(__float_as_uint(ss)));
                const float rstd = rsqrtf(ss * (1.f / DM) + EPS);
                float am = 0.f;
#pragma unroll
                for (int j = 0; j < 4; ++j) { const int c0 = 256 * j + 16 * i16; const float* shp = nmod + (size_t)b * 6144 + c0; const float* scp = shp + 1024;
#pragma unroll
                    for (int q = 0; q < 4; ++q) { const f32x4 gn = *(const f32x4*)(ngain + c0 + 4 * q), sc = *(const f32x4*)(scp + 4 * q), sh = *(const f32x4*)(shp + 4 * q);
                        const f32x2 h0 = {acc[j][2 * q].x * rstd * gn[0] * (1.f + sc[0]) + sh[0], acc[j][2 * q].y * rstd * gn[1] * (1.f + sc[1]) + sh[1]};
                        const f32x2 h1 = {acc[j][2 * q + 1].x * rstd * gn[2] * (1.f + sc[2]) + sh[2], acc[j][2 * q + 1].y * rstd * gn[3] * (1.f + sc[3]) + sh[3]};
                        acc[j][2 * q] = h0; acc[j][2 * q + 1] = h1; am = fmaxf(am, fmaxf(fmaxf(fabsf(h0.x), fabsf(h0.y)), fmaxf(fabsf(h1.x), fabsf(h1.y)))); } }
                am = fmaxf(am, __uint_as_float(dppu<0xB1>(__float_as_uint(am)))); am = fmaxf(am, __uint_as_float(dppu<0x4E>(__float_as_uint(am))));
                am = fmaxf(am, __uint_as_float(dppu<0x124>(__float_as_uint(am)))); am = fmaxf(am, __uint_as_float(dppu<0x128>(__float_as_uint(am))));
                am = fmaxf(am, 1e-20f); const float qi = 127.f / am;
#pragma unroll
                for (int j = 0; j < 4; ++j) { v4u o;
#pragma unroll
                    for (int q = 0; q < 4; ++q) { const int q0 = (int)rintf(acc[j][2 * q].x * qi), q1 = (int)rintf(acc[j][2 * q].y * qi), q2 = (int)rintf(acc[j][2 * q + 1].x * qi), q3 = (int)rintf(acc[j][2 * q + 1].y * qi);
                        o[q] = ((unsigned)q0 & 255u) | (((unsigned)q1 & 255u) << 8) | (((unsigned)q2 & 255u) << 16) | ((unsigned)q3 << 24); }
                    *(v4u*)(A.ws + WS_IDS + (size_t)tok * DM + 256 * j + 16 * i16) = o; }
                if (i16 == 0) ((float*)(A.ws + WS_SA))[tok] = am * (1.f / 127.f);
            }
        }
    }
}
__device__ __forceinline__ void convert_tables_int8(const Ctx& C, const Args& A) {
    unsigned char* T8 = A.ws + WS_TAB; float* TS = (float*)(A.ws + WS_TSC);
    for (int R0 = C.gw * 4; R0 < 4 * 16384; R0 += C.NGW * 4) {
        const int t = R0 >> 14;
        const float* src = A.in[t == 0 ? 15 : t == 1 ? 16 : t == 2 ? 28 : 29] + (size_t)(R0 & 16383) * DM + 16 * C.lane;
        f32x4 x[4][4]; float am[4];
#pragma unroll
        for (int r = 0; r < 4; ++r) { am[r] = 0.f;
#pragma unroll
            for (int q = 0; q < 4; ++q) x[r][q] = *(const f32x4*)(src + (size_t)r * DM + 4 * q); }
#pragma unroll
        for (int r = 0; r < 4; ++r) {
#pragma unroll
            for (int q = 0; q < 4; ++q) am[r] = fmaxf(am[r], fmaxf(fmaxf(fabsf(x[r][q].x), fabsf(x[r][q].y)), fmaxf(fabsf(x[r][q].z), fabsf(x[r][q].w))));
            am[r] = wave_max(am[r]);
            const float sc = (am[r] > 0.f) ? 127.f / am[r] : 1.f, inv = (am[r] > 0.f) ? am[r] * (1.f / 127.f) : 1.f;
            v4u o;
#pragma unroll
            for (int q = 0; q < 4; ++q) { const int q0 = (int)rintf(x[r][q].x * sc), q1 = (int)rintf(x[r][q].y * sc), q2 = (int)rintf(x[r][q].z * sc), q3 = (int)rintf(x[r][q].w * sc);
                o[q] = ((unsigned)q0 & 255u) | (((unsigned)q1 & 255u) << 8) | (((unsigned)q2 & 255u) << 16) | ((unsigned)q3 << 24); }
            *(v4u*)(T8 + (size_t)(R0 + r) * DM + 16 * C.lane) = o;
            if (C.lane == 0) TS[R0 + r] = inv;
        }
    }
}
constexpr size_t WS_NL = 3 * MiB, WS_NP = WS_NL + 512 * 1024;
constexpr size_t WS_GC = WS_MOD + 512 * 1024, WS_ML = WS_GC + 4096, WS_MP = WS_ML + 4096;
constexpr size_t OUT_SL = 0, OUT_SP = 64 * MiB;
typedef float f32x16 __attribute__((ext_vector_type(16)));
typedef short s16x4 __attribute__((ext_vector_type(4)));
__device__ __forceinline__ unsigned offb(unsigned row, unsigned ch) { return 256u * row + 16u * (ch ^ (((row & 3u) << 2) | ((row >> 2) & 3u))); }
__device__ __forceinline__ s16x4 tr_read4(unsigned lds_addr) { s16x4 r; asm volatile("ds_read_b64_tr_b16 %0, %1\n\ts_waitcnt lgkmcnt(0)" : "=&v"(r) : "v"(lds_addr) : "memory"); return r; }
__device__ __forceinline__ void tr_read4x2(s16x4& r0, s16x4& r1, unsigned a0, unsigned a1) {
    asm volatile("ds_read_b64_tr_b16 %0, %2\n\tds_read_b64_tr_b16 %1, %3\n\ts_waitcnt lgkmcnt(0)" : "=&v"(r0), "=&v"(r1) : "v"(a0), "v"(a1) : "memory"); }
__device__ __forceinline__ void tr_read4x6(s16x4 (&r)[6], unsigned a0, unsigned a1, unsigned a2, unsigned a3, unsigned a4, unsigned a5) {
    asm volatile("ds_read_b64_tr_b16 %0, %6\n\tds_read_b64_tr_b16 %1, %7\n\tds_read_b64_tr_b16 %2, %8\n\tds_read_b64_tr_b16 %3, %9\n\tds_read_b64_tr_b16 %4, %10\n\tds_read_b64_tr_b16 %5, %11\n\ts_waitcnt lgkmcnt(0)"
                 : "=&v"(r[0]), "=&v"(r[1]), "=&v"(r[2]), "=&v"(r[3]), "=&v"(r[4]), "=&v"(r[5]) : "v"(a0), "v"(a1), "v"(a2), "v"(a3), "v"(a4), "v"(a5) : "memory"); }
__device__ __forceinline__ void tr_read4x8(s16x4 (&r)[8], unsigned a0, unsigned a1, unsigned a2, unsigned a3, unsigned a4, unsigned a5, unsigned a6, unsigned a7) {
    asm volatile("ds_read_b64_tr_b16 %0, %8\n\tds_read_b64_tr_b16 %1, %9\n\tds_read_b64_tr_b16 %2, %10\n\tds_read_b64_tr_b16 %3, %11\n\tds_read_b64_tr_b16 %4, %12\n\tds_read_b64_tr_b16 %5, %13\n\tds_read_b64_tr_b16 %6, %14\n\tds_read_b64_tr_b16 %7, %15\n\ts_waitcnt lgkmcnt(0)"
                 : "=&v"(r[0]), "=&v"(r[1]), "=&v"(r[2]), "=&v"(r[3]), "=&v"(r[4]), "=&v"(r[5]), "=&v"(r[6]), "=&v"(r[7]) : "v"(a0), "v"(a1), "v"(a2), "v"(a3), "v"(a4), "v"(a5), "v"(a6), "v"(a7) : "memory"); }
__device__ __forceinline__ float scan_sum64(float v, int lane) {
#pragma unroll
    for (int o = 1; o < 64; o <<= 1) { const float t = __shfl_up(v, o); if (lane >= o) v += t; }
    return v;
}
__device__ __forceinline__ float scan_max64(float v, int lane) {
#pragma unroll
    for (int o = 1; o < 64; o <<= 1) { const float t = __shfl_up(v, o); if (lane >= o) v = fmaxf(v, t); }
    return v;
}
__device__ __forceinline__ pg8::bf16x8 mk_frag(s16x4 a, s16x4 b) { return (pg8::bf16x8){a[0], a[1], a[2], a[3], b[0], b[1], b[2], b[3]}; }

__device__ __forceinline__ void phase_mlstm_local(const Ctx& C, const Args& A) {
    const bf16* P = (const bf16*)(A.ws + WS_BIG);
    const float* LF = (const float*)(A.ws + WS_LF); const float* LI = (const float*)(A.ws + WS_LI);
    bf16* SL = (bf16*)((unsigned char*)A.out + OUT_SL); float* NL = (float*)(A.ws + WS_NL);
    float* GC = (float*)(A.ws + WS_GC); float* ML = (float*)(A.ws + WS_ML);
    LAS unsigned char* tK = C.lds; LAS unsigned char* tV = C.lds + 32768; LAS float* wtab = (LAS float*)(C.lds + 65536);
    const unsigned ldsK = (unsigned)(uintptr_t)tK, ldsV = (unsigned)(uintptr_t)tV;
    const int lane = C.lane, wid = C.wave, tid = C.tid;
    for (int unit = C.bid; unit < 1024; unit += C.G) {
        const int bh = unit >> 5, c = unit & 31, b = bh >> 2, hh = bh & 3;
        const size_t tok0 = (size_t)b * SEQ + c * 128;
        if (wid == 0) {
            const float2 lf = *(const float2*)(LF + (size_t)bh * SEQ + c * 128 + 2 * lane), li = *(const float2*)(LI + (size_t)bh * SEQ + c * 128 + 2 * lane);
            const float pr = lf.x + lf.y, inc = scan_sum64(pr, lane), ex = inc - pr;
            const float b0 = ex + lf.x, b1 = b0 + lf.y;
            const float g = __shfl(inc, 63);
            const float a0 = g - b0 + li.x, a1 = g - b1 + li.y;
            const float mloc = wave_max(fmaxf(a0, a1));
            wtab[2 * lane] = __expf(a0 - mloc); wtab[2 * lane + 1] = __expf(a1 - mloc);
            if (lane == 0) { GC[unit] = g; ML[unit] = mloc; }
        }
        __syncthreads();
#pragma unroll
        for (int i = 0; i < 4; ++i) { const int id = tid + 512 * i, row = id >> 4, ch = id & 15;
            const bf16* src = P + (tok0 + row) * INP + hh * 128 + ch * 8;
            const v4u kv = *(const v4u*)(src + 512), vv = *(const v4u*)(src + 1024);
            const float w = wtab[row];
            v4u ko; ko.x = pk2(bflo(kv.x) * w, bfhi(kv.x) * w); ko.y = pk2(bflo(kv.y) * w, bfhi(kv.y) * w); ko.z = pk2(bflo(kv.z) * w, bfhi(kv.z) * w); ko.w = pk2(bflo(kv.w) * w, bfhi(kv.w) * w);
            *(LAS v4u*)(tK + offb(row, ch)) = ko; *(LAS v4u*)(tV + offb(row, ch)) = vv; }
        __syncthreads();
        if (tid < 128) { const int d = tid; float s = 0.f;
#pragma unroll 8
            for (int l = 0; l < 128; ++l) s += bf2f(*(const LAS unsigned short*)(tK + offb(l, d >> 3) + (d & 7) * 2));
            NL[(size_t)unit * 128 + d] = s; }
        {
            const int db = wid & 3, eh = wid >> 2;
            const unsigned h = lane >> 5, blk = (lane >> 4) & 1, q = (lane & 15) >> 2, p = lane & 3;
            f32x16 acc[2];
#pragma unroll
            for (int eb = 0; eb < 2; ++eb)
#pragma unroll
                for (int r = 0; r < 16; ++r) acc[eb][r] = 0.f;
#pragma unroll
            for (int ks = 0; ks < 8; ++ks) {
                const unsigned r0 = 16 * ks + 8 * h + q, cA = 4 * db + 2 * blk + (p >> 1), cB0 = 4 * (2 * eh) + 2 * blk + (p >> 1), cB1 = cB0 + 4, po = 8 * (p & 1);
                s16x4 t[6];
                tr_read4x6(t, ldsK + offb(r0, cA) + po, ldsK + offb(r0 + 4, cA) + po, ldsV + offb(r0, cB0) + po, ldsV + offb(r0 + 4, cB0) + po, ldsV + offb(r0, cB1) + po, ldsV + offb(r0 + 4, cB1) + po);
                const pg8::bf16x8 af = mk_frag(t[0], t[1]);
                acc[0] = __builtin_amdgcn_mfma_f32_32x32x16_bf16(af, mk_frag(t[2], t[3]), acc[0], 0, 0, 0);
                acc[1] = __builtin_amdgcn_mfma_f32_32x32x16_bf16(af, mk_frag(t[4], t[5]), acc[1], 0, 0, 0);
            }
            const int hi = lane >> 5;
#pragma unroll
            for (int eb = 0; eb < 2; ++eb) { const int e = 32 * (2 * eh + eb) + (lane & 31);
#pragma unroll
                for (int g4 = 0; g4 < 4; ++g4) { uint2 o; o.x = pk2(acc[eb][4 * g4], acc[eb][4 * g4 + 1]); o.y = pk2(acc[eb][4 * g4 + 2], acc[eb][4 * g4 + 3]);
                    *(uint2*)(SL + ((size_t)unit * 128 + e) * 128 + 32 * db + 8 * g4 + 4 * hi) = o; } }
        }
        __syncthreads();
    }
}

__device__ __forceinline__ void phase_mlstm_scan(const Ctx& C, const Args& A) {
    const bf16* SL = (const bf16*)((unsigned char*)A.out + OUT_SL); bf16* SP = (bf16*)((unsigned char*)A.out + OUT_SP);
    const float* NL = (const float*)(A.ws + WS_NL); float* NP = (float*)(A.ws + WS_NP);
    const float* GC = (const float*)(A.ws + WS_GC); const float* ML = (const float*)(A.ws + WS_ML); float* MP = (float*)(A.ws + WS_MP);
    for (long it = C.gt; it < 32L * 128 * 32; it += C.NGT) {
        const int d4 = (int)(it & 31), e = (int)((it >> 5) & 127), bh = (int)(it >> 12);
        f32x4 s = {0.f, 0.f, 0.f, 0.f}, n = {0.f, 0.f, 0.f, 0.f}; float m = 0.f;
        const bool do_n = (e == 0);
#pragma unroll 4
        for (int c = 0; c < 32; ++c) {
            const size_t unit = (size_t)bh * 32 + c;
            uint2 o; o.x = pk2(s.x, s.y); o.y = pk2(s.z, s.w);
            *(uint2*)(SP + (unit * 128 + e) * 128 + 4 * d4) = o;
            if (do_n) { *(f32x4*)(NP + unit * 128 + 4 * d4) = n; if (d4 == 0) MP[unit] = m; }
            const float g = GC[unit], ml = ML[unit];
            const float mn = fmaxf(g + m, ml), dec = __expf(g + m - mn), sc = __expf(ml - mn);
            const uint2 xw = *(const uint2*)(SL + (unit * 128 + e) * 128 + 4 * d4); const f32x4 x = {bflo(xw.x), bfhi(xw.x), bflo(xw.y), bfhi(xw.y)};
            s = s * dec + x * sc;
            if (do_n) { const f32x4 y = *(const f32x4*)(NL + unit * 128 + 4 * d4); n = n * dec + y * sc; }
            m = mn;
        }
    }
}

__device__ __forceinline__ void phase_mlstm_out(const Ctx& C, const Args& A) {
    const bf16* P = (const bf16*)(A.ws + WS_BIG); bf16* mix = (bf16*)(A.ws + WS_H);
    const float* LF = (const float*)(A.ws + WS_LF); const float* LI = (const float*)(A.ws + WS_LI);
    const bf16* SP = (const bf16*)((unsigned char*)A.out + OUT_SP); const float* NP = (const float*)(A.ws + WS_NP); const float* MP = (const float*)(A.ws + WS_MP);
    const float* gain = A.in[9];
    LAS unsigned char* tV = C.lds; LAS float* abt = (LAS float*)(C.lds + 65536); LAS float* Mt = abt + 128; LAS float* bt = abt + 256; LAS float* npt = abt + 384; LAS float* ssq = abt + 512;
    const unsigned ldsV = (unsigned)(uintptr_t)tV;
    const int lane = C.lane, wid = C.wave, tid = C.tid, hi = lane >> 5, l31 = lane & 31;
    constexpr float QS = 0.08838834764831845f;
    for (int unit = C.bid; unit < 1024; unit += C.G) {
        const int bh = unit >> 5, c = unit & 31, b = bh >> 2, hh = bh & 3;
        const size_t tok0 = (size_t)b * SEQ + c * 128;
        const float mprev = MP[unit];
        if (wid == 0) {
            const float2 lf = *(const float2*)(LF + (size_t)bh * SEQ + c * 128 + 2 * lane), li = *(const float2*)(LI + (size_t)bh * SEQ + c * 128 + 2 * lane);
            const float pr = lf.x + lf.y, inc = scan_sum64(pr, lane), ex = inc - pr;
            const float b0 = ex + lf.x, b1 = b0 + lf.y;
            const float ab0 = li.x - b0, ab1 = li.y - b1;
            const float pmx = scan_max64(fmaxf(ab0, ab1), lane);
            float pme = __shfl_up(pmx, 1); if (lane == 0) pme = -INFINITY;
            const float pm0 = fmaxf(pme, ab0), pm1 = fmaxf(pm0, ab1);
            abt[2 * lane] = ab0; abt[2 * lane + 1] = ab1; bt[2 * lane] = b0; bt[2 * lane + 1] = b1;
            Mt[2 * lane] = fmaxf(mprev, pm0); Mt[2 * lane + 1] = fmaxf(mprev, pm1);
        }
        if (wid == 1) { npt[2 * lane] = NP[(size_t)unit * 128 + 2 * lane]; npt[2 * lane + 1] = NP[(size_t)unit * 128 + 2 * lane + 1]; }
#pragma unroll
        for (int i = 0; i < 4; ++i) { const int id = tid + 512 * i, row = id >> 4, ch = id & 15;
            *(LAS v4u*)(tV + offb(row, ch)) = *(const v4u*)(P + (tok0 + row) * INP + 1024 + hh * 128 + ch * 8); }
        __syncthreads();
        const int lb = wid & 3, eh = wid >> 2;
        const int l = 32 * lb + l31;
        const float Ml = Mt[l], iw = __expf(mprev - Ml) * QS;
        pg8::bf16x8 qf[8];
#pragma unroll
        for (int ks = 0; ks < 8; ++ks) qf[ks] = *(const pg8::bf16x8*)(P + (tok0 + l) * INP + hh * 128 + 16 * ks + 8 * hi);
        float qn = 0.f;
#pragma unroll
        for (int ks = 0; ks < 8; ++ks)
#pragma unroll
            for (int j = 0; j < 8; ++j) qn += bf2f((unsigned short)qf[ks][j]) * npt[16 * ks + 8 * hi + j];
        qn += __shfl_xor(qn, 32);
        f32x16 acc[2];
#pragma unroll
        for (int eb = 0; eb < 2; ++eb) {
#pragma unroll
            for (int r = 0; r < 16; ++r) acc[eb][r] = 0.f;
            const bf16* sp = SP + ((size_t)unit * 128 + 32 * (2 * eh + eb) + l31) * 128 + 8 * hi;
#pragma unroll
            for (int ks = 0; ks < 8; ++ks) acc[eb] = __builtin_amdgcn_mfma_f32_32x32x16_bf16(*(const pg8::bf16x8*)(sp + 16 * ks), qf[ks], acc[eb], 0, 0, 0);
#pragma unroll
            for (int r = 0; r < 16; ++r) acc[eb][r] *= iw;
        }
        float den = 0.f;
        const unsigned g16 = lane >> 4, blk = g16 & 1, q = (lane & 15) >> 2, p = lane & 3;
        for (int sb = 0; sb <= lb; ++sb) {
            f32x16 X;
#pragma unroll
            for (int r = 0; r < 16; ++r) X[r] = 0.f;
            const bf16* kp = P + (tok0 + 32 * sb + l31) * INP + 512 + hh * 128 + 8 * hi;
#pragma unroll
            for (int ks = 0; ks < 8; ++ks) X = __builtin_amdgcn_mfma_f32_32x32x16_bf16(*(const pg8::bf16x8*)(kp + 16 * ks), qf[ks], X, 0, 0, 0);
            float pv[16];
#pragma unroll
            for (int r = 0; r < 16; ++r) { const int s = 32 * sb + (r & 3) + 8 * (r >> 2) + 4 * hi;
                const float v = X[r] * QS * __expf(abt[s] - Ml);
                pv[r] = (s <= l) ? v : 0.f; den += pv[r]; }
            pg8::bf16x8 pf[2];
#pragma unroll
            for (int st = 0; st < 2; ++st) { v4u t; t.x = pk2(pv[8 * st], pv[8 * st + 1]); t.y = pk2(pv[8 * st + 2], pv[8 * st + 3]); t.z = pk2(pv[8 * st + 4], pv[8 * st + 5]); t.w = pk2(pv[8 * st + 6], pv[8 * st + 7]);
                pf[st] = __builtin_bit_cast(pg8::bf16x8, t); }
            { const unsigned c0 = 4 * (2 * eh) + 2 * blk + (p >> 1), c1 = c0 + 4, ra = 32 * sb + 4 * hi + q, po = 8 * (p & 1);
              s16x4 t[8];
              tr_read4x8(t, ldsV + offb(ra, c0) + po, ldsV + offb(ra + 8, c0) + po, ldsV + offb(ra + 16, c0) + po, ldsV + offb(ra + 24, c0) + po,
                            ldsV + offb(ra, c1) + po, ldsV + offb(ra + 8, c1) + po, ldsV + offb(ra + 16, c1) + po, ldsV + offb(ra + 24, c1) + po);
#pragma unroll
              for (int eb = 0; eb < 2; ++eb)
#pragma unroll
                  for (int st = 0; st < 2; ++st) acc[eb] = __builtin_amdgcn_mfma_f32_32x32x16_bf16(mk_frag(t[4 * eb + 2 * st], t[4 * eb + 2 * st + 1]), pf[st], acc[eb], 0, 0, 0); }
        }
        den += __shfl_xor(den, 32);
        den += iw * qn;
        const float dn = 1.f / fmaxf(fabsf(den), __expf(-(bt[l] + Ml)));
        float ss = 0.f;
#pragma unroll
        for (int eb = 0; eb < 2; ++eb)
#pragma unroll
            for (int r = 0; r < 16; ++r) { acc[eb][r] *= dn; ss += acc[eb][r] * acc[eb][r]; }
        ss += __shfl_xor(ss, 32);
        if (hi == 0) ssq[eh * 128 + l] = ss;
        __syncthreads();
        const float rstd = rsqrtf((ssq[l] + ssq[128 + l]) * (1.f / 128.f) + EPS);
#pragma unroll
        for (int eb = 0; eb < 2; ++eb)
#pragma unroll
            for (int g4 = 0; g4 < 4; ++g4) { const int e = 32 * (2 * eh + eb) + 8 * g4 + 4 * hi;
                const uint2 ow = *(const uint2*)(P + (tok0 + l) * INP + 1536 + hh * 128 + e);
                const f32x4 gn = *(const f32x4*)(gain + hh * 128 + e);
                uint2 o; o.x = pk2(acc[eb][4 * g4] * rstd * gn.x * sigmoidf_(bflo(ow.x)), acc[eb][4 * g4 + 1] * rstd * gn.y * sigmoidf_(bfhi(ow.x)));
                o.y = pk2(acc[eb][4 * g4 + 2] * rstd * gn.z * sigmoidf_(bflo(ow.y)), acc[eb][4 * g4 + 3] * rstd * gn.w * sigmoidf_(bfhi(ow.y)));
                *(uint2*)(mix + (tok0 + l) * DM + hh * 128 + e) = o; }
        __syncthreads();
    }
}
template <bool I8>
struct EpiQKV {
    static constexpr bool PERM = true, AFTER_DRAIN = false;
    bf16* O; bf16* KF; bf16* VH; const float* qg; const float* kg; const float* sa; const float* sw;
    __device__ __forceinline__ void operator()(const typename pg8::AccSel<I8>::type (&acc)[2][2][4][2], const pg8::Unit& u, int wr, int wc, int fr, int fq) const {
        using pg8::f32x4;
        f32x4 cs[2][2];
#pragma unroll
        for (int bj = 0; bj < 2; ++bj)
#pragma unroll
            for (int n = 0; n < 2; ++n) cs[bj][n] = I8 ? *(const f32x4*)(sw + u.pn * 256 + 128 * bj + 32 * wc + 8 * fq + 4 * n) : (f32x4){1.f, 1.f, 1.f, 1.f};
        const int kind = u.pn >> 2;
        const float* gp = (kind == 0) ? qg : kg;
        const float post = (kind == 0) ? 0.125f * 1.4426950408889634f : 1.0f;
        f32x4 gv[2][2];
#pragma unroll
        for (int bj = 0; bj < 2; ++bj)
#pragma unroll
            for (int n = 0; n < 2; ++n) gv[bj][n] = (kind < 2) ? *(const f32x4*)(gp + 32 * bj + 8 * fq + 4 * n) * post : (f32x4){1.f, 1.f, 1.f, 1.f};
#pragma unroll
        for (int ai = 0; ai < 2; ++ai)
#pragma unroll
            for (int m = 0; m < 4; ++m) {
                const int row = u.pm * 256 + ai * 128 + wr * 64 + m * 16 + fr;
                f32x4 xv[2][2]; float ss = 0.f;
                { const float rsc = I8 ? sa[row] : 1.f;
#pragma unroll
                  for (int bj = 0; bj < 2; ++bj)
#pragma unroll
                      for (int n = 0; n < 2; ++n) { const auto a = acc[ai][bj][m][n]; const f32x4 x = (f32x4){(float)a[0], (float)a[1], (float)a[2], (float)a[3]} * cs[bj][n] * rsc; xv[bj][n] = x;
                          ss += (x[0] * x[0] + x[1] * x[1]) + (x[2] * x[2] + x[3] * x[3]); } }
                ss += __shfl_xor(ss, 16); ss += __shfl_xor(ss, 32);
                const float rs = (kind < 2) ? rsqrtf(ss * (1.f / 64.f) + EPS) : 1.0f;
                bf16* dst = (kind == 1) ? KF + ((size_t)(((row >> 12) * 16 + (u.pn - 4) * 4 + wc) * 128 + ((row & 4095) >> 5)) * 2048 + (size_t)((fq >> 1) * 512 + ((fq & 1) * 32 + (row & 31)) * 8))
                                        : (kind == 2) ? VH + ((size_t)(((row >> 12) * 16 + (u.pn & 3) * 4 + wc) * 4096 + (row & 4095)) * 64 + 8 * fq)
                                        : O + (size_t)row * 1024 + (u.pn & 3) * 256 + 64 * wc + 8 * fq;
                const int bjstep = (kind == 1) ? 1024 : 32;
#pragma unroll
                for (int bj = 0; bj < 2; ++bj) { const f32x4 v0 = xv[bj][0] * gv[bj][0] * rs, v1 = xv[bj][1] * gv[bj][1] * rs;
                    v4u w; w.x = pk2(v0[0], v0[1]); w.y = pk2(v0[2], v0[3]); w.z = pk2(v1[0], v1[1]); w.w = pk2(v1[2], v1[3]);
                    *(v4u*)(dst + bjstep * bj) = w; }
            }
    }
};

__device__ __forceinline__ unsigned voff(unsigned row, unsigned ch) { return row * 128u + 16u * (ch ^ (row & 7u)); }
__device__ __forceinline__ void phase_attn(const Ctx& C, const Args& A) {
    const bf16* QV = (const bf16*)(A.ws + WS_BIG); const bf16* KF = (const bf16*)(A.ws + WS_BIG + 64 * MiB); const bf16* VH = (const bf16*)(A.ws + WS_BIG + 128 * MiB); bf16* O = (bf16*)(A.ws + WS_H);
    LAS unsigned char* tV = C.lds + C.wave * 4096;
    const unsigned ldsV = (unsigned)(uintptr_t)tV;
    const int lane = C.lane, hi = lane >> 5, l31 = lane & 31;
    const unsigned blk = (lane >> 4) & 1, q4 = (lane & 15) >> 2, p = lane & 3;
    const int per_wave = (16384 + C.NGW - 1) / C.NGW;
    for (int u = C.gw * per_wave; u < C.gw * per_wave + per_wave; ++u) {
        if (u >= 16384) break;
        const int bh = u >> 7, qt = u & 127, b = bh >> 4, hd = bh & 15;
        const size_t tokb = (size_t)b * SEQ;
        const int l = qt * 32 + l31;
        pg8::bf16x8 qf[4];
#pragma unroll
        for (int ks = 0; ks < 4; ++ks) qf[ks] = *(const pg8::bf16x8*)(QV + (tokb + l) * 1024 + hd * 64 + 16 * ks + 8 * hi);
        f32x16 acc[2];
#pragma unroll
        for (int eb = 0; eb < 2; ++eb)
#pragma unroll
            for (int r = 0; r < 16; ++r) acc[eb][r] = 0.f;
        float carry = 1.f;
        pg8::bf16x8 kf[4]; v4u vv[4];
#define ATT_LOAD(kt_) { const size_t s0_ = tokb + (size_t)(kt_) * 32; const bf16* kp_ = KF + ((size_t)(bh * 128 + (kt_)) * 2048 + lane * 8); \
            _Pragma("unroll") for (int ks = 0; ks < 4; ++ks) kf[ks] = *(const pg8::bf16x8*)(kp_ + ks * 512); \
            _Pragma("unroll") for (int i = 0; i < 4; ++i) { const int id = lane + 64 * i; vv[i] = *(const v4u*)(VH + ((size_t)bh * 4096 + (size_t)(kt_) * 32) * 64 + id * 8); } }
        ATT_LOAD(qt)
        for (int kt = qt; kt >= 0; --kt) {
            f32x16 X;
#pragma unroll
            for (int r = 0; r < 16; ++r) X[r] = 0.f;
#pragma unroll
            for (int ks = 0; ks < 4; ++ks) X = __builtin_amdgcn_mfma_f32_32x32x16_bf16(kf[ks], qf[ks], X, 0, 0, 0);
#pragma unroll
            for (int i = 0; i < 4; ++i) { const int id = lane + 64 * i; *(LAS v4u*)(tV + voff(id >> 3, id & 7)) = vv[i]; }
            if (kt > 0) ATT_LOAD(kt - 1)
            const int sbase = kt * 32 + 4 * hi;
            float rr[16];
#pragma unroll
            for (int r = 0; r < 16; ++r) rr[r] = __builtin_amdgcn_rcpf(1.f + __builtin_amdgcn_exp2f(X[r]));
            if (kt == qt) {
#pragma unroll
                for (int r = 0; r < 16; ++r) { const int s = sbase + (r & 3) + 8 * (r >> 2); rr[r] = (s < l) ? rr[r] : 1.f; }
            }
            float To[4], Tp[4];
#pragma unroll
            for (int g = 0; g < 4; ++g) { To[g] = (rr[4 * g] * rr[4 * g + 1]) * (rr[4 * g + 2] * rr[4 * g + 3]); Tp[g] = __shfl_xor(To[g], 32); }
            float base[4]; float run = 1.f;
#pragma unroll
            for (int g = 3; g >= 0; --g) { base[g] = carry * run * (hi == 0 ? Tp[g] : 1.f); run *= To[g] * Tp[g]; }
            float att[16];
#pragma unroll
            for (int g = 0; g < 4; ++g) { float w = base[g];
#pragma unroll
                for (int i = 3; i >= 0; --i) { const int r = 4 * g + i; att[r] = (1.f - rr[r]) * w; w *= rr[r]; } }
            carry *= run;
            pg8::bf16x8 pf[2];
#pragma unroll
            for (int st = 0; st < 2; ++st) { v4u t; t.x = pg8::cvt_pk_bf16(att[8 * st], att[8 * st + 1]); t.y = pg8::cvt_pk_bf16(att[8 * st + 2], att[8 * st + 3]); t.z = pg8::cvt_pk_bf16(att[8 * st + 4], att[8 * st + 5]); t.w = pg8::cvt_pk_bf16(att[8 * st + 6], att[8 * st + 7]);
                pf[st] = __builtin_bit_cast(pg8::bf16x8, t); }
            s16x4 vf[8];
            { const unsigned a0 = ldsV + voff(4 * hi + q4, 2 * blk + (p >> 1)) + 8 * (p & 1), a1 = ldsV + voff(4 * hi + q4 + 8, 2 * blk + (p >> 1)) + 8 * (p & 1);
              const unsigned a2 = ldsV + voff(16 + 4 * hi + q4, 2 * blk + (p >> 1)) + 8 * (p & 1), a3 = ldsV + voff(24 + 4 * hi + q4, 2 * blk + (p >> 1)) + 8 * (p & 1);
              const unsigned a4 = ldsV + voff(4 * hi + q4, 4 + 2 * blk + (p >> 1)) + 8 * (p & 1), a5 = ldsV + voff(4 * hi + q4 + 8, 4 + 2 * blk + (p >> 1)) + 8 * (p & 1);
              const unsigned a6 = ldsV + voff(16 + 4 * hi + q4, 4 + 2 * blk + (p >> 1)) + 8 * (p & 1), a7 = ldsV + voff(24 + 4 * hi + q4, 4 + 2 * blk + (p >> 1)) + 8 * (p & 1);
              asm volatile("ds_read_b64_tr_b16 %0, %8\n\tds_read_b64_tr_b16 %1, %9\n\tds_read_b64_tr_b16 %2, %10\n\tds_read_b64_tr_b16 %3, %11\n\t"
                           "ds_read_b64_tr_b16 %4, %12\n\tds_read_b64_tr_b16 %5, %13\n\tds_read_b64_tr_b16 %6, %14\n\tds_read_b64_tr_b16 %7, %15\n\ts_waitcnt lgkmcnt(0)"
                           : "=&v"(vf[0]), "=&v"(vf[1]), "=&v"(vf[2]), "=&v"(vf[3]), "=&v"(vf[4]), "=&v"(vf[5]), "=&v"(vf[6]), "=&v"(vf[7])
                           : "v"(a0), "v"(a1), "v"(a2), "v"(a3), "v"(a4), "v"(a5), "v"(a6), "v"(a7) : "memory"); }
#pragma unroll
            for (int eb = 0; eb < 2; ++eb)
#pragma unroll
                for (int st = 0; st < 2; ++st) acc[eb] = __builtin_amdgcn_mfma_f32_32x32x16_bf16(mk_frag(vf[4 * eb + 2 * st], vf[4 * eb + 2 * st + 1]), pf[st], acc[eb], 0, 0, 0);
            if (__all(carry == 0.f)) break;
        }
#undef ATT_LOAD
#pragma unroll
        for (int eb = 0; eb < 2; ++eb)
#pragma unroll
            for (int g4 = 0; g4 < 4; ++g4) { const u32x2 o = {pk2(acc[eb][4 * g4], acc[eb][4 * g4 + 1]), pk2(acc[eb][4 * g4 + 2], acc[eb][4 * g4 + 3])};
                const unsigned c8 = (unsigned)(8 * eb + 2 * g4 + hi);
                *(LAS u32x2*)(tV + l31 * 128 + ((c8 ^ ((unsigned)(l31 & 7) << 1)) << 3)) = o; }
        asm volatile("s_waitcnt lgkmcnt(0)" ::: "memory");
#pragma unroll
        for (int i = 0; i < 4; ++i) { const int id = lane + 64 * i, rr = id >> 3, q = id & 7;
            const v4u w = *(const LAS v4u*)(tV + rr * 128 + (((unsigned)(2 * q) ^ ((unsigned)(rr & 7) << 1)) << 3));
            *(v4u*)(O + (tokb + qt * 32 + rr) * DM + hd * 64 + 8 * q) = w; }
        asm volatile("s_waitcnt lgkmcnt(0)" ::: "memory");
    }
}

__device__ __forceinline__ void phase_attn_ring(const Ctx& C, const Args& A) {
    const bf16* QV = (const bf16*)(A.ws + WS_BIG); const bf16* KF = (const bf16*)(A.ws + WS_BIG + 64 * MiB); const bf16* VH = (const bf16*)(A.ws + WS_BIG + 128 * MiB); bf16* O = (bf16*)(A.ws + WS_H);
    LAS unsigned char* ring = C.lds;
    LAS unsigned char* tV = C.lds + (C.wave < 4 ? 114688 + C.wave * 4096 : 147456 + (C.wave - 4) * 4096);
    const unsigned ldsR = (unsigned)(uintptr_t)ring, ldsP = (unsigned)(uintptr_t)tV;
    const int lane = C.lane, hi = lane >> 5, l31 = lane & 31;
    const unsigned blk = (lane >> 4) & 1, q4 = (lane & 15) >> 2, p = lane & 3;
    const unsigned trA = voff(4 * hi + q4, 2 * blk + (p >> 1)) + 8 * (p & 1), trB = voff(4 * hi + q4, 4 + 2 * blk + (p >> 1)) + 8 * (p & 1);
    const int nblk = C.G, per = (2048 + nblk - 1) / nblk;
    const int bu_lo = C.bid * per, bu_hi = (bu_lo + per < 2048) ? bu_lo + per : 2048;
    if (bu_lo >= bu_hi) return;
    const int cidx = C.tid & 255; const bool isV = C.tid >= 256;
    const bf16* srcb = (isV ? VH : KF) + cidx * 8;
    const unsigned dstoff = isV ? 4096u + voff((unsigned)cidx >> 3, (unsigned)cidx & 7) : (unsigned)cidx * 16u;
    pg8::bf16x8 qf[4];
    {
        const int bh = bu_lo >> 4, G = bu_lo & 15;
        for (int t = 8 * G - 6; t <= 8 * G + 7; ++t) if (t >= 0) { const v4u w = *(const v4u*)(srcb + (size_t)(bh * 128 + t) * 2048); *(LAS v4u*)(ring + (t % 14) * 8192 + dstoff) = w; }
        const int qt = 8 * G + C.wave; const size_t row = (size_t)(bh >> 4) * SEQ + qt * 32 + l31;
#pragma unroll
        for (int ks = 0; ks < 4; ++ks) qf[ks] = *(const pg8::bf16x8*)(QV + row * 1024 + (bh & 15) * 64 + 16 * ks + 8 * hi);
    }
    __syncthreads();
    for (int bu = bu_lo; bu < bu_hi; ++bu) {
        const int bh = bu >> 4, G = bu & 15, b = bh >> 4, hd = bh & 15;
        const int qt = 8 * G + C.wave;
        const size_t tokb = (size_t)b * SEQ;
        const int l = qt * 32 + l31;
        const bool more = bu + 1 < bu_hi; const int nbh = (bu + 1) >> 4, nG = (bu + 1) & 15;
        v4u st[8]; pg8::bf16x8 qn[4];
        if (more) {
#pragma unroll
            for (int i = 0; i < 8; ++i) st[i] = *(const v4u*)(srcb + (size_t)(nbh * 128 + 8 * nG + i) * 2048);
            const size_t row = (size_t)(nbh >> 4) * SEQ + (8 * nG + C.wave) * 32 + l31;
#pragma unroll
            for (int ks = 0; ks < 4; ++ks) qn[ks] = *(const pg8::bf16x8*)(QV + row * 1024 + (nbh & 15) * 64 + 16 * ks + 8 * hi);
        }
        f32x16 acc[2];
#pragma unroll
        for (int eb = 0; eb < 2; ++eb)
#pragma unroll
            for (int r = 0; r < 16; ++r) acc[eb][r] = 0.f;
        float carry = 1.f;
        const int lowt = (8 * G - 6 > 0) ? 8 * G - 6 : 0;
        int slot = qt % 14;
        for (int kt = qt; kt >= 0; --kt) {
            pg8::bf16x8 kf[4]; unsigned vb;
            if (kt >= lowt) {
                const LAS unsigned char* sp_ = ring + slot * 8192 + lane * 16;
#pragma unroll
                for (int ks = 0; ks < 4; ++ks) kf[ks] = *(const LAS pg8::bf16x8*)(sp_ + ks * 1024);
                vb = ldsR + (unsigned)slot * 8192u + 4096u;
            } else {
                const bf16* kp_ = KF + ((size_t)(bh * 128 + kt) * 2048 + lane * 8);
#pragma unroll
                for (int ks = 0; ks < 4; ++ks) kf[ks] = *(const pg8::bf16x8*)(kp_ + ks * 512);
#pragma unroll
                for (int i = 0; i < 4; ++i) { const int id = lane + 64 * i; const v4u w = *(const v4u*)(VH + ((size_t)bh * 4096 + (size_t)kt * 32) * 64 + id * 8); *(LAS v4u*)(tV + voff(id >> 3, id & 7)) = w; }
                vb = ldsP;
            }
            slot = slot == 0 ? 13 : slot - 1;
            f32x16 X;
#pragma unroll
            for (int r = 0; r < 16; ++r) X[r] = 0.f;
#pragma unroll
            for (int ks = 0; ks < 4; ++ks) X = __builtin_amdgcn_mfma_f32_32x32x16_bf16(kf[ks], qf[ks], X, 0, 0, 0);
            s16x4 vf[8];
            { const unsigned a0 = vb + trA, a4 = vb + trB;
              asm volatile("ds_read_b64_tr_b16 %0, %8\n\tds_read_b64_tr_b16 %1, %8 offset:1024\n\tds_read_b64_tr_b16 %2, %8 offset:2048\n\tds_read_b64_tr_b16 %3, %8 offset:3072\n\t"
                           "ds_read_b64_tr_b16 %4, %9\n\tds_read_b64_tr_b16 %5, %9 offset:1024\n\tds_read_b64_tr_b16 %6, %9 offset:2048\n\tds_read_b64_tr_b16 %7, %9 offset:3072\n\ts_waitcnt lgkmcnt(0)"
                           : "=&v"(vf[0]), "=&v"(vf[1]), "=&v"(vf[2]), "=&v"(vf[3]), "=&v"(vf[4]), "=&v"(vf[5]), "=&v"(vf[6]), "=&v"(vf[7])
                           : "v"(a0), "v"(a4) : "memory"); }
            const int sbase = kt * 32 + 4 * hi;
            float rr[16];
#pragma unroll
            for (int r = 0; r < 16; ++r) rr[r] = __builtin_amdgcn_rcpf(1.f + __builtin_amdgcn_exp2f(X[r]));
            if (kt == qt) {
#pragma unroll
                for (int r = 0; r < 16; ++r) { const int s = sbase + (r & 3) + 8 * (r >> 2); rr[r] = (s < l) ? rr[r] : 1.f; }
            }
            float To[4], Tp[4];
#pragma unroll
            for (int g = 0; g < 4; ++g) { To[g] = (rr[4 * g] * rr[4 * g + 1]) * (rr[4 * g + 2] * rr[4 * g + 3]); Tp[g] = __shfl_xor(To[g], 32); }
            float base[4]; float run = 1.f;
#pragma unroll
            for (int g = 3; g >= 0; --g) { base[g] = carry * run * (hi == 0 ? Tp[g] : 1.f); run *= To[g] * Tp[g]; }
            float att[16];
#pragma unroll
            for (int g = 0; g < 4; ++g) { float w = base[g];
#pragma unroll
                for (int i = 3; i >= 0; --i) { const int r = 4 * g + i; att[r] = (1.f - rr[r]) * w; w *= rr[r]; } }
            carry *= run;
            pg8::bf16x8 pf[2];
#pragma unroll
            for (int st_ = 0; st_ < 2; ++st_) { v4u t; t.x = pg8::cvt_pk_bf16(att[8 * st_], att[8 * st_ + 1]); t.y = pg8::cvt_pk_bf16(att[8 * st_ + 2], att[8 * st_ + 3]); t.z = pg8::cvt_pk_bf16(att[8 * st_ + 4], att[8 * st_ + 5]); t.w = pg8::cvt_pk_bf16(att[8 * st_ + 6], att[8 * st_ + 7]);
                pf[st_] = __builtin_bit_cast(pg8::bf16x8, t); }
#pragma unroll
            for (int eb = 0; eb < 2; ++eb)
#pragma unroll
                for (int st_ = 0; st_ < 2; ++st_) acc[eb] = __builtin_amdgcn_mfma_f32_32x32x16_bf16(mk_frag(vf[4 * eb + 2 * st_], vf[4 * eb + 2 * st_ + 1]), pf[st_], acc[eb], 0, 0, 0);
            if (__all(carry == 0.f)) break;
        }
#pragma unroll
        for (int eb = 0; eb < 2; ++eb)
#pragma unroll
            for (int g4 = 0; g4 < 4; ++g4) { const u32x2 o = {pk2(acc[eb][4 * g4], acc[eb][4 * g4 + 1]), pk2(acc[eb][4 * g4 + 2], acc[eb][4 * g4 + 3])};
                const unsigned c8 = (unsigned)(8 * eb + 2 * g4 + hi);
                *(LAS u32x2*)(tV + l31 * 128 + ((c8 ^ ((unsigned)(l31 & 7) << 1)) << 3)) = o; }
        asm volatile("s_waitcnt lgkmcnt(0)" ::: "memory");
#pragma unroll
        for (int i = 0; i < 4; ++i) { const int id = lane + 64 * i, rr_ = id >> 3, q = id & 7;
            const v4u w = *(const LAS v4u*)(tV + rr_ * 128 + (((unsigned)(2 * q) ^ ((unsigned)(rr_ & 7) << 1)) << 3));
            *(v4u*)(O + (tokb + qt * 32 + rr_) * DM + hd * 64 + 8 * q) = w; }
        __syncthreads();
        if (more) {
#pragma unroll
            for (int i = 0; i < 8; ++i) *(LAS v4u*)(ring + ((8 * nG + i) % 14) * 8192 + dstoff) = st[i];
#pragma unroll
            for (int ks = 0; ks < 4; ++ks) qf[ks] = qn[ks];
        }
        __syncthreads();
    }
}
constexpr int N_PHASES = 16;
#ifndef MK_ONE_LAUNCH
#define MK_ONE_LAUNCH 1
#endif

__global__ void __launch_bounds__(NWAVES * 64, 2) mk_fwd(Args args) {
    extern __shared__ __attribute__((aligned(16))) unsigned char lds_raw[];
    Ctx C;
    C.lds = (LAS unsigned char*)lds_raw;
    C.tid = threadIdx.x; C.lane = C.tid & 63; C.wave = __builtin_amdgcn_readfirstlane(C.tid >> 6);
    C.G = gridDim.x; C.bid = blockIdx.x;
    C.gw = C.bid * NWAVES + C.wave; C.NGW = C.G * NWAVES;
    C.gt = (long)C.bid * (NWAVES * 64) + C.tid; C.NGT = (long)C.G * (NWAVES * 64);
    unsigned char* ws = args.ws;
    volatile LAS unsigned* MISC = (volatile LAS unsigned*)(C.lds + MISC_OFF);
    for (int u = C.tid; u < (LDS_BYTES - LDSCTL_OFF) / 4; u += NWAVES * 64) ((LAS unsigned*)(C.lds + LDSCTL_OFF))[u] = 0u;
    __syncthreads();
#if MK_ONE_LAUNCH
    XcdBarrier bar = xcd_barrier_post((unsigned*)((gu32*)(ws + WS_CTL) + CW_BAR), MISC + 8);
#ifdef PROBE_DBLBAR
#define GRID_BAR() do { xcd_barrier(bar); xcd_barrier(bar); } while (0)
#else
#define GRID_BAR() xcd_barrier(bar)
#endif
#else
    (void)MISC; XcdBarrier bar; bar.bar = nullptr; bar.x = 0; bar.st = nullptr;
#define GRID_BAR() do {} while (0)
#endif
    const int lo = args.ph_lo, hi = args.ph_hi;
#define IN(k) (lo <= (k) && (k) < hi)
#ifndef PROBE_MASK
#define PROBE_MASK 0
#endif
#define PROBE_T0(k) unsigned long long pt0_ = 0; if ((PROBE_MASK >> (k)) & 1) pt0_ = __builtin_amdgcn_s_memrealtime();
#define PROBE_T1(k) if ((PROBE_MASK >> (k)) & 1) { const unsigned long long t1_ = __builtin_amdgcn_s_memrealtime(); const unsigned long long d_ = t1_ - pt0_; while (__builtin_amdgcn_s_memrealtime() - t1_ < d_) __builtin_amdgcn_s_sleep(8); }
#define SEAM(k) do { if (IN(k) && IN((k) + 1)) GRID_BAR(); } while (0)
    float* mod0 = (float*)(ws + WS_MOD); float* mod1 = mod0 + (size_t)NB * 6144;
    bf16* Hb = (bf16*)(ws + WS_H); bf16* BIG = (bf16*)(ws + WS_BIG); bf16* XB = (bf16*)(ws + WS_XB);

    const unsigned char* TAB = ws + WS_TAB; const float* TSC = (const float*)(ws + WS_TSC);
#ifdef PROBE_INSTR
    {
        unsigned xs[16]; float fs[16];
#pragma unroll
        for (int i = 0; i < 16; ++i) { xs[i] = (unsigned)(C.tid * 2654435761u + i * 40503u); fs[i] = (float)(C.tid * 7 + i) * 0.37f; }
#pragma unroll 1
        for (int it = 0; it < 4096; ++it) {
#pragma unroll
            for (int rep = 0; rep < 2; ++rep) {
#pragma unroll
                for (int i = 0; i < 16; i += 2) {
#if PROBE_INSTR == 10
                    { const unsigned a = xs[i], b = xs[i + 1]; xs[i] = a < b ? b : a; xs[i + 1] = (a < b ? a : b) + (unsigned)it; }
#elif PROBE_INSTR == 11
                    { const float a = fs[i], b = fs[i + 1]; fs[i] = fmaxf(a, b); fs[i + 1] = fminf(a, b) + 1.0f; }
#elif PROBE_INSTR == 12
                    { const unsigned a = xs[i], b = xs[i + 1]; xs[i] = a + b; xs[i + 1] = (a ^ b) + (unsigned)it; }
#endif
                }
            }
        }
        float sm = 0.f;
#pragma unroll
        for (int i = 0; i < 16; ++i) sm += fs[i] + __uint_as_float(xs[i] & 0x3fffffffu);
        if (sm == 1234.5678f) args.out[C.tid] = sm;
    }
#endif
    if (IN(0)) { PROBE_T0(0) { phase_prep(C, args); convert_tables_int8(C, args); } PROBE_T1(0) } SEAM(0);
    bf16* H8B = (bf16*)(ws + WS_IDS);
    unsigned char* W8 = (unsigned char*)args.out; float* SW = (float*)((unsigned char*)args.out + OUT_SW); float* SA = (float*)(ws + WS_SA);
    if (IN(1)) { PROBE_T0(1) { phase_rowpass<true, false, true>(C, args, args.in[0], args.in[4], mod0, 0, 1, Hb, SA);
        quantize_rows(C, (const bf16*)(ws + WS_WIN), INP, W8 + OUT_W8IN, SW + SW_IN);
        quantize_rows(C, (const bf16*)(ws + WS_WC0), 2048, W8 + OUT_W8C0, SW + SW_C0); quantize_rows(C, (const bf16*)(ws + WS_WC1), 2048, W8 + OUT_W8C1, SW + SW_C1);
        quantize_rows(C, (const bf16*)(ws + WS_WQKV), 3072, W8 + OUT_W8QKV, SW + SW_QKV); } PROBE_T1(1) } SEAM(1);
    if (IN(2)) { PROBE_T0(2) { pg8::Gemm g{Hb, (const bf16*)(W8 + OUT_W8IN), NTOK, INP, DM / 2}; pg8::StaticOrder S; S.init(NTOK, INP, C.G, C.bid);
        EpiBf16I8 E{BIG, INP, SA, SW + SW_IN};
        pg8::gemm_phase<EpiBf16I8, pg8::StaticOrder, true, true, true>(C.lds, g, S, E); } PROBE_T1(2) } SEAM(2);
    if (IN(3)) { PROBE_T0(3) { phase_mlstm_local(C, args); phase_conv(C, args); } PROBE_T1(3) } SEAM(3);
    if (IN(4)) { PROBE_T0(4) { phase_mlstm_scan(C, args); } PROBE_T1(4) } SEAM(4);
    if (IN(5)) { PROBE_T0(5) { phase_mlstm_out(C, args); } PROBE_T1(5) } SEAM(5);
    if (IN(6)) { PROBE_T0(6) { pg8::Gemm g{Hb, (const bf16*)(ws + WS_WOUT0), NTOK, DM, DM}; pg8::StaticOrder S; S.init(NTOK, DM, C.G, C.bid);
        EpiResid<false> E{args.in[0], XB, mod0 + 2 * 1024};
        pg8::gemm_phase<EpiResid<false>, pg8::StaticOrder, true, true>(C.lds, g, S, E); } PROBE_T1(6) } SEAM(6);
    if (IN(7)) { PROBE_T0(7) { phase_rowpass<false, true, true>(C, args, XB, args.in[11], mod0, 3, 4, H8B, SA); } PROBE_T1(7) } SEAM(7);
    if (IN(8)) { PROBE_T0(8) { pg8::Gemm g{H8B, (const bf16*)(W8 + OUT_W8C0), NTOK, 2048, DM / 2}; pg8::StaticOrder S; S.init(NTOK, 2048, C.G, C.bid);
        EpiBf16I8 E{BIG, 2048, SA, SW + SW_C0};
        pg8::gemm_phase<EpiBf16I8, pg8::StaticOrder, true, true, true>(C.lds, g, S, E); } PROBE_T1(8) } SEAM(8);
    if (IN(9)) { PROBE_T0(9) { phase_peer<true>(C, args, TAB, TAB + TAB_BYTES, TSC, TSC + 16384, mod0 + 5 * 1024, args.in[19], mod1, bar); } PROBE_T1(9) } SEAM(9);
    if (IN(10)) { PROBE_T0(10) { pg8::Gemm g{H8B, (const bf16*)(W8 + OUT_W8QKV), NTOK, 3072, DM / 2}; pg8::StaticOrder S; S.init(NTOK, 3072, C.G, C.bid);
        EpiQKV<true> E{BIG, (bf16*)(ws + WS_BIG + 64 * MiB), (bf16*)(ws + WS_BIG + 128 * MiB), args.in[21], args.in[22], SA, SW + SW_QKV};
        pg8::gemm_phase<EpiQKV<true>, pg8::StaticOrder, true, true, true>(C.lds, g, S, E); } PROBE_T1(10) } SEAM(10);
    if (IN(11)) { PROBE_T0(11) { phase_attn_ring(C, args); } PROBE_T1(11) } SEAM(11);
    if (IN(12)) { PROBE_T0(12) { pg8::Gemm g{Hb, (const bf16*)(ws + WS_WOUT1), NTOK, DM, DM}; pg8::StaticOrder S; S.init(NTOK, DM, C.G, C.bid);
        EpiResid<true> E{XB, XB, mod1 + 2 * 1024};
        pg8::gemm_phase<EpiResid<true>, pg8::StaticOrder, true, true>(C.lds, g, S, E); } PROBE_T1(12) } SEAM(12);
    if (IN(13)) { PROBE_T0(13) { phase_rowpass<false, true, true>(C, args, XB, args.in[24], mod1, 3, 4, H8B, SA); } PROBE_T1(13) } SEAM(13);
    if (IN(14)) { PROBE_T0(14) { pg8::Gemm g{H8B, (const bf16*)(W8 + OUT_W8C1), NTOK, 2048, DM / 2}; pg8::StaticOrder S; S.init(NTOK, 2048, C.G, C.bid);
        EpiBf16I8 E{BIG, 2048, SA, SW + SW_C1};
        pg8::gemm_phase<EpiBf16I8, pg8::StaticOrder, true, true, true>(C.lds, g, S, E); } PROBE_T1(14) } SEAM(14);
#ifdef PROBE_DRY
    if (IN(15)) { phase_peer<false, PROBE_DRY>(C, args, TAB + 2 * TAB_BYTES, TAB + 3 * TAB_BYTES, TSC + 2 * 16384, TSC + 3 * 16384, mod1 + 5 * 1024, nullptr, nullptr, bar); GRID_BAR(); }
#endif
    if (IN(15)) { PROBE_T0(15) { phase_peer<false>(C, args, TAB + 2 * TAB_BYTES, TAB + 3 * TAB_BYTES, TSC + 2 * 16384, TSC + 3 * 16384, mod1 + 5 * 1024, nullptr, nullptr, bar); } PROBE_T1(15) }
#undef IN
#undef SEAM
}

extern "C" void kernel_launch(void* const* d_in, const int* in_sizes, int n_in, void* d_out, int out_size, void* d_ws, size_t ws_size, hipStream_t stream) {
    static int grid = 0;
    if (grid == 0) {
        if (n_in != 30 || out_size != NTOK * DM || ws_size < WS_END2) { fprintf(stderr, "kernel_launch: unexpected shapes (n_in %d out %d ws %zu)\n", n_in, out_size, ws_size); grid = -1; return; }
        int dev = 0, cus = 0;
        if (hipGetDevice(&dev) != hipSuccess || hipDeviceGetAttribute(&cus, hipDeviceAttributeMultiprocessorCount, dev) != hipSuccess) { grid = -1; return; }
        if (hipFuncSetAttribute((const void*)mk_fwd, hipFuncAttributeMaxDynamicSharedMemorySize, LDS_BYTES) != hipSuccess) { fprintf(stderr, "kernel_launch: hipFuncSetAttribute failed\n"); grid = -1; return; }
        int per_cu = 0;
        if (hipOccupancyMaxActiveBlocksPerMultiprocessor(&per_cu, (const void*)mk_fwd, NWAVES * 64, LDS_BYTES) != hipSuccess || per_cu < 1) fprintf(stderr, "kernel_launch: occupancy query reports %d\n", per_cu);
        (void)hipGetLastError();
        grid = cus;
    }
    if (grid < 0) return;
    (void)hipMemsetAsync((char*)d_ws + WS_CTL + CW_BAR * 4, 0, XCD_BAR_WORDS * 4, stream);
    Args a{};
    for (int i = 0; i < 30; ++i) a.in[i] = (const float*)d_in[i];
    a.out = (float*)d_out; a.ws = (unsigned char*)d_ws;
#if MK_ONE_LAUNCH
    a.ph_lo = 0; a.ph_hi = N_PHASES;
    hipLaunchKernelGGL(mk_fwd, dim3(grid), dim3(NWAVES * 64), LDS_BYTES, stream, a);
#else
    for (int p = 0; p < N_PHASES; ++p) { a.ph_lo = p; a.ph_hi = p + 1; hipLaunchKernelGGL(mk_fwd, dim3(grid), dim3(NWAVES * 64), LDS_BYTES, stream, a); }
#endif
}
```

```cpp
#include <hip/hip_runtime.h>
#include <cstdio>
#include <cstdint>
#include <cmath>
#define PROBE_MASK 0
namespace pg8 {
#define PG8_LAS __attribute__((address_space(3)))
typedef unsigned short bf16_t;
typedef short bf16x8 __attribute__((ext_vector_type(8)));
typedef float f32x4 __attribute__((ext_vector_type(4)));
typedef unsigned u32x4 __attribute__((ext_vector_type(4)));
constexpr int BM = 256, BK = 64, HALF = 128, HTB = HALF * BK * 2  , STAGE_BYTES = 8 * HTB, NXCD = 8, WGM = 8;

__host__ __device__ __forceinline__ int lds_byte(int r, int c) { const int st = (r >> 4) * 2 + (c >> 5), rr = r & 15, cc = c & 31, ob = rr * 64 + cc * 2; return st * 1024 + (ob ^ (((ob >> 9) & 1) << 5)); }
__host__ __device__ __forceinline__ void stage_rc(int b, int& R, int& C) { const int st = b / 1024, sb = b % 1024, swz = sb ^ (((sb >> 9) & 1) << 5); R = (st >> 1) * 16 + swz / 64; C = (st & 1) * 32 + (swz % 64) / 2; }
__host__ __device__ __forceinline__ int perm32(int rho) { const int n = rho >> 4, i = rho & 15; return 8 * (i >> 2) + 4 * n + (i & 3); }

struct Unit { int pm, pn; };
struct Gemm { const bf16_t* A; const bf16_t* Bt; int M, N, K; };

struct StaticOrder {
    int nM, nN, nwg, G, c;
    __host__ __device__ void init(int M, int N, int G_, int c_) { nM = M / BM; nN = N / BM; nwg = nM * nN; G = G_; c = c_; }
    __host__ __device__ bool next(int i, Unit& u) const {
        const long L = (long)i * G + c; if (L >= nwg) return false;
        int wgid = (int)L; { const int q = nwg / NXCD, r = nwg % NXCD, xcd = wgid % NXCD, off = wgid / NXCD; wgid = (xcd < r ? xcd * (q + 1) : r * (q + 1) + (xcd - r) * q) + off; }
        const int nig = WGM * nN, gid = wgid / nig, fm = gid * WGM, gsz = (nM - fm) < WGM ? (nM - fm) : WGM;
        u.pm = fm + ((wgid % nig) % gsz); u.pn = (wgid % nig) / gsz; return true;
    }
    __device__ __forceinline__ void a_ready(const Unit&) const {}
    __device__ __forceinline__ void done(const Unit&) const {}
};

__device__ __forceinline__ unsigned cvt_pk_bf16(float lo, float hi) { unsigned r; asm volatile("v_cvt_pk_bf16_f32 %0, %1, %2" : "=v"(r) : "v"(lo), "v"(hi)); return r; }
typedef float f32x2 __attribute__((ext_vector_type(2)));
__device__ __forceinline__ f32x2 gelu_pk(f32x2 v) {
    const f32x2 av = __builtin_elementwise_abs(v), d = av * 0.2316418882f + 1.0f;
    f32x2 t; t.x = __builtin_amdgcn_rcpf(d.x); t.y = __builtin_amdgcn_rcpf(d.y);
    f32x2 q = t * 0.5307027145f + (-0.7265760135f); q = q * t + 0.7107068705f; q = q * t + (-0.142248368f); q = q * t + 0.127414796f; q = q * t;
    const f32x2 s = (v * v) * (-0.72134752044f);
    f32x2 e; e.x = __builtin_amdgcn_exp2f(s.x); e.y = __builtin_amdgcn_exp2f(s.y);
    const f32x2 m = v * (q * e), r = v - m;
    f32x2 o; o.x = v.x < 0.f ? m.x : r.x; o.y = v.y < 0.f ? m.y : r.y; return o;
}

template <int ACT  > struct EpiBf16 {
    static constexpr bool PERM = true, AFTER_DRAIN = false; static_assert(ACT == 0 || ACT == 1, "EpiBf16: ACT is 0 (none) or 1 (gelu_pk)");
    bf16_t* O; int ldc; const float* bias; int split_cols; size_t split_stride; float scale0;
    __device__ __forceinline__ void operator()(const f32x4 (&acc)[2][2][4][2], const Unit& u, int wr, int wc, int fr, int fq) const {
        const int row0 = u.pm * BM + wr * 64 + fr; int colt = u.pn * BM; bf16_t* base = O;
        float sc = 1.f; if (split_cols) { const int t = colt / split_cols; base += (size_t)t * split_stride; colt -= t * split_cols; if (t == 0) sc = scale0; }
        const int col0 = colt + wc * 32 + 8 * fq, bcol0 = u.pn * BM + wc * 32 + 8 * fq;
        f32x4 bv[2][2];
#pragma unroll
        for (int bj = 0; bj < 2; ++bj)
#pragma unroll
            for (int n = 0; n < 2; ++n) bv[bj][n] = bias ? *(const f32x4*)(bias + bcol0 + bj * HALF + 4 * n) : (f32x4){0.f, 0.f, 0.f, 0.f};
#pragma unroll
        for (int ai = 0; ai < 2; ++ai)
#pragma unroll
            for (int m = 0; m < 4; ++m) { bf16_t* rowp = base + (size_t)(row0 + ai * HALF + m * 16) * ldc + col0;
#pragma unroll
                for (int bj = 0; bj < 2; ++bj) { f32x4 v0 = acc[ai][bj][m][0] + bv[bj][0], v1 = acc[ai][bj][m][1] + bv[bj][1];
                    if (ACT == 1) { f32x2 a = gelu_pk((f32x2){v0[0], v0[1]}), b = gelu_pk((f32x2){v0[2], v0[3]}), c = gelu_pk((f32x2){v1[0], v1[1]}), d = gelu_pk((f32x2){v1[2], v1[3]});
                        v0 = (f32x4){a.x, a.y, b.x, b.y}; v1 = (f32x4){c.x, c.y, d.x, d.y}; }
                    v0 = v0 * sc; v1 = v1 * sc; u32x4 w; w.x = cvt_pk_bf16(v0[0], v0[1]); w.y = cvt_pk_bf16(v0[2], v0[3]); w.z = cvt_pk_bf16(v1[0], v1[1]); w.w = cvt_pk_bf16(v1[2], v1[3]);
                    *(u32x4*)(rowp + bj * HALF) = w; } }
    }
};
typedef int i32x4 __attribute__((ext_vector_type(4)));
template <bool I8> struct AccSel { typedef f32x4 type; };
template <> struct AccSel<true> { typedef i32x4 type; };
template <class Epi, class Sched, bool ALIGN_EPI = false, bool SP2 = false, bool I8 = false>
__device__ __forceinline__ void gemm_phase(PG8_LAS unsigned char* lds, const Gemm g, const Sched& S, const Epi& E) {
    const int tid = threadIdx.x, wid = __builtin_amdgcn_readfirstlane(tid >> 6), lane = tid & 63, wr = wid >> 2, wc = wid & 3, fr = lane & 15, fq = lane >> 4;
    const int K = g.K, nt = K / BK;
    unsigned voffA[2], voffB[2];
#pragma unroll
    for (int i = 0; i < 2; ++i) { int R, C; stage_rc(tid * 16 + i * 8192, R, C); const int Rb = Epi::PERM ? ((R & ~31) + perm32(R & 31)) : R;
        voffA[i] = (unsigned)(R * K + C) * 2u; voffB[i] = (unsigned)(Rb * K + C) * 2u; }
    const size_t kstep = (size_t)(BK * 2);
    const size_t hstep = (size_t)HALF * K * 2;
    const size_t tstep = 2 * hstep;
    const unsigned ldsw = (unsigned)wid * 1024u;
    const int aoff = lds_byte(wr * 64 + fr, fq * 8), boff = lds_byte(wc * 32 + fr, fq * 8);
#define PG8_SA(b, h) (((b) * 2 + (h)) * HTB)
#define PG8_SB(b, h) ((4 + (b) * 2 + (h)) * HTB)
#define PG8_STAGE(bufoff, gbase, voff) do { _Pragma("unroll") for (int _i = 0; _i < 2; ++_i) \
        __builtin_amdgcn_global_load_lds((const unsigned*)((const char*)(gbase) + (voff)[_i]), (PG8_LAS unsigned*)(lds + (bufoff) + ldsw + _i * 8192), 16, 0, 0); } while (0)
#define PG8_LDA(dst, b, h) do { _Pragma("unroll") for (int m = 0; m < 4; ++m) _Pragma("unroll") for (int k = 0; k < 2; ++k) dst[m][k] = *(const PG8_LAS bf16x8*)(lds + PG8_SA(b, h) + aoff + m * 2048 + k * 1024); } while (0)
#define PG8_LDB(dst, b, h) do { _Pragma("unroll") for (int n = 0; n < 2; ++n) _Pragma("unroll") for (int k = 0; k < 2; ++k) dst[n][k] = *(const PG8_LAS bf16x8*)(lds + PG8_SB(b, h) + boff + n * 2048 + k * 1024); } while (0)
#define PG8_MMA(ai, bj, At, Bt) do { __builtin_amdgcn_s_setprio(1); _Pragma("unroll") for (int m = 0; m < 4; ++m) _Pragma("unroll") for (int n = 0; n < 2; ++n) _Pragma("unroll") for (int k = 0; k < 2; ++k) \
        { if constexpr (I8) acc[ai][bj][m][n] = __builtin_bit_cast(acc_t, __builtin_amdgcn_mfma_i32_16x16x64_i8(__builtin_bit_cast(i32x4, Bt[n][k]), __builtin_bit_cast(i32x4, At[m][k]), __builtin_bit_cast(i32x4, acc[ai][bj][m][n]), 0, 0, 0)); \
          else acc[ai][bj][m][n] = __builtin_bit_cast(acc_t, __builtin_amdgcn_mfma_f32_16x16x32_bf16(Bt[n][k], At[m][k], __builtin_bit_cast(f32x4, acc[ai][bj][m][n]), 0, 0, 0)); } __builtin_amdgcn_s_setprio(0); } while (0)
#define PG8_WAIT_V(n) asm volatile("s_waitcnt vmcnt(" #n ")" ::: "memory")
#define PG8_WAIT_L(n) asm volatile("s_waitcnt lgkmcnt(" #n ")" ::: "memory")
#define PG8_BAR __builtin_amdgcn_s_barrier()
#define PG8_SCHED __builtin_amdgcn_sched_barrier(0)
    Unit cur, nxt; int ui = 0;
    if (!S.next(0, cur)) return;
    typedef typename AccSel<I8>::type acc_t; const acc_t acc_zero = {};
    acc_t acc[2][2][4][2];
#pragma unroll
    for (int a = 0; a < 2; ++a)
#pragma unroll
        for (int b = 0; b < 2; ++b)
#pragma unroll
            for (int m = 0; m < 4; ++m)
#pragma unroll
                for (int n = 0; n < 2; ++n) acc[a][b][m][n] = acc_zero;
    bf16x8 At[4][2], B0[2][2], B1[2][2];
    const char* cA = (const char*)g.A + (size_t)cur.pm * tstep; const char* cB = (const char*)g.Bt + (size_t)cur.pn * tstep;
    S.a_ready(cur);
    if constexpr (SP2) {
        PG8_STAGE(PG8_SB(0, 0), cB, voffB); PG8_STAGE(PG8_SB(0, 1), cB + hstep, voffB); PG8_STAGE(PG8_SA(0, 0), cA, voffA); PG8_STAGE(PG8_SA(0, 1), cA + hstep, voffA);
        if (wr == 1) PG8_BAR;
        PG8_WAIT_V(2); PG8_BAR;
        PG8_STAGE(PG8_SB(1, 0), cB + kstep, voffB); PG8_STAGE(PG8_SA(1, 0), cA + kstep, voffA); PG8_STAGE(PG8_SB(1, 1), cB + hstep + kstep, voffB);
        PG8_WAIT_V(6); PG8_BAR;
    } else {
        PG8_STAGE(PG8_SB(0, 0), cB, voffB); PG8_STAGE(PG8_SA(0, 0), cA, voffA); PG8_STAGE(PG8_SB(0, 1), cB + hstep, voffB); PG8_STAGE(PG8_SA(0, 1), cA + hstep, voffA);
        if (wr == 1) PG8_BAR;
        PG8_WAIT_V(4); PG8_BAR;
        PG8_STAGE(PG8_SB(1, 0), cB + kstep, voffB); PG8_STAGE(PG8_SA(1, 0), cA + kstep, voffA); PG8_STAGE(PG8_SB(1, 1), cB + hstep + kstep, voffB);
        PG8_WAIT_V(6); PG8_BAR;
    }
    for (;;) {
        const bool has_next = S.next(ui + 1, nxt);
        const char* nA = has_next ? (const char*)g.A + (size_t)nxt.pm * tstep : cA; const char* nB = has_next ? (const char*)g.Bt + (size_t)nxt.pn * tstep : cB;
        for (int t = 0; t < nt; t += 2) {
            const bool last = (t == nt - 2);
            const char* a1 = cA + (size_t)(t + 1) * kstep;
            const char* a2 = last ? nA : cA + (size_t)(t + 2) * kstep; const char* b2 = last ? nB : cB + (size_t)(t + 2) * kstep;
            const char* a3 = a2 + kstep; const char* b3 = b2 + kstep;
            if (last && has_next) S.a_ready(nxt);
            if constexpr (SP2) {
            PG8_LDB(B0, 0, 0); PG8_LDB(B1, 0, 1); PG8_SCHED; PG8_LDA(At, 0, 0); PG8_STAGE(PG8_SA(1, 1), a1 + hstep, voffA);
            PG8_WAIT_V(8); PG8_WAIT_L(0); PG8_BAR; PG8_MMA(0, 0, At, B0); PG8_MMA(0, 1, At, B1); PG8_BAR; PG8_SCHED;
            PG8_LDA(At, 0, 1); PG8_STAGE(PG8_SB(0, 0), b2, voffB); PG8_STAGE(PG8_SB(0, 1), b2 + hstep, voffB); PG8_STAGE(PG8_SA(0, 0), a2, voffA);
            PG8_WAIT_V(8); PG8_WAIT_L(0); PG8_BAR; PG8_MMA(1, 0, At, B0); PG8_MMA(1, 1, At, B1); PG8_BAR; PG8_SCHED;
            PG8_LDB(B0, 1, 0); PG8_LDB(B1, 1, 1); PG8_SCHED; PG8_LDA(At, 1, 0); PG8_STAGE(PG8_SA(0, 1), a2 + hstep, voffA);
            PG8_WAIT_V(8); PG8_WAIT_L(0); PG8_BAR; PG8_MMA(0, 0, At, B0); PG8_MMA(0, 1, At, B1); PG8_BAR; PG8_SCHED;
            PG8_LDA(At, 1, 1); PG8_STAGE(PG8_SB(1, 0), b3, voffB); PG8_STAGE(PG8_SB(1, 1), b3 + hstep, voffB); PG8_STAGE(PG8_SA(1, 0), a3, voffA);
            PG8_WAIT_V(8); PG8_WAIT_L(0); PG8_BAR; PG8_MMA(1, 0, At, B0); PG8_MMA(1, 1, At, B1); PG8_BAR; PG8_SCHED;
            } else {
            PG8_LDB(B0, 0, 0); PG8_SCHED; PG8_LDA(At, 0, 0); PG8_STAGE(PG8_SA(1, 1), a1 + hstep, voffA);
            PG8_WAIT_L(8); PG8_BAR; PG8_WAIT_L(0); PG8_MMA(0, 0, At, B0); PG8_BAR; PG8_SCHED;
            PG8_LDB(B1, 0, 1); PG8_STAGE(PG8_SB(0, 0), b2, voffB);
            PG8_BAR; PG8_WAIT_L(0); PG8_MMA(0, 1, At, B1); PG8_BAR;
            PG8_LDA(At, 0, 1); PG8_STAGE(PG8_SA(0, 0), a2, voffA);
            PG8_BAR; PG8_WAIT_L(0); PG8_MMA(1, 0, At, B0); PG8_BAR; PG8_SCHED;
            PG8_STAGE(PG8_SB(0, 1), b2 + hstep, voffB);
            PG8_WAIT_V(6); PG8_BAR; PG8_MMA(1, 1, At, B1); PG8_BAR;
            PG8_LDB(B0, 1, 0); PG8_SCHED; PG8_LDA(At, 1, 0); PG8_STAGE(PG8_SA(0, 1), a2 + hstep, voffA);
            PG8_WAIT_L(8); PG8_BAR; PG8_WAIT_L(0); PG8_MMA(0, 0, At, B0); PG8_BAR; PG8_SCHED;
            PG8_LDB(B1, 1, 1); PG8_STAGE(PG8_SB(1, 0), b3, voffB);
            PG8_BAR; PG8_WAIT_L(0); PG8_MMA(0, 1, At, B1); PG8_BAR;
            PG8_LDA(At, 1, 1); PG8_STAGE(PG8_SA(1, 0), a3, voffA);
            PG8_BAR; PG8_WAIT_L(0); PG8_MMA(1, 0, At, B0); PG8_BAR; PG8_SCHED;
            PG8_STAGE(PG8_SB(1, 1), b3 + hstep, voffB);
            PG8_WAIT_V(6); PG8_BAR; PG8_MMA(1, 1, At, B1); PG8_BAR;
            }
        }
        if constexpr (ALIGN_EPI) { if (wr == 0) PG8_BAR; }
        if constexpr (!Epi::AFTER_DRAIN) { E(acc, cur, wr, wc, fr, fq); S.done(cur); }
        if (!has_next) break;
#pragma unroll
        for (int a = 0; a < 2; ++a)
#pragma unroll
            for (int b = 0; b < 2; ++b)
#pragma unroll
                for (int m = 0; m < 4; ++m)
#pragma unroll
                    for (int n = 0; n < 2; ++n) acc[a][b][m][n] = acc_zero;
        cur = nxt; cA = nA; cB = nB; ++ui;
        if constexpr (ALIGN_EPI) { if (wr == 1) PG8_BAR; }
    }
    PG8_WAIT_V(0);
    if constexpr (!ALIGN_EPI) { if (wr == 0) PG8_BAR; }
    PG8_BAR;
    if constexpr (Epi::AFTER_DRAIN) { E.fused(acc, cur, wr, wc, fr, fq, lds, wid, lane); S.done(cur); }
#undef PG8_SA
#undef PG8_SB
#undef PG8_STAGE
#undef PG8_LDA
#undef PG8_LDB
#undef PG8_MMA
#undef PG8_WAIT_V
#undef PG8_WAIT_L
#undef PG8_BAR
#undef PG8_SCHED
}
}
#define GAS __attribute__((address_space(1)))
#define LAS __attribute__((address_space(3)))
typedef unsigned short bf16;
typedef unsigned v4u __attribute__((ext_vector_type(4)));
typedef float f32x4 __attribute__((ext_vector_type(4)));
typedef short bf16x8 __attribute__((ext_vector_type(8)));
typedef GAS unsigned gu32;
typedef GAS unsigned long long gu64;
#define RLX_AGENT __ATOMIC_RELAXED, __HIP_MEMORY_SCOPE_AGENT
#define LDS_WAIT() asm volatile("s_waitcnt lgkmcnt(0)" ::: "memory")
#define VM_WAIT() asm volatile("s_waitcnt vmcnt(0)" ::: "memory")
__device__ __forceinline__ unsigned long long rt() { return __builtin_amdgcn_s_memrealtime(); }
__device__ __forceinline__ unsigned f2bf(float f) { unsigned u = __builtin_bit_cast(unsigned, f); return (u + 0x7fffu + ((u >> 16) & 1u)) >> 16; }
typedef float pk2_f32x2 __attribute__((ext_vector_type(2))); typedef __bf16 pk2_bf16x2 __attribute__((ext_vector_type(2)));
__device__ __forceinline__ unsigned pk2(float lo, float hi) { const pk2_f32x2 v = {lo, hi}; return __builtin_bit_cast(unsigned, __builtin_convertvector(v, pk2_bf16x2)); }

#define XB_TMO      128
#define XB_XCNT(j)  (256  + 64 * (j))
#define XB_XSUB(j)  (1280 + 64 * (j))
#define XB_XGEN(j)  (2304 + 64 * (j))
#define XB_TOP      3328
#define XB_TOPGEN   3392
#define XCD_BAR_WORDS 3456
#define XB_SPIN_CAP (1u << 18)

__device__ __forceinline__ unsigned xb_ld(unsigned* p)              { return __hip_atomic_load(p, __ATOMIC_RELAXED, __HIP_MEMORY_SCOPE_AGENT); }
__device__ __forceinline__ unsigned xb_add(unsigned* p, unsigned v) { return __hip_atomic_fetch_add(p, v, __ATOMIC_RELAXED, __HIP_MEMORY_SCOPE_AGENT); }
__device__ __forceinline__ unsigned xb_xcc_id() { return (unsigned)__builtin_amdgcn_s_getreg((3 << 11) | 20) & 0xFu; }
#define XB_SPIN(cond, bar) do { unsigned _sp = 0; while (cond) { __builtin_amdgcn_s_sleep(1); \
    if ((++_sp & 255u) == 0u) { if (xb_ld(&(bar)[XB_TMO])) break; if (_sp > XB_SPIN_CAP) { atomicAdd(&(bar)[XB_TMO], 1u); break; } } } } while (0)

struct XcdBarrier {
    unsigned* bar; unsigned x;
    volatile LAS unsigned* st;
};

__device__ __forceinline__ XcdBarrier xcd_barrier_post(unsigned* bar, volatile LAS unsigned* st) {
    XcdBarrier b; b.bar = bar; b.x = xb_xcc_id(); b.st = st;
    if (threadIdx.x == 0) (void)xb_add(&bar[XB_XCNT(b.x)], 1u);
    return b;
}
__device__ __forceinline__ void xcd_barrier_complete(unsigned* bar, unsigned x, unsigned& nloc, unsigned& nx) {
    const unsigned G = gridDim.x * gridDim.y * gridDim.z;
    unsigned sum, cnt, mine, sp = 0u;
    for (;;) {
        sum = 0u; cnt = 0u; mine = 0u;
#pragma unroll
        for (unsigned j = 0; j < 16; ++j) { const unsigned c = xb_ld(&bar[XB_XCNT(j)]); sum += c; cnt += (c > 0u) ? 1u : 0u; mine = (j == x) ? c : mine; }
        if (sum == G) break;
        __builtin_amdgcn_s_sleep(1);
        if ((++sp & 255u) == 0u) { if (xb_ld(&bar[XB_TMO])) break; if (sp > XB_SPIN_CAP) { atomicAdd(&bar[XB_TMO], 1u); break; } }
    }
    nloc = mine > 0u ? mine : 1u; nx = cnt > 0u ? cnt : 1u;
}

__device__ __forceinline__ void xcd_barrier(const XcdBarrier& b) {
    asm volatile("s_waitcnt vmcnt(0)" ::: "memory");
    __syncthreads();
    if (threadIdx.x == 0) {
        unsigned* bar = b.bar;
        __builtin_amdgcn_s_waitcnt(0);
        unsigned nloc = b.st[0], nx = b.st[1];
        if (nloc == 0u) { xcd_barrier_complete(bar, b.x, nloc, nx); b.st[0] = nloc; b.st[1] = nx; }
        const unsigned old = xb_add(&bar[XB_XSUB(b.x)], 1u);
        const unsigned gen = old / nloc;
        if (old + 1u == (gen + 1u) * nloc) {
            __builtin_amdgcn_fence(__ATOMIC_RELEASE, "agent");
            asm volatile("s_waitcnt vmcnt(0)" ::: "memory");
            const unsigned og = xb_add(&bar[XB_TOP], 1u);
            const unsigned tg = og / nx;
            if (og + 1u == (tg + 1u) * nx) xb_add(&bar[XB_TOPGEN], 1u);
            else XB_SPIN(xb_ld(&bar[XB_TOPGEN]) == tg, bar);
            __builtin_amdgcn_fence(__ATOMIC_ACQUIRE, "agent");
            xb_add(&bar[XB_XGEN(b.x)], 1u);
            asm volatile("s_waitcnt vmcnt(0)" ::: "memory");
        } else {
            XB_SPIN(xb_ld(&bar[XB_XGEN(b.x)]) == gen, bar);
            __builtin_amdgcn_fence(__ATOMIC_ACQUIRE, "agent");
            asm volatile("s_waitcnt vmcnt(0)" ::: "memory");
        }
    }
    __syncthreads();
}
#ifndef MK_ONE_LAUNCH
#define MK_ONE_LAUNCH 1
#endif
constexpr int NWAVES = 8;
constexpr int NB = 8, SEQ = 4096, DM = 1024, NTOK = NB * SEQ;
constexpr int INW = 3592, INP = 3584;
constexpr float EPS = 1e-6f;
constexpr size_t MiB = 1u << 20;
constexpr size_t WS_CTL = 0, CTL_ZERO_BYTES = 1 * MiB;
constexpr size_t WS_MOD = 1 * MiB;
constexpr size_t WS_LF = 2 * MiB, WS_LI = WS_LF + 512 * 1024;
constexpr size_t WS_FC = 3 * MiB;
constexpr size_t WS_WIN = 4 * MiB, WS_WOUT0 = 11 * MiB, WS_WC0 = 13 * MiB, WS_WQKV = 17 * MiB, WS_WOUT1 = 23 * MiB, WS_WC1 = 25 * MiB;
constexpr size_t WS_H = 32 * MiB;
constexpr size_t WS_BIG = 96 * MiB;
constexpr size_t WS_IDS = 320 * MiB, WS_GATES = 336 * MiB;
constexpr size_t WS_END = 352 * MiB;
constexpr int CW_BAR = 4096;
constexpr int RING_BYTES = 131072, LDSCTL_OFF = RING_BYTES, MISC_OFF = LDSCTL_OFF + 320, LDS_BYTES = 163840;

__device__ __forceinline__ float wave_sum(float v) {
#pragma unroll
    for (int o = 1; o < 64; o <<= 1) v += __shfl_xor(v, o);
    return v;
}
__device__ __forceinline__ float wave_max(float v) {
#pragma unroll
    for (int o = 1; o < 64; o <<= 1) v = fmaxf(v, __shfl_xor(v, o));
    return v;
}
__device__ __forceinline__ float bf2f(unsigned short b) { return __uint_as_float((unsigned)b << 16); }
__device__ __forceinline__ float bflo(unsigned w) { return __uint_as_float(w << 16); }
__device__ __forceinline__ float bfhi(unsigned w) { return __uint_as_float(w & 0xffff0000u); }
__device__ __forceinline__ float sigmoidf_(float x) { return 1.f / (1.f + __expf(-x)); }
__device__ __forceinline__ float softplusf_(float x) { return fmaxf(x, 0.f) + __logf(1.f + __expf(-fabsf(x))); }
__device__ __forceinline__ float logsigmoidf_(float x) { return fminf(x, 0.f) - __logf(1.f + __expf(-fabsf(x))); }
__device__ __forceinline__ float gelu_exact(float x) { return 0.5f * x * (1.f + erff(x * 0.70710678118654752f)); }
__device__ __forceinline__ float gelu_as(float v) {
    const float av = fabsf(v), t = __builtin_amdgcn_rcpf(av * 0.2316418882f + 1.0f);
    float q = t * 0.5307027145f + (-0.7265760135f); q = q * t + 0.7107068705f; q = q * t + (-0.142248368f); q = q * t + 0.127414796f; q = q * t;
    const float e = __builtin_amdgcn_exp2f((v * v) * (-0.72134752044f));
    const float m = v * (q * e);
    return v < 0.f ? m : v - m;
}

struct Args { const float* in[30]; float* out; unsigned char* ws; int ph_lo, ph_hi; };

struct Ctx {
    LAS unsigned char* lds;
    int tid, lane, wave, G, bid;
    int gw, NGW;
    long gt, NGT;
};
template <bool BASE_BF16>
struct EpiResid {
    static constexpr bool PERM = true, AFTER_DRAIN = false;
    const void* base; bf16* out; const float* gate;
    __device__ __forceinline__ void operator()(const pg8::f32x4 (&acc)[2][2][4][2], const pg8::Unit& u, int wr, int wc, int fr, int fq) const {
        using pg8::f32x4;
        const int col0 = u.pn * 256 + wc * 32 + 8 * fq;
        const float* gp = gate + (size_t)((u.pm * 256) / SEQ) * 6144 + col0;
        f32x4 gv[2][2];
#pragma unroll
        for (int bj = 0; bj < 2; ++bj)
#pragma unroll
            for (int n = 0; n < 2; ++n) { gv[bj][n] = *(const f32x4*)(gp + bj * 128 + 4 * n); gv[bj][n] = gv[bj][n] + 1.0f; }
#pragma unroll
        for (int ai = 0; ai < 2; ++ai)
#pragma unroll
            for (int m = 0; m < 4; ++m) {
                const int r = ai * 128 + wr * 64 + m * 16 + fr; const size_t off = (size_t)(u.pm * 256 + r) * DM + col0;
#pragma unroll
                for (int bj = 0; bj < 2; ++bj) {
                    f32x4 b0, b1;
                    if (BASE_BF16) { const v4u w = *(const v4u*)((const bf16*)base + off + bj * 128); b0 = (f32x4){bflo(w.x), bfhi(w.x), bflo(w.y), bfhi(w.y)}; b1 = (f32x4){bflo(w.z), bfhi(w.z), bflo(w.w), bfhi(w.w)}; }
                    else { b0 = *(const f32x4*)((const float*)base + off + bj * 128); b1 = *(const f32x4*)((const float*)base + off + bj * 128 + 4); }
                    const f32x4 v0 = b0 + gv[bj][0] * acc[ai][bj][m][0], v1 = b1 + gv[bj][1] * acc[ai][bj][m][1];
                    v4u o; o.x = pk2(v0[0], v0[1]); o.y = pk2(v0[2], v0[3]); o.z = pk2(v1[0], v1[1]); o.w = pk2(v1[2], v1[3]);
                    *(v4u*)(out + off + bj * 128) = o;
                }
            }
    }
};

constexpr size_t WS_SA = WS_MOD + 768 * 1024;
constexpr size_t OUT_W8 = 96 * MiB;
constexpr size_t OUT_W8IN = OUT_W8, OUT_W8C0 = OUT_W8 + 4 * MiB, OUT_W8QKV = OUT_W8 + 6 * MiB, OUT_W8C1 = OUT_W8 + 9 * MiB, OUT_SW = OUT_W8 + 11 * MiB;
constexpr int SW_IN = 0, SW_C0 = 4096, SW_QKV = 8192, SW_C1 = 12288;
__device__ __forceinline__ void quantize_rows(const Ctx& C, const bf16* W, int N, unsigned char* W8, float* SW) {
    for (int n = C.gw; n < N; n += C.NGW) {
        const v4u w0 = *(const v4u*)(W + (size_t)n * DM + 16 * C.lane), w1 = *(const v4u*)(W + (size_t)n * DM + 16 * C.lane + 8);
        float x[16] = {bflo(w0.x), bfhi(w0.x), bflo(w0.y), bfhi(w0.y), bflo(w0.z), bfhi(w0.z), bflo(w0.w), bfhi(w0.w), bflo(w1.x), bfhi(w1.x), bflo(w1.y), bfhi(w1.y), bflo(w1.z), bfhi(w1.z), bflo(w1.w), bfhi(w1.w)};
        float am = 0.f;
#pragma unroll
        for (int i = 0; i < 16; ++i) am = fmaxf(am, fabsf(x[i]));
        am = fmaxf(wave_max(am), 1e-30f); const float qi = 127.f / am;
        v4u o;
#pragma unroll
        for (int q = 0; q < 4; ++q) { const int q0 = (int)rintf(x[4 * q] * qi), q1 = (int)rintf(x[4 * q + 1] * qi), q2 = (int)rintf(x[4 * q + 2] * qi), q3 = (int)rintf(x[4 * q + 3] * qi);
            o[q] = ((unsigned)q0 & 255u) | (((unsigned)q1 & 255u) << 8) | (((unsigned)q2 & 255u) << 16) | ((unsigned)q3 << 24); }
        *(v4u*)(W8 + (size_t)n * DM + 16 * C.lane) = o;
        if (C.lane == 0) SW[n] = am * (1.f / 127.f);
    }
}
struct EpiBf16I8 {
    static constexpr bool PERM = true, AFTER_DRAIN = false;
    bf16* O; int ldc; const float* sa; const float* sw;
    __device__ __forceinline__ void operator()(const pg8::i32x4 (&acc)[2][2][4][2], const pg8::Unit& u, int wr, int wc, int fr, int fq) const {
        using pg8::f32x4;
        const int col0 = u.pn * 256 + wc * 32 + 8 * fq;
        f32x4 cs[2][2];
#pragma unroll
        for (int bj = 0; bj < 2; ++bj)
#pragma unroll
            for (int n = 0; n < 2; ++n) cs[bj][n] = *(const f32x4*)(sw + col0 + bj * 128 + 4 * n);
#pragma unroll
        for (int ai = 0; ai < 2; ++ai)
#pragma unroll
            for (int m = 0; m < 4; ++m) { const int row = u.pm * 256 + ai * 128 + wr * 64 + m * 16 + fr; const float rs = sa[row];
                bf16* rowp = O + (size_t)row * ldc + col0;
#pragma unroll
                for (int bj = 0; bj < 2; ++bj) { const pg8::i32x4 a0 = acc[ai][bj][m][0], a1 = acc[ai][bj][m][1];
                    v4u w; w.x = pk2((float)a0[0] * rs * cs[bj][0][0], (float)a0[1] * rs * cs[bj][0][1]); w.y = pk2((float)a0[2] * rs * cs[bj][0][2], (float)a0[3] * rs * cs[bj][0][3]);
                    w.z = pk2((float)a1[0] * rs * cs[bj][1][0], (float)a1[1] * rs * cs[bj][1][1]); w.w = pk2((float)a1[2] * rs * cs[bj][1][2], (float)a1[3] * rs * cs[bj][1][3]);
                    *(v4u*)(rowp + bj * 128) = w; } }
    }
};

__device__ __forceinline__ void transpose_item(const float* W, int ldw, int src_col0, bf16* WT, int K, int dst_row0, int k0, LAS float* scr, int lane) {
#pragma unroll 8
    for (int i = 0; i < 32; ++i) { const int kk = 2 * i + (lane >> 5); scr[kk * 33 + (lane & 31)] = W[(size_t)(k0 + kk) * ldw + src_col0 + (lane & 31)]; }
    LDS_WAIT(); asm volatile("" ::: "memory");
    const int c = lane & 7;
#pragma unroll
    for (int j = 0; j < 4; ++j) { const int n = (lane >> 3) + 8 * j; const LAS float* s = scr + (8 * c) * 33 + n;
        v4u o; o.x = pk2(s[0 * 33], s[1 * 33]); o.y = pk2(s[2 * 33], s[3 * 33]); o.z = pk2(s[4 * 33], s[5 * 33]); o.w = pk2(s[6 * 33], s[7 * 33]);
        *(GAS v4u*)(WT + (size_t)(dst_row0 + n) * K + k0 + 8 * c) = o; }
    LDS_WAIT(); asm volatile("" ::: "memory");
}

__device__ __forceinline__ void phase_prep(const Ctx& C, const Args& A) {
    unsigned char* ws = A.ws;
    {
        LAS float* scr = (LAS float*)(C.lds + C.wave * 16384);
        constexpr int I_IN = 16 * (INP / 32), I_O = 16 * 32, I_QKV = 16 * 96;
        constexpr int NIT = I_IN + I_O + I_QKV + I_O;
        for (int it = C.gw; it < NIT; it += C.NGW) {
            int r = it;
            if (r < I_IN) { const int kb = r / (INP / 32), nb = r % (INP / 32); const int dst = nb * 32, src = dst + (dst >= 2048 ? 8 : 0);
                transpose_item(A.in[5], INW, src, (bf16*)(ws + WS_WIN), 1024, dst, kb * 64, scr, C.lane); continue; } r -= I_IN;
            if (r < I_O) { const int kb = r / 32, nb = r % 32; transpose_item(A.in[10], 1024, nb * 32, (bf16*)(ws + WS_WOUT0), 1024, nb * 32, kb * 64, scr, C.lane); continue; } r -= I_O;
            if (r < I_QKV) { const int kb = r / 96, nb = r % 96; const int src = (nb >> 3) * 256 + 64 * (nb & 3) + 32 * ((nb >> 2) & 1);
                transpose_item(A.in[20], 3072, src, (bf16*)(ws + WS_WQKV), 1024, nb * 32, kb * 64, scr, C.lane); continue; } r -= I_QKV;
            { const int kb = r / 32, nb = r % 32; transpose_item(A.in[23], 1024, nb * 32, (bf16*)(ws + WS_WOUT1), 1024, nb * 32, kb * 64, scr, C.lane); }
        }
    }
    {
        LAS float* sc = (LAS float*)C.lds;
        LAS float* red = (LAS float*)(C.lds + 32768);
        if (C.bid < 96) {
            __syncthreads();
            for (int i = C.tid; i < NB * DM; i += NWAVES * 64) { const float v = A.in[1][i]; sc[i] = v / (1.f + __expf(-v)); }
            __syncthreads();
            for (int item = C.bid; item < 96; item += C.G) {
                const int l = item / 48, jc = item % 48;
                const float* W = A.in[l ? 17 : 2] + 128 * jc + 2 * C.lane;
                float a0[NB], a1[NB];
#pragma unroll
                for (int b = 0; b < NB; ++b) a0[b] = a1[b] = 0.f;
#pragma unroll 32
                for (int kk = 0; kk < 128; ++kk) { const int k = 128 * C.wave + kk; const float2 w = *(const float2*)(W + (size_t)k * 6144);
#pragma unroll
                    for (int b = 0; b < NB; ++b) { const float s = sc[b * DM + k]; a0[b] += s * w.x; a1[b] += s * w.y; } }
#pragma unroll
                for (int b = 0; b < NB; ++b) { red[(C.wave * NB + b) * 128 + 2 * C.lane] = a0[b]; red[(C.wave * NB + b) * 128 + 2 * C.lane + 1] = a1[b]; }
                __syncthreads();
                float* mod = (float*)(ws + WS_MOD);
                for (int o = C.tid; o < NB * 128; o += NWAVES * 64) { const int b = o >> 7, j = o & 127; float s = A.in[l ? 18 : 3][128 * jc + j];
#pragma unroll
                    for (int w = 0; w < NWAVES; ++w) s += red[(w * NB + b) * 128 + j];
                    mod[(size_t)(l * NB + b) * 6144 + 128 * jc + j] = s; }
                __syncthreads();
            }
        }
    }
    {
        LAS float* kt = (LAS float*)C.lds;
        LAS float* wt = (LAS float*)(C.lds + 128 * 132 * 4);
        for (int item = C.bid; item < 512; item += C.G) {
            const int l = item >> 8, hh = (item >> 4) & 15, kb = item & 15;
            const float* Wq = A.in[l ? 25 : 12]; const float* Kh = A.in[l ? ((hh & 1) ? 27 : 26) : ((hh & 1) ? 14 : 13)];
            bf16* Wc = (bf16*)(ws + (l ? WS_WC1 : WS_WC0));
            __syncthreads();
#pragma unroll
            for (int i = 0; i < 8; ++i) { const int id = C.tid + 512 * i, row = id >> 5, c4 = id & 31; *(LAS f32x4*)(kt + row * 132 + 4 * c4) = *(const f32x4*)(Kh + row * 128 + 4 * c4); }
#pragma unroll
            for (int i = 0; i < 4; ++i) { const int id = C.tid + 512 * i, row = id >> 5, c4 = id & 31; *(LAS f32x4*)(wt + row * 132 + 4 * c4) = *(const f32x4*)(Wq + (size_t)(kb * 64 + row) * 2048 + hh * 128 + 4 * c4); }
            __syncthreads();
            const int key = C.tid & 127, kg = C.tid >> 7;
            float acc[16];
#pragma unroll
            for (int i = 0; i < 16; ++i) acc[i] = 0.f;
#pragma unroll 2
            for (int d4 = 0; d4 < 32; ++d4) { const f32x4 kv = *(const LAS f32x4*)(kt + key * 132 + 4 * d4);
#pragma unroll
                for (int i = 0; i < 16; ++i) { const f32x4 wv = *(const LAS f32x4*)(wt + (kg * 16 + i) * 132 + 4 * d4); acc[i] += (kv.x * wv.x + kv.y * wv.y) + (kv.z * wv.z + kv.w * wv.w); } }
            v4u o0, o1; o0.x = pk2(acc[0], acc[1]); o0.y = pk2(acc[2], acc[3]); o0.z = pk2(acc[4], acc[5]); o0.w = pk2(acc[6], acc[7]);
            o1.x = pk2(acc[8], acc[9]); o1.y = pk2(acc[10], acc[11]); o1.z = pk2(acc[12], acc[13]); o1.w = pk2(acc[14], acc[15]);
            bf16* dst = Wc + (size_t)(hh * 128 + key) * 1024 + kb * 64 + kg * 16;
            *(v4u*)dst = o0; *(v4u*)(dst + 8) = o1;
        }
        __syncthreads();
    }
}

template <bool GATES, bool IN_BF16, bool OUT_I8 = false>
__device__ __forceinline__ void phase_rowpass(const Ctx& C, const Args& A, const void* xin, const float* gain, const float* modl  , int ch_shift, int ch_scale, bf16* hout, float* sa = nullptr) {
    f32x4 wg0[GATES ? 16 : 1], wg1[GATES ? 16 : 1];
    if (GATES) {
        const float* Wg = A.in[5] + 2048;
#pragma unroll
        for (int j = 0; j < 4; ++j)
#pragma unroll
            for (int e = 0; e < 4; ++e) { const int k = 4 * C.lane + 256 * j + e; wg0[4 * j + e] = *(const f32x4*)(Wg + (size_t)k * INW); wg1[4 * j + e] = *(const f32x4*)(Wg + (size_t)k * INW + 4); }
    }
    for (int row = C.gw; row < NTOK; row += C.NGW) {
        const int b = row >> 12;
        f32x4 v[4]; float ss = 0.f;
#pragma unroll
        for (int j = 0; j < 4; ++j) {
            if (IN_BF16) { const uint2 w = *(const uint2*)((const bf16*)xin + (size_t)row * DM + 4 * C.lane + 256 * j); v[j] = (f32x4){bflo(w.x), bfhi(w.x), bflo(w.y), bfhi(w.y)}; }
            else v[j] = *(const f32x4*)((const float*)xin + (size_t)row * DM + 4 * C.lane + 256 * j);
            ss += v[j].x * v[j].x + v[j].y * v[j].y + v[j].z * v[j].z + v[j].w * v[j].w; }
        const float rstd = rsqrtf(wave_sum(ss) * (1.f / DM) + EPS);
        const float* shp = modl + (size_t)b * 6144 + ch_shift * 1024 + 4 * C.lane; const float* scp = modl + (size_t)b * 6144 + ch_scale * 1024 + 4 * C.lane;
        f32x4 h[4];
#pragma unroll
        for (int j = 0; j < 4; ++j) { const f32x4 g = *(const f32x4*)(gain + 4 * C.lane + 256 * j), sc = *(const f32x4*)(scp + 256 * j), sh = *(const f32x4*)(shp + 256 * j);
            h[j] = v[j] * rstd * g * (sc + 1.0f) + sh;
            if (!OUT_I8) { uint2 o; o.x = pk2(h[j].x, h[j].y); o.y = pk2(h[j].z, h[j].w);
                *(uint2*)(hout + (size_t)row * DM + 4 * C.lane + 256 * j) = o; } }
        if (OUT_I8) {
            float am = 0.f;
#pragma unroll
            for (int j = 0; j < 4; ++j) am = fmaxf(am, fmaxf(fmaxf(fabsf(h[j].x), fabsf(h[j].y)), fmaxf(fabsf(h[j].z), fabsf(h[j].w))));
            am = fmaxf(wave_max(am), 1e-20f); const float qi = 127.f / am;
            unsigned char* h8 = (unsigned char*)hout + (size_t)row * DM + 4 * C.lane;
#pragma unroll
            for (int j = 0; j < 4; ++j) { const int q0 = (int)rintf(h[j].x * qi), q1 = (int)rintf(h[j].y * qi), q2 = (int)rintf(h[j].z * qi), q3 = (int)rintf(h[j].w * qi);
                *(unsigned*)(h8 + 256 * j) = ((unsigned)q0 & 255u) | (((unsigned)q1 & 255u) << 8) | (((unsigned)q2 & 255u) << 16) | ((unsigned)q3 << 24); }
            if (C.lane == 0) sa[row] = am * (1.f / 127.f);
        }
        if (GATES) {
            f32x4 d0 = {0.f, 0.f, 0.f, 0.f}, d1 = {0.f, 0.f, 0.f, 0.f};
#pragma unroll
            for (int j = 0; j < 4; ++j)
#pragma unroll
                for (int e = 0; e < 4; ++e) { const float hv = h[j][e]; d0 += wg0[4 * j + e] * hv; d1 += wg1[4 * j + e] * hv; }
            float d[8] = {d0.x, d0.y, d0.z, d0.w, d1.x, d1.y, d1.z, d1.w};
#pragma unroll
            for (int q = 0; q < 8; ++q) d[q] = wave_sum(d[q]);
            if (C.lane == 0) {
                const int s = row & (SEQ - 1); float* LF = (float*)(A.ws + WS_LF); float* LI = (float*)(A.ws + WS_LI);
#pragma unroll
                for (int hh = 0; hh < 4; ++hh) { LI[(size_t)(b * 4 + hh) * SEQ + s] = d[hh] + A.in[6][hh]; LF[(size_t)(b * 4 + hh) * SEQ + s] = logsigmoidf_(d[4 + hh] + A.in[7][hh]); }
            }
        }
    }
}

__device__ __forceinline__ void phase_conv(const Ctx& C, const Args& A) {
    const bf16* P = (const bf16*)(A.ws + WS_BIG); bf16* mix = (bf16*)(A.ws + WS_H); const float* cw = A.in[8];
    for (long it = C.gt; it < (long)NTOK * 64; it += C.NGT) {
        const int cg = (int)(it & 63), tok = (int)(it >> 6), t = tok & (SEQ - 1), c0 = cg * 8;
        float conv[8];
#pragma unroll
        for (int e = 0; e < 8; ++e) conv[e] = 0.f;
#pragma unroll
        for (int k = 0; k < 3; ++k) {
            const int dt = 2 - k;
            if (t - dt >= 0) {
                const bf16* r = P + (size_t)(tok - dt) * INP;
                const v4u cc = *(const v4u*)(r + 2560 + c0), chv = *(const v4u*)(r + 3072 + c0);
                const f32x4 w0 = *(const f32x4*)(cw + k * 512 + c0), w1 = *(const f32x4*)(cw + k * 512 + c0 + 4);
                conv[0] += w0.x * bflo(cc.x) * bflo(chv.x); conv[1] += w0.y * bfhi(cc.x) * bfhi(chv.x);
                conv[2] += w0.z * bflo(cc.y) * bflo(chv.y); conv[3] += w0.w * bfhi(cc.y) * bfhi(chv.y);
                conv[4] += w1.x * bflo(cc.z) * bflo(chv.z); conv[5] += w1.y * bfhi(cc.z) * bfhi(chv.z);
                conv[6] += w1.z * bflo(cc.w) * bflo(chv.w); conv[7] += w1.w * bfhi(cc.w) * bfhi(chv.w);
            }
        }
        const v4u cb = *(const v4u*)(P + (size_t)tok * INP + 2048 + c0);
        v4u o; o.x = pk2(conv[0] * bflo(cb.x), conv[1] * bfhi(cb.x)); o.y = pk2(conv[2] * bflo(cb.y), conv[3] * bfhi(cb.y));
        o.z = pk2(conv[4] * bflo(cb.z), conv[5] * bfhi(cb.z)); o.w = pk2(conv[6] * bflo(cb.w), conv[7] * bfhi(cb.w));
        *(v4u*)(mix + (size_t)tok * DM + 512 + c0) = o;
    }
}
constexpr size_t WS_TAB = 352 * MiB;
constexpr size_t TAB_BYTES = (size_t)16384 * 1024;
constexpr size_t WS_TSC = WS_TAB + 4 * TAB_BYTES;
constexpr size_t WS_XB = 420 * MiB;
constexpr size_t WS_END2 = WS_XB + 64 * MiB;
typedef float f32x2 __attribute__((ext_vector_type(2)));
typedef __bf16 bf16x2_t __attribute__((ext_vector_type(2)));
typedef unsigned u32x2 __attribute__((ext_vector_type(2)));
__device__ __forceinline__ float dot2bf(unsigned a, unsigned b, float c) { return __builtin_amdgcn_fdot2_f32_bf16(__builtin_bit_cast(bf16x2_t, a), __builtin_bit_cast(bf16x2_t, b), c, false); }
template <int CTRL> __device__ __forceinline__ unsigned dppu(unsigned v) { return (unsigned)__builtin_amdgcn_update_dpp(0, (int)v, CTRL, 0xF, 0xF, true); }
__device__ __forceinline__ float wave_sum_dpp(float v) {
    v += __uint_as_float(dppu<0xB1>(__float_as_uint(v)));
    v += __uint_as_float(dppu<0x4E>(__float_as_uint(v)));
    v += __uint_as_float(dppu<0x124>(__float_as_uint(v)));
    v += __uint_as_float(dppu<0x128>(__float_as_uint(v)));
    const unsigned u = __float_as_uint(v);
    return (__uint_as_float(__builtin_amdgcn_readlane(u, 0)) + __uint_as_float(__builtin_amdgcn_readlane(u, 16))) + (__uint_as_float(__builtin_amdgcn_readlane(u, 32)) + __uint_as_float(__builtin_amdgcn_readlane(u, 48)));
}
__device__ __forceinline__ void ins16(unsigned (&val)[16], unsigned k) {
#pragma unroll
    for (int j = 0; j < 16; ++j) { const unsigned t = val[j] < k ? val[j] : k; val[j] = val[j] < k ? k : val[j]; k = t; }
}
#define PEER_CE(x, i, l) { const unsigned a_ = x[i] < x[l] ? x[l] : x[i], b_ = x[i] < x[l] ? x[i] : x[l]; x[i] = a_; x[l] = b_; }
__device__ __forceinline__ void sort16_desc(unsigned (&x)[16]) {
#pragma unroll
    for (int k = 2; k <= 16; k <<= 1)
#pragma unroll
        for (int j = k >> 1; j > 0; j >>= 1)
#pragma unroll
            for (int i = 0; i < 16; ++i) { const int l = i ^ j; if (l > i) { if ((i & k) == 0) { PEER_CE(x, i, l) } else { PEER_CE(x, l, i) } } }
}
__device__ __forceinline__ void merge16_desc(unsigned (&v)[16], const unsigned (&s)[16]) {
#pragma unroll
    for (int i = 0; i < 16; ++i) v[i] = v[i] < s[15 - i] ? s[15 - i] : v[i];
#pragma unroll
    for (int j = 8; j > 0; j >>= 1)
#pragma unroll
        for (int i = 0; i < 16; ++i) { const int l = i ^ j; if (l > i) PEER_CE(v, i, l) }
}
__device__ __forceinline__ unsigned ord32(unsigned b) { return b ^ ((unsigned)((int)b >> 31) | 0x80000000u); }
__device__ __forceinline__ float unord(unsigned o, unsigned mask) { o &= mask; return __uint_as_float((o & 0x80000000u) ? (o ^ 0x80000000u) : (~o & mask)); }

template <bool NEXT, int DRY = 0>
__device__ __forceinline__ void phase_peer(const Ctx& C, const Args& A, const unsigned char* Utab, const unsigned char* Vtab, const float* SU, const float* SV, const float* g2  ,
                                           const float* ngain, const float* nmod  , const XcdBarrier& bar) {
    const bf16* SC = (const bf16*)(A.ws + WS_BIG); bf16* Hb = (bf16*)(A.ws + WS_H);
#ifndef PEER_NBK
#define PEER_NBK 32
#endif
    constexpr int NBK = PEER_NBK, BSH = (NBK == 32 ? 9 : NBK == 64 ? 8 : 7), BPL = NBK / 16;
    LAS unsigned char* wb = C.lds + C.wave * (1024 + 32 * NBK + 8192);
    LAS unsigned char* IDXB = wb; LAS unsigned* CNT = (LAS unsigned*)(wb + 1024); LAS unsigned* PRE = (LAS unsigned*)(wb + 1024 + 16 * NBK); LAS v4u* ENT = (LAS v4u*)(wb + 1024 + 32 * NBK);
#ifndef PEER_SYNC_EVERY
#define PEER_SYNC_EVERY 32
#endif
    const bool wg_uniform = (DRY != 6) && ((NTOK / 4) % C.NGW == 0);
    unsigned flip = 0u;
#ifdef PEER_STAGGER
    if (C.wave >= 4) { const unsigned long long t0_ = __builtin_amdgcn_s_memrealtime(); while (__builtin_amdgcn_s_memrealtime() - t0_ < (unsigned long long)PEER_STAGGER) __builtin_amdgcn_s_sleep(16); }
#endif
    const int gw_ = (DRY == 6) ? ((C.bid >> 1) * NWAVES + C.wave) : C.gw, ngw_ = (DRY == 6) ? (C.NGW >> 1) : C.NGW;
    if (DRY == 6 && (C.bid & 1)) return;
    for (int tb = gw_; tb < NTOK / 4; tb += ngw_) {
        const int tok0 = tb * 4;
#if MK_ONE_LAUNCH && defined(PEER_SYNC)
        if (tb >= C.NGW) xcd_barrier(bar);
#endif
        int lane = C.lane; asm volatile("" : "+v"(lane));
        const int par = lane & 1, tl = lane >> 4, grp = lane & 15, head = grp >> 1, i16 = lane & 15;
        {
            unsigned val[16];
            const v4u* sp = (const v4u*)(SC + (size_t)(tok0 + tl) * 2048 + grp * 128);
            v4u raw[16];
#pragma unroll
            for (int c = 0; c < 16; ++c) raw[c] = sp[c];
#pragma unroll
            for (int c = 0; c < 16; c += 2) {
                const v4u c0 = raw[c], c1 = raw[c + 1];
                const unsigned ib = 127u - 8u * (unsigned)c;
                unsigned ks[16];
#pragma unroll
                for (int e = 0; e < 4; ++e) { ks[2 * e] = (ord32(c0[e] << 16) & 0xFFFF0000u) | (ib - 2u * e); ks[2 * e + 1] = (ord32(c0[e] & 0xFFFF0000u) & 0xFFFF0000u) | (ib - 2u * e - 1u);
                    ks[8 + 2 * e] = (ord32(c1[e] << 16) & 0xFFFF0000u) | (ib - 8u - 2u * e); ks[9 + 2 * e] = (ord32(c1[e] & 0xFFFF0000u) & 0xFFFF0000u) | (ib - 9u - 2u * e); }
                sort16_desc(ks);
                if (c == 0) {
#pragma unroll
                    for (int j = 0; j < 16; ++j) val[j] = ks[j];
                } else merge16_desc(val, ks);
            }
#pragma unroll
            for (int z = 0; z < NBK / 16; ++z) CNT[lane + 64 * z] = 0u;
            float X[16], Y[16];
            v4u ib4 = {0u, 0u, 0u, 0u};
#pragma unroll
            for (int j = 0; j < 16; ++j) { X[j] = unord(val[j], 0xFFFF0000u); Y[j] = unord(dppu<0xB1>(val[j]), 0xFFFF0000u); ib4[j >> 2] |= (127u - (val[j] & 127u)) << (8 * (j & 3)); }
            *(LAS v4u*)(IDXB + lane * 16) = ib4;
            unsigned cand[16], cb2[16];
            unsigned parv = (unsigned)par; asm volatile("" : "+v"(parv));
#define PEER_CKEY(p, q) ((((p) == (q)) && parv) ? 0u : ((ord32(__float_as_uint(X[p] + Y[q])) & 0xFFFFFF00u) | (255u - ((unsigned)((p) * 16 + (q)) + parv * (unsigned)(15 * ((q) - (p)))))))
            cand[0] = PEER_CKEY(0, 0); cand[1] = PEER_CKEY(0, 1); cand[2] = PEER_CKEY(0, 2); cand[3] = PEER_CKEY(0, 3); cand[4] = PEER_CKEY(0, 4); cand[5] = PEER_CKEY(0, 5); cand[6] = PEER_CKEY(0, 6); cand[7] = PEER_CKEY(0, 7);
            cand[8] = PEER_CKEY(0, 8); cand[9] = PEER_CKEY(0, 9); cand[10] = PEER_CKEY(0, 10); cand[11] = PEER_CKEY(0, 11); cand[12] = PEER_CKEY(0, 12); cand[13] = PEER_CKEY(0, 13); cand[14] = PEER_CKEY(0, 14); cand[15] = PEER_CKEY(0, 15);
            cb2[0] = PEER_CKEY(1, 1); cb2[1] = PEER_CKEY(1, 2); cb2[2] = PEER_CKEY(1, 3); cb2[3] = PEER_CKEY(1, 4); cb2[4] = PEER_CKEY(1, 5); cb2[5] = PEER_CKEY(1, 6); cb2[6] = PEER_CKEY(1, 7);
            cb2[7] = PEER_CKEY(2, 2); cb2[8] = PEER_CKEY(2, 3); cb2[9] = PEER_CKEY(2, 4); cb2[10] = PEER_CKEY(3, 3); cb2[11] = 0u; cb2[12] = 0u; cb2[13] = 0u; cb2[14] = 0u; cb2[15] = 0u;
#undef PEER_CKEY
            sort16_desc(cand); sort16_desc(cb2); merge16_desc(cand, cb2);
            unsigned mg[16]; float fv[16]; float mx = -INFINITY;
#pragma unroll
            for (int k = 0; k < 16; ++k) { const unsigned o = dppu<0xB1>(cand[15 - k]); mg[k] = cand[k] < o ? o : cand[k]; fv[k] = unord(mg[k], 0xFFFFFF00u); mx = fmaxf(mx, fv[k]); }
            float ssum = 0.f;
#pragma unroll
            for (int k = 0; k < 16; ++k) { fv[k] = __expf(fv[k] - mx); ssum += fv[k]; }
            const float inv = 1.f / ssum;
            asm volatile("s_waitcnt lgkmcnt(0)" ::: "memory");
            unsigned eid[8], rk[8]; float esu[8], egv[8];
#pragma unroll
            for (int k = 0; k < 8; ++k) { const unsigned fi = 255u - (mg[k] & 255u);
                const unsigned e1 = IDXB[(lane & ~1) * 16 + (fi >> 4)], e2 = IDXB[(lane | 1) * 16 + (fi & 15u)];
                eid[k] = e1 * 128u + e2;
                rk[k] = __hip_atomic_fetch_add(CNT + tl * NBK + (eid[k] >> BSH), 1u, __ATOMIC_RELAXED, __HIP_MEMORY_SCOPE_WORKGROUP);
                esu[k] = SU[eid[k]]; egv[k] = fv[k] * inv * SV[eid[k]]; }
            asm volatile("s_waitcnt lgkmcnt(0)" ::: "memory");
            { unsigned cb[BPL]; unsigned s = 0u;
#pragma unroll
              for (int z = 0; z < BPL; ++z) { cb[z] = CNT[tl * NBK + BPL * i16 + z]; s += cb[z]; }
              const unsigned tot = s;
              s += dppu<0x111>(s); s += dppu<0x112>(s); s += dppu<0x114>(s); s += dppu<0x118>(s);
              unsigned ex = s - tot;
#pragma unroll
              for (int z = 0; z < BPL; ++z) { PRE[tl * NBK + BPL * i16 + z] = ex; ex += cb[z]; } }
            asm volatile("s_waitcnt lgkmcnt(0)" ::: "memory");
#pragma unroll
            for (int k = 0; k < 8; ++k) { unsigned pos = PRE[tl * NBK + (eid[k] >> BSH)] + rk[k]; pos = flip ? 127u - pos : pos;
                ENT[tl * 128 + pos] = (v4u){eid[k], __float_as_uint(esu[k]), __float_as_uint(egv[k]), 0u}; }
            asm volatile("s_waitcnt lgkmcnt(0)" ::: "memory");
            flip ^= 1u;
        }
        if (wg_uniform) __syncthreads();
        if (DRY != 3) {
            const int tok = tok0 + tl; const int b = tok >> 12;
            LAS v4u* E = ENT + tl * 128;
            float cmax = 0.f;
            {
                unsigned hq[16]; const float hs = ((const float*)(A.ws + WS_SA))[tok];
#pragma unroll
                for (int j = 0; j < 4; ++j) { const v4u hw = *(const v4u*)(A.ws + WS_IDS + (size_t)tok * DM + 256 * j + 16 * i16); hq[4 * j] = hw.x; hq[4 * j + 1] = hw.y; hq[4 * j + 2] = hw.z; hq[4 * j + 3] = hw.w; }
                v4u B[8][4]; unsigned idr[8]; float mine = 0.f;
#define PEER_LOADI(R_, tab, id_) { const unsigned off = ((id_) & (DRY == 2 ? 1023u : 16383u)) * 1024u + 16u * (unsigned)i16; \
                _Pragma("unroll") for (int j = 0; j < 4; ++j) R_[j] = (DRY == 5 && j >= 2) ? R_[j - 2] : *(const v4u*)((tab) + off + 256 * j); }
#define PEER_DOTS(U_, t_) { int d0 = 0, d1 = 0, d2 = 0, d3 = 0; \
                _Pragma("unroll") for (int e = 0; e < 4; ++e) { d0 = __builtin_amdgcn_sdot4((int)U_[0][e], (int)hq[e], d0, false); d1 = __builtin_amdgcn_sdot4((int)U_[1][e], (int)hq[4 + e], d1, false); \
                    d2 = __builtin_amdgcn_sdot4((int)U_[2][e], (int)hq[8 + e], d2, false); d3 = __builtin_amdgcn_sdot4((int)U_[3][e], (int)hq[12 + e], d3, false); } \
                unsigned ds_ = (unsigned)((d0 + d1) + (d2 + d3)); ds_ += dppu<0xB1>(ds_); ds_ += dppu<0x4E>(ds_); ds_ += dppu<0x124>(ds_); ds_ += dppu<0x128>(ds_); \
                mine = (i16 == ((t_) & 15)) ? (float)(int)ds_ : mine; }
#pragma unroll
                for (int k = 0; k < 8; ++k) idr[k] = E[k].x;
#pragma unroll
                for (int k = 0; k < 8; ++k) PEER_LOADI(B[k], Utab, idr[k])
#pragma unroll 1
                for (int r = 0; r < 128; r += 8) {
                    if (wg_uniform && (r & (PEER_SYNC_EVERY - 1)) == 0 && r) __syncthreads();
                    if (r + 8 < 128) {
#pragma unroll
                        for (int k = 0; k < 8; ++k) idr[k] = E[r + 8 + k].x;
                    }
#pragma unroll
                    for (int k = 0; k < 8; ++k) { PEER_DOTS(B[k], r + k) if (r + 8 < 128) PEER_LOADI(B[k], Utab, idr[k]) }
                    if (r & 8) {
                        const int t = (r & ~15) + i16; const v4u en = E[t];
                        const float cf = gelu_as(mine * (__uint_as_float(en.y) * hs)) * __uint_as_float(en.z);
                        ((LAS float*)(E + t))[3] = cf; cmax = fmaxf(cmax, fabsf(cf));
                    }
                }
#undef PEER_DOTS
            }
            if (wg_uniform) __syncthreads();
            cmax = fmaxf(cmax, __uint_as_float(dppu<0xB1>(__float_as_uint(cmax)))); cmax = fmaxf(cmax, __uint_as_float(dppu<0x4E>(__float_as_uint(cmax))));
            cmax = fmaxf(cmax, __uint_as_float(dppu<0x124>(__float_as_uint(cmax)))); cmax = fmaxf(cmax, __uint_as_float(dppu<0x128>(__float_as_uint(cmax))));
            cmax = fmaxf(cmax, 1e-30f);
            int acci[4][16];
#pragma unroll
            for (int j = 0; j < 4; ++j)
#pragma unroll
                for (int e = 0; e < 16; ++e) acci[j][e] = 0;
            if (DRY != 4) {
                const float cq = 127.f / cmax;
                asm volatile("s_waitcnt lgkmcnt(0)" ::: "memory");
                unsigned pk0, pk1;
                { int q[8];
#pragma unroll
                  for (int k = 0; k < 8; ++k) q[k] = (int)rintf(((const LAS float*)(E + 8 * i16 + k))[3] * cq);
                  pk0 = ((unsigned)q[0] & 255u) | (((unsigned)q[1] & 255u) << 8) | (((unsigned)q[2] & 255u) << 16) | ((unsigned)q[3] << 24);
                  pk1 = ((unsigned)q[4] & 255u) | (((unsigned)q[5] & 255u) << 8) | (((unsigned)q[6] & 255u) << 16) | ((unsigned)q[7] << 24); }
                asm volatile("s_waitcnt lgkmcnt(0)" ::: "memory");
                ((LAS unsigned*)(E + 2 * i16))[1] = pk0; ((LAS unsigned*)(E + 2 * i16 + 1))[1] = pk1;
                asm volatile("s_waitcnt lgkmcnt(0)" ::: "memory");
                v4u Ba[4][2], Bb[4][2];
#define PEER_LOADG(B_, g_, hf_) { _Pragma("unroll") for (int n = 0; n < 4; ++n) { const unsigned id_ = E[4 * (g_) + n].x; const unsigned off = (id_ & (DRY == 2 ? 1023u : 16383u)) * 1024u + 16u * (unsigned)i16 + 512u * (hf_); \
                    _Pragma("unroll") for (int jj = 0; jj < 2; ++jj) B_[n][jj] = *(const v4u*)(Vtab + off + 256 * jj); } }
#define PEER_GROUP(B_, g_, hf_) { const unsigned a4 = ((const LAS unsigned*)(E + (g_)))[1]; \
                    _Pragma("unroll") for (int jj = 0; jj < 2; ++jj) _Pragma("unroll") for (int e = 0; e < 4; ++e) { \
                        const unsigned p01l = __builtin_amdgcn_perm(B_[1][jj][e], B_[0][jj][e], 0x05010400u), p01h = __builtin_amdgcn_perm(B_[1][jj][e], B_[0][jj][e], 0x07030602u); \
                        const unsigned p23l = __builtin_amdgcn_perm(B_[3][jj][e], B_[2][jj][e], 0x05010400u), p23h = __builtin_amdgcn_perm(B_[3][jj][e], B_[2][jj][e], 0x07030602u); \
                        acci[2 * (hf_) + jj][4 * e + 0] = __builtin_amdgcn_sdot4((int)__builtin_amdgcn_perm(p23l, p01l, 0x05040100u), (int)a4, acci[2 * (hf_) + jj][4 * e + 0], false); \
                        acci[2 * (hf_) + jj][4 * e + 1] = __builtin_amdgcn_sdot4((int)__builtin_amdgcn_perm(p23l, p01l, 0x07060302u), (int)a4, acci[2 * (hf_) + jj][4 * e + 1], false); \
                        acci[2 * (hf_) + jj][4 * e + 2] = __builtin_amdgcn_sdot4((int)__builtin_amdgcn_perm(p23h, p01h, 0x05040100u), (int)a4, acci[2 * (hf_) + jj][4 * e + 2], false); \
                        acci[2 * (hf_) + jj][4 * e + 3] = __builtin_amdgcn_sdot4((int)__builtin_amdgcn_perm(p23h, p01h, 0x07060302u), (int)a4, acci[2 * (hf_) + jj][4 * e + 3], false); } }
                PEER_LOADG(Ba, 0, 0)
#pragma unroll 1
                for (int g = 0; g < 32; ++g) {
                    if (wg_uniform && (g & (PEER_SYNC_EVERY / 4 - 1)) == 0 && g) __syncthreads();
                    PEER_LOADG(Bb, g, 1)
                    PEER_GROUP(Ba, g, 0)
                    if (g + 1 < 32) PEER_LOADG(Ba, g + 1, 0)
                    PEER_GROUP(Bb, g, 1)
                }
#undef PEER_LOADG
#undef PEER_GROUP
            }
            const float osc = cmax * (1.f / 127.f);
            f32x2 acc[4][8];
#pragma unroll
            for (int j = 0; j < 4; ++j)
#pragma unroll
                for (int e = 0; e < 8; ++e) acc[j][e] = (f32x2){(float)acci[j][2 * e] * osc, (float)acci[j][2 * e + 1] * osc};
#undef PEER_LOADI
            float ss = 0.f;
#pragma unroll
            for (int j = 0; j < 4; ++j) { const size_t eo = (size_t)tok * DM + 256 * j + 16 * i16; const float* gp = g2 + (size_t)b * 6144 + 256 * j + 16 * i16;
                bf16* XBp = (bf16*)(A.ws + WS_XB) + eo; const v4u xw0 = *(const v4u*)XBp, xw1 = *(const v4u*)(XBp + 8);
                unsigned ow[8];
#pragma unroll
                for (int q = 0; q < 4; ++q) { const unsigned w0 = q < 2 ? xw0[2 * q] : xw1[2 * q - 4], w1 = q < 2 ? xw0[2 * q + 1] : xw1[2 * q - 3]; const f32x4 g0 = *(const f32x4*)(gp + 4 * q);
                    const f32x4 xn = {bflo(w0) + (1.f + g0[0]) * acc[j][2 * q].x, bfhi(w0) + (1.f + g0[1]) * acc[j][2 * q].y, bflo(w1) + (1.f + g0[2]) * acc[j][2 * q + 1].x, bfhi(w1) + (1.f + g0[3]) * acc[j][2 * q + 1].y};
                    if (NEXT) { ow[2 * q] = pk2(xn[0], xn[1]); ow[2 * q + 1] = pk2(xn[2], xn[3]); }
                    else if (DRY == 0 || xn[0] == 1234.5678f) *(f32x4*)(A.out + eo + 4 * q) = xn;
                    acc[j][2 * q] = (f32x2){xn[0], xn[1]}; acc[j][2 * q + 1] = (f32x2){xn[2], xn[3]};
                    ss += (xn[0] * xn[0] + xn[1] * xn[1]) + (xn[2] * xn[2] + xn[3] * xn[3]); }
                if (NEXT && (DRY == 0 || ss == 1234.5678f)) { *(v4u*)XBp = (v4u){ow[0], ow[1], ow[2], ow[3]}; *(v4u*)(XBp + 8) = (v4u){ow[4], ow[5], ow[6], ow[7]}; } }
            if (DRY != 0) { if (ss == 1234.5678f) A.out[tok] = ss; }
            if (NEXT && DRY == 0) {
                ss += __uint_as_float(dppu<0xB1>(__float_as_uint(ss))); ss += __uint_as_float(dppu<0x4E>(__float_as_uint(ss)));
                ss += __uint_as_float(dppu<0x124>(__float_as_uint(ss))); ss += __uint_as_float(dppu<0x128>(__float_as_uint(ss)));
                const float rstd = rsqrtf(ss * (1.f / DM) + EPS);
                float am = 0.f;
#pragma unroll
                for (int j = 0; j < 4; ++j) { const int c0 = 256 * j + 16 * i16; const float* shp = nmod + (size_t)b * 6144 + c0; const float* scp = shp + 1024;
#pragma unroll
                    for (int q = 0; q < 4; ++q) { const f32x4 gn = *(const f32x4*)(ngain + c0 + 4 * q), sc = *(const f32x4*)(scp + 4 * q), sh = *(const f32x4*)(shp + 4 * q);
                        const f32x2 h0 = {acc[j][2 * q].x * rstd * gn[0] * (1.f + sc[0]) + sh[0], acc[j][2 * q].y * rstd * gn[1] * (1.f + sc[1]) + sh[1]};
                        const f32x2 h1 = {acc[j][2 * q + 1].x * rstd * gn[2] * (1.f + sc[2]) + sh[2], acc[j][2 * q + 1].y * rstd * gn[3] * (1.f + sc[3]) + sh[3]};
                        acc[j][2 * q] = h0; acc[j][2 * q + 1] = h1; am = fmaxf(am, fmaxf(fmaxf(fabsf(h0.x), fabsf(h0.y)), fmaxf(fabsf(h1.x), fabsf(h1.y)))); } }
                am = fmaxf(am, __uint_as_float(dppu<0xB1>(__float_as_uint(am)))); am = fmaxf(am, __uint_as_float(dppu<0x4E>(__float_as_uint(am))));
                am = fmaxf(am, __uint_as_float(dppu<0x124>(__float_as_uint(am)))); am = fmaxf(am, __uint_as_float(dppu<0x128>(__float_as_uint(am))));
                am = fmaxf(am, 1e-20f); const float qi = 127.f / am;
#pragma unroll
                for (int j = 0; j < 4; ++j) { v4u o;
#pragma unroll
                    for (int q = 0; q < 4; ++q) { const int q0 = (int)rintf(acc[j][2 * q].x * qi), q1 = (int)rintf(acc[j][2 * q].y * qi), q2 = (int)rintf(acc[j][2 * q + 1].x * qi), q3 = (int)rintf(acc[j][2 * q + 1].y * qi);
                        o[q] = ((unsigned)q0 & 255u) | (((unsigned)q1 & 255u) << 8) | (((unsigned)q2 & 255u) << 16) | ((unsigned)q3 << 24); }
                    *(v4u*)(A.ws + WS_IDS + (size_t)tok * DM + 256 * j + 16 * i16) = o; }
                if (i16 == 0) ((float*)(A.ws + WS_SA))[tok] = am * (1.f / 127.f);
            }
        }
    }
}
__device__ __forceinline__ void convert_tables_int8(const Ctx& C, const Args& A) {
    unsigned char* T8 = A.ws + WS_TAB; float* TS = (float*)(A.ws + WS_TSC);
    for (int R0 = C.gw * 4; R0 < 4 * 16384; R0 += C.NGW * 4) {
        const int t = R0 >> 14;
        const float* src = A.in[t == 0 ? 15 : t == 1 ? 16 : t == 2 ? 28 : 29] + (size_t)(R0 & 16383) * DM + 16 * C.lane;
        f32x4 x[4][4]; float am[4];
#pragma unroll
        for (int r = 0; r < 4; ++r) { am[r] = 0.f;
#pragma unroll
            for (int q = 0; q < 4; ++q) x[r][q] = *(const f32x4*)(src + (size_t)r * DM + 4 * q); }
#pragma unroll
        for (int r = 0; r < 4; ++r) {
#pragma unroll
            for (int q = 0; q < 4; ++q) am[r] = fmaxf(am[r], fmaxf(fmaxf(fabsf(x[r][q].x), fabsf(x[r][q].y)), fmaxf(fabsf(x[r][q].z), fabsf(x[r][q].w))));
            am[r] = wave_max(am[r]);
            const float sc = (am[r] > 0.f) ? 127.f / am[r] : 1.f, inv = (am[r] > 0.f) ? am[r] * (1.f / 127.f) : 1.f;
            v4u o;
#pragma unroll
            for (int q = 0; q < 4; ++q) { const int q0 = (int)rintf(x[r][q].x * sc), q1 = (int)rintf(x[r][q].y * sc), q2 = (int)rintf(x[r][q].z * sc), q3 = (int)rintf(x[r][q].w * sc);
                o[q] = ((unsigned)q0 & 255u) | (((unsigned)q1 & 255u) << 8) | (((unsigned)q2 & 255u) << 16) | ((unsigned)q3 << 24); }
            *(v4u*)(T8 + (size_t)(R0 + r) * DM + 16 * C.lane) = o;
            if (C.lane == 0) TS[R0 + r] = inv;
        }
    }
}
constexpr size_t WS_NL = 3 * MiB, WS_NP = WS_NL + 512 * 1024;
constexpr size_t WS_GC = WS_MOD + 512 * 1024, WS_ML = WS_GC + 4096, WS_MP = WS_ML + 4096;
constexpr size_t OUT_SL = 0, OUT_SP = 64 * MiB;
typedef float f32x16 __attribute__((ext_vector_type(16)));
typedef short s16x4 __attribute__((ext_vector_type(4)));
__device__ __forceinline__ unsigned offb(unsigned row, unsigned ch) { return 256u * row + 16u * (ch ^ (((row & 3u) << 2) | ((row >> 2) & 3u))); }
__device__ __forceinline__ s16x4 tr_read4(unsigned lds_addr) { s16x4 r; asm volatile("ds_read_b64_tr_b16 %0, %1\n\ts_waitcnt lgkmcnt(0)" : "=&v"(r) : "v"(lds_addr) : "memory"); return r; }
__device__ __forceinline__ void tr_read4x2(s16x4& r0, s16x4& r1, unsigned a0, unsigned a1) {
    asm volatile("ds_read_b64_tr_b16 %0, %2\n\tds_read_b64_tr_b16 %1, %3\n\ts_waitcnt lgkmcnt(0)" : "=&v"(r0), "=&v"(r1) : "v"(a0), "v"(a1) : "memory"); }
__device__ __forceinline__ void tr_read4x6(s16x4 (&r)[6], unsigned a0, unsigned a1, unsigned a2, unsigned a3, unsigned a4, unsigned a5) {
    asm volatile("ds_read_b64_tr_b16 %0, %6\n\tds_read_b64_tr_b16 %1, %7\n\tds_read_b64_tr_b16 %2, %8\n\tds_read_b64_tr_b16 %3, %9\n\tds_read_b64_tr_b16 %4, %10\n\tds_read_b64_tr_b16 %5, %11\n\ts_waitcnt lgkmcnt(0)"
                 : "=&v"(r[0]), "=&v"(r[1]), "=&v"(r[2]), "=&v"(r[3]), "=&v"(r[4]), "=&v"(r[5]) : "v"(a0), "v"(a1), "v"(a2), "v"(a3), "v"(a4), "v"(a5) : "memory"); }
__device__ __forceinline__ void tr_read4x8(s16x4 (&r)[8], unsigned a0, unsigned a1, unsigned a2, unsigned a3, unsigned a4, unsigned a5, unsigned a6, unsigned a7) {
    asm volatile("ds_read_b64_tr_b16 %0, %8\n\tds_read_b64_tr_b16 %1, %9\n\tds_read_b64_tr_b16 %2, %10\n\tds_read_b64_tr_b16 %3, %11\n\tds_read_b64_tr_b16 %4, %12\n\tds_read_b64_tr_b16 %5, %13\n\tds_read_b64_tr_b16 %6, %14\n\tds_read_b64_tr_b16 %7, %15\n\ts_waitcnt lgkmcnt(0)"
                 : "=&v"(r[0]), "=&v"(r[1]), "=&v"(r[2]), "=&v"(r[3]), "=&v"(r[4]), "=&v"(r[5]), "=&v"(r[6]), "=&v"(r[7]) : "v"(a0), "v"(a1), "v"(a2), "v"(a3), "v"(a4), "v"(a5), "v"(a6), "v"(a7) : "memory"); }
__device__ __forceinline__ float scan_sum64(float v, int lane) {
#pragma unroll
    for (int o = 1; o < 64; o <<= 1) { const float t = __shfl_up(v, o); if (lane >= o) v += t; }
    return v;
}
__device__ __forceinline__ float scan_max64(float v, int lane) {
#pragma unroll
    for (int o = 1; o < 64; o <<= 1) { const float t = __shfl_up(v, o); if (lane >= o) v = fmaxf(v, t); }
    return v;
}
__device__ __forceinline__ pg8::bf16x8 mk_frag(s16x4 a, s16x4 b) { return (pg8::bf16x8){a[0], a[1], a[2], a[3], b[0], b[1], b[2], b[3]}; }

__device__ __forceinline__ void phase_mlstm_local(const Ctx& C, const Args& A) {
    const bf16* P = (const bf16*)(A.ws + WS_BIG);
    const float* LF = (const float*)(A.ws + WS_LF); const float* LI = (const float*)(A.ws + WS_LI);
    bf16* SL = (bf16*)((unsigned char*)A.out + OUT_SL); float* NL = (float*)(A.ws + WS_NL);
    float* GC = (float*)(A.ws + WS_GC); float* ML = (float*)(A.ws + WS_ML);
    LAS unsigned char* tK = C.lds; LAS unsigned char* tV = C.lds + 32768; LAS float* wtab = (LAS float*)(C.lds + 65536);
    const unsigned ldsK = (unsigned)(uintptr_t)tK, ldsV = (unsigned)(uintptr_t)tV;
    const int lane = C.lane, wid = C.wave, tid = C.tid;
    for (int unit = C.bid; unit < 1024; unit += C.G) {
        const int bh = unit >> 5, c = unit & 31, b = bh >> 2, hh = bh & 3;
        const size_t tok0 = (size_t)b * SEQ + c * 128;
        if (wid == 0) {
            const float2 lf = *(const float2*)(LF + (size_t)bh * SEQ + c * 128 + 2 * lane), li = *(const float2*)(LI + (size_t)bh * SEQ + c * 128 + 2 * lane);
            const float pr = lf.x + lf.y, inc = scan_sum64(pr, lane), ex = inc - pr;
            const float b0 = ex + lf.x, b1 = b0 + lf.y;
            const float g = __shfl(inc, 63);
            const float a0 = g - b0 + li.x, a1 = g - b1 + li.y;
            const float mloc = wave_max(fmaxf(a0, a1));
            wtab[2 * lane] = __expf(a0 - mloc); wtab[2 * lane + 1] = __expf(a1 - mloc);
            if (lane == 0) { GC[unit] = g; ML[unit] = mloc; }
        }
        __syncthreads();
#pragma unroll
        for (int i = 0; i < 4; ++i) { const int id = tid + 512 * i, row = id >> 4, ch = id & 15;
            const bf16* src = P + (tok0 + row) * INP + hh * 128 + ch * 8;
            const v4u kv = *(const v4u*)(src + 512), vv = *(const v4u*)(src + 1024);
            const float w = wtab[row];
            v4u ko; ko.x = pk2(bflo(kv.x) * w, bfhi(kv.x) * w); ko.y = pk2(bflo(kv.y) * w, bfhi(kv.y) * w); ko.z = pk2(bflo(kv.z) * w, bfhi(kv.z) * w); ko.w = pk2(bflo(kv.w) * w, bfhi(kv.w) * w);
            *(LAS v4u*)(tK + offb(row, ch)) = ko; *(LAS v4u*)(tV + offb(row, ch)) = vv; }
        __syncthreads();
        if (tid < 128) { const int d = tid; float s = 0.f;
#pragma unroll 8
            for (int l = 0; l < 128; ++l) s += bf2f(*(const LAS unsigned short*)(tK + offb(l, d >> 3) + (d & 7) * 2));
            NL[(size_t)unit * 128 + d] = s; }
        {
            const int db = wid & 3, eh = wid >> 2;
            const unsigned h = lane >> 5, blk = (lane >> 4) & 1, q = (lane & 15) >> 2, p = lane & 3;
            f32x16 acc[2];
#pragma unroll
            for (int eb = 0; eb < 2; ++eb)
#pragma unroll
                for (int r = 0; r < 16; ++r) acc[eb][r] = 0.f;
#pragma unroll
            for (int ks = 0; ks < 8; ++ks) {
                const unsigned r0 = 16 * ks + 8 * h + q, cA = 4 * db + 2 * blk + (p >> 1), cB0 = 4 * (2 * eh) + 2 * blk + (p >> 1), cB1 = cB0 + 4, po = 8 * (p & 1);
                s16x4 t[6];
                tr_read4x6(t, ldsK + offb(r0, cA) + po, ldsK + offb(r0 + 4, cA) + po, ldsV + offb(r0, cB0) + po, ldsV + offb(r0 + 4, cB0) + po, ldsV + offb(r0, cB1) + po, ldsV + offb(r0 + 4, cB1) + po);
                const pg8::bf16x8 af = mk_frag(t[0], t[1]);
                acc[0] = __builtin_amdgcn_mfma_f32_32x32x16_bf16(af, mk_frag(t[2], t[3]), acc[0], 0, 0, 0);
                acc[1] = __builtin_amdgcn_mfma_f32_32x32x16_bf16(af, mk_frag(t[4], t[5]), acc[1], 0, 0, 0);
            }
            const int hi = lane >> 5;
#pragma unroll
            for (int eb = 0; eb < 2; ++eb) { const int e = 32 * (2 * eh + eb) + (lane & 31);
#pragma unroll
                for (int g4 = 0; g4 < 4; ++g4) { uint2 o; o.x = pk2(acc[eb][4 * g4], acc[eb][4 * g4 + 1]); o.y = pk2(acc[eb][4 * g4 + 2], acc[eb][4 * g4 + 3]);
                    *(uint2*)(SL + ((size_t)unit * 128 + e) * 128 + 32 * db + 8 * g4 + 4 * hi) = o; } }
        }
        __syncthreads();
    }
}

__device__ __forceinline__ void phase_mlstm_scan(const Ctx& C, const Args& A) {
    const bf16* SL = (const bf16*)((unsigned char*)A.out + OUT_SL); bf16* SP = (bf16*)((unsigned char*)A.out + OUT_SP);
    const float* NL = (const float*)(A.ws + WS_NL); float* NP = (float*)(A.ws + WS_NP);
    const float* GC = (const float*)(A.ws + WS_GC); const float* ML = (const float*)(A.ws + WS_ML); float* MP = (float*)(A.ws + WS_MP);
    for (long it = C.gt; it < 32L * 128 * 32; it += C.NGT) {
        const int d4 = (int)(it & 31), e = (int)((it >> 5) & 127), bh = (int)(it >> 12);
        f32x4 s = {0.f, 0.f, 0.f, 0.f}, n = {0.f, 0.f, 0.f, 0.f}; float m = 0.f;
        const bool do_n = (e == 0);
#pragma unroll 4
        for (int c = 0; c < 32; ++c) {
            const size_t unit = (size_t)bh * 32 + c;
            uint2 o; o.x = pk2(s.x, s.y); o.y = pk2(s.z, s.w);
            *(uint2*)(SP + (unit * 128 + e) * 128 + 4 * d4) = o;
            if (do_n) { *(f32x4*)(NP + unit * 128 + 4 * d4) = n; if (d4 == 0) MP[unit] = m; }
            const float g = GC[unit], ml = ML[unit];
            const float mn = fmaxf(g + m, ml), dec = __expf(g + m - mn), sc = __expf(ml - mn);
            const uint2 xw = *(const uint2*)(SL + (unit * 128 + e) * 128 + 4 * d4); const f32x4 x = {bflo(xw.x), bfhi(xw.x), bflo(xw.y), bfhi(xw.y)};
            s = s * dec + x * sc;
            if (do_n) { const f32x4 y = *(const f32x4*)(NL + unit * 128 + 4 * d4); n = n * dec + y * sc; }
            m = mn;
        }
    }
}

__device__ __forceinline__ void phase_mlstm_out(const Ctx& C, const Args& A) {
    const bf16* P = (const bf16*)(A.ws + WS_BIG); bf16* mix = (bf16*)(A.ws + WS_H);
    const float* LF = (const float*)(A.ws + WS_LF); const float* LI = (const float*)(A.ws + WS_LI);
    const bf16* SP = (const bf16*)((unsigned char*)A.out + OUT_SP); const float* NP = (const float*)(A.ws + WS_NP); const float* MP = (const float*)(A.ws + WS_MP);
    const float* gain = A.in[9];
    LAS unsigned char* tV = C.lds; LAS float* abt = (LAS float*)(C.lds + 65536); LAS float* Mt = abt + 128; LAS float* bt = abt + 256; LAS float* npt = abt + 384; LAS float* ssq = abt + 512;
    const unsigned ldsV = (unsigned)(uintptr_t)tV;
    const int lane = C.lane, wid = C.wave, tid = C.tid, hi = lane >> 5, l31 = lane & 31;
    constexpr float QS = 0.08838834764831845f;
    for (int unit = C.bid; unit < 1024; unit += C.G) {
        const int bh = unit >> 5, c = unit & 31, b = bh >> 2, hh = bh & 3;
        const size_t tok0 = (size_t)b * SEQ + c * 128;
        const float mprev = MP[unit];
        if (wid == 0) {
            const float2 lf = *(const float2*)(LF + (size_t)bh * SEQ + c * 128 + 2 * lane), li = *(const float2*)(LI + (size_t)bh * SEQ + c * 128 + 2 * lane);
            const float pr = lf.x + lf.y, inc = scan_sum64(pr, lane), ex = inc - pr;
            const float b0 = ex + lf.x, b1 = b0 + lf.y;
            const float ab0 = li.x - b0, ab1 = li.y - b1;
            const float pmx = scan_max64(fmaxf(ab0, ab1), lane);
            float pme = __shfl_up(pmx, 1); if (lane == 0) pme = -INFINITY;
            const float pm0 = fmaxf(pme, ab0), pm1 = fmaxf(pm0, ab1);
            abt[2 * lane] = ab0; abt[2 * lane + 1] = ab1; bt[2 * lane] = b0; bt[2 * lane + 1] = b1;
            Mt[2 * lane] = fmaxf(mprev, pm0); Mt[2 * lane + 1] = fmaxf(mprev, pm1);
        }
        if (wid == 1) { npt[2 * lane] = NP[(size_t)unit * 128 + 2 * lane]; npt[2 * lane + 1] = NP[(size_t)unit * 128 + 2 * lane + 1]; }
#pragma unroll
        for (int i = 0; i < 4; ++i) { const int id = tid + 512 * i, row = id >> 4, ch = id & 15;
            *(LAS v4u*)(tV + offb(row, ch)) = *(const v4u*)(P + (tok0 + row) * INP + 1024 + hh * 128 + ch * 8); }
        __syncthreads();
        const int lb = wid & 3, eh = wid >> 2;
        const int l = 32 * lb + l31;
        const float Ml = Mt[l], iw = __expf(mprev - Ml) * QS;
        pg8::bf16x8 qf[8];
#pragma unroll
        for (int ks = 0; ks < 8; ++ks) qf[ks] = *(const pg8::bf16x8*)(P + (tok0 + l) * INP + hh * 128 + 16 * ks + 8 * hi);
        float qn = 0.f;
#pragma unroll
        for (int ks = 0; ks < 8; ++ks)
#pragma unroll
            for (int j = 0; j < 8; ++j) qn += bf2f((unsigned short)qf[ks][j]) * npt[16 * ks + 8 * hi + j];
        qn += __shfl_xor(qn, 32);
        f32x16 acc[2];
#pragma unroll
        for (int eb = 0; eb < 2; ++eb) {
#pragma unroll
            for (int r = 0; r < 16; ++r) acc[eb][r] = 0.f;
            const bf16* sp = SP + ((size_t)unit * 128 + 32 * (2 * eh + eb) + l31) * 128 + 8 * hi;
#pragma unroll
            for (int ks = 0; ks < 8; ++ks) acc[eb] = __builtin_amdgcn_mfma_f32_32x32x16_bf16(*(const pg8::bf16x8*)(sp + 16 * ks), qf[ks], acc[eb], 0, 0, 0);
#pragma unroll
            for (int r = 0; r < 16; ++r) acc[eb][r] *= iw;
        }
        float den = 0.f;
        const unsigned g16 = lane >> 4, blk = g16 & 1, q = (lane & 15) >> 2, p = lane & 3;
        for (int sb = 0; sb <= lb; ++sb) {
            f32x16 X;
#pragma unroll
            for (int r = 0; r < 16; ++r) X[r] = 0.f;
            const bf16* kp = P + (tok0 + 32 * sb + l31) * INP + 512 + hh * 128 + 8 * hi;
#pragma unroll
            for (int ks = 0; ks < 8; ++ks) X = __builtin_amdgcn_mfma_f32_32x32x16_bf16(*(const pg8::bf16x8*)(kp + 16 * ks), qf[ks], X, 0, 0, 0);
            float pv[16];
#pragma unroll
            for (int r = 0; r < 16; ++r) { const int s = 32 * sb + (r & 3) + 8 * (r >> 2) + 4 * hi;
                const float v = X[r] * QS * __expf(abt[s] - Ml);
                pv[r] = (s <= l) ? v : 0.f; den += pv[r]; }
            pg8::bf16x8 pf[2];
#pragma unroll
            for (int st = 0; st < 2; ++st) { v4u t; t.x = pk2(pv[8 * st], pv[8 * st + 1]); t.y = pk2(pv[8 * st + 2], pv[8 * st + 3]); t.z = pk2(pv[8 * st + 4], pv[8 * st + 5]); t.w = pk2(pv[8 * st + 6], pv[8 * st + 7]);
                pf[st] = __builtin_bit_cast(pg8::bf16x8, t); }
            { const unsigned c0 = 4 * (2 * eh) + 2 * blk + (p >> 1), c1 = c0 + 4, ra = 32 * sb + 4 * hi + q, po = 8 * (p & 1);
              s16x4 t[8];
              tr_read4x8(t, ldsV + offb(ra, c0) + po, ldsV + offb(ra + 8, c0) + po, ldsV + offb(ra + 16, c0) + po, ldsV + offb(ra + 24, c0) + po,
                            ldsV + offb(ra, c1) + po, ldsV + offb(ra + 8, c1) + po, ldsV + offb(ra + 16, c1) + po, ldsV + offb(ra + 24, c1) + po);
#pragma unroll
              for (int eb = 0; eb < 2; ++eb)
#pragma unroll
                  for (int st = 0; st < 2; ++st) acc[eb] = __builtin_amdgcn_mfma_f32_32x32x16_bf16(mk_frag(t[4 * eb + 2 * st], t[4 * eb + 2 * st + 1]), pf[st], acc[eb], 0, 0, 0); }
        }
        den += __shfl_xor(den, 32);
        den += iw * qn;
        const float dn = 1.f / fmaxf(fabsf(den), __expf(-(bt[l] + Ml)));
        float ss = 0.f;
#pragma unroll
        for (int eb = 0; eb < 2; ++eb)
#pragma unroll
            for (int r = 0; r < 16; ++r) { acc[eb][r] *= dn; ss += acc[eb][r] * acc[eb][r]; }
        ss += __shfl_xor(ss, 32);
        if (hi == 0) ssq[eh * 128 + l] = ss;
        __syncthreads();
        const float rstd = rsqrtf((ssq[l] + ssq[128 + l]) * (1.f / 128.f) + EPS);
#pragma unroll
        for (int eb = 0; eb < 2; ++eb)
#pragma unroll
            for (int g4 = 0; g4 < 4; ++g4) { const int e = 32 * (2 * eh + eb) + 8 * g4 + 4 * hi;
                const uint2 ow = *(const uint2*)(P + (tok0 + l) * INP + 1536 + hh * 128 + e);
                const f32x4 gn = *(const f32x4*)(gain + hh * 128 + e);
                uint2 o; o.x = pk2(acc[eb][4 * g4] * rstd * gn.x * sigmoidf_(bflo(ow.x)), acc[eb][4 * g4 + 1] * rstd * gn.y * sigmoidf_(bfhi(ow.x)));
                o.y = pk2(acc[eb][4 * g4 + 2] * rstd * gn.z * sigmoidf_(bflo(ow.y)), acc[eb][4 * g4 + 3] * rstd * gn.w * sigmoidf_(bfhi(ow.y)));
                *(uint2*)(mix + (tok0 + l) * DM + hh * 128 + e) = o; }
        __syncthreads();
    }
}
template <bool I8>
struct EpiQKV {
    static constexpr bool PERM = true, AFTER_DRAIN = false;
    bf16* O; bf16* KF; bf16* VH; const float* qg; const float* kg; const float* sa; const float* sw;
    __device__ __forceinline__ void operator()(const typename pg8::AccSel<I8>::type (&acc)[2][2][4][2], const pg8::Unit& u, int wr, int wc, int fr, int fq) const {
        using pg8::f32x4;
        f32x4 cs[2][2];
#pragma unroll
        for (int bj = 0; bj < 2; ++bj)
#pragma unroll
            for (int n = 0; n < 2; ++n) cs[bj][n] = I8 ? *(const f32x4*)(sw + u.pn * 256 + 128 * bj + 32 * wc + 8 * fq + 4 * n) : (f32x4){1.f, 1.f, 1.f, 1.f};
        const int kind = u.pn >> 2;
        const float* gp = (kind == 0) ? qg : kg;
        const float post = (kind == 0) ? 0.125f * 1.4426950408889634f : 1.0f;
        f32x4 gv[2][2];
#pragma unroll
        for (int bj = 0; bj < 2; ++bj)
#pragma unroll
            for (int n = 0; n < 2; ++n) gv[bj][n] = (kind < 2) ? *(const f32x4*)(gp + 32 * bj + 8 * fq + 4 * n) * post : (f32x4){1.f, 1.f, 1.f, 1.f};
#pragma unroll
        for (int ai = 0; ai < 2; ++ai)
#pragma unroll
            for (int m = 0; m < 4; ++m) {
                const int row = u.pm * 256 + ai * 128 + wr * 64 + m * 16 + fr;
                f32x4 xv[2][2]; float ss = 0.f;
                { const float rsc = I8 ? sa[row] : 1.f;
#pragma unroll
                  for (int bj = 0; bj < 2; ++bj)
#pragma unroll
                      for (int n = 0; n < 2; ++n) { const auto a = acc[ai][bj][m][n]; const f32x4 x = (f32x4){(float)a[0], (float)a[1], (float)a[2], (float)a[3]} * cs[bj][n] * rsc; xv[bj][n] = x;
                          ss += (x[0] * x[0] + x[1] * x[1]) + (x[2] * x[2] + x[3] * x[3]); } }
                ss += __shfl_xor(ss, 16); ss += __shfl_xor(ss, 32);
                const float rs = (kind < 2) ? rsqrtf(ss * (1.f / 64.f) + EPS) : 1.0f;
                bf16* dst = (kind == 1) ? KF + ((size_t)(((row >> 12) * 16 + (u.pn - 4) * 4 + wc) * 128 + ((row & 4095) >> 5)) * 2048 + (size_t)((fq >> 1) * 512 + ((fq & 1) * 32 + (row & 31)) * 8))
                                        : (kind == 2) ? VH + ((size_t)(((row >> 12) * 16 + (u.pn & 3) * 4 + wc) * 4096 + (row & 4095)) * 64 + 8 * fq)
                                        : O + (size_t)row * 1024 + (u.pn & 3) * 256 + 64 * wc + 8 * fq;
                const int bjstep = (kind == 1) ? 1024 : 32;
#pragma unroll
                for (int bj = 0; bj < 2; ++bj) { const f32x4 v0 = xv[bj][0] * gv[bj][0] * rs, v1 = xv[bj][1] * gv[bj][1] * rs;
                    v4u w; w.x = pk2(v0[0], v0[1]); w.y = pk2(v0[2], v0[3]); w.z = pk2(v1[0], v1[1]); w.w = pk2(v1[2], v1[3]);
                    *(v4u*)(dst + bjstep * bj) = w; }
            }
    }
};

__device__ __forceinline__ unsigned voff(unsigned row, unsigned ch) { return row * 128u + 16u * (ch ^ (row & 7u)); }
__device__ __forceinline__ void phase_attn(const Ctx& C, const Args& A) {
    const bf16* QV = (const bf16*)(A.ws + WS_BIG); const bf16* KF = (const bf16*)(A.ws + WS_BIG + 64 * MiB); const bf16* VH = (const bf16*)(A.ws + WS_BIG + 128 * MiB); bf16* O = (bf16*)(A.ws + WS_H);
    LAS unsigned char* tV = C.lds + C.wave * 4096;
    const unsigned ldsV = (unsigned)(uintptr_t)tV;
    const int lane = C.lane, hi = lane >> 5, l31 = lane & 31;
    const unsigned blk = (lane >> 4) & 1, q4 = (lane & 15) >> 2, p = lane & 3;
    const int per_wave = (16384 + C.NGW - 1) / C.NGW;
    for (int u = C.gw * per_wave; u < C.gw * per_wave + per_wave; ++u) {
        if (u >= 16384) break;
        const int bh = u >> 7, qt = u & 127, b = bh >> 4, hd = bh & 15;
        const size_t tokb = (size_t)b * SEQ;
        const int l = qt * 32 + l31;
        pg8::bf16x8 qf[4];
#pragma unroll
        for (int ks = 0; ks < 4; ++ks) qf[ks] = *(const pg8::bf16x8*)(QV + (tokb + l) * 1024 + hd * 64 + 16 * ks + 8 * hi);
        f32x16 acc[2];
#pragma unroll
        for (int eb = 0; eb < 2; ++eb)
#pragma unroll
            for (int r = 0; r < 16; ++r) acc[eb][r] = 0.f;
        float carry = 1.f;
        pg8::bf16x8 kf[4]; v4u vv[4];
#define ATT_LOAD(kt_) { const size_t s0_ = tokb + (size_t)(kt_) * 32; const bf16* kp_ = KF + ((size_t)(bh * 128 + (kt_)) * 2048 + lane * 8); \
            _Pragma("unroll") for (int ks = 0; ks < 4; ++ks) kf[ks] = *(const pg8::bf16x8*)(kp_ + ks * 512); \
            _Pragma("unroll") for (int i = 0; i < 4; ++i) { const int id = lane + 64 * i; vv[i] = *(const v4u*)(VH + ((size_t)bh * 4096 + (size_t)(kt_) * 32) * 64 + id * 8); } }
        ATT_LOAD(qt)
        for (int kt = qt; kt >= 0; --kt) {
            f32x16 X;
#pragma unroll
            for (int r = 0; r < 16; ++r) X[r] = 0.f;
#pragma unroll
            for (int ks = 0; ks < 4; ++ks) X = __builtin_amdgcn_mfma_f32_32x32x16_bf16(kf[ks], qf[ks], X, 0, 0, 0);
#pragma unroll
            for (int i = 0; i < 4; ++i) { const int id = lane + 64 * i; *(LAS v4u*)(tV + voff(id >> 3, id & 7)) = vv[i]; }
            if (kt > 0) ATT_LOAD(kt - 1)
            const int sbase = kt * 32 + 4 * hi;
            float rr[16];
#pragma unroll
            for (int r = 0; r < 16; ++r) rr[r] = __builtin_amdgcn_rcpf(1.f + __builtin_amdgcn_exp2f(X[r]));
            if (kt == qt) {
#pragma unroll
                for (int r = 0; r < 16; ++r) { const int s = sbase + (r & 3) + 8 * (r >> 2); rr[r] = (s < l) ? rr[r] : 1.f; }
            }
            float To[4], Tp[4];
#pragma unroll
            for (int g = 0; g < 4; ++g) { To[g] = (rr[4 * g] * rr[4 * g + 1]) * (rr[4 * g + 2] * rr[4 * g + 3]); Tp[g] = __shfl_xor(To[g], 32); }
            float base[4]; float run = 1.f;
#pragma unroll
            for (int g = 3; g >= 0; --g) { base[g] = carry * run * (hi == 0 ? Tp[g] : 1.f); run *= To[g] * Tp[g]; }
            float att[16];
#pragma unroll
            for (int g = 0; g < 4; ++g) { float w = base[g];
#pragma unroll
                for (int i = 3; i >= 0; --i) { const int r = 4 * g + i; att[r] = (1.f - rr[r]) * w; w *= rr[r]; } }
            carry *= run;
            pg8::bf16x8 pf[2];
#pragma unroll
            for (int st = 0; st < 2; ++st) { v4u t; t.x = pg8::cvt_pk_bf16(att[8 * st], att[8 * st + 1]); t.y = pg8::cvt_pk_bf16(att[8 * st + 2], att[8 * st + 3]); t.z = pg8::cvt_pk_bf16(att[8 * st + 4], att[8 * st + 5]); t.w = pg8::cvt_pk_bf16(att[8 * st + 6], att[8 * st + 7]);
                pf[st] = __builtin_bit_cast(pg8::bf16x8, t); }
            s16x4 vf[8];
            { const unsigned a0 = ldsV + voff(4 * hi + q4, 2 * blk + (p >> 1)) + 8 * (p & 1), a1 = ldsV + voff(4 * hi + q4 + 8, 2 * blk + (p >> 1)) + 8 * (p & 1);
              const unsigned a2 = ldsV + voff(16 + 4 * hi + q4, 2 * blk + (p >> 1)) + 8 * (p & 1), a3 = ldsV + voff(24 + 4 * hi + q4, 2 * blk + (p >> 1)) + 8 * (p & 1);
              const unsigned a4 = ldsV + voff(4 * hi + q4, 4 + 2 * blk + (p >> 1)) + 8 * (p & 1), a5 = ldsV + voff(4 * hi + q4 + 8, 4 + 2 * blk + (p >> 1)) + 8 * (p & 1);
              const unsigned a6 = ldsV + voff(16 + 4 * hi + q4, 4 + 2 * blk + (p >> 1)) + 8 * (p & 1), a7 = ldsV + voff(24 + 4 * hi + q4, 4 + 2 * blk + (p >> 1)) + 8 * (p & 1);
              asm volatile("ds_read_b64_tr_b16 %0, %8\n\tds_read_b64_tr_b16 %1, %9\n\tds_read_b64_tr_b16 %2, %10\n\tds_read_b64_tr_b16 %3, %11\n\t"
                           "ds_read_b64_tr_b16 %4, %12\n\tds_read_b64_tr_b16 %5, %13\n\tds_read_b64_tr_b16 %6, %14\n\tds_read_b64_tr_b16 %7, %15\n\ts_waitcnt lgkmcnt(0)"
                           : "=&v"(vf[0]), "=&v"(vf[1]), "=&v"(vf[2]), "=&v"(vf[3]), "=&v"(vf[4]), "=&v"(vf[5]), "=&v"(vf[6]), "=&v"(vf[7])
                           : "v"(a0), "v"(a1), "v"(a2), "v"(a3), "v"(a4), "v"(a5), "v"(a6), "v"(a7) : "memory"); }
#pragma unroll
            for (int eb = 0; eb < 2; ++eb)
#pragma unroll
                for (int st = 0; st < 2; ++st) acc[eb] = __builtin_amdgcn_mfma_f32_32x32x16_bf16(mk_frag(vf[4 * eb + 2 * st], vf[4 * eb + 2 * st + 1]), pf[st], acc[eb], 0, 0, 0);
            if (__all(carry == 0.f)) break;
        }
#undef ATT_LOAD
#pragma unroll
        for (int eb = 0; eb < 2; ++eb)
#pragma unroll
            for (int g4 = 0; g4 < 4; ++g4) { const u32x2 o = {pk2(acc[eb][4 * g4], acc[eb][4 * g4 + 1]), pk2(acc[eb][4 * g4 + 2], acc[eb][4 * g4 + 3])};
                const unsigned c8 = (unsigned)(8 * eb + 2 * g4 + hi);
                *(LAS u32x2*)(tV + l31 * 128 + ((c8 ^ ((unsigned)(l31 & 7) << 1)) << 3)) = o; }
        asm volatile("s_waitcnt lgkmcnt(0)" ::: "memory");
#pragma unroll
        for (int i = 0; i < 4; ++i) { const int id = lane + 64 * i, rr = id >> 3, q = id & 7;
            const v4u w = *(const LAS v4u*)(tV + rr * 128 + (((unsigned)(2 * q) ^ ((unsigned)(rr & 7) << 1)) << 3));
            *(v4u*)(O + (tokb + qt * 32 + rr) * DM + hd * 64 + 8 * q) = w; }
        asm volatile("s_waitcnt lgkmcnt(0)" ::: "memory");
    }
}

__device__ __forceinline__ void phase_attn_ring(const Ctx& C, const Args& A) {
    const bf16* QV = (const bf16*)(A.ws + WS_BIG); const bf16* KF = (const bf16*)(A.ws + WS_BIG + 64 * MiB); const bf16* VH = (const bf16*)(A.ws + WS_BIG + 128 * MiB); bf16* O = (bf16*)(A.ws + WS_H);
    LAS unsigned char* ring = C.lds;
    LAS unsigned char* tV = C.lds + (C.wave < 4 ? 114688 + C.wave * 4096 : 147456 + (C.wave - 4) * 4096);
    const unsigned ldsR = (unsigned)(uintptr_t)ring, ldsP = (unsigned)(uintptr_t)tV;
    const int lane = C.lane, hi = lane >> 5, l31 = lane & 31;
    const unsigned blk = (lane >> 4) & 1, q4 = (lane & 15) >> 2, p = lane & 3;
    const unsigned trA = voff(4 * hi + q4, 2 * blk + (p >> 1)) + 8 * (p & 1), trB = voff(4 * hi + q4, 4 + 2 * blk + (p >> 1)) + 8 * (p & 1);
    const int nblk = C.G, per = (2048 + nblk - 1) / nblk;
    const int bu_lo = C.bid * per, bu_hi = (bu_lo + per < 2048) ? bu_lo + per : 2048;
    if (bu_lo >= bu_hi) return;
    const int cidx = C.tid & 255; const bool isV = C.tid >= 256;
    const bf16* srcb = (isV ? VH : KF) + cidx * 8;
    const unsigned dstoff = isV ? 4096u + voff((unsigned)cidx >> 3, (unsigned)cidx & 7) : (unsigned)cidx * 16u;
    pg8::bf16x8 qf[4];
    {
        const int bh = bu_lo >> 4, G = bu_lo & 15;
        for (int t = 8 * G - 6; t <= 8 * G + 7; ++t) if (t >= 0) { const v4u w = *(const v4u*)(srcb + (size_t)(bh * 128 + t) * 2048); *(LAS v4u*)(ring + (t % 14) * 8192 + dstoff) = w; }
        const int qt = 8 * G + C.wave; const size_t row = (size_t)(bh >> 4) * SEQ + qt * 32 + l31;
#pragma unroll
        for (int ks = 0; ks < 4; ++ks) qf[ks] = *(const pg8::bf16x8*)(QV + row * 1024 + (bh & 15) * 64 + 16 * ks + 8 * hi);
    }
    __syncthreads();
    for (int bu = bu_lo; bu < bu_hi; ++bu) {
        const int bh = bu >> 4, G = bu & 15, b = bh >> 4, hd = bh & 15;
        const int qt = 8 * G + C.wave;
        const size_t tokb = (size_t)b * SEQ;
        const int l = qt * 32 + l31;
        const bool more = bu + 1 < bu_hi; const int nbh = (bu + 1) >> 4, nG = (bu + 1) & 15;
        v4u st[8]; pg8::bf16x8 qn[4];
        if (more) {
#pragma unroll
            for (int i = 0; i < 8; ++i) st[i] = *(const v4u*)(srcb + (size_t)(nbh * 128 + 8 * nG + i) * 2048);
            const size_t row = (size_t)(nbh >> 4) * SEQ + (8 * nG + C.wave) * 32 + l31;
#pragma unroll
            for (int ks = 0; ks < 4; ++ks) qn[ks] = *(const pg8::bf16x8*)(QV + row * 1024 + (nbh & 15) * 64 + 16 * ks + 8 * hi);
        }
        f32x16 acc[2];
#pragma unroll
        for (int eb = 0; eb < 2; ++eb)
#pragma unroll
            for (int r = 0; r < 16; ++r) acc[eb][r] = 0.f;
        float carry = 1.f;
        const int lowt = (8 * G - 6 > 0) ? 8 * G - 6 : 0;
        int slot = qt % 14;
        pg8::bf16x8 kf[4];
#define ATT_KLOAD(kt_, slot_) { if ((kt_) >= lowt) { const LAS unsigned char* sp_ = ring + (slot_) * 8192 + lane * 16; \
                _Pragma("unroll") for (int ks = 0; ks < 4; ++ks) kf[ks] = *(const LAS pg8::bf16x8*)(sp_ + ks * 1024); } \
            else { const bf16* kp_ = KF + ((size_t)(bh * 128 + (kt_)) * 2048 + lane * 8); \
                _Pragma("unroll") for (int ks = 0; ks < 4; ++ks) kf[ks] = *(const pg8::bf16x8*)(kp_ + ks * 512); } }
        ATT_KLOAD(qt, slot)
        for (int kt = qt; kt >= 0; --kt) {
            unsigned vb;
            if (kt >= lowt) vb = ldsR + (unsigned)slot * 8192u + 4096u;
            else {
#pragma unroll
                for (int i = 0; i < 4; ++i) { const int id = lane + 64 * i; const v4u w = *(const v4u*)(VH + ((size_t)bh * 4096 + (size_t)kt * 32) * 64 + id * 8); *(LAS v4u*)(tV + voff(id >> 3, id & 7)) = w; }
                vb = ldsP;
            }
            slot = slot == 0 ? 13 : slot - 1;
            f32x16 X;
#pragma unroll
            for (int r = 0; r < 16; ++r) X[r] = 0.f;
#pragma unroll
            for (int ks = 0; ks < 4; ++ks) X = __builtin_amdgcn_mfma_f32_32x32x16_bf16(kf[ks], qf[ks], X, 0, 0, 0);
            if (kt > 0) ATT_KLOAD(kt - 1, slot)
            s16x4 vf[8];
            { const unsigned a0 = vb + trA, a4 = vb + trB;
              asm volatile("ds_read_b64_tr_b16 %0, %8\n\tds_read_b64_tr_b16 %1, %8 offset:1024\n\tds_read_b64_tr_b16 %2, %8 offset:2048\n\tds_read_b64_tr_b16 %3, %8 offset:3072\n\t"
                           "ds_read_b64_tr_b16 %4, %9\n\tds_read_b64_tr_b16 %5, %9 offset:1024\n\tds_read_b64_tr_b16 %6, %9 offset:2048\n\tds_read_b64_tr_b16 %7, %9 offset:3072\n\ts_waitcnt lgkmcnt(0)"
                           : "=&v"(vf[0]), "=&v"(vf[1]), "=&v"(vf[2]), "=&v"(vf[3]), "=&v"(vf[4]), "=&v"(vf[5]), "=&v"(vf[6]), "=&v"(vf[7])
                           : "v"(a0), "v"(a4) : "memory"); }
            const int sbase = kt * 32 + 4 * hi;
            float rr[16];
#pragma unroll
            for (int r = 0; r < 16; ++r) rr[r] = __builtin_amdgcn_rcpf(1.f + __builtin_amdgcn_exp2f(X[r]));
            if (kt == qt) {
#pragma unroll
                for (int r = 0; r < 16; ++r) { const int s = sbase + (r & 3) + 8 * (r >> 2); rr[r] = (s < l) ? rr[r] : 1.f; }
            }
            float To[4], Tp[4];
#pragma unroll
            for (int g = 0; g < 4; ++g) { To[g] = (rr[4 * g] * rr[4 * g + 1]) * (rr[4 * g + 2] * rr[4 * g + 3]); const auto sw_ = __builtin_amdgcn_permlane32_swap(__float_as_uint(To[g]), __float_as_uint(To[g]), false, false); Tp[g] = __uint_as_float(hi ? sw_[0] : sw_[1]); }
            float base[4]; float run = 1.f;
#pragma unroll
            for (int g = 3; g >= 0; --g) { base[g] = carry * run * (hi == 0 ? Tp[g] : 1.f); run *= To[g] * Tp[g]; }
            float att[16];
#pragma unroll
            for (int g = 0; g < 4; ++g) { float w = base[g];
#pragma unroll
                for (int i = 3; i >= 0; --i) { const int r = 4 * g + i; att[r] = (1.f - rr[r]) * w; w *= rr[r]; } }
            carry *= run;
            pg8::bf16x8 pf[2];
#pragma unroll
            for (int st_ = 0; st_ < 2; ++st_) { v4u t; t.x = pg8::cvt_pk_bf16(att[8 * st_], att[8 * st_ + 1]); t.y = pg8::cvt_pk_bf16(att[8 * st_ + 2], att[8 * st_ + 3]); t.z = pg8::cvt_pk_bf16(att[8 * st_ + 4], att[8 * st_ + 5]); t.w = pg8::cvt_pk_bf16(att[8 * st_ + 6], att[8 * st_ + 7]);
                pf[st_] = __builtin_bit_cast(pg8::bf16x8, t); }
#pragma unroll
            for (int eb = 0; eb < 2; ++eb)
#pragma unroll
                for (int st_ = 0; st_ < 2; ++st_) acc[eb] = __builtin_amdgcn_mfma_f32_32x32x16_bf16(mk_frag(vf[4 * eb + 2 * st_], vf[4 * eb + 2 * st_ + 1]), pf[st_], acc[eb], 0, 0, 0);
            if (__all(carry == 0.f)) break;
        }
#undef ATT_KLOAD
#pragma unroll
        for (int eb = 0; eb < 2; ++eb)
#pragma unroll
            for (int g4 = 0; g4 < 4; ++g4) { const u32x2 o = {pk2(acc[eb][4 * g4], acc[eb][4 * g4 + 1]), pk2(acc[eb][4 * g4 + 2], acc[eb][4 * g4 + 3])};
                const unsigned c8 = (unsigned)(8 * eb + 2 * g4 + hi);
                *(LAS u32x2*)(tV + l31 * 128 + ((c8 ^ ((unsigned)(l31 & 7) << 1)) << 3)) = o; }
        asm volatile("s_waitcnt lgkmcnt(0)" ::: "memory");
#pragma unroll
        for (int i = 0; i < 4; ++i) { const int id = lane + 64 * i, rr_ = id >> 3, q = id & 7;
            const v4u w = *(const LAS v4u*)(tV + rr_ * 128 + (((unsigned)(2 * q) ^ ((unsigned)(rr_ & 7) << 1)) << 3));
            *(v4u*)(O + (tokb + qt * 32 + rr_) * DM + hd * 64 + 8 * q) = w; }
        __syncthreads();
        if (more) {
#pragma unroll
            for (int i = 0; i < 8; ++i) *(LAS v4u*)(ring + ((8 * nG + i) % 14) * 8192 + dstoff) = st[i];
#pragma unroll
            for (int ks = 0; ks < 4; ++ks) qf[ks] = qn[ks];
        }
        __syncthreads();
    }
}
constexpr int N_PHASES = 16;
#ifndef MK_ONE_LAUNCH
#define MK_ONE_LAUNCH 1
#endif

__global__ void __launch_bounds__(NWAVES * 64, 2) mk_fwd(Args args) {
    extern __shared__ __attribute__((aligned(16))) unsigned char lds_raw[];
    Ctx C;
    C.lds = (LAS unsigned char*)lds_raw;
    C.tid = threadIdx.x; C.lane = C.tid & 63; C.wave = __builtin_amdgcn_readfirstlane(C.tid >> 6);
    C.G = gridDim.x; C.bid = blockIdx.x;
    C.gw = C.bid * NWAVES + C.wave; C.NGW = C.G * NWAVES;
    C.gt = (long)C.bid * (NWAVES * 64) + C.tid; C.NGT = (long)C.G * (NWAVES * 64);
    unsigned char* ws = args.ws;
    volatile LAS unsigned* MISC = (volatile LAS unsigned*)(C.lds + MISC_OFF);
    for (int u = C.tid; u < (LDS_BYTES - LDSCTL_OFF) / 4; u += NWAVES * 64) ((LAS unsigned*)(C.lds + LDSCTL_OFF))[u] = 0u;
    __syncthreads();
#if MK_ONE_LAUNCH
    XcdBarrier bar = xcd_barrier_post((unsigned*)((gu32*)(ws + WS_CTL) + CW_BAR), MISC + 8);
#ifdef PROBE_DBLBAR
#define GRID_BAR() do { xcd_barrier(bar); xcd_barrier(bar); } while (0)
#else
#define GRID_BAR() xcd_barrier(bar)
#endif
#else
    (void)MISC; XcdBarrier bar; bar.bar = nullptr; bar.x = 0; bar.st = nullptr;
#define GRID_BAR() do {} while (0)
#endif
    const int lo = args.ph_lo, hi = args.ph_hi;
#define IN(k) (lo <= (k) && (k) < hi)
#ifndef PROBE_MASK
#define PROBE_MASK 0
#endif
#define PROBE_T0(k) unsigned long long pt0_ = 0; if ((PROBE_MASK >> (k)) & 1) pt0_ = __builtin_amdgcn_s_memrealtime();
#define PROBE_T1(k) if ((PROBE_MASK >> (k)) & 1) { const unsigned long long t1_ = __builtin_amdgcn_s_memrealtime(); const unsigned long long d_ = t1_ - pt0_; while (__builtin_amdgcn_s_memrealtime() - t1_ < d_) __builtin_amdgcn_s_sleep(8); }
#define SEAM(k) do { if (IN(k) && IN((k) + 1)) GRID_BAR(); } while (0)
    float* mod0 = (float*)(ws + WS_MOD); float* mod1 = mod0 + (size_t)NB * 6144;
    bf16* Hb = (bf16*)(ws + WS_H); bf16* BIG = (bf16*)(ws + WS_BIG); bf16* XB = (bf16*)(ws + WS_XB);

    const unsigned char* TAB = ws + WS_TAB; const float* TSC = (const float*)(ws + WS_TSC);
#ifdef PROBE_INSTR
    {
        unsigned xs[16]; float fs[16];
#pragma unroll
        for (int i = 0; i < 16; ++i) { xs[i] = (unsigned)(C.tid * 2654435761u + i * 40503u); fs[i] = (float)(C.tid * 7 + i) * 0.37f; }
#pragma unroll 1
        for (int it = 0; it < 4096; ++it) {
#pragma unroll
            for (int rep = 0; rep < 2; ++rep) {
#pragma unroll
                for (int i = 0; i < 16; i += 2) {
#if PROBE_INSTR == 10
                    { const unsigned a = xs[i], b = xs[i + 1]; xs[i] = a < b ? b : a; xs[i + 1] = (a < b ? a : b) + (unsigned)it; }
#elif PROBE_INSTR == 11
                    { const float a = fs[i], b = fs[i + 1]; fs[i] = fmaxf(a, b); fs[i + 1] = fminf(a, b) + 1.0f; }
#elif PROBE_INSTR == 12
                    { const unsigned a = xs[i], b = xs[i + 1]; xs[i] = a + b; xs[i + 1] = (a ^ b) + (unsigned)it; }
#endif
                }
            }
        }
        float sm = 0.f;
#pragma unroll
        for (int i = 0; i < 16; ++i) sm += fs[i] + __uint_as_float(xs[i] & 0x3fffffffu);
        if (sm == 1234.5678f) args.out[C.tid] = sm;
    }
#endif
    if (IN(0)) { PROBE_T0(0) { phase_prep(C, args); convert_tables_int8(C, args); } PROBE_T1(0) } SEAM(0);
    bf16* H8B = (bf16*)(ws + WS_IDS);
    unsigned char* W8 = (unsigned char*)args.out; float* SW = (float*)((unsigned char*)args.out + OUT_SW); float* SA = (float*)(ws + WS_SA);
    if (IN(1)) { PROBE_T0(1) { phase_rowpass<true, false, true>(C, args, args.in[0], args.in[4], mod0, 0, 1, Hb, SA);
        quantize_rows(C, (const bf16*)(ws + WS_WIN), INP, W8 + OUT_W8IN, SW + SW_IN);
        quantize_rows(C, (const bf16*)(ws + WS_WC0), 2048, W8 + OUT_W8C0, SW + SW_C0); quantize_rows(C, (const bf16*)(ws + WS_WC1), 2048, W8 + OUT_W8C1, SW + SW_C1);
        quantize_rows(C, (const bf16*)(ws + WS_WQKV), 3072, W8 + OUT_W8QKV, SW + SW_QKV); } PROBE_T1(1) } SEAM(1);
    if (IN(2)) { PROBE_T0(2) { pg8::Gemm g{Hb, (const bf16*)(W8 + OUT_W8IN), NTOK, INP, DM / 2}; pg8::StaticOrder S; S.init(NTOK, INP, C.G, C.bid);
        EpiBf16I8 E{BIG, INP, SA, SW + SW_IN};
        pg8::gemm_phase<EpiBf16I8, pg8::StaticOrder, true, true, true>(C.lds, g, S, E); } PROBE_T1(2) } SEAM(2);
    if (IN(3)) { PROBE_T0(3) { phase_mlstm_local(C, args); phase_conv(C, args); } PROBE_T1(3) } SEAM(3);
    if (IN(4)) { PROBE_T0(4) { phase_mlstm_scan(C, args); } PROBE_T1(4) } SEAM(4);
    if (IN(5)) { PROBE_T0(5) { phase_mlstm_out(C, args); } PROBE_T1(5) } SEAM(5);
    if (IN(6)) { PROBE_T0(6) { pg8::Gemm g{Hb, (const bf16*)(ws + WS_WOUT0), NTOK, DM, DM}; pg8::StaticOrder S; S.init(NTOK, DM, C.G, C.bid);
        EpiResid<false> E{args.in[0], XB, mod0 + 2 * 1024};
        pg8::gemm_phase<EpiResid<false>, pg8::StaticOrder, true, true>(C.lds, g, S, E); } PROBE_T1(6) } SEAM(6);
    if (IN(7)) { PROBE_T0(7) { phase_rowpass<false, true, true>(C, args, XB, args.in[11], mod0, 3, 4, H8B, SA); } PROBE_T1(7) } SEAM(7);
    if (IN(8)) { PROBE_T0(8) { pg8::Gemm g{H8B, (const bf16*)(W8 + OUT_W8C0), NTOK, 2048, DM / 2}; pg8::StaticOrder S; S.init(NTOK, 2048, C.G, C.bid);
        EpiBf16I8 E{BIG, 2048, SA, SW + SW_C0};
        pg8::gemm_phase<EpiBf16I8, pg8::StaticOrder, true, true, true>(C.lds, g, S, E); } PROBE_T1(8) } SEAM(8);
    if (IN(9)) { PROBE_T0(9) { phase_peer<true>(C, args, TAB, TAB + TAB_BYTES, TSC, TSC + 16384, mod0 + 5 * 1024, args.in[19], mod1, bar); } PROBE_T1(9) } SEAM(9);
    if (IN(10)) { PROBE_T0(10) { pg8::Gemm g{H8B, (const bf16*)(W8 + OUT_W8QKV), NTOK, 3072, DM / 2}; pg8::StaticOrder S; S.init(NTOK, 3072, C.G, C.bid);
        EpiQKV<true> E{BIG, (bf16*)(ws + WS_BIG + 64 * MiB), (bf16*)(ws + WS_BIG + 128 * MiB), args.in[21], args.in[22], SA, SW + SW_QKV};
        pg8::gemm_phase<EpiQKV<true>, pg8::StaticOrder, true, true, true>(C.lds, g, S, E); } PROBE_T1(10) } SEAM(10);
    if (IN(11)) { PROBE_T0(11) { phase_attn_ring(C, args); } PROBE_T1(11) } SEAM(11);
    if (IN(12)) { PROBE_T0(12) { pg8::Gemm g{Hb, (const bf16*)(ws + WS_WOUT1), NTOK, DM, DM}; pg8::StaticOrder S; S.init(NTOK, DM, C.G, C.bid);
        EpiResid<true> E{XB, XB, mod1 + 2 * 1024};
        pg8::gemm_phase<EpiResid<true>, pg8::StaticOrder, true, true>(C.lds, g, S, E); } PROBE_T1(12) } SEAM(12);
    if (IN(13)) { PROBE_T0(13) { phase_rowpass<false, true, true>(C, args, XB, args.in[24], mod1, 3, 4, H8B, SA); } PROBE_T1(13) } SEAM(13);
    if (IN(14)) { PROBE_T0(14) { pg8::Gemm g{H8B, (const bf16*)(W8 + OUT_W8C1), NTOK, 2048, DM / 2}; pg8::StaticOrder S; S.init(NTOK, 2048, C.G, C.bid);
        EpiBf16I8 E{BIG, 2048, SA, SW + SW_C1};
        pg8::gemm_phase<EpiBf16I8, pg8::StaticOrder, true, true, true>(C.lds, g, S, E); } PROBE_T1(14) } SEAM(14);
#ifdef PROBE_DRY
    if (IN(15)) { phase_peer<false, PROBE_DRY>(C, args, TAB + 2 * TAB_BYTES, TAB + 3 * TAB_BYTES, TSC + 2 * 16384, TSC + 3 * 16384, mod1 + 5 * 1024, nullptr, nullptr, bar); GRID_BAR(); }
#endif
    if (IN(15)) { PROBE_T0(15) { phase_peer<false>(C, args, TAB + 2 * TAB_BYTES, TAB + 3 * TAB_BYTES, TSC + 2 * 16384, TSC + 3 * 16384, mod1 + 5 * 1024, nullptr, nullptr, bar); } PROBE_T1(15) }
#undef IN
#undef SEAM
}

extern "C" void kernel_launch(void* const* d_in, const int* in_sizes, int n_in, void* d_out, int out_size, void* d_ws, size_t ws_size, hipStream_t stream) {
    static int grid = 0;
    if (grid == 0) {
        if (n_in != 30 || out_size != NTOK * DM || ws_size < WS_END2) { fprintf(stderr, "kernel_launch: unexpected shapes (n_in %d out %d ws %zu)\n", n_in, out_size, ws_size); grid = -1; return; }
        int dev = 0, cus = 0;
        if (hipGetDevice(&dev) != hipSuccess || hipDeviceGetAttribute(&cus, hipDeviceAttributeMultiprocessorCount, dev) != hipSuccess) { grid = -1; return; }
        if (hipFuncSetAttribute((const void*)mk_fwd, hipFuncAttributeMaxDynamicSharedMemorySize, LDS_BYTES) != hipSuccess) { fprintf(stderr, "kernel_launch: hipFuncSetAttribute failed\n"); grid = -1; return; }
        int per_cu = 0;
        if (hipOccupancyMaxActiveBlocksPerMultiprocessor(&per_cu, (const void*)mk_fwd, NWAVES * 64, LDS_BYTES) != hipSuccess || per_cu < 1) fprintf(stderr, "kernel_launch: occupancy query reports %d\n", per_cu);
        (void)hipGetLastError();
        grid = cus;
    }
    if (grid < 0) return;
    (void)hipMemsetAsync((char*)d_ws + WS_CTL + CW_BAR * 4, 0, XCD_BAR_WORDS * 4, stream);
    Args a{};
    for (int i = 0; i < 30; ++i) a.in[i] = (const float*)d_in[i];
    a.out = (float*)d_out; a.ws = (unsigned char*)d_ws;
#if MK_ONE_LAUNCH
    a.ph_lo = 0; a.ph_hi = N_PHASES;
    hipLaunchKernelGGL(mk_fwd, dim3(grid), dim3(NWAVES * 64), LDS_BYTES, stream, a);
#else
    for (int p = 0; p < N_PHASES; ++p) { a.ph_lo = p; a.ph_hi = p + 1; hipLaunchKernelGGL(mk_fwd, dim3(grid), dim3(NWAVES * 64), LDS_BYTES, stream, a); }
#endif
}
```

```cpp
#include <hip/hip_runtime.h>
#include <cstdio>
#include <cstdint>
#include <cmath>
#define PROBE_MASK 0
namespace pg8 {
#define PG8_LAS __attribute__((address_space(3)))
typedef unsigned short bf16_t;
typedef short bf16x8 __attribute__((ext_vector_type(8)));
typedef float f32x4 __attribute__((ext_vector_type(4)));
typedef unsigned u32x4 __attribute__((ext_vector_type(4)));
constexpr int BM = 256, BK = 64, HALF = 128, HTB = HALF * BK * 2  , STAGE_BYTES = 8 * HTB, NXCD = 8, WGM = 8;

__host__ __device__ __forceinline__ int lds_byte(int r, int c) { const int st = (r >> 4) * 2 + (c >> 5), rr = r & 15, cc = c & 31, ob = rr * 64 + cc * 2; return st * 1024 + (ob ^ (((ob >> 9) & 1) << 5)); }
__host__ __device__ __forceinline__ void stage_rc(int b, int& R, int& C) { const int st = b / 1024, sb = b % 1024, swz = sb ^ (((sb >> 9) & 1) << 5); R = (st >> 1) * 16 + swz / 64; C = (st & 1) * 32 + (swz % 64) / 2; }
__host__ __device__ __forceinline__ int perm32(int rho) { const int n = rho >> 4, i = rho & 15; return 8 * (i >> 2) + 4 * n + (i & 3); }

struct Unit { int pm, pn; };
struct Gemm { const bf16_t* A; const bf16_t* Bt; int M, N, K; };

struct StaticOrder {
    int nM, nN, nwg, G, c;
    __host__ __device__ void init(int M, int N, int G_, int c_) { nM = M / BM; nN = N / BM; nwg = nM * nN; G = G_; c = c_; }
    __host__ __device__ bool next(int i, Unit& u) const {
        const long L = (long)i * G + c; if (L >= nwg) return false;
        int wgid = (int)L; { const int q = nwg / NXCD, r = nwg % NXCD, xcd = wgid % NXCD, off = wgid / NXCD; wgid = (xcd < r ? xcd * (q + 1) : r * (q + 1) + (xcd - r) * q) + off; }
        const int nig = WGM * nN, gid = wgid / nig, fm = gid * WGM, gsz = (nM - fm) < WGM ? (nM - fm) : WGM;
        u.pm = fm + ((wgid % nig) % gsz); u.pn = (wgid % nig) / gsz; return true;
    }
    __device__ __forceinline__ void a_ready(const Unit&) const {}
    __device__ __forceinline__ void done(const Unit&) const {}
};

__device__ __forceinline__ unsigned cvt_pk_bf16(float lo, float hi) { unsigned r; asm volatile("v_cvt_pk_bf16_f32 %0, %1, %2" : "=v"(r) : "v"(lo), "v"(hi)); return r; }
typedef float f32x2 __attribute__((ext_vector_type(2)));
__device__ __forceinline__ f32x2 gelu_pk(f32x2 v) {
    const f32x2 av = __builtin_elementwise_abs(v), d = av * 0.2316418882f + 1.0f;
    f32x2 t; t.x = __builtin_amdgcn_rcpf(d.x); t.y = __builtin_amdgcn_rcpf(d.y);
    f32x2 q = t * 0.5307027145f + (-0.7265760135f); q = q * t + 0.7107068705f; q = q * t + (-0.142248368f); q = q * t + 0.127414796f; q = q * t;
    const f32x2 s = (v * v) * (-0.72134752044f);
    f32x2 e; e.x = __builtin_amdgcn_exp2f(s.x); e.y = __builtin_amdgcn_exp2f(s.y);
    const f32x2 m = v * (q * e), r = v - m;
    f32x2 o; o.x = v.x < 0.f ? m.x : r.x; o.y = v.y < 0.f ? m.y : r.y; return o;
}

template <int ACT  > struct EpiBf16 {
    static constexpr bool PERM = true, AFTER_DRAIN = false; static_assert(ACT == 0 || ACT == 1, "EpiBf16: ACT is 0 (none) or 1 (gelu_pk)");
    bf16_t* O; int ldc; const float* bias; int split_cols; size_t split_stride; float scale0;
    __device__ __forceinline__ void operator()(const f32x4 (&acc)[2][2][4][2], const Unit& u, int wr, int wc, int fr, int fq) const {
        const int row0 = u.pm * BM + wr * 64 + fr; int colt = u.pn * BM; bf16_t* base = O;
        float sc = 1.f; if (split_cols) { const int t = colt / split_cols; base += (size_t)t * split_stride; colt -= t * split_cols; if (t == 0) sc = scale0; }
        const int col0 = colt + wc * 32 + 8 * fq, bcol0 = u.pn * BM + wc * 32 + 8 * fq;
        f32x4 bv[2][2];
#pragma unroll
        for (int bj = 0; bj < 2; ++bj)
#pragma unroll
            for (int n = 0; n < 2; ++n) bv[bj][n] = bias ? *(const f32x4*)(bias + bcol0 + bj * HALF + 4 * n) : (f32x4){0.f, 0.f, 0.f, 0.f};
#pragma unroll
        for (int ai = 0; ai < 2; ++ai)
#pragma unroll
            for (int m = 0; m < 4; ++m) { bf16_t* rowp = base + (size_t)(row0 + ai * HALF + m * 16) * ldc + col0;
#pragma unroll
                for (int bj = 0; bj < 2; ++bj) { f32x4 v0 = acc[ai][bj][m][0] + bv[bj][0], v1 = acc[ai][bj][m][1] + bv[bj][1];
                    if (ACT == 1) { f32x2 a = gelu_pk((f32x2){v0[0], v0[1]}), b = gelu_pk((f32x2){v0[2], v0[3]}), c = gelu_pk((f32x2){v1[0], v1[1]}), d = gelu_pk((f32x2){v1[2], v1[3]});
                        v0 = (f32x4){a.x, a.y, b.x, b.y}; v1 = (f32x4){c.x, c.y, d.x, d.y}; }
                    v0 = v0 * sc; v1 = v1 * sc; u32x4 w; w.x = cvt_pk_bf16(v0[0], v0[1]); w.y = cvt_pk_bf16(v0[2], v0[3]); w.z = cvt_pk_bf16(v1[0], v1[1]); w.w = cvt_pk_bf16(v1[2], v1[3]);
                    *(u32x4*)(rowp + bj * HALF) = w; } }
    }
};
typedef int i32x4 __attribute__((ext_vector_type(4)));
template <bool I8> struct AccSel { typedef f32x4 type; };
template <> struct AccSel<true> { typedef i32x4 type; };
template <class Epi, class Sched, bool ALIGN_EPI = false, bool SP2 = false, bool I8 = false>
__device__ __forceinline__ void gemm_phase(PG8_LAS unsigned char* lds, const Gemm g, const Sched& S, const Epi& E) {
    const int tid = threadIdx.x, wid = __builtin_amdgcn_readfirstlane(tid >> 6), lane = tid & 63, wr = wid >> 2, wc = wid & 3, fr = lane & 15, fq = lane >> 4;
    const int K = g.K, nt = K / BK;
    unsigned voffA[2], voffB[2];
#pragma unroll
    for (int i = 0; i < 2; ++i) { int R, C; stage_rc(tid * 16 + i * 8192, R, C); const int Rb = Epi::PERM ? ((R & ~31) + perm32(R & 31)) : R;
        voffA[i] = (unsigned)(R * K + C) * 2u; voffB[i] = (unsigned)(Rb * K + C) * 2u; }
    const size_t kstep = (size_t)(BK * 2);
    const size_t hstep = (size_t)HALF * K * 2;
    const size_t tstep = 2 * hstep;
    const unsigned ldsw = (unsigned)wid * 1024u;
    const int aoff = lds_byte(wr * 64 + fr, fq * 8), boff = lds_byte(wc * 32 + fr, fq * 8);
#define PG8_SA(b, h) (((b) * 2 + (h)) * HTB)
#define PG8_SB(b, h) ((4 + (b) * 2 + (h)) * HTB)
#define PG8_STAGE(bufoff, gbase, voff) do { _Pragma("unroll") for (int _i = 0; _i < 2; ++_i) \
        __builtin_amdgcn_global_load_lds((const unsigned*)((const char*)(gbase) + (voff)[_i]), (PG8_LAS unsigned*)(lds + (bufoff) + ldsw + _i * 8192), 16, 0, 0); } while (0)
#define PG8_LDA(dst, b, h) do { _Pragma("unroll") for (int m = 0; m < 4; ++m) _Pragma("unroll") for (int k = 0; k < 2; ++k) dst[m][k] = *(const PG8_LAS bf16x8*)(lds + PG8_SA(b, h) + aoff + m * 2048 + k * 1024); } while (0)
#define PG8_LDB(dst, b, h) do { _Pragma("unroll") for (int n = 0; n < 2; ++n) _Pragma("unroll") for (int k = 0; k < 2; ++k) dst[n][k] = *(const PG8_LAS bf16x8*)(lds + PG8_SB(b, h) + boff + n * 2048 + k * 1024); } while (0)
#define PG8_MMA(ai, bj, At, Bt) do { __builtin_amdgcn_s_setprio(1); _Pragma("unroll") for (int m = 0; m < 4; ++m) _Pragma("unroll") for (int n = 0; n < 2; ++n) _Pragma("unroll") for (int k = 0; k < 2; ++k) \
        { if constexpr (I8) acc[ai][bj][m][n] = __builtin_bit_cast(acc_t, __builtin_amdgcn_mfma_i32_16x16x64_i8(__builtin_bit_cast(i32x4, Bt[n][k]), __builtin_bit_cast(i32x4, At[m][k]), __builtin_bit_cast(i32x4, acc[ai][bj][m][n]), 0, 0, 0)); \
          else acc[ai][bj][m][n] = __builtin_bit_cast(acc_t, __builtin_amdgcn_mfma_f32_16x16x32_bf16(Bt[n][k], At[m][k], __builtin_bit_cast(f32x4, acc[ai][bj][m][n]), 0, 0, 0)); } __builtin_amdgcn_s_setprio(0); } while (0)
#define PG8_WAIT_V(n) asm volatile("s_waitcnt vmcnt(" #n ")" ::: "memory")
#define PG8_WAIT_L(n) asm volatile("s_waitcnt lgkmcnt(" #n ")" ::: "memory")
#define PG8_BAR __builtin_amdgcn_s_barrier()
#define PG8_SCHED __builtin_amdgcn_sched_barrier(0)
    Unit cur, nxt; int ui = 0;
    if (!S.next(0, cur)) return;
    typedef typename AccSel<I8>::type acc_t; const acc_t acc_zero = {};
    acc_t acc[2][2][4][2];
#pragma unroll
    for (int a = 0; a < 2; ++a)
#pragma unroll
        for (int b = 0; b < 2; ++b)
#pragma unroll
            for (int m = 0; m < 4; ++m)
#pragma unroll
                for (int n = 0; n < 2; ++n) acc[a][b][m][n] = acc_zero;
    bf16x8 At[4][2], B0[2][2], B1[2][2];
    const char* cA = (const char*)g.A + (size_t)cur.pm * tstep; const char* cB = (const char*)g.Bt + (size_t)cur.pn * tstep;
    S.a_ready(cur);
    if constexpr (SP2) {
        PG8_STAGE(PG8_SB(0, 0), cB, voffB); PG8_STAGE(PG8_SB(0, 1), cB + hstep, voffB); PG8_STAGE(PG8_SA(0, 0), cA, voffA); PG8_STAGE(PG8_SA(0, 1), cA + hstep, voffA);
        if (wr == 1) PG8_BAR;
        PG8_WAIT_V(2); PG8_BAR;
        PG8_STAGE(PG8_SB(1, 0), cB + kstep, voffB); PG8_STAGE(PG8_SA(1, 0), cA + kstep, voffA); PG8_STAGE(PG8_SB(1, 1), cB + hstep + kstep, voffB);
        PG8_WAIT_V(6); PG8_BAR;
    } else {
        PG8_STAGE(PG8_SB(0, 0), cB, voffB); PG8_STAGE(PG8_SA(0, 0), cA, voffA); PG8_STAGE(PG8_SB(0, 1), cB + hstep, voffB); PG8_STAGE(PG8_SA(0, 1), cA + hstep, voffA);
        if (wr == 1) PG8_BAR;
        PG8_WAIT_V(4); PG8_BAR;
        PG8_STAGE(PG8_SB(1, 0), cB + kstep, voffB); PG8_STAGE(PG8_SA(1, 0), cA + kstep, voffA); PG8_STAGE(PG8_SB(1, 1), cB + hstep + kstep, voffB);
        PG8_WAIT_V(6); PG8_BAR;
    }
    for (;;) {
        const bool has_next = S.next(ui + 1, nxt);
        const char* nA = has_next ? (const char*)g.A + (size_t)nxt.pm * tstep : cA; const char* nB = has_next ? (const char*)g.Bt + (size_t)nxt.pn * tstep : cB;
        for (int t = 0; t < nt; t += 2) {
            const bool last = (t == nt - 2);
            const char* a1 = cA + (size_t)(t + 1) * kstep;
            const char* a2 = last ? nA : cA + (size_t)(t + 2) * kstep; const char* b2 = last ? nB : cB + (size_t)(t + 2) * kstep;
            const char* a3 = a2 + kstep; const char* b3 = b2 + kstep;
            if (last && has_next) S.a_ready(nxt);
            if constexpr (SP2) {
            PG8_LDB(B0, 0, 0); PG8_LDB(B1, 0, 1); PG8_SCHED; PG8_LDA(At, 0, 0); PG8_STAGE(PG8_SA(1, 1), a1 + hstep, voffA);
            PG8_WAIT_V(8); PG8_WAIT_L(0); PG8_BAR; PG8_MMA(0, 0, At, B0); PG8_MMA(0, 1, At, B1); PG8_BAR; PG8_SCHED;
            PG8_LDA(At, 0, 1); PG8_STAGE(PG8_SB(0, 0), b2, voffB); PG8_STAGE(PG8_SB(0, 1), b2 + hstep, voffB); PG8_STAGE(PG8_SA(0, 0), a2, voffA);
            PG8_WAIT_V(8); PG8_WAIT_L(0); PG8_BAR; PG8_MMA(1, 0, At, B0); PG8_MMA(1, 1, At, B1); PG8_BAR; PG8_SCHED;
            PG8_LDB(B0, 1, 0); PG8_LDB(B1, 1, 1); PG8_SCHED; PG8_LDA(At, 1, 0); PG8_STAGE(PG8_SA(0, 1), a2 + hstep, voffA);
            PG8_WAIT_V(8); PG8_WAIT_L(0); PG8_BAR; PG8_MMA(0, 0, At, B0); PG8_MMA(0, 1, At, B1); PG8_BAR; PG8_SCHED;
            PG8_LDA(At, 1, 1); PG8_STAGE(PG8_SB(1, 0), b3, voffB); PG8_STAGE(PG8_SB(1, 1), b3 + hstep, voffB); PG8_STAGE(PG8_SA(1, 0), a3, voffA);
            PG8_WAIT_V(8); PG8_WAIT_L(0); PG8_BAR; PG8_MMA(1, 0, At, B0); PG8_MMA(1, 1, At, B1); PG8_BAR; PG8_SCHED;
            } else {
            PG8_LDB(B0, 0, 0); PG8_SCHED; PG8_LDA(At, 0, 0); PG8_STAGE(PG8_SA(1, 1), a1 + hstep, voffA);
            PG8_WAIT_L(8); PG8_BAR; PG8_WAIT_L(0); PG8_MMA(0, 0, At, B0); PG8_BAR; PG8_SCHED;
            PG8_LDB(B1, 0, 1); PG8_STAGE(PG8_SB(0, 0), b2, voffB);
            PG8_BAR; PG8_WAIT_L(0); PG8_MMA(0, 1, At, B1); PG8_BAR;
            PG8_LDA(At, 0, 1); PG8_STAGE(PG8_SA(0, 0), a2, voffA);
            PG8_BAR; PG8_WAIT_L(0); PG8_MMA(1, 0, At, B0); PG8_BAR; PG8_SCHED;
            PG8_STAGE(PG8_SB(0, 1), b2 + hstep, voffB);
            PG8_WAIT_V(6); PG8_BAR; PG8_MMA(1, 1, At, B1); PG8_BAR;
            PG8_LDB(B0, 1, 0); PG8_SCHED; PG8_LDA(At, 1, 0); PG8_STAGE(PG8_SA(0, 1), a2 + hstep, voffA);
            PG8_WAIT_L(8); PG8_BAR; PG8_WAIT_L(0); PG8_MMA(0, 0, At, B0); PG8_BAR; PG8_SCHED;
            PG8_LDB(B1, 1, 1); PG8_STAGE(PG8_SB(1, 0), b3, voffB);
            PG8_BAR; PG8_WAIT_L(0); PG8_MMA(0, 1, At, B1); PG8_BAR;
            PG8_LDA(At, 1, 1); PG8_STAGE(PG8_SA(1, 0), a3, voffA);
            PG8_BAR; PG8_WAIT_L(0); PG8_MMA(1, 0, At, B0); PG8_BAR; PG8_SCHED;
            PG8_STAGE(PG8_SB(1, 1), b3 + hstep, voffB);
            PG8_WAIT_V(6); PG8_BAR; PG8_MMA(1, 1, At, B1); PG8_BAR;
            }
        }
        if constexpr (ALIGN_EPI) { if (wr == 0) PG8_BAR; }
        if constexpr (!Epi::AFTER_DRAIN) { E(acc, cur, wr, wc, fr, fq); S.done(cur); }
        if (!has_next) break;
#pragma unroll
        for (int a = 0; a < 2; ++a)
#pragma unroll
            for (int b = 0; b < 2; ++b)
#pragma unroll
                for (int m = 0; m < 4; ++m)
#pragma unroll
                    for (int n = 0; n < 2; ++n) acc[a][b][m][n] = acc_zero;
        cur = nxt; cA = nA; cB = nB; ++ui;
        if constexpr (ALIGN_EPI) { if (wr == 1) PG8_BAR; }
    }
    PG8_WAIT_V(0);
    if constexpr (!ALIGN_EPI) { if (wr == 0) PG8_BAR; }
    PG8_BAR;
    if constexpr (Epi::AFTER_DRAIN) { E.fused(acc, cur, wr, wc, fr, fq, lds, wid, lane); S.done(cur); }
#undef PG8_SA
#undef PG8_SB
#undef PG8_STAGE
#undef PG8_LDA
#undef PG8_LDB
#undef PG8_MMA
#undef PG8_WAIT_V
#undef PG8_WAIT_L
#undef PG8_BAR
#undef PG8_SCHED
}
}
#define GAS __attribute__((address_space(1)))
#define LAS __attribute__((address_space(3)))
typedef unsigned short bf16;
typedef unsigned v4u __attribute__((ext_vector_type(4)));
typedef float f32x4 __attribute__((ext_vector_type(4)));
typedef short bf16x8 __attribute__((ext_vector_type(8)));
typedef GAS unsigned gu32;
typedef GAS unsigned long long gu64;
#define RLX_AGENT __ATOMIC_RELAXED, __HIP_MEMORY_SCOPE_AGENT
#define LDS_WAIT() asm volatile("s_waitcnt lgkmcnt(0)" ::: "memory")
#define VM_WAIT() asm volatile("s_waitcnt vmcnt(0)" ::: "memory")
__device__ __forceinline__ unsigned long long rt() { return __builtin_amdgcn_s_memrealtime(); }
__device__ __forceinline__ unsigned f2bf(float f) { unsigned u = __builtin_bit_cast(unsigned, f); return (u + 0x7fffu + ((u >> 16) & 1u)) >> 16; }
typedef float pk2_f32x2 __attribute__((ext_vector_type(2))); typedef __bf16 pk2_bf16x2 __attribute__((ext_vector_type(2)));
__device__ __forceinline__ unsigned pk2(float lo, float hi) { const pk2_f32x2 v = {lo, hi}; return __builtin_bit_cast(unsigned, __builtin_convertvector(v, pk2_bf16x2)); }

#define XB_TMO      128
#define XB_XCNT(j)  (256  + 64 * (j))
#define XB_XSUB(j)  (1280 + 64 * (j))
#define XB_XGEN(j)  (2304 + 64 * (j))
#define XB_TOP      3328
#define XB_TOPGEN   3392
#define XCD_BAR_WORDS 3456
#define XB_SPIN_CAP (1u << 18)

__device__ __forceinline__ unsigned xb_ld(unsigned* p)              { return __hip_atomic_load(p, __ATOMIC_RELAXED, __HIP_MEMORY_SCOPE_AGENT); }
__device__ __forceinline__ unsigned xb_add(unsigned* p, unsigned v) { return __hip_atomic_fetch_add(p, v, __ATOMIC_RELAXED, __HIP_MEMORY_SCOPE_AGENT); }
__device__ __forceinline__ unsigned xb_xcc_id() { return (unsigned)__builtin_amdgcn_s_getreg((3 << 11) | 20) & 0xFu; }
#define XB_SPIN(cond, bar) do { unsigned _sp = 0; while (cond) { __builtin_amdgcn_s_sleep(1); \
    if ((++_sp & 255u) == 0u) { if (xb_ld(&(bar)[XB_TMO])) break; if (_sp > XB_SPIN_CAP) { atomicAdd(&(bar)[XB_TMO], 1u); break; } } } } while (0)

struct XcdBarrier {
    unsigned* bar; unsigned x;
    volatile LAS unsigned* st;
};

__device__ __forceinline__ XcdBarrier xcd_barrier_post(unsigned* bar, volatile LAS unsigned* st) {
    XcdBarrier b; b.bar = bar; b.x = xb_xcc_id(); b.st = st;
    if (threadIdx.x == 0) (void)xb_add(&bar[XB_XCNT(b.x)], 1u);
    return b;
}
__device__ __forceinline__ void xcd_barrier_complete(unsigned* bar, unsigned x, unsigned& nloc, unsigned& nx) {
    const unsigned G = gridDim.x * gridDim.y * gridDim.z;
    unsigned sum, cnt, mine, sp = 0u;
    for (;;) {
        sum = 0u; cnt = 0u; mine = 0u;
#pragma unroll
        for (unsigned j = 0; j < 16; ++j) { const unsigned c = xb_ld(&bar[XB_XCNT(j)]); sum += c; cnt += (c > 0u) ? 1u : 0u; mine = (j == x) ? c : mine; }
        if (sum == G) break;
        __builtin_amdgcn_s_sleep(1);
        if ((++sp & 255u) == 0u) { if (xb_ld(&bar[XB_TMO])) break; if (sp > XB_SPIN_CAP) { atomicAdd(&bar[XB_TMO], 1u); break; } }
    }
    nloc = mine > 0u ? mine : 1u; nx = cnt > 0u ? cnt : 1u;
}

__device__ __forceinline__ void xcd_barrier(const XcdBarrier& b) {
    asm volatile("s_waitcnt vmcnt(0)" ::: "memory");
    __syncthreads();
    if (threadIdx.x == 0) {
        unsigned* bar = b.bar;
        __builtin_amdgcn_s_waitcnt(0);
        unsigned nloc = b.st[0], nx = b.st[1];
        if (nloc == 0u) { xcd_barrier_complete(bar, b.x, nloc, nx); b.st[0] = nloc; b.st[1] = nx; }
        const unsigned old = xb_add(&bar[XB_XSUB(b.x)], 1u);
        const unsigned gen = old / nloc;
        if (old + 1u == (gen + 1u) * nloc) {
            __builtin_amdgcn_fence(__ATOMIC_RELEASE, "agent");
            asm volatile("s_waitcnt vmcnt(0)" ::: "memory");
            const unsigned og = xb_add(&bar[XB_TOP], 1u);
            const unsigned tg = og / nx;
            if (og + 1u == (tg + 1u) * nx) xb_add(&bar[XB_TOPGEN], 1u);
            else XB_SPIN(xb_ld(&bar[XB_TOPGEN]) == tg, bar);
            __builtin_amdgcn_fence(__ATOMIC_ACQUIRE, "agent");
            xb_add(&bar[XB_XGEN(b.x)], 1u);
            asm volatile("s_waitcnt vmcnt(0)" ::: "memory");
        } else {
            XB_SPIN(xb_ld(&bar[XB_XGEN(b.x)]) == gen, bar);
            __builtin_amdgcn_fence(__ATOMIC_ACQUIRE, "agent");
            asm volatile("s_waitcnt vmcnt(0)" ::: "memory");
        }
    }
    __syncthreads();
}
#ifndef MK_ONE_LAUNCH
#define MK_ONE_LAUNCH 1
#endif
constexpr int NWAVES = 8;
constexpr int NB = 8, SEQ = 4096, DM = 1024, NTOK = NB * SEQ;
constexpr int INW = 3592, INP = 3584;
constexpr float EPS = 1e-6f;
constexpr size_t MiB = 1u << 20;
constexpr size_t WS_CTL = 0, CTL_ZERO_BYTES = 1 * MiB;
constexpr size_t WS_MOD = 1 * MiB;
constexpr size_t WS_LF = 2 * MiB, WS_LI = WS_LF + 512 * 1024;
constexpr size_t WS_FC = 3 * MiB;
constexpr size_t WS_WIN = 4 * MiB, WS_WOUT0 = 11 * MiB, WS_WC0 = 13 * MiB, WS_WQKV = 17 * MiB, WS_WOUT1 = 23 * MiB, WS_WC1 = 25 * MiB;
constexpr size_t WS_H = 32 * MiB;
constexpr size_t WS_BIG = 96 * MiB;
constexpr size_t WS_IDS = 320 * MiB, WS_GATES = 336 * MiB;
constexpr size_t WS_END = 352 * MiB;
constexpr int CW_BAR = 4096;
constexpr int RING_BYTES = 131072, LDSCTL_OFF = RING_BYTES, MISC_OFF = LDSCTL_OFF + 320, LDS_BYTES = 163840;

__device__ __forceinline__ float wave_sum(float v) {
#pragma unroll
    for (int o = 1; o < 64; o <<= 1) v += __shfl_xor(v, o);
    return v;
}
__device__ __forceinline__ float wave_max(float v) {
#pragma unroll
    for (int o = 1; o < 64; o <<= 1) v = fmaxf(v, __shfl_xor(v, o));
    return v;
}
__device__ __forceinline__ float bf2f(unsigned short b) { return __uint_as_float((unsigned)b << 16); }
__device__ __forceinline__ float bflo(unsigned w) { return __uint_as_float(w << 16); }
__device__ __forceinline__ float bfhi(unsigned w) { return __uint_as_float(w & 0xffff0000u); }
__device__ __forceinline__ float sigmoidf_(float x) { return 1.f / (1.f + __expf(-x)); }
__device__ __forceinline__ float softplusf_(float x) { return fmaxf(x, 0.f) + __logf(1.f + __expf(-fabsf(x))); }
__device__ __forceinline__ float logsigmoidf_(float x) { return fminf(x, 0.f) - __logf(1.f + __expf(-fabsf(x))); }
__device__ __forceinline__ float gelu_exact(float x) { return 0.5f * x * (1.f + erff(x * 0.70710678118654752f)); }
__device__ __forceinline__ float gelu_as(float v) {
    const float av = fabsf(v), t = __builtin_amdgcn_rcpf(av * 0.2316418882f + 1.0f);
    float q = t * 0.5307027145f + (-0.7265760135f); q = q * t + 0.7107068705f; q = q * t + (-0.142248368f); q = q * t + 0.127414796f; q = q * t;
    const float e = __builtin_amdgcn_exp2f((v * v) * (-0.72134752044f));
    const float m = v * (q * e);
    return v < 0.f ? m : v - m;
}

struct Args { const float* in[30]; float* out; unsigned char* ws; int ph_lo, ph_hi; };

struct Ctx {
    LAS unsigned char* lds;
    int tid, lane, wave, G, bid;
    int gw, NGW;
    long gt, NGT;
};
template <bool BASE_BF16>
struct EpiResid {
    static constexpr bool PERM = true, AFTER_DRAIN = false;
    const void* base; bf16* out; const float* gate;
    __device__ __forceinline__ void operator()(const pg8::f32x4 (&acc)[2][2][4][2], const pg8::Unit& u, int wr, int wc, int fr, int fq) const {
        using pg8::f32x4;
        const int col0 = u.pn * 256 + wc * 32 + 8 * fq;
        const float* gp = gate + (size_t)((u.pm * 256) / SEQ) * 6144 + col0;
        f32x4 gv[2][2];
#pragma unroll
        for (int bj = 0; bj < 2; ++bj)
#pragma unroll
            for (int n = 0; n < 2; ++n) { gv[bj][n] = *(const f32x4*)(gp + bj * 128 + 4 * n); gv[bj][n] = gv[bj][n] + 1.0f; }
#pragma unroll
        for (int ai = 0; ai < 2; ++ai)
#pragma unroll
            for (int m = 0; m < 4; ++m) {
                const int r = ai * 128 + wr * 64 + m * 16 + fr; const size_t off = (size_t)(u.pm * 256 + r) * DM + col0;
#pragma unroll
                for (int bj = 0; bj < 2; ++bj) {
                    f32x4 b0, b1;
                    if (BASE_BF16) { const v4u w = *(const v4u*)((const bf16*)base + off + bj * 128); b0 = (f32x4){bflo(w.x), bfhi(w.x), bflo(w.y), bfhi(w.y)}; b1 = (f32x4){bflo(w.z), bfhi(w.z), bflo(w.w), bfhi(w.w)}; }
                    else { b0 = *(const f32x4*)((const float*)base + off + bj * 128); b1 = *(const f32x4*)((const float*)base + off + bj * 128 + 4); }
                    const f32x4 v0 = b0 + gv[bj][0] * acc[ai][bj][m][0], v1 = b1 + gv[bj][1] * acc[ai][bj][m][1];
                    v4u o; o.x = pk2(v0[0], v0[1]); o.y = pk2(v0[2], v0[3]); o.z = pk2(v1[0], v1[1]); o.w = pk2(v1[2], v1[3]);
                    *(v4u*)(out + off + bj * 128) = o;
                }
            }
    }
};

constexpr size_t WS_SA = WS_MOD + 768 * 1024;
constexpr size_t OUT_W8 = 96 * MiB;
constexpr size_t OUT_W8IN = OUT_W8, OUT_W8C0 = OUT_W8 + 4 * MiB, OUT_W8QKV = OUT_W8 + 6 * MiB, OUT_W8C1 = OUT_W8 + 9 * MiB, OUT_SW = OUT_W8 + 11 * MiB;
constexpr int SW_IN = 0, SW_C0 = 4096, SW_QKV = 8192, SW_C1 = 12288;
__device__ __forceinline__ void quantize_rows(const Ctx& C, const bf16* W, int N, unsigned char* W8, float* SW) {
    for (int n = C.gw; n < N; n += C.NGW) {
        const v4u w0 = *(const v4u*)(W + (size_t)n * DM + 16 * C.lane), w1 = *(const v4u*)(W + (size_t)n * DM + 16 * C.lane + 8);
        float x[16] = {bflo(w0.x), bfhi(w0.x), bflo(w0.y), bfhi(w0.y), bflo(w0.z), bfhi(w0.z), bflo(w0.w), bfhi(w0.w), bflo(w1.x), bfhi(w1.x), bflo(w1.y), bfhi(w1.y), bflo(w1.z), bfhi(w1.z), bflo(w1.w), bfhi(w1.w)};
        float am = 0.f;
#pragma unroll
        for (int i = 0; i < 16; ++i) am = fmaxf(am, fabsf(x[i]));
        am = fmaxf(wave_max(am), 1e-30f); const float qi = 127.f / am;
        v4u o;
#pragma unroll
        for (int q = 0; q < 4; ++q) { const int q0 = (int)rintf(x[4 * q] * qi), q1 = (int)rintf(x[4 * q + 1] * qi), q2 = (int)rintf(x[4 * q + 2] * qi), q3 = (int)rintf(x[4 * q + 3] * qi);
            o[q] = ((unsigned)q0 & 255u) | (((unsigned)q1 & 255u) << 8) | (((unsigned)q2 & 255u) << 16) | ((unsigned)q3 << 24); }
        *(v4u*)(W8 + (size_t)n * DM + 16 * C.lane) = o;
        if (C.lane == 0) SW[n] = am * (1.f / 127.f);
    }
}
struct EpiBf16I8 {
    static constexpr bool PERM = true, AFTER_DRAIN = false;
    bf16* O; int ldc; const float* sa; const float* sw;
    __device__ __forceinline__ void operator()(const pg8::i32x4 (&acc)[2][2][4][2], const pg8::Unit& u, int wr, int wc, int fr, int fq) const {
        using pg8::f32x4;
        const int col0 = u.pn * 256 + wc * 32 + 8 * fq;
        f32x4 cs[2][2];
#pragma unroll
        for (int bj = 0; bj < 2; ++bj)
#pragma unroll
            for (int n = 0; n < 2; ++n) cs[bj][n] = *(const f32x4*)(sw + col0 + bj * 128 + 4 * n);
#pragma unroll
        for (int ai = 0; ai < 2; ++ai)
#pragma unroll
            for (int m = 0; m < 4; ++m) { const int row = u.pm * 256 + ai * 128 + wr * 64 + m * 16 + fr; const float rs = sa[row];
                bf16* rowp = O + (size_t)row * ldc + col0;
#pragma unroll
                for (int bj = 0; bj < 2; ++bj) { const pg8::i32x4 a0 = acc[ai][bj][m][0], a1 = acc[ai][bj][m][1];
                    v4u w; w.x = pk2((float)a0[0] * rs * cs[bj][0][0], (float)a0[1] * rs * cs[bj][0][1]); w.y = pk2((float)a0[2] * rs * cs[bj][0][2], (float)a0[3] * rs * cs[bj][0][3]);
                    w.z = pk2((float)a1[0] * rs * cs[bj][1][0], (float)a1[1] * rs * cs[bj][1][1]); w.w = pk2((float)a1[2] * rs * cs[bj][1][2], (float)a1[3] * rs * cs[bj][1][3]);
                    *(v4u*)(rowp + bj * 128) = w; } }
    }
};

__device__ __forceinline__ void transpose_item(const float* W, int ldw, int src_col0, bf16* WT, int K, int dst_row0, int k0, LAS float* scr, int lane) {
#pragma unroll 8
    for (int i = 0; i < 32; ++i) { const int kk = 2 * i + (lane >> 5); scr[kk * 33 + (lane & 31)] = W[(size_t)(k0 + kk) * ldw + src_col0 + (lane & 31)]; }
    LDS_WAIT(); asm volatile("" ::: "memory");
    const int c = lane & 7;
#pragma unroll
    for (int j = 0; j < 4; ++j) { const int n = (lane >> 3) + 8 * j; const LAS float* s = scr + (8 * c) * 33 + n;
        v4u o; o.x = pk2(s[0 * 33], s[1 * 33]); o.y = pk2(s[2 * 33], s[3 * 33]); o.z = pk2(s[4 * 33], s[5 * 33]); o.w = pk2(s[6 * 33], s[7 * 33]);
        *(GAS v4u*)(WT + (size_t)(dst_row0 + n) * K + k0 + 8 * c) = o; }
    LDS_WAIT(); asm volatile("" ::: "memory");
}

__device__ __forceinline__ void phase_prep(const Ctx& C, const Args& A) {
    unsigned char* ws = A.ws;
    {
        LAS float* scr = (LAS float*)(C.lds + C.wave * 16384);
        constexpr int I_IN = 16 * (INP / 32), I_O = 16 * 32, I_QKV = 16 * 96;
        constexpr int NIT = I_IN + I_O + I_QKV + I_O;
        for (int it = C.gw; it < NIT; it += C.NGW) {
            int r = it;
            if (r < I_IN) { const int kb = r / (INP / 32), nb = r % (INP / 32); const int dst = nb * 32, src = dst + (dst >= 2048 ? 8 : 0);
                transpose_item(A.in[5], INW, src, (bf16*)(ws + WS_WIN), 1024, dst, kb * 64, scr, C.lane); continue; } r -= I_IN;
            if (r < I_O) { const int kb = r / 32, nb = r % 32; transpose_item(A.in[10], 1024, nb * 32, (bf16*)(ws + WS_WOUT0), 1024, nb * 32, kb * 64, scr, C.lane); continue; } r -= I_O;
            if (r < I_QKV) { const int kb = r / 96, nb = r % 96; const int src = (nb >> 3) * 256 + 64 * (nb & 3) + 32 * ((nb >> 2) & 1);
                transpose_item(A.in[20], 3072, src, (bf16*)(ws + WS_WQKV), 1024, nb * 32, kb * 64, scr, C.lane); continue; } r -= I_QKV;
            { const int kb = r / 32, nb = r % 32; transpose_item(A.in[23], 1024, nb * 32, (bf16*)(ws + WS_WOUT1), 1024, nb * 32, kb * 64, scr, C.lane); }
        }
    }
    {
        LAS float* sc = (LAS float*)C.lds;
        LAS float* red = (LAS float*)(C.lds + 32768);
        if (C.bid < 96) {
            __syncthreads();
            for (int i = C.tid; i < NB * DM; i += NWAVES * 64) { const float v = A.in[1][i]; sc[i] = v / (1.f + __expf(-v)); }
            __syncthreads();
            for (int item = C.bid; item < 96; item += C.G) {
                const int l = item / 48, jc = item % 48;
                const float* W = A.in[l ? 17 : 2] + 128 * jc + 2 * C.lane;
                float a0[NB], a1[NB];
#pragma unroll
                for (int b = 0; b < NB; ++b) a0[b] = a1[b] = 0.f;
#pragma unroll 32
                for (int kk = 0; kk < 128; ++kk) { const int k = 128 * C.wave + kk; const float2 w = *(const float2*)(W + (size_t)k * 6144);
#pragma unroll
                    for (int b = 0; b < NB; ++b) { const float s = sc[b * DM + k]; a0[b] += s * w.x; a1[b] += s * w.y; } }
#pragma unroll
                for (int b = 0; b < NB; ++b) { red[(C.wave * NB + b) * 128 + 2 * C.lane] = a0[b]; red[(C.wave * NB + b) * 128 + 2 * C.lane + 1] = a1[b]; }
                __syncthreads();
                float* mod = (float*)(ws + WS_MOD);
                for (int o = C.tid; o < NB * 128; o += NWAVES * 64) { const int b = o >> 7, j = o & 127; float s = A.in[l ? 18 : 3][128 * jc + j];
#pragma unroll
                    for (int w = 0; w < NWAVES; ++w) s += red[(w * NB + b) * 128 + j];
                    mod[(size_t)(l * NB + b) * 6144 + 128 * jc + j] = s; }
                __syncthreads();
            }
        }
    }
    {
        LAS float* kt = (LAS float*)C.lds;
        LAS float* wt = (LAS float*)(C.lds + 128 * 132 * 4);
        for (int item = C.bid; item < 512; item += C.G) {
            const int l = item >> 8, hh = (item >> 4) & 15, kb = item & 15;
            const float* Wq = A.in[l ? 25 : 12]; const float* Kh = A.in[l ? ((hh & 1) ? 27 : 26) : ((hh & 1) ? 14 : 13)];
            bf16* Wc = (bf16*)(ws + (l ? WS_WC1 : WS_WC0));
            __syncthreads();
#pragma unroll
            for (int i = 0; i < 8; ++i) { const int id = C.tid + 512 * i, row = id >> 5, c4 = id & 31; *(LAS f32x4*)(kt + row * 132 + 4 * c4) = *(const f32x4*)(Kh + row * 128 + 4 * c4); }
#pragma unroll
            for (int i = 0; i < 4; ++i) { const int id = C.tid + 512 * i, row = id >> 5, c4 = id & 31; *(LAS f32x4*)(wt + row * 132 + 4 * c4) = *(const f32x4*)(Wq + (size_t)(kb * 64 + row) * 2048 + hh * 128 + 4 * c4); }
            __syncthreads();
            const int key = C.tid & 127, kg = C.tid >> 7;
            float acc[16];
#pragma unroll
            for (int i = 0; i < 16; ++i) acc[i] = 0.f;
#pragma unroll 2
            for (int d4 = 0; d4 < 32; ++d4) { const f32x4 kv = *(const LAS f32x4*)(kt + key * 132 + 4 * d4);
#pragma unroll
                for (int i = 0; i < 16; ++i) { const f32x4 wv = *(const LAS f32x4*)(wt + (kg * 16 + i) * 132 + 4 * d4); acc[i] += (kv.x * wv.x + kv.y * wv.y) + (kv.z * wv.z + kv.w * wv.w); } }
            v4u o0, o1; o0.x = pk2(acc[0], acc[1]); o0.y = pk2(acc[2], acc[3]); o0.z = pk2(acc[4], acc[5]); o0.w = pk2(acc[6], acc[7]);
            o1.x = pk2(acc[8], acc[9]); o1.y = pk2(acc[10], acc[11]); o1.z = pk2(acc[12], acc[13]); o1.w = pk2(acc[14], acc[15]);
            bf16* dst = Wc + (size_t)(hh * 128 + key) * 1024 + kb * 64 + kg * 16;
            *(v4u*)dst = o0; *(v4u*)(dst + 8) = o1;
        }
        __syncthreads();
    }
}

template <bool GATES, bool IN_BF16, bool OUT_I8 = false>
__device__ __forceinline__ void phase_rowpass(const Ctx& C, const Args& A, const void* xin, const float* gain, const float* modl  , int ch_shift, int ch_scale, bf16* hout, float* sa = nullptr) {
    f32x4 wg0[GATES ? 16 : 1], wg1[GATES ? 16 : 1];
    if (GATES) {
        const float* Wg = A.in[5] + 2048;
#pragma unroll
        for (int j = 0; j < 4; ++j)
#pragma unroll
            for (int e = 0; e < 4; ++e) { const int k = 4 * C.lane + 256 * j + e; wg0[4 * j + e] = *(const f32x4*)(Wg + (size_t)k * INW); wg1[4 * j + e] = *(const f32x4*)(Wg + (size_t)k * INW + 4); }
    }
    for (int row = C.gw; row < NTOK; row += C.NGW) {
        const int b = row >> 12;
        f32x4 v[4]; float ss = 0.f;
#pragma unroll
        for (int j = 0; j < 4; ++j) {
            if (IN_BF16) { const uint2 w = *(const uint2*)((const bf16*)xin + (size_t)row * DM + 4 * C.lane + 256 * j); v[j] = (f32x4){bflo(w.x), bfhi(w.x), bflo(w.y), bfhi(w.y)}; }
            else v[j] = *(const f32x4*)((const float*)xin + (size_t)row * DM + 4 * C.lane + 256 * j);
            ss += v[j].x * v[j].x + v[j].y * v[j].y + v[j].z * v[j].z + v[j].w * v[j].w; }
        const float rstd = rsqrtf(wave_sum(ss) * (1.f / DM) + EPS);
        const float* shp = modl + (size_t)b * 6144 + ch_shift * 1024 + 4 * C.lane; const float* scp = modl + (size_t)b * 6144 + ch_scale * 1024 + 4 * C.lane;
        f32x4 h[4];
#pragma unroll
        for (int j = 0; j < 4; ++j) { const f32x4 g = *(const f32x4*)(gain + 4 * C.lane + 256 * j), sc = *(const f32x4*)(scp + 256 * j), sh = *(const f32x4*)(shp + 256 * j);
            h[j] = v[j] * rstd * g * (sc + 1.0f) + sh;
            if (!OUT_I8) { uint2 o; o.x = pk2(h[j].x, h[j].y); o.y = pk2(h[j].z, h[j].w);
                *(uint2*)(hout + (size_t)row * DM + 4 * C.lane + 256 * j) = o; } }
        if (OUT_I8) {
            float am = 0.f;
#pragma unroll
            for (int j = 0; j < 4; ++j) am = fmaxf(am, fmaxf(fmaxf(fabsf(h[j].x), fabsf(h[j].y)), fmaxf(fabsf(h[j].z), fabsf(h[j].w))));
            am = fmaxf(wave_max(am), 1e-20f); const float qi = 127.f / am;
            unsigned char* h8 = (unsigned char*)hout + (size_t)row * DM + 4 * C.lane;
#pragma unroll
            for (int j = 0; j < 4; ++j) { const int q0 = (int)rintf(h[j].x * qi), q1 = (int)rintf(h[j].y * qi), q2 = (int)rintf(h[j].z * qi), q3 = (int)rintf(h[j].w * qi);
                *(unsigned*)(h8 + 256 * j) = ((unsigned)q0 & 255u) | (((unsigned)q1 & 255u) << 8) | (((unsigned)q2 & 255u) << 16) | ((unsigned)q3 << 24); }
            if (C.lane == 0) sa[row] = am * (1.f / 127.f);
        }
        if (GATES) {
            f32x4 d0 = {0.f, 0.f, 0.f, 0.f}, d1 = {0.f, 0.f, 0.f, 0.f};
#pragma unroll
            for (int j = 0; j < 4; ++j)
#pragma unroll
                for (int e = 0; e < 4; ++e) { const float hv = h[j][e]; d0 += wg0[4 * j + e] * hv; d1 += wg1[4 * j + e] * hv; }
            float d[8] = {d0.x, d0.y, d0.z, d0.w, d1.x, d1.y, d1.z, d1.w};
#pragma unroll
            for (int q = 0; q < 8; ++q) d[q] = wave_sum(d[q]);
            if (C.lane == 0) {
                const int s = row & (SEQ - 1); float* LF = (float*)(A.ws + WS_LF); float* LI = (float*)(A.ws + WS_LI);
#pragma unroll
                for (int hh = 0; hh < 4; ++hh) { LI[(size_t)(b * 4 + hh) * SEQ + s] = d[hh] + A.in[6][hh]; LF[(size_t)(b * 4 + hh) * SEQ + s] = logsigmoidf_(d[4 + hh] + A.in[7][hh]); }
            }
        }
    }
}

__device__ __forceinline__ void phase_conv(const Ctx& C, const Args& A) {
    const bf16* P = (const bf16*)(A.ws + WS_BIG); bf16* mix = (bf16*)(A.ws + WS_H); const float* cw = A.in[8];
    for (long it = C.gt; it < (long)NTOK * 64; it += C.NGT) {
        const int cg = (int)(it & 63), tok = (int)(it >> 6), t = tok & (SEQ - 1), c0 = cg * 8;
        float conv[8];
#pragma unroll
        for (int e = 0; e < 8; ++e) conv[e] = 0.f;
#pragma unroll
        for (int k = 0; k < 3; ++k) {
            const int dt = 2 - k;
            if (t - dt >= 0) {
                const bf16* r = P + (size_t)(tok - dt) * INP;
                const v4u cc = *(const v4u*)(r + 2560 + c0), chv = *(const v4u*)(r + 3072 + c0);
                const f32x4 w0 = *(const f32x4*)(cw + k * 512 + c0), w1 = *(const f32x4*)(cw + k * 512 + c0 + 4);
                conv[0] += w0.x * bflo(cc.x) * bflo(chv.x); conv[1] += w0.y * bfhi(cc.x) * bfhi(chv.x);
                conv[2] += w0.z * bflo(cc.y) * bflo(chv.y); conv[3] += w0.w * bfhi(cc.y) * bfhi(chv.y);
                conv[4] += w1.x * bflo(cc.z) * bflo(chv.z); conv[5] += w1.y * bfhi(cc.z) * bfhi(chv.z);
                conv[6] += w1.z * bflo(cc.w) * bflo(chv.w); conv[7] += w1.w * bfhi(cc.w) * bfhi(chv.w);
            }
        }
        const v4u cb = *(const v4u*)(P + (size_t)tok * INP + 2048 + c0);
        v4u o; o.x = pk2(conv[0] * bflo(cb.x), conv[1] * bfhi(cb.x)); o.y = pk2(conv[2] * bflo(cb.y), conv[3] * bfhi(cb.y));
        o.z = pk2(conv[4] * bflo(cb.z), conv[5] * bfhi(cb.z)); o.w = pk2(conv[6] * bflo(cb.w), conv[7] * bfhi(cb.w));
        *(v4u*)(mix + (size_t)tok * DM + 512 + c0) = o;
    }
}
constexpr size_t WS_TAB = 352 * MiB;
constexpr size_t TAB_BYTES = (size_t)16384 * 1024;
constexpr size_t WS_TSC = WS_TAB + 4 * TAB_BYTES;
constexpr size_t WS_XB = 420 * MiB;
constexpr size_t WS_END2 = WS_XB + 64 * MiB;
typedef float f32x2 __attribute__((ext_vector_type(2)));
typedef __bf16 bf16x2_t __attribute__((ext_vector_type(2)));
typedef unsigned u32x2 __attribute__((ext_vector_type(2)));
__device__ __forceinline__ float dot2bf(unsigned a, unsigned b, float c) { return __builtin_amdgcn_fdot2_f32_bf16(__builtin_bit_cast(bf16x2_t, a), __builtin_bit_cast(bf16x2_t, b), c, false); }
template <int CTRL> __device__ __forceinline__ unsigned dppu(unsigned v) { return (unsigned)__builtin_amdgcn_update_dpp(0, (int)v, CTRL, 0xF, 0xF, true); }
__device__ __forceinline__ float wave_sum_dpp(float v) {
    v += __uint_as_float(dppu<0xB1>(__float_as_uint(v)));
    v += __uint_as_float(dppu<0x4E>(__float_as_uint(v)));
    v += __uint_as_float(dppu<0x124>(__float_as_uint(v)));
    v += __uint_as_float(dppu<0x128>(__float_as_uint(v)));
    const unsigned u = __float_as_uint(v);
    return (__uint_as_float(__builtin_amdgcn_readlane(u, 0)) + __uint_as_float(__builtin_amdgcn_readlane(u, 16))) + (__uint_as_float(__builtin_amdgcn_readlane(u, 32)) + __uint_as_float(__builtin_amdgcn_readlane(u, 48)));
}
__device__ __forceinline__ void ins16(unsigned (&val)[16], unsigned k) {
#pragma unroll
    for (int j = 0; j < 16; ++j) { const unsigned t = val[j] < k ? val[j] : k; val[j] = val[j] < k ? k : val[j]; k = t; }
}
#define PEER_CE(x, i, l) { const unsigned a_ = x[i] < x[l] ? x[l] : x[i], b_ = x[i] < x[l] ? x[i] : x[l]; x[i] = a_; x[l] = b_; }
__device__ __forceinline__ void sort16_desc(unsigned (&x)[16]) {
#pragma unroll
    for (int k = 2; k <= 16; k <<= 1)
#pragma unroll
        for (int j = k >> 1; j > 0; j >>= 1)
#pragma unroll
            for (int i = 0; i < 16; ++i) { const int l = i ^ j; if (l > i) { if ((i & k) == 0) { PEER_CE(x, i, l) } else { PEER_CE(x, l, i) } } }
}
__device__ __forceinline__ void merge16_desc(unsigned (&v)[16], const unsigned (&s)[16]) {
#pragma unroll
    for (int i = 0; i < 16; ++i) v[i] = v[i] < s[15 - i] ? s[15 - i] : v[i];
#pragma unroll
    for (int j = 8; j > 0; j >>= 1)
#pragma unroll
        for (int i = 0; i < 16; ++i) { const int l = i ^ j; if (l > i) PEER_CE(v, i, l) }
}
__device__ __forceinline__ unsigned ord32(unsigned b) { return b ^ ((unsigned)((int)b >> 31) | 0x80000000u); }
__device__ __forceinline__ float unord(unsigned o, unsigned mask) { o &= mask; return __uint_as_float((o & 0x80000000u) ? (o ^ 0x80000000u) : (~o & mask)); }

template <bool NEXT, int DRY = 0>
__device__ __forceinline__ void phase_peer(const Ctx& C, const Args& A, const unsigned char* Utab, const unsigned char* Vtab, const float* SU, const float* SV, const float* g2  ,
                                           const float* ngain, const float* nmod  , const XcdBarrier& bar) {
    const bf16* SC = (const bf16*)(A.ws + WS_BIG); bf16* Hb = (bf16*)(A.ws + WS_H);
#ifndef PEER_NBK
#define PEER_NBK 32
#endif
    constexpr int NBK = PEER_NBK, BSH = (NBK == 32 ? 9 : NBK == 64 ? 8 : 7), BPL = NBK / 16;
    LAS unsigned char* wb = C.lds + C.wave * (1024 + 32 * NBK + 8192);
    LAS unsigned char* IDXB = wb; LAS unsigned* CNT = (LAS unsigned*)(wb + 1024); LAS unsigned* PRE = (LAS unsigned*)(wb + 1024 + 16 * NBK); LAS v4u* ENT = (LAS v4u*)(wb + 1024 + 32 * NBK);
#ifndef PEER_SYNC_EVERY
#define PEER_SYNC_EVERY 32
#endif
    const bool wg_uniform = (DRY != 6) && ((NTOK / 4) % C.NGW == 0);
    unsigned flip = 0u;
#ifdef PEER_STAGGER
    if (C.wave >= 4) { const unsigned long long t0_ = __builtin_amdgcn_s_memrealtime(); while (__builtin_amdgcn_s_memrealtime() - t0_ < (unsigned long long)PEER_STAGGER) __builtin_amdgcn_s_sleep(16); }
#endif
    const int gw_ = (DRY == 6) ? ((C.bid >> 1) * NWAVES + C.wave) : C.gw, ngw_ = (DRY == 6) ? (C.NGW >> 1) : C.NGW;
    if (DRY == 6 && (C.bid & 1)) return;
    for (int tb = gw_; tb < NTOK / 4; tb += ngw_) {
        const int tok0 = tb * 4;
#if MK_ONE_LAUNCH && defined(PEER_SYNC)
        if (tb >= C.NGW) xcd_barrier(bar);
#endif
        int lane = C.lane; asm volatile("" : "+v"(lane));
        const int par = lane & 1, tl = lane >> 4, grp = lane & 15, head = grp >> 1, i16 = lane & 15;
        {
            unsigned val[16];
            const v4u* sp = (const v4u*)(SC + (size_t)(tok0 + tl) * 2048 + grp * 128);
            v4u raw[16];
#pragma unroll
            for (int c = 0; c < 16; ++c) raw[c] = sp[c];
#pragma unroll
            for (int c = 0; c < 16; c += 2) {
                const v4u c0 = raw[c], c1 = raw[c + 1];
                const unsigned ib = 127u - 8u * (unsigned)c;
                unsigned ks[16];
#pragma unroll
                for (int e = 0; e < 4; ++e) { ks[2 * e] = (ord32(c0[e] << 16) & 0xFFFF0000u) | (ib - 2u * e); ks[2 * e + 1] = (ord32(c0[e] & 0xFFFF0000u) & 0xFFFF0000u) | (ib - 2u * e - 1u);
                    ks[8 + 2 * e] = (ord32(c1[e] << 16) & 0xFFFF0000u) | (ib - 8u - 2u * e); ks[9 + 2 * e] = (ord32(c1[e] & 0xFFFF0000u) & 0xFFFF0000u) | (ib - 9u - 2u * e); }
                sort16_desc(ks);
                if (c == 0) {
#pragma unroll
                    for (int j = 0; j < 16; ++j) val[j] = ks[j];
                } else merge16_desc(val, ks);
            }
#pragma unroll
            for (int z = 0; z < NBK / 16; ++z) CNT[lane + 64 * z] = 0u;
            float X[16], Y[16];
            v4u ib4 = {0u, 0u, 0u, 0u};
#pragma unroll
            for (int j = 0; j < 16; ++j) { X[j] = unord(val[j], 0xFFFF0000u); Y[j] = unord(dppu<0xB1>(val[j]), 0xFFFF0000u); ib4[j >> 2] |= (127u - (val[j] & 127u)) << (8 * (j & 3)); }
            *(LAS v4u*)(IDXB + lane * 16) = ib4;
            unsigned cand[16], cb2[16];
            unsigned parv = (unsigned)par; asm volatile("" : "+v"(parv));
#define PEER_CKEY(p, q) ((((p) == (q)) && parv) ? 0u : ((ord32(__float_as_uint(X[p] + Y[q])) & 0xFFFFFF00u) | (255u - ((unsigned)((p) * 16 + (q)) + parv * (unsigned)(15 * ((q) - (p)))))))
            cand[0] = PEER_CKEY(0, 0); cand[1] = PEER_CKEY(0, 1); cand[2] = PEER_CKEY(0, 2); cand[3] = PEER_CKEY(0, 3); cand[4] = PEER_CKEY(0, 4); cand[5] = PEER_CKEY(0, 5); cand[6] = PEER_CKEY(0, 6); cand[7] = PEER_CKEY(0, 7);
            cand[8] = PEER_CKEY(0, 8); cand[9] = PEER_CKEY(0, 9); cand[10] = PEER_CKEY(0, 10); cand[11] = PEER_CKEY(0, 11); cand[12] = PEER_CKEY(0, 12); cand[13] = PEER_CKEY(0, 13); cand[14] = PEER_CKEY(0, 14); cand[15] = PEER_CKEY(0, 15);
            cb2[0] = PEER_CKEY(1, 1); cb2[1] = PEER_CKEY(1, 2); cb2[2] = PEER_CKEY(1, 3); cb2[3] = PEER_CKEY(1, 4); cb2[4] = PEER_CKEY(1, 5); cb2[5] = PEER_CKEY(1, 6); cb2[6] = PEER_CKEY(1, 7);
            cb2[7] = PEER_CKEY(2, 2); cb2[8] = PEER_CKEY(2, 3); cb2[9] = PEER_CKEY(2, 4); cb2[10] = PEER_CKEY(3, 3); cb2[11] = 0u; cb2[12] = 0u; cb2[13] = 0u; cb2[14] = 0u; cb2[15] = 0u;
#undef PEER_CKEY
            sort16_desc(cand); sort16_desc(cb2); merge16_desc(cand, cb2);
            unsigned mg[16]; float fv[16]; float mx = -INFINITY;
#pragma unroll
            for (int k = 0; k < 16; ++k) { const unsigned o = dppu<0xB1>(cand[15 - k]); mg[k] = cand[k] < o ? o : cand[k]; fv[k] = unord(mg[k], 0xFFFFFF00u); mx = fmaxf(mx, fv[k]); }
            float ssum = 0.f;
#pragma unroll
            for (int k = 0; k < 16; ++k) { fv[k] = __expf(fv[k] - mx); ssum += fv[k]; }
            const float inv = 1.f / ssum;
            asm volatile("s_waitcnt lgkmcnt(0)" ::: "memory");
            unsigned eid[8], rk[8]; float esu[8], egv[8];
#pragma unroll
            for (int k = 0; k < 8; ++k) { const unsigned fi = 255u - (mg[k] & 255u);
                const unsigned e1 = IDXB[(lane & ~1) * 16 + (fi >> 4)], e2 = IDXB[(lane | 1) * 16 + (fi & 15u)];
                eid[k] = e1 * 128u + e2;
                rk[k] = __hip_atomic_fetch_add(CNT + tl * NBK + (eid[k] >> BSH), 1u, __ATOMIC_RELAXED, __HIP_MEMORY_SCOPE_WORKGROUP);
                esu[k] = SU[eid[k]]; egv[k] = fv[k] * inv * SV[eid[k]]; }
            asm volatile("s_waitcnt lgkmcnt(0)" ::: "memory");
            { unsigned cb[BPL]; unsigned s = 0u;
#pragma unroll
              for (int z = 0; z < BPL; ++z) { cb[z] = CNT[tl * NBK + BPL * i16 + z]; s += cb[z]; }
              const unsigned tot = s;
              s += dppu<0x111>(s); s += dppu<0x112>(s); s += dppu<0x114>(s); s += dppu<0x118>(s);
              unsigned ex = s - tot;
#pragma unroll
              for (int z = 0; z < BPL; ++z) { PRE[tl * NBK + BPL * i16 + z] = ex; ex += cb[z]; } }
            asm volatile("s_waitcnt lgkmcnt(0)" ::: "memory");
#pragma unroll
            for (int k = 0; k < 8; ++k) { unsigned pos = PRE[tl * NBK + (eid[k] >> BSH)] + rk[k]; pos = flip ? 127u - pos : pos;
                ENT[tl * 128 + pos] = (v4u){eid[k], __float_as_uint(esu[k]), __float_as_uint(egv[k]), 0u}; }
            asm volatile("s_waitcnt lgkmcnt(0)" ::: "memory");
            flip ^= 1u;
        }
        if (wg_uniform) __syncthreads();
        if (DRY != 3) {
            const int tok = tok0 + tl; const int b = tok >> 12;
            LAS v4u* E = ENT + tl * 128;
            float cmax = 0.f;
            {
                unsigned hq[16]; const float hs = ((const float*)(A.ws + WS_SA))[tok];
#pragma unroll
                for (int j = 0; j < 4; ++j) { const v4u hw = *(const v4u*)(A.ws + WS_IDS + (size_t)tok * DM + 256 * j + 16 * i16); hq[4 * j] = hw.x; hq[4 * j + 1] = hw.y; hq[4 * j + 2] = hw.z; hq[4 * j + 3] = hw.w; }
                v4u B[8][4]; unsigned idr[8]; float mine = 0.f;
#define PEER_LOADI(R_, tab, id_) { const unsigned off = ((id_) & (DRY == 2 ? 1023u : 16383u)) * 1024u + 16u * (unsigned)i16; \
                _Pragma("unroll") for (int j = 0; j < 4; ++j) R_[j] = (DRY == 5 && j >= 2) ? R_[j - 2] : *(const v4u*)((tab) + off + 256 * j); }
#define PEER_DOTS(U_, t_) { int d0 = 0, d1 = 0, d2 = 0, d3 = 0; \
                _Pragma("unroll") for (int e = 0; e < 4; ++e) { d0 = __builtin_amdgcn_sdot4((int)U_[0][e], (int)hq[e], d0, false); d1 = __builtin_amdgcn_sdot4((int)U_[1][e], (int)hq[4 + e], d1, false); \
                    d2 = __builtin_amdgcn_sdot4((int)U_[2][e], (int)hq[8 + e], d2, false); d3 = __builtin_amdgcn_sdot4((int)U_[3][e], (int)hq[12 + e], d3, false); } \
                unsigned ds_ = (unsigned)((d0 + d1) + (d2 + d3)); ds_ += dppu<0xB1>(ds_); ds_ += dppu<0x4E>(ds_); ds_ += dppu<0x124>(ds_); ds_ += dppu<0x128>(ds_); \
                mine = (i16 == ((t_) & 15)) ? (float)(int)ds_ : mine; }
#pragma unroll
                for (int k = 0; k < 8; ++k) idr[k] = E[k].x;
#pragma unroll
                for (int k = 0; k < 8; ++k) PEER_LOADI(B[k], Utab, idr[k])
#pragma unroll 1
                for (int r = 0; r < 128; r += 8) {
                    if (wg_uniform && (r & (PEER_SYNC_EVERY - 1)) == 0 && r) __syncthreads();
                    if (r + 8 < 128) {
#pragma unroll
                        for (int k = 0; k < 8; ++k) idr[k] = E[r + 8 + k].x;
                    }
#pragma unroll
                    for (int k = 0; k < 8; ++k) { PEER_DOTS(B[k], r + k) if (r + 8 < 128) PEER_LOADI(B[k], Utab, idr[k]) }
                    if (r & 8) {
                        const int t = (r & ~15) + i16; const v4u en = E[t];
                        const float cf = gelu_as(mine * (__uint_as_float(en.y) * hs)) * __uint_as_float(en.z);
                        ((LAS float*)(E + t))[3] = cf; cmax = fmaxf(cmax, fabsf(cf));
                    }
                }
#undef PEER_DOTS
            }
            if (wg_uniform) __syncthreads();
            cmax = fmaxf(cmax, __uint_as_float(dppu<0xB1>(__float_as_uint(cmax)))); cmax = fmaxf(cmax, __uint_as_float(dppu<0x4E>(__float_as_uint(cmax))));
            cmax = fmaxf(cmax, __uint_as_float(dppu<0x124>(__float_as_uint(cmax)))); cmax = fmaxf(cmax, __uint_as_float(dppu<0x128>(__float_as_uint(cmax))));
            cmax = fmaxf(cmax, 1e-30f);
            int acci[4][16];
#pragma unroll
            for (int j = 0; j < 4; ++j)
#pragma unroll
                for (int e = 0; e < 16; ++e) acci[j][e] = 0;
            if (DRY != 4) {
                const float cq = 127.f / cmax;
                asm volatile("s_waitcnt lgkmcnt(0)" ::: "memory");
                unsigned pk0, pk1;
                { int q[8];
#pragma unroll
                  for (int k = 0; k < 8; ++k) q[k] = (int)rintf(((const LAS float*)(E + 8 * i16 + k))[3] * cq);
                  pk0 = ((unsigned)q[0] & 255u) | (((unsigned)q[1] & 255u) << 8) | (((unsigned)q[2] & 255u) << 16) | ((unsigned)q[3] << 24);
                  pk1 = ((unsigned)q[4] & 255u) | (((unsigned)q[5] & 255u) << 8) | (((unsigned)q[6] & 255u) << 16) | ((unsigned)q[7] << 24); }
                asm volatile("s_waitcnt lgkmcnt(0)" ::: "memory");
                ((LAS unsigned*)(E + 2 * i16))[1] = pk0; ((LAS unsigned*)(E + 2 * i16 + 1))[1] = pk1;
                asm volatile("s_waitcnt lgkmcnt(0)" ::: "memory");
                v4u Ba[4][2], Bb[4][2];
#define PEER_LOADG(B_, g_, hf_) { _Pragma("unroll") for (int n = 0; n < 4; ++n) { const unsigned id_ = E[4 * (g_) + n].x; const unsigned off = (id_ & (DRY == 2 ? 1023u : 16383u)) * 1024u + 16u * (unsigned)i16 + 512u * (hf_); \
                    _Pragma("unroll") for (int jj = 0; jj < 2; ++jj) B_[n][jj] = *(const v4u*)(Vtab + off + 256 * jj); } }
#define PEER_GROUP(B_, g_, hf_) { const unsigned a4 = ((const LAS unsigned*)(E + (g_)))[1]; \
                    _Pragma("unroll") for (int jj = 0; jj < 2; ++jj) _Pragma("unroll") for (int e = 0; e < 4; ++e) { \
                        const unsigned p01l = __builtin_amdgcn_perm(B_[1][jj][e], B_[0][jj][e], 0x05010400u), p01h = __builtin_amdgcn_perm(B_[1][jj][e], B_[0][jj][e], 0x07030602u); \
                        const unsigned p23l = __builtin_amdgcn_perm(B_[3][jj][e], B_[2][jj][e], 0x05010400u), p23h = __builtin_amdgcn_perm(B_[3][jj][e], B_[2][jj][e], 0x07030602u); \
                        acci[2 * (hf_) + jj][4 * e + 0] = __builtin_amdgcn_sdot4((int)__builtin_amdgcn_perm(p23l, p01l, 0x05040100u), (int)a4, acci[2 * (hf_) + jj][4 * e + 0], false); \
                        acci[2 * (hf_) + jj][4 * e + 1] = __builtin_amdgcn_sdot4((int)__builtin_amdgcn_perm(p23l, p01l, 0x07060302u), (int)a4, acci[2 * (hf_) + jj][4 * e + 1], false); \
                        acci[2 * (hf_) + jj][4 * e + 2] = __builtin_amdgcn_sdot4((int)__builtin_amdgcn_perm(p23h, p01h, 0x05040100u), (int)a4, acci[2 * (hf_) + jj][4 * e + 2], false); \
                        acci[2 * (hf_) + jj][4 * e + 3] = __builtin_amdgcn_sdot4((int)__builtin_amdgcn_perm(p23h, p01h, 0x07060302u), (int)a4, acci[2 * (hf_) + jj][4 * e + 3], false); } }
                PEER_LOADG(Ba, 0, 0)
#pragma unroll 1
                for (int g = 0; g < 32; ++g) {
                    if (wg_uniform && (g & (PEER_SYNC_EVERY / 4 - 1)) == 0 && g) __syncthreads();
                    PEER_LOADG(Bb, g, 1)
                    PEER_GROUP(Ba, g, 0)
                    if (g + 1 < 32) PEER_LOADG(Ba, g + 1, 0)
                    PEER_GROUP(Bb, g, 1)
                }
#undef PEER_LOADG
#undef PEER_GROUP
            }
            const float osc = cmax * (1.f / 127.f);
            f32x2 acc[4][8];
#pragma unroll
            for (int j = 0; j < 4; ++j)
#pragma unroll
                for (int e = 0; e < 8; ++e) acc[j][e] = (f32x2){(float)acci[j][2 * e] * osc, (float)acci[j][2 * e + 1] * osc};
#undef PEER_LOADI
            float ss = 0.f;
#pragma unroll
            for (int j = 0; j < 4; ++j) { const size_t eo = (size_t)tok * DM + 256 * j + 16 * i16; const float* gp = g2 + (size_t)b * 6144 + 256 * j + 16 * i16;
                bf16* XBp = (bf16*)(A.ws + WS_XB) + eo; const v4u xw0 = *(const v4u*)XBp, xw1 = *(const v4u*)(XBp + 8);
                unsigned ow[8];
#pragma unroll
                for (int q = 0; q < 4; ++q) { const unsigned w0 = q < 2 ? xw0[2 * q] : xw1[2 * q - 4], w1 = q < 2 ? xw0[2 * q + 1] : xw1[2 * q - 3]; const f32x4 g0 = *(const f32x4*)(gp + 4 * q);
                    const f32x4 xn = {bflo(w0) + (1.f + g0[0]) * acc[j][2 * q].x, bfhi(w0) + (1.f + g0[1]) * acc[j][2 * q].y, bflo(w1) + (1.f + g0[2]) * acc[j][2 * q + 1].x, bfhi(w1) + (1.f + g0[3]) * acc[j][2 * q + 1].y};
                    if (NEXT) { ow[2 * q] = pk2(xn[0], xn[1]); ow[2 * q + 1] = pk2(xn[2], xn[3]); }
                    else if (DRY == 0 || xn[0] == 1234.5678f) *(f32x4*)(A.out + eo + 4 * q) = xn;
                    acc[j][2 * q] = (f32x2){xn[0], xn[1]}; acc[j][2 * q + 1] = (f32x2){xn[2], xn[3]};
                    ss += (xn[0] * xn[0] + xn[1] * xn[1]) + (xn[2] * xn[2] + xn[3] * xn[3]); }
                if (NEXT && (DRY == 0 || ss == 1234.5678f)) { *(v4u*)XBp = (v4u){ow[0], ow[1], ow[2], ow[3]}; *(v4u*)(XBp + 8) = (v4u){ow[4], ow[5], ow[6], ow[7]}; } }
            if (DRY != 0) { if (ss == 1234.5678f) A.out[tok] = ss; }
            if (NEXT && DRY == 0) {
                ss += __uint_as_float(dppu<0xB1>(__float_as_uint(ss))); ss += __uint_as_float(dppu<0x4E>(__float_as_uint(ss)));
                ss += __uint_as_float(dppu<0x124>(__float_as_uint(ss))); ss += __uint_as_float(dppu<0x128>(__float_as_uint(ss)));
                const float rstd = rsqrtf(ss * (1.f / DM) + EPS);
                float am = 0.f;
#pragma unroll
                for (int j = 0; j < 4; ++j) { const int c0 = 256 * j + 16 * i16; const float* shp = nmod + (size_t)b * 6144 + c0; const float* scp = shp + 1024;
#pragma unroll
                    for (int q = 0; q < 4; ++q) { const f32x4 gn = *(const f32x4*)(ngain + c0 + 4 * q), sc = *(const f32x4*)(scp + 4 * q), sh = *(const f32x4*)(shp + 4 * q);
                        const f32x2 h0 = {acc[j][2 * q].x * rstd * gn[0] * (1.f + sc[0]) + sh[0], acc[j][2 * q].y * rstd * gn[1] * (1.f + sc[1]) + sh[1]};
                        const f32x2 h1 = {acc[j][2 * q + 1].x * rstd * gn[2] * (1.f + sc[2]) + sh[2], acc[j][2 * q + 1].y * rstd * gn[3] * (1.f + sc[3]) + sh[3]};
                        acc[j][2 * q] = h0; acc[j][2 * q + 1] = h1; am = fmaxf(am, fmaxf(fmaxf(fabsf(h0.x), fabsf(h0.y)), fmaxf(fabsf(h1.x), fabsf(h1.y)))); } }
                am = fmaxf(am, __uint_as_float(dppu<0xB1>(__float_as_uint(am)))); am = fmaxf(am, __uint_as_float(dppu<0x4E>(__float_as_uint(am))));
                am = fmaxf(am, __uint_as_float(dppu<0x124>(__float_as_uint(am)))); am = fmaxf(am, __uint_as_float(dppu<0x128>(__float_as_uint(am))));
                am = fmaxf(am, 1e-20f); const float qi = 127.f / am;
#pragma unroll
                for (int j = 0; j < 4; ++j) { v4u o;
#pragma unroll
                    for (int q = 0; q < 4; ++q) { const int q0 = (int)rintf(acc[j][2 * q].x * qi), q1 = (int)rintf(acc[j][2 * q].y * qi), q2 = (int)rintf(acc[j][2 * q + 1].x * qi), q3 = (int)rintf(acc[j][2 * q + 1].y * qi);
                        o[q] = ((unsigned)q0 & 255u) | (((unsigned)q1 & 255u) << 8) | (((unsigned)q2 & 255u) << 16) | ((unsigned)q3 << 24); }
                    *(v4u*)(A.ws + WS_IDS + (size_t)tok * DM + 256 * j + 16 * i16) = o; }
                if (i16 == 0) ((float*)(A.ws + WS_SA))[tok] = am * (1.f / 127.f);
            }
        }
    }
}
__device__ __forceinline__ void convert_tables_int8(const Ctx& C, const Args& A) {
    unsigned char* T8 = A.ws + WS_TAB; float* TS = (float*)(A.ws + WS_TSC);
    for (int R0 = C.gw * 4; R0 < 4 * 16384; R0 += C.NGW * 4) {
        const int t = R0 >> 14;
        const float* src = A.in[t == 0 ? 15 : t == 1 ? 16 : t == 2 ? 28 : 29] + (size_t)(R0 & 16383) * DM + 16 * C.lane;
        f32x4 x[4][4]; float am[4];
#pragma unroll
        for (int r = 0; r < 4; ++r) { am[r] = 0.f;
#pragma unroll
            for (int q = 0; q < 4; ++q) x[r][q] = *(const f32x4*)(src + (size_t)r * DM + 4 * q); }
#pragma unroll
        for (int r = 0; r < 4; ++r) {
#pragma unroll
            for (int q = 0; q < 4; ++q) am[r] = fmaxf(am[r], fmaxf(fmaxf(fabsf(x[r][q].x), fabsf(x[r][q].y)), fmaxf(fabsf(x[r][q].z), fabsf(x[r][q].w))));
            am[r] = wave_max(am[r]);
            const float sc = (am[r] > 0.f) ? 127.f / am[r] : 1.f, inv = (am[r] > 0.f) ? am[r] * (1.f / 127.f) : 1.f;
            v4u o;
#pragma unroll
            for (int q = 0; q < 4; ++q) { const int q0 = (int)rintf(x[r][q].x * sc), q1 = (int)rintf(x[r][q].y * sc), q2 = (int)rintf(x[r][q].z * sc), q3 = (int)rintf(x[r][q].w * sc);
                o[q] = ((unsigned)q0 & 255u) | (((unsigned)q1 & 255u) << 8) | (((unsigned)q2 & 255u) << 16) | ((unsigned)q3 << 24); }
            *(v4u*)(T8 + (size_t)(R0 + r) * DM + 16 * C.lane) = o;
            if (C.lane == 0) TS[R0 + r] = inv;
        }
    }
}
constexpr size_t WS_NL = 3 * MiB, WS_NP = WS_NL + 512 * 1024;
constexpr size_t WS_GC = WS_MOD + 512 * 1024, WS_ML = WS_GC + 4096, WS_MP = WS_ML + 4096;
constexpr size_t OUT_SL = 0, OUT_SP = 64 * MiB;
typedef float f32x16 __attribute__((ext_vector_type(16)));
typedef short s16x4 __attribute__((ext_vector_type(4)));
__device__ __forceinline__ unsigned offb(unsigned row, unsigned ch) { return 256u * row + 16u * (ch ^ (((row & 3u) << 2) | ((row >> 2) & 3u))); }
__device__ __forceinline__ s16x4 tr_read4(unsigned lds_addr) { s16x4 r; asm volatile("ds_read_b64_tr_b16 %0, %1\n\ts_waitcnt lgkmcnt(0)" : "=&v"(r) : "v"(lds_addr) : "memory"); return r; }
__device__ __forceinline__ void tr_read4x2(s16x4& r0, s16x4& r1, unsigned a0, unsigned a1) {
    asm volatile("ds_read_b64_tr_b16 %0, %2\n\tds_read_b64_tr_b16 %1, %3\n\ts_waitcnt lgkmcnt(0)" : "=&v"(r0), "=&v"(r1) : "v"(a0), "v"(a1) : "memory"); }
__device__ __forceinline__ void tr_read4x6(s16x4 (&r)[6], unsigned a0, unsigned a1, unsigned a2, unsigned a3, unsigned a4, unsigned a5) {
    asm volatile("ds_read_b64_tr_b16 %0, %6\n\tds_read_b64_tr_b16 %1, %7\n\tds_read_b64_tr_b16 %2, %8\n\tds_read_b64_tr_b16 %3, %9\n\tds_read_b64_tr_b16 %4, %10\n\tds_read_b64_tr_b16 %5, %11\n\ts_waitcnt lgkmcnt(0)"
                 : "=&v"(r[0]), "=&v"(r[1]), "=&v"(r[2]), "=&v"(r[3]), "=&v"(r[4]), "=&v"(r[5]) : "v"(a0), "v"(a1), "v"(a2), "v"(a3), "v"(a4), "v"(a5) : "memory"); }
__device__ __forceinline__ void tr_read4x8(s16x4 (&r)[8], unsigned a0, unsigned a1, unsigned a2, unsigned a3, unsigned a4, unsigned a5, unsigned a6, unsigned a7) {
    asm volatile("ds_read_b64_tr_b16 %0, %8\n\tds_read_b64_tr_b16 %1, %9\n\tds_read_b64_tr_b16 %2, %10\n\tds_read_b64_tr_b16 %3, %11\n\tds_read_b64_tr_b16 %4, %12\n\tds_read_b64_tr_b16 %5, %13\n\tds_read_b64_tr_b16 %6, %14\n\tds_read_b64_tr_b16 %7, %15\n\ts_waitcnt lgkmcnt(0)"
                 : "=&v"(r[0]), "=&v"(r[1]), "=&v"(r[2]), "=&v"(r[3]), "=&v"(r[4]), "=&v"(r[5]), "=&v"(r[6]), "=&v"(r[7]) : "v"(a0), "v"(a1), "v"(a2), "v"(a3), "v"(a4), "v"(a5), "v"(a6), "v"(a7) : "memory"); }
__device__ __forceinline__ float scan_sum64(float v, int lane) {
#pragma unroll
    for (int o = 1; o < 64; o <<= 1) { const float t = __shfl_up(v, o); if (lane >= o) v += t; }
    return v;
}
__device__ __forceinline__ float scan_max64(float v, int lane) {
#pragma unroll
    for (int o = 1; o < 64; o <<= 1) { const float t = __shfl_up(v, o); if (lane >= o) v = fmaxf(v, t); }
    return v;
}
__device__ __forceinline__ pg8::bf16x8 mk_frag(s16x4 a, s16x4 b) { return (pg8::bf16x8){a[0], a[1], a[2], a[3], b[0], b[1], b[2], b[3]}; }

__device__ __forceinline__ void phase_mlstm_local(const Ctx& C, const Args& A) {
    const bf16* P = (const bf16*)(A.ws + WS_BIG);
    const float* LF = (const float*)(A.ws + WS_LF); const float* LI = (const float*)(A.ws + WS_LI);
    bf16* SL = (bf16*)((unsigned char*)A.out + OUT_SL); float* NL = (float*)(A.ws + WS_NL);
    float* GC = (float*)(A.ws + WS_GC); float* ML = (float*)(A.ws + WS_ML);
    LAS unsigned char* tK = C.lds; LAS unsigned char* tV = C.lds + 32768; LAS float* wtab = (LAS float*)(C.lds + 65536);
    const unsigned ldsK = (unsigned)(uintptr_t)tK, ldsV = (unsigned)(uintptr_t)tV;
    const int lane = C.lane, wid = C.wave, tid = C.tid;
    for (int unit = C.bid; unit < 1024; unit += C.G) {
        const int bh = unit >> 5, c = unit & 31, b = bh >> 2, hh = bh & 3;
        const size_t tok0 = (size_t)b * SEQ + c * 128;
        v4u kvr[4], vvr[4];
#pragma unroll
        for (int i = 0; i < 4; ++i) { const int id = tid + 512 * i, row = id >> 4, ch = id & 15;
            const bf16* src = P + (tok0 + row) * INP + hh * 128 + ch * 8;
            kvr[i] = *(const v4u*)(src + 512); vvr[i] = *(const v4u*)(src + 1024); }
        if (wid == 0) {
            const float2 lf = *(const float2*)(LF + (size_t)bh * SEQ + c * 128 + 2 * lane), li = *(const float2*)(LI + (size_t)bh * SEQ + c * 128 + 2 * lane);
            const float pr = lf.x + lf.y, inc = scan_sum64(pr, lane), ex = inc - pr;
            const float b0 = ex + lf.x, b1 = b0 + lf.y;
            const float g = __shfl(inc, 63);
            const float a0 = g - b0 + li.x, a1 = g - b1 + li.y;
            const float mloc = wave_max(fmaxf(a0, a1));
            wtab[2 * lane] = __expf(a0 - mloc); wtab[2 * lane + 1] = __expf(a1 - mloc);
            if (lane == 0) { GC[unit] = g; ML[unit] = mloc; }
        }
        __syncthreads();
#pragma unroll
        for (int i = 0; i < 4; ++i) { const int id = tid + 512 * i, row = id >> 4, ch = id & 15;
            const v4u kv = kvr[i], vv = vvr[i];
            const float w = wtab[row];
            v4u ko; ko.x = pk2(bflo(kv.x) * w, bfhi(kv.x) * w); ko.y = pk2(bflo(kv.y) * w, bfhi(kv.y) * w); ko.z = pk2(bflo(kv.z) * w, bfhi(kv.z) * w); ko.w = pk2(bflo(kv.w) * w, bfhi(kv.w) * w);
            *(LAS v4u*)(tK + offb(row, ch)) = ko; *(LAS v4u*)(tV + offb(row, ch)) = vv; }
        __syncthreads();
        if (tid < 128) { const int d = tid; float s = 0.f;
#pragma unroll 8
            for (int l = 0; l < 128; ++l) s += bf2f(*(const LAS unsigned short*)(tK + offb(l, d >> 3) + (d & 7) * 2));
            NL[(size_t)unit * 128 + d] = s; }
        {
            const int db = wid & 3, eh = wid >> 2;
            const unsigned h = lane >> 5, blk = (lane >> 4) & 1, q = (lane & 15) >> 2, p = lane & 3;
            f32x16 acc[2];
#pragma unroll
            for (int eb = 0; eb < 2; ++eb)
#pragma unroll
                for (int r = 0; r < 16; ++r) acc[eb][r] = 0.f;
#pragma unroll
            for (int ks = 0; ks < 8; ++ks) {
                const unsigned r0 = 16 * ks + 8 * h + q, cA = 4 * db + 2 * blk + (p >> 1), cB0 = 4 * (2 * eh) + 2 * blk + (p >> 1), cB1 = cB0 + 4, po = 8 * (p & 1);
                s16x4 t[6];
                tr_read4x6(t, ldsK + offb(r0, cA) + po, ldsK + offb(r0 + 4, cA) + po, ldsV + offb(r0, cB0) + po, ldsV + offb(r0 + 4, cB0) + po, ldsV + offb(r0, cB1) + po, ldsV + offb(r0 + 4, cB1) + po);
                const pg8::bf16x8 af = mk_frag(t[0], t[1]);
                acc[0] = __builtin_amdgcn_mfma_f32_32x32x16_bf16(af, mk_frag(t[2], t[3]), acc[0], 0, 0, 0);
                acc[1] = __builtin_amdgcn_mfma_f32_32x32x16_bf16(af, mk_frag(t[4], t[5]), acc[1], 0, 0, 0);
            }
            const int hi = lane >> 5;
#pragma unroll
            for (int eb = 0; eb < 2; ++eb) { const int e = 32 * (2 * eh + eb) + (lane & 31);
#pragma unroll
                for (int g4 = 0; g4 < 4; ++g4) { uint2 o; o.x = pk2(acc[eb][4 * g4], acc[eb][4 * g4 + 1]); o.y = pk2(acc[eb][4 * g4 + 2], acc[eb][4 * g4 + 3]);
                    *(uint2*)(SL + ((size_t)unit * 128 + e) * 128 + 32 * db + 8 * g4 + 4 * hi) = o; } }
        }
        __syncthreads();
    }
}

__device__ __forceinline__ void phase_mlstm_scan(const Ctx& C, const Args& A) {
    const bf16* SL = (const bf16*)((unsigned char*)A.out + OUT_SL); bf16* SP = (bf16*)((unsigned char*)A.out + OUT_SP);
    const float* NL = (const float*)(A.ws + WS_NL); float* NP = (float*)(A.ws + WS_NP);
    const float* GC = (const float*)(A.ws + WS_GC); const float* ML = (const float*)(A.ws + WS_ML); float* MP = (float*)(A.ws + WS_MP);
    for (long it = C.gt; it < 32L * 128 * 32; it += C.NGT) {
        const int d4 = (int)(it & 31), e = (int)((it >> 5) & 127), bh = (int)(it >> 12);
        f32x4 s = {0.f, 0.f, 0.f, 0.f}, n = {0.f, 0.f, 0.f, 0.f}; float m = 0.f;
        const bool do_n = (e == 0);
#pragma unroll 1
        for (int c0 = 0; c0 < 32; c0 += 16) {
            uint2 xw[16]; float gq[16], mq[16];
#pragma unroll
            for (int k = 0; k < 16; ++k) { const size_t unit = (size_t)bh * 32 + c0 + k;
                xw[k] = *(const uint2*)(SL + (unit * 128 + e) * 128 + 4 * d4); gq[k] = GC[unit]; mq[k] = ML[unit]; }
#pragma unroll
            for (int k = 0; k < 16; ++k) {
                const size_t unit = (size_t)bh * 32 + c0 + k;
                uint2 o; o.x = pk2(s.x, s.y); o.y = pk2(s.z, s.w);
                *(uint2*)(SP + (unit * 128 + e) * 128 + 4 * d4) = o;
                if (do_n) { *(f32x4*)(NP + unit * 128 + 4 * d4) = n; if (d4 == 0) MP[unit] = m; }
                const float g = gq[k], ml = mq[k];
                const float mn = fmaxf(g + m, ml), dec = __expf(g + m - mn), sc = __expf(ml - mn);
                const f32x4 x = {bflo(xw[k].x), bfhi(xw[k].x), bflo(xw[k].y), bfhi(xw[k].y)};
                s = s * dec + x * sc;
                if (do_n) { const f32x4 y = *(const f32x4*)(NL + unit * 128 + 4 * d4); n = n * dec + y * sc; }
                m = mn;
            }
        }
    }
}

__device__ __forceinline__ void phase_mlstm_out(const Ctx& C, const Args& A) {
    const bf16* P = (const bf16*)(A.ws + WS_BIG); bf16* mix = (bf16*)(A.ws + WS_H);
    const float* LF = (const float*)(A.ws + WS_LF); const float* LI = (const float*)(A.ws + WS_LI);
    const bf16* SP = (const bf16*)((unsigned char*)A.out + OUT_SP); const float* NP = (const float*)(A.ws + WS_NP); const float* MP = (const float*)(A.ws + WS_MP);
    const float* gain = A.in[9];
    LAS unsigned char* tV = C.lds; LAS unsigned char* tK = C.lds + 32768; LAS float* abt = (LAS float*)(C.lds + 65536); LAS float* Mt = abt + 128; LAS float* bt = abt + 256; LAS float* npt = abt + 384; LAS float* ssq = abt + 512;
    const unsigned ldsV = (unsigned)(uintptr_t)tV;
    const int lane = C.lane, wid = C.wave, tid = C.tid, hi = lane >> 5, l31 = lane & 31;
    constexpr float QS = 0.08838834764831845f;
    for (int unit = C.bid; unit < 1024; unit += C.G) {
        const int bh = unit >> 5, c = unit & 31, b = bh >> 2, hh = bh & 3;
        const size_t tok0 = (size_t)b * SEQ + c * 128;
        const float mprev = MP[unit];
        const int lb = wid & 3, eh = wid >> 2;
        const int l = 32 * lb + l31;
        v4u vvr[4], kvr[4];
#pragma unroll
        for (int i = 0; i < 4; ++i) { const int id = tid + 512 * i, row = id >> 4, ch = id & 15;
            const bf16* src = P + (tok0 + row) * INP + hh * 128 + ch * 8;
            vvr[i] = *(const v4u*)(src + 1024); kvr[i] = *(const v4u*)(src + 512); }
        pg8::bf16x8 qf[8];
#pragma unroll
        for (int ks = 0; ks < 8; ++ks) qf[ks] = *(const pg8::bf16x8*)(P + (tok0 + l) * INP + hh * 128 + 16 * ks + 8 * hi);
        pg8::bf16x8 spf[2][8];
#pragma unroll
        for (int eb = 0; eb < 2; ++eb) { const bf16* sp = SP + ((size_t)unit * 128 + 32 * (2 * eh + eb) + l31) * 128 + 8 * hi;
#pragma unroll
            for (int ks = 0; ks < 8; ++ks) spf[eb][ks] = *(const pg8::bf16x8*)(sp + 16 * ks); }
        if (wid == 0) {
            const float2 lf = *(const float2*)(LF + (size_t)bh * SEQ + c * 128 + 2 * lane), li = *(const float2*)(LI + (size_t)bh * SEQ + c * 128 + 2 * lane);
            const float pr = lf.x + lf.y, inc = scan_sum64(pr, lane), ex = inc - pr;
            const float b0 = ex + lf.x, b1 = b0 + lf.y;
            const float ab0 = li.x - b0, ab1 = li.y - b1;
            const float pmx = scan_max64(fmaxf(ab0, ab1), lane);
            float pme = __shfl_up(pmx, 1); if (lane == 0) pme = -INFINITY;
            const float pm0 = fmaxf(pme, ab0), pm1 = fmaxf(pm0, ab1);
            abt[2 * lane] = ab0; abt[2 * lane + 1] = ab1; bt[2 * lane] = b0; bt[2 * lane + 1] = b1;
            Mt[2 * lane] = fmaxf(mprev, pm0); Mt[2 * lane + 1] = fmaxf(mprev, pm1);
        }
        if (wid == 1) { npt[2 * lane] = NP[(size_t)unit * 128 + 2 * lane]; npt[2 * lane + 1] = NP[(size_t)unit * 128 + 2 * lane + 1]; }
#pragma unroll
        for (int i = 0; i < 4; ++i) { const int id = tid + 512 * i, row = id >> 4, ch = id & 15;
            *(LAS v4u*)(tV + offb(row, ch)) = vvr[i]; *(LAS v4u*)(tK + offb(row, ch)) = kvr[i]; }
        __syncthreads();
        const float Ml = Mt[l], iw = __expf(mprev - Ml) * QS;
        float qn = 0.f;
#pragma unroll
        for (int ks = 0; ks < 8; ++ks)
#pragma unroll
            for (int j = 0; j < 8; ++j) qn += bf2f((unsigned short)qf[ks][j]) * npt[16 * ks + 8 * hi + j];
        qn += __shfl_xor(qn, 32);
        f32x16 acc[2];
#pragma unroll
        for (int eb = 0; eb < 2; ++eb) {
#pragma unroll
            for (int r = 0; r < 16; ++r) acc[eb][r] = 0.f;
#pragma unroll
            for (int ks = 0; ks < 8; ++ks) acc[eb] = __builtin_amdgcn_mfma_f32_32x32x16_bf16(spf[eb][ks], qf[ks], acc[eb], 0, 0, 0);
#pragma unroll
            for (int r = 0; r < 16; ++r) acc[eb][r] *= iw;
        }
        uint2 owr[2][4]; f32x4 gnr[2][4];
#pragma unroll
        for (int eb = 0; eb < 2; ++eb)
#pragma unroll
            for (int g4 = 0; g4 < 4; ++g4) { const int e = 32 * (2 * eh + eb) + 8 * g4 + 4 * hi;
                owr[eb][g4] = *(const uint2*)(P + (tok0 + l) * INP + 1536 + hh * 128 + e); gnr[eb][g4] = *(const f32x4*)(gain + hh * 128 + e); }
        float den = 0.f;
        const unsigned g16 = lane >> 4, blk = g16 & 1, q = (lane & 15) >> 2, p = lane & 3;
        for (int sb = 0; sb <= lb; ++sb) {
            f32x16 X;
#pragma unroll
            for (int r = 0; r < 16; ++r) X[r] = 0.f;
#pragma unroll
            for (int ks = 0; ks < 8; ++ks) X = __builtin_amdgcn_mfma_f32_32x32x16_bf16(*(const LAS pg8::bf16x8*)(tK + offb(32 * sb + l31, 2 * ks + hi)), qf[ks], X, 0, 0, 0);
            float pv[16];
#pragma unroll
            for (int r = 0; r < 16; ++r) { const int s = 32 * sb + (r & 3) + 8 * (r >> 2) + 4 * hi;
                const float v = X[r] * QS * __expf(abt[s] - Ml);
                pv[r] = (s <= l) ? v : 0.f; den += pv[r]; }
            pg8::bf16x8 pf[2];
#pragma unroll
            for (int st = 0; st < 2; ++st) { v4u t; t.x = pk2(pv[8 * st], pv[8 * st + 1]); t.y = pk2(pv[8 * st + 2], pv[8 * st + 3]); t.z = pk2(pv[8 * st + 4], pv[8 * st + 5]); t.w = pk2(pv[8 * st + 6], pv[8 * st + 7]);
                pf[st] = __builtin_bit_cast(pg8::bf16x8, t); }
            { const unsigned c0 = 4 * (2 * eh) + 2 * blk + (p >> 1), c1 = c0 + 4, ra = 32 * sb + 4 * hi + q, po = 8 * (p & 1);
              s16x4 t[8];
              tr_read4x8(t, ldsV + offb(ra, c0) + po, ldsV + offb(ra + 8, c0) + po, ldsV + offb(ra + 16, c0) + po, ldsV + offb(ra + 24, c0) + po,
                            ldsV + offb(ra, c1) + po, ldsV + offb(ra + 8, c1) + po, ldsV + offb(ra + 16, c1) + po, ldsV + offb(ra + 24, c1) + po);
#pragma unroll
              for (int eb = 0; eb < 2; ++eb)
#pragma unroll
                  for (int st = 0; st < 2; ++st) acc[eb] = __builtin_amdgcn_mfma_f32_32x32x16_bf16(mk_frag(t[4 * eb + 2 * st], t[4 * eb + 2 * st + 1]), pf[st], acc[eb], 0, 0, 0); }
        }
        den += __shfl_xor(den, 32);
        den += iw * qn;
        const float dn = 1.f / fmaxf(fabsf(den), __expf(-(bt[l] + Ml)));
        float ss = 0.f;
#pragma unroll
        for (int eb = 0; eb < 2; ++eb)
#pragma unroll
            for (int r = 0; r < 16; ++r) { acc[eb][r] *= dn; ss += acc[eb][r] * acc[eb][r]; }
        ss += __shfl_xor(ss, 32);
        if (hi == 0) ssq[eh * 128 + l] = ss;
        __syncthreads();
        const float rstd = rsqrtf((ssq[l] + ssq[128 + l]) * (1.f / 128.f) + EPS);
#pragma unroll
        for (int eb = 0; eb < 2; ++eb)
#pragma unroll
            for (int g4 = 0; g4 < 4; ++g4) { const int e = 32 * (2 * eh + eb) + 8 * g4 + 4 * hi;
                const uint2 ow = owr[eb][g4]; const f32x4 gn = gnr[eb][g4];
                uint2 o; o.x = pk2(acc[eb][4 * g4] * rstd * gn.x * sigmoidf_(bflo(ow.x)), acc[eb][4 * g4 + 1] * rstd * gn.y * sigmoidf_(bfhi(ow.x)));
                o.y = pk2(acc[eb][4 * g4 + 2] * rstd * gn.z * sigmoidf_(bflo(ow.y)), acc[eb][4 * g4 + 3] * rstd * gn.w * sigmoidf_(bfhi(ow.y)));
                *(uint2*)(mix + (tok0 + l) * DM + hh * 128 + e) = o; }
        __syncthreads();
    }
}
template <bool I8>
struct EpiQKV {
    static constexpr bool PERM = true, AFTER_DRAIN = false;
    bf16* O; bf16* KF; bf16* VH; const float* qg; const float* kg; const float* sa; const float* sw;
    __device__ __forceinline__ void operator()(const typename pg8::AccSel<I8>::type (&acc)[2][2][4][2], const pg8::Unit& u, int wr, int wc, int fr, int fq) const {
        using pg8::f32x4;
        f32x4 cs[2][2];
#pragma unroll
        for (int bj = 0; bj < 2; ++bj)
#pragma unroll
            for (int n = 0; n < 2; ++n) cs[bj][n] = I8 ? *(const f32x4*)(sw + u.pn * 256 + 128 * bj + 32 * wc + 8 * fq + 4 * n) : (f32x4){1.f, 1.f, 1.f, 1.f};
        const int kind = u.pn >> 2;
        const float* gp = (kind == 0) ? qg : kg;
        const float post = (kind == 0) ? 0.125f * 1.4426950408889634f : 1.0f;
        f32x4 gv[2][2];
#pragma unroll
        for (int bj = 0; bj < 2; ++bj)
#pragma unroll
            for (int n = 0; n < 2; ++n) gv[bj][n] = (kind < 2) ? *(const f32x4*)(gp + 32 * bj + 8 * fq + 4 * n) * post : (f32x4){1.f, 1.f, 1.f, 1.f};
#pragma unroll
        for (int ai = 0; ai < 2; ++ai)
#pragma unroll
            for (int m = 0; m < 4; ++m) {
                const int row = u.pm * 256 + ai * 128 + wr * 64 + m * 16 + fr;
                f32x4 xv[2][2]; float ss = 0.f;
                { const float rsc = I8 ? sa[row] : 1.f;
#pragma unroll
                  for (int bj = 0; bj < 2; ++bj)
#pragma unroll
                      for (int n = 0; n < 2; ++n) { const auto a = acc[ai][bj][m][n]; const f32x4 x = (f32x4){(float)a[0], (float)a[1], (float)a[2], (float)a[3]} * cs[bj][n] * rsc; xv[bj][n] = x;
                          ss += (x[0] * x[0] + x[1] * x[1]) + (x[2] * x[2] + x[3] * x[3]); } }
                ss += __shfl_xor(ss, 16); ss += __shfl_xor(ss, 32);
                const float rs = (kind < 2) ? rsqrtf(ss * (1.f / 64.f) + EPS) : 1.0f;
                bf16* dst = (kind == 1) ? KF + ((size_t)(((row >> 12) * 16 + (u.pn - 4) * 4 + wc) * 128 + ((row & 4095) >> 5)) * 2048 + (size_t)((fq >> 1) * 512 + ((fq & 1) * 32 + (row & 31)) * 8))
                                        : (kind == 2) ? VH + ((size_t)(((row >> 12) * 16 + (u.pn & 3) * 4 + wc) * 4096 + (row & 4095)) * 64 + 8 * fq)
                                        : O + (size_t)row * 1024 + (u.pn & 3) * 256 + 64 * wc + 8 * fq;
                const int bjstep = (kind == 1) ? 1024 : 32;
#pragma unroll
                for (int bj = 0; bj < 2; ++bj) { const f32x4 v0 = xv[bj][0] * gv[bj][0] * rs, v1 = xv[bj][1] * gv[bj][1] * rs;
                    v4u w; w.x = pk2(v0[0], v0[1]); w.y = pk2(v0[2], v0[3]); w.z = pk2(v1[0], v1[1]); w.w = pk2(v1[2], v1[3]);
                    *(v4u*)(dst + bjstep * bj) = w; }
            }
    }
};

__device__ __forceinline__ unsigned voff(unsigned row, unsigned ch) { return row * 128u + 16u * (ch ^ (row & 7u)); }
__device__ __forceinline__ void phase_attn(const Ctx& C, const Args& A) {
    const bf16* QV = (const bf16*)(A.ws + WS_BIG); const bf16* KF = (const bf16*)(A.ws + WS_BIG + 64 * MiB); const bf16* VH = (const bf16*)(A.ws + WS_BIG + 128 * MiB); bf16* O = (bf16*)(A.ws + WS_H);
    LAS unsigned char* tV = C.lds + C.wave * 4096;
    const unsigned ldsV = (unsigned)(uintptr_t)tV;
    const int lane = C.lane, hi = lane >> 5, l31 = lane & 31;
    const unsigned blk = (lane >> 4) & 1, q4 = (lane & 15) >> 2, p = lane & 3;
    const int per_wave = (16384 + C.NGW - 1) / C.NGW;
    for (int u = C.gw * per_wave; u < C.gw * per_wave + per_wave; ++u) {
        if (u >= 16384) break;
        const int bh = u >> 7, qt = u & 127, b = bh >> 4, hd = bh & 15;
        const size_t tokb = (size_t)b * SEQ;
        const int l = qt * 32 + l31;
        pg8::bf16x8 qf[4];
#pragma unroll
        for (int ks = 0; ks < 4; ++ks) qf[ks] = *(const pg8::bf16x8*)(QV + (tokb + l) * 1024 + hd * 64 + 16 * ks + 8 * hi);
        f32x16 acc[2];
#pragma unroll
        for (int eb = 0; eb < 2; ++eb)
#pragma unroll
            for (int r = 0; r < 16; ++r) acc[eb][r] = 0.f;
        float carry = 1.f;
        pg8::bf16x8 kf[4]; v4u vv[4];
#define ATT_LOAD(kt_) { const size_t s0_ = tokb + (size_t)(kt_) * 32; const bf16* kp_ = KF + ((size_t)(bh * 128 + (kt_)) * 2048 + lane * 8); \
            _Pragma("unroll") for (int ks = 0; ks < 4; ++ks) kf[ks] = *(const pg8::bf16x8*)(kp_ + ks * 512); \
            _Pragma("unroll") for (int i = 0; i < 4; ++i) { const int id = lane + 64 * i; vv[i] = *(const v4u*)(VH + ((size_t)bh * 4096 + (size_t)(kt_) * 32) * 64 + id * 8); } }
        ATT_LOAD(qt)
        for (int kt = qt; kt >= 0; --kt) {
            f32x16 X;
#pragma unroll
            for (int r = 0; r < 16; ++r) X[r] = 0.f;
#pragma unroll
            for (int ks = 0; ks < 4; ++ks) X = __builtin_amdgcn_mfma_f32_32x32x16_bf16(kf[ks], qf[ks], X, 0, 0, 0);
#pragma unroll
            for (int i = 0; i < 4; ++i) { const int id = lane + 64 * i; *(LAS v4u*)(tV + voff(id >> 3, id & 7)) = vv[i]; }
            if (kt > 0) ATT_LOAD(kt - 1)
            const int sbase = kt * 32 + 4 * hi;
            float rr[16];
#pragma unroll
            for (int r = 0; r < 16; ++r) rr[r] = __builtin_amdgcn_rcpf(1.f + __builtin_amdgcn_exp2f(X[r]));
            if (kt == qt) {
#pragma unroll
                for (int r = 0; r < 16; ++r) { const int s = sbase + (r & 3) + 8 * (r >> 2); rr[r] = (s < l) ? rr[r] : 1.f; }
            }
            float To[4], Tp[4];
#pragma unroll
            for (int g = 0; g < 4; ++g) { To[g] = (rr[4 * g] * rr[4 * g + 1]) * (rr[4 * g + 2] * rr[4 * g + 3]); Tp[g] = __shfl_xor(To[g], 32); }
            float base[4]; float run = 1.f;
#pragma unroll
            for (int g = 3; g >= 0; --g) { base[g] = carry * run * (hi == 0 ? Tp[g] : 1.f); run *= To[g] * Tp[g]; }
            float att[16];
#pragma unroll
            for (int g = 0; g < 4; ++g) { float w = base[g];
#pragma unroll
                for (int i = 3; i >= 0; --i) { const int r = 4 * g + i; att[r] = (1.f - rr[r]) * w; w *= rr[r]; } }
            carry *= run;
            pg8::bf16x8 pf[2];
#pragma unroll
            for (int st = 0; st < 2; ++st) { v4u t; t.x = pg8::cvt_pk_bf16(att[8 * st], att[8 * st + 1]); t.y = pg8::cvt_pk_bf16(att[8 * st + 2], att[8 * st + 3]); t.z = pg8::cvt_pk_bf16(att[8 * st + 4], att[8 * st + 5]); t.w = pg8::cvt_pk_bf16(att[8 * st + 6], att[8 * st + 7]);
                pf[st] = __builtin_bit_cast(pg8::bf16x8, t); }
            s16x4 vf[8];
            { const unsigned a0 = ldsV + voff(4 * hi + q4, 2 * blk + (p >> 1)) + 8 * (p & 1), a1 = ldsV + voff(4 * hi + q4 + 8, 2 * blk + (p >> 1)) + 8 * (p & 1);
              const unsigned a2 = ldsV + voff(16 + 4 * hi + q4, 2 * blk + (p >> 1)) + 8 * (p & 1), a3 = ldsV + voff(24 + 4 * hi + q4, 2 * blk + (p >> 1)) + 8 * (p & 1);
              const unsigned a4 = ldsV + voff(4 * hi + q4, 4 + 2 * blk + (p >> 1)) + 8 * (p & 1), a5 = ldsV + voff(4 * hi + q4 + 8, 4 + 2 * blk + (p >> 1)) + 8 * (p & 1);
              const unsigned a6 = ldsV + voff(16 + 4 * hi + q4, 4 + 2 * blk + (p >> 1)) + 8 * (p & 1), a7 = ldsV + voff(24 + 4 * hi + q4, 4 + 2 * blk + (p >> 1)) + 8 * (p & 1);
              asm volatile("ds_read_b64_tr_b16 %0, %8\n\tds_read_b64_tr_b16 %1, %9\n\tds_read_b64_tr_b16 %2, %10\n\tds_read_b64_tr_b16 %3, %11\n\t"
                           "ds_read_b64_tr_b16 %4, %12\n\tds_read_b64_tr_b16 %5, %13\n\tds_read_b64_tr_b16 %6, %14\n\tds_read_b64_tr_b16 %7, %15\n\ts_waitcnt lgkmcnt(0)"
                           : "=&v"(vf[0]), "=&v"(vf[1]), "=&v"(vf[2]), "=&v"(vf[3]), "=&v"(vf[4]), "=&v"(vf[5]), "=&v"(vf[6]), "=&v"(vf[7])
                           : "v"(a0), "v"(a1), "v"(a2), "v"(a3), "v"(a4), "v"(a5), "v"(a6), "v"(a7) : "memory"); }
#pragma unroll
            for (int eb = 0; eb < 2; ++eb)
#pragma unroll
                for (int st = 0; st < 2; ++st) acc[eb] = __builtin_amdgcn_mfma_f32_32x32x16_bf16(mk_frag(vf[4 * eb + 2 * st], vf[4 * eb + 2 * st + 1]), pf[st], acc[eb], 0, 0, 0);
            if (__all(carry == 0.f)) break;
        }
#undef ATT_LOAD
#pragma unroll
        for (int eb = 0; eb < 2; ++eb)
#pragma unroll
            for (int g4 = 0; g4 < 4; ++g4) { const u32x2 o = {pk2(acc[eb][4 * g4], acc[eb][4 * g4 + 1]), pk2(acc[eb][4 * g4 + 2], acc[eb][4 * g4 + 3])};
                const unsigned c8 = (unsigned)(8 * eb + 2 * g4 + hi);
                *(LAS u32x2*)(tV + l31 * 128 + ((c8 ^ ((unsigned)(l31 & 7) << 1)) << 3)) = o; }
        asm volatile("s_waitcnt lgkmcnt(0)" ::: "memory");
#pragma unroll
        for (int i = 0; i < 4; ++i) { const int id = lane + 64 * i, rr = id >> 3, q = id & 7;
            const v4u w = *(const LAS v4u*)(tV + rr * 128 + (((unsigned)(2 * q) ^ ((unsigned)(rr & 7) << 1)) << 3));
            *(v4u*)(O + (tokb + qt * 32 + rr) * DM + hd * 64 + 8 * q) = w; }
        asm volatile("s_waitcnt lgkmcnt(0)" ::: "memory");
    }
}

__device__ __forceinline__ void phase_attn_ring(const Ctx& C, const Args& A) {
    const bf16* QV = (const bf16*)(A.ws + WS_BIG); const bf16* KF = (const bf16*)(A.ws + WS_BIG + 64 * MiB); const bf16* VH = (const bf16*)(A.ws + WS_BIG + 128 * MiB); bf16* O = (bf16*)(A.ws + WS_H);
    LAS unsigned char* ring = C.lds;
    LAS unsigned char* tV = C.lds + (C.wave < 4 ? 114688 + C.wave * 4096 : 147456 + (C.wave - 4) * 4096);
    const unsigned ldsR = (unsigned)(uintptr_t)ring, ldsP = (unsigned)(uintptr_t)tV;
    const int lane = C.lane, hi = lane >> 5, l31 = lane & 31;
    const unsigned blk = (lane >> 4) & 1, q4 = (lane & 15) >> 2, p = lane & 3;
    const unsigned trA = voff(4 * hi + q4, 2 * blk + (p >> 1)) + 8 * (p & 1), trB = voff(4 * hi + q4, 4 + 2 * blk + (p >> 1)) + 8 * (p & 1);
    const int nblk = C.G, per = (2048 + nblk - 1) / nblk;
    const int bu_lo = C.bid * per, bu_hi = (bu_lo + per < 2048) ? bu_lo + per : 2048;
    if (bu_lo >= bu_hi) return;
    const int cidx = C.tid & 255; const bool isV = C.tid >= 256;
    const bf16* srcb = (isV ? VH : KF) + cidx * 8;
    const unsigned dstoff = isV ? 4096u + voff((unsigned)cidx >> 3, (unsigned)cidx & 7) : (unsigned)cidx * 16u;
    pg8::bf16x8 qf[4];
    {
        const int bh = bu_lo >> 4, G = bu_lo & 15;
        for (int t = 8 * G - 6; t <= 8 * G + 7; ++t) if (t >= 0) { const v4u w = *(const v4u*)(srcb + (size_t)(bh * 128 + t) * 2048); *(LAS v4u*)(ring + (t % 14) * 8192 + dstoff) = w; }
        const int qt = 8 * G + C.wave; const size_t row = (size_t)(bh >> 4) * SEQ + qt * 32 + l31;
#pragma unroll
        for (int ks = 0; ks < 4; ++ks) qf[ks] = *(const pg8::bf16x8*)(QV + row * 1024 + (bh & 15) * 64 + 16 * ks + 8 * hi);
    }
    __syncthreads();
    for (int bu = bu_lo; bu < bu_hi; ++bu) {
        const int bh = bu >> 4, G = bu & 15, b = bh >> 4, hd = bh & 15;
        const int qt = 8 * G + C.wave;
        const size_t tokb = (size_t)b * SEQ;
        const int l = qt * 32 + l31;
        const bool more = bu + 1 < bu_hi; const int nbh = (bu + 1) >> 4, nG = (bu + 1) & 15;
        v4u st[8]; pg8::bf16x8 qn[4];
        if (more) {
#pragma unroll
            for (int i = 0; i < 8; ++i) st[i] = *(const v4u*)(srcb + (size_t)(nbh * 128 + 8 * nG + i) * 2048);
            const size_t row = (size_t)(nbh >> 4) * SEQ + (8 * nG + C.wave) * 32 + l31;
#pragma unroll
            for (int ks = 0; ks < 4; ++ks) qn[ks] = *(const pg8::bf16x8*)(QV + row * 1024 + (nbh & 15) * 64 + 16 * ks + 8 * hi);
        }
        f32x16 acc[2];
#pragma unroll
        for (int eb = 0; eb < 2; ++eb)
#pragma unroll
            for (int r = 0; r < 16; ++r) acc[eb][r] = 0.f;
        float carry = 1.f;
        const int lowt = (8 * G - 6 > 0) ? 8 * G - 6 : 0;
        int slot = qt % 14;
        pg8::bf16x8 kf[4];
#define ATT_KLOAD(kt_, slot_) { if ((kt_) >= lowt) { const LAS unsigned char* sp_ = ring + (slot_) * 8192 + lane * 16; \
                _Pragma("unroll") for (int ks = 0; ks < 4; ++ks) kf[ks] = *(const LAS pg8::bf16x8*)(sp_ + ks * 1024); } \
            else { const bf16* kp_ = KF + ((size_t)(bh * 128 + (kt_)) * 2048 + lane * 8); \
                _Pragma("unroll") for (int ks = 0; ks < 4; ++ks) kf[ks] = *(const pg8::bf16x8*)(kp_ + ks * 512); } }
        ATT_KLOAD(qt, slot)
        for (int kt = qt; kt >= 0; --kt) {
            unsigned vb;
            if (kt >= lowt) vb = ldsR + (unsigned)slot * 8192u + 4096u;
            else {
#pragma unroll
                for (int i = 0; i < 4; ++i) { const int id = lane + 64 * i; const v4u w = *(const v4u*)(VH + ((size_t)bh * 4096 + (size_t)kt * 32) * 64 + id * 8); *(LAS v4u*)(tV + voff(id >> 3, id & 7)) = w; }
                vb = ldsP;
            }
            slot = slot == 0 ? 13 : slot - 1;
            f32x16 X;
#pragma unroll
            for (int r = 0; r < 16; ++r) X[r] = 0.f;
#pragma unroll
            for (int ks = 0; ks < 4; ++ks) X = __builtin_amdgcn_mfma_f32_32x32x16_bf16(kf[ks], qf[ks], X, 0, 0, 0);
            if (kt > 0) ATT_KLOAD(kt - 1, slot)
            s16x4 vf[8];
            { const unsigned a0 = vb + trA, a4 = vb + trB;
              asm volatile("ds_read_b64_tr_b16 %0, %8\n\tds_read_b64_tr_b16 %1, %8 offset:1024\n\tds_read_b64_tr_b16 %2, %8 offset:2048\n\tds_read_b64_tr_b16 %3, %8 offset:3072\n\t"
                           "ds_read_b64_tr_b16 %4, %9\n\tds_read_b64_tr_b16 %5, %9 offset:1024\n\tds_read_b64_tr_b16 %6, %9 offset:2048\n\tds_read_b64_tr_b16 %7, %9 offset:3072\n\ts_waitcnt lgkmcnt(0)"
                           : "=&v"(vf[0]), "=&v"(vf[1]), "=&v"(vf[2]), "=&v"(vf[3]), "=&v"(vf[4]), "=&v"(vf[5]), "=&v"(vf[6]), "=&v"(vf[7])
                           : "v"(a0), "v"(a4) : "memory"); }
            const int sbase = kt * 32 + 4 * hi;
            float rr[16];
#pragma unroll
            for (int r = 0; r < 16; ++r) rr[r] = __builtin_amdgcn_rcpf(1.f + __builtin_amdgcn_exp2f(X[r]));
            if (kt == qt) {
#pragma unroll
                for (int r = 0; r < 16; ++r) { const int s = sbase + (r & 3) + 8 * (r >> 2); rr[r] = (s < l) ? rr[r] : 1.f; }
            }
            float To[4], Tp[4];
#pragma unroll
            for (int g = 0; g < 4; ++g) { To[g] = (rr[4 * g] * rr[4 * g + 1]) * (rr[4 * g + 2] * rr[4 * g + 3]); const auto sw_ = __builtin_amdgcn_permlane32_swap(__float_as_uint(To[g]), __float_as_uint(To[g]), false, false); Tp[g] = __uint_as_float(hi ? sw_[0] : sw_[1]); }
            float base[4]; float run = 1.f;
#pragma unroll
            for (int g = 3; g >= 0; --g) { base[g] = carry * run * (hi == 0 ? Tp[g] : 1.f); run *= To[g] * Tp[g]; }
            float att[16];
#pragma unroll
            for (int g = 0; g < 4; ++g) { float w = base[g];
#pragma unroll
                for (int i = 3; i >= 0; --i) { const int r = 4 * g + i; att[r] = (1.f - rr[r]) * w; w *= rr[r]; } }
            carry *= run;
            pg8::bf16x8 pf[2];
#pragma unroll
            for (int st_ = 0; st_ < 2; ++st_) { v4u t; t.x = pg8::cvt_pk_bf16(att[8 * st_], att[8 * st_ + 1]); t.y = pg8::cvt_pk_bf16(att[8 * st_ + 2], att[8 * st_ + 3]); t.z = pg8::cvt_pk_bf16(att[8 * st_ + 4], att[8 * st_ + 5]); t.w = pg8::cvt_pk_bf16(att[8 * st_ + 6], att[8 * st_ + 7]);
                pf[st_] = __builtin_bit_cast(pg8::bf16x8, t); }
#pragma unroll
            for (int eb = 0; eb < 2; ++eb)
#pragma unroll
                for (int st_ = 0; st_ < 2; ++st_) acc[eb] = __builtin_amdgcn_mfma_f32_32x32x16_bf16(mk_frag(vf[4 * eb + 2 * st_], vf[4 * eb + 2 * st_ + 1]), pf[st_], acc[eb], 0, 0, 0);
            if (__all(carry == 0.f)) break;
        }
#undef ATT_KLOAD
#pragma unroll
        for (int eb = 0; eb < 2; ++eb)
#pragma unroll
            for (int g4 = 0; g4 < 4; ++g4) { const u32x2 o = {pk2(acc[eb][4 * g4], acc[eb][4 * g4 + 1]), pk2(acc[eb][4 * g4 + 2], acc[eb][4 * g4 + 3])};
                const unsigned c8 = (unsigned)(8 * eb + 2 * g4 + hi);
                *(LAS u32x2*)(tV + l31 * 128 + ((c8 ^ ((unsigned)(l31 & 7) << 1)) << 3)) = o; }
        asm volatile("s_waitcnt lgkmcnt(0)" ::: "memory");
#pragma unroll
        for (int i = 0; i < 4; ++i) { const int id = lane + 64 * i, rr_ = id >> 3, q = id & 7;
            const v4u w = *(const LAS v4u*)(tV + rr_ * 128 + (((unsigned)(2 * q) ^ ((unsigned)(rr_ & 7) << 1)) << 3));
            *(v4u*)(O + (tokb + qt * 32 + rr_) * DM + hd * 64 + 8 * q) = w; }
        __syncthreads();
        if (more) {
#pragma unroll
            for (int i = 0; i < 8; ++i) *(LAS v4u*)(ring + ((8 * nG + i) % 14) * 8192 + dstoff) = st[i];
#pragma unroll
            for (int ks = 0; ks < 4; ++ks) qf[ks] = qn[ks];
        }
        __syncthreads();
    }
}
constexpr int N_PHASES = 16;
#ifndef MK_ONE_LAUNCH
#define MK_ONE_LAUNCH 1
#endif

__global__ void __launch_bounds__(NWAVES * 64, 2) mk_fwd(Args args) {
    extern __shared__ __attribute__((aligned(16))) unsigned char lds_raw[];
    Ctx C;
    C.lds = (LAS unsigned char*)lds_raw;
    C.tid = threadIdx.x; C.lane = C.tid & 63; C.wave = __builtin_amdgcn_readfirstlane(C.tid >> 6);
    C.G = gridDim.x; C.bid = blockIdx.x;
    C.gw = C.bid * NWAVES + C.wave; C.NGW = C.G * NWAVES;
    C.gt = (long)C.bid * (NWAVES * 64) + C.tid; C.NGT = (long)C.G * (NWAVES * 64);
    unsigned char* ws = args.ws;
    volatile LAS unsigned* MISC = (volatile LAS unsigned*)(C.lds + MISC_OFF);
    for (int u = C.tid; u < (LDS_BYTES - LDSCTL_OFF) / 4; u += NWAVES * 64) ((LAS unsigned*)(C.lds + LDSCTL_OFF))[u] = 0u;
    __syncthreads();
#if MK_ONE_LAUNCH
    XcdBarrier bar = xcd_barrier_post((unsigned*)((gu32*)(ws + WS_CTL) + CW_BAR), MISC + 8);
#ifdef PROBE_DBLBAR
#define GRID_BAR() do { xcd_barrier(bar); xcd_barrier(bar); } while (0)
#else
#define GRID_BAR() xcd_barrier(bar)
#endif
#else
    (void)MISC; XcdBarrier bar; bar.bar = nullptr; bar.x = 0; bar.st = nullptr;
#define GRID_BAR() do {} while (0)
#endif
    const int lo = args.ph_lo, hi = args.ph_hi;
#define IN(k) (lo <= (k) && (k) < hi)
#ifndef PROBE_MASK
#define PROBE_MASK 0
#endif
#define PROBE_T0(k) unsigned long long pt0_ = 0; if ((PROBE_MASK >> (k)) & 1) pt0_ = __builtin_amdgcn_s_memrealtime();
#define PROBE_T1(k) if ((PROBE_MASK >> (k)) & 1) { const unsigned long long t1_ = __builtin_amdgcn_s_memrealtime(); const unsigned long long d_ = t1_ - pt0_; while (__builtin_amdgcn_s_memrealtime() - t1_ < d_) __builtin_amdgcn_s_sleep(8); }
#define SEAM(k) do { if (IN(k) && IN((k) + 1)) GRID_BAR(); } while (0)
    float* mod0 = (float*)(ws + WS_MOD); float* mod1 = mod0 + (size_t)NB * 6144;
    bf16* Hb = (bf16*)(ws + WS_H); bf16* BIG = (bf16*)(ws + WS_BIG); bf16* XB = (bf16*)(ws + WS_XB);

    const unsigned char* TAB = ws + WS_TAB; const float* TSC = (const float*)(ws + WS_TSC);
#ifdef PROBE_INSTR
    {
        unsigned xs[16]; float fs[16];
#pragma unroll
        for (int i = 0; i < 16; ++i) { xs[i] = (unsigned)(C.tid * 2654435761u + i * 40503u); fs[i] = (float)(C.tid * 7 + i) * 0.37f; }
#pragma unroll 1
        for (int it = 0; it < 4096; ++it) {
#pragma unroll
            for (int rep = 0; rep < 2; ++rep) {
#pragma unroll
                for (int i = 0; i < 16; i += 2) {
#if PROBE_INSTR == 10
                    { const unsigned a = xs[i], b = xs[i + 1]; xs[i] = a < b ? b : a; xs[i + 1] = (a < b ? a : b) + (unsigned)it; }
#elif PROBE_INSTR == 11
                    { const float a = fs[i], b = fs[i + 1]; fs[i] = fmaxf(a, b); fs[i + 1] = fminf(a, b) + 1.0f; }
#elif PROBE_INSTR == 12
                    { const unsigned a = xs[i], b = xs[i + 1]; xs[i] = a + b; xs[i + 1] = (a ^ b) + (unsigned)it; }
#endif
                }
            }
        }
        float sm = 0.f;
#pragma unroll
        for (int i = 0; i < 16; ++i) sm += fs[i] + __uint_as_float(xs[i] & 0x3fffffffu);
        if (sm == 1234.5678f) args.out[C.tid] = sm;
    }
#endif
    if (IN(0)) { PROBE_T0(0) { phase_prep(C, args); convert_tables_int8(C, args); } PROBE_T1(0) } SEAM(0);
    bf16* H8B = (bf16*)(ws + WS_IDS);
    unsigned char* W8 = (unsigned char*)args.out; float* SW = (float*)((unsigned char*)args.out + OUT_SW); float* SA = (float*)(ws + WS_SA);
    if (IN(1)) { PROBE_T0(1) { phase_rowpass<true, false, true>(C, args, args.in[0], args.in[4], mod0, 0, 1, Hb, SA);
        quantize_rows(C, (const bf16*)(ws + WS_WIN), INP, W8 + OUT_W8IN, SW + SW_IN);
        quantize_rows(C, (const bf16*)(ws + WS_WC0), 2048, W8 + OUT_W8C0, SW + SW_C0); quantize_rows(C, (const bf16*)(ws + WS_WC1), 2048, W8 + OUT_W8C1, SW + SW_C1);
        quantize_rows(C, (const bf16*)(ws + WS_WQKV), 3072, W8 + OUT_W8QKV, SW + SW_QKV); } PROBE_T1(1) } SEAM(1);
    if (IN(2)) { PROBE_T0(2) { pg8::Gemm g{Hb, (const bf16*)(W8 + OUT_W8IN), NTOK, INP, DM / 2}; pg8::StaticOrder S; S.init(NTOK, INP, C.G, C.bid);
        EpiBf16I8 E{BIG, INP, SA, SW + SW_IN};
        pg8::gemm_phase<EpiBf16I8, pg8::StaticOrder, true, true, true>(C.lds, g, S, E); } PROBE_T1(2) } SEAM(2);
    if (IN(3)) { PROBE_T0(3) { phase_mlstm_local(C, args); phase_conv(C, args); } PROBE_T1(3) } SEAM(3);
    if (IN(4)) { PROBE_T0(4) { phase_mlstm_scan(C, args); } PROBE_T1(4) } SEAM(4);
    if (IN(5)) { PROBE_T0(5) { phase_mlstm_out(C, args); } PROBE_T1(5) } SEAM(5);
    if (IN(6)) { PROBE_T0(6) { pg8::Gemm g{Hb, (const bf16*)(ws + WS_WOUT0), NTOK, DM, DM}; pg8::StaticOrder S; S.init(NTOK, DM, C.G, C.bid);
        EpiResid<false> E{args.in[0], XB, mod0 + 2 * 1024};
        pg8::gemm_phase<EpiResid<false>, pg8::StaticOrder, true, true>(C.lds, g, S, E); } PROBE_T1(6) } SEAM(6);
    if (IN(7)) { PROBE_T0(7) { phase_rowpass<false, true, true>(C, args, XB, args.in[11], mod0, 3, 4, H8B, SA); } PROBE_T1(7) } SEAM(7);
    if (IN(8)) { PROBE_T0(8) { pg8::Gemm g{H8B, (const bf16*)(W8 + OUT_W8C0), NTOK, 2048, DM / 2}; pg8::StaticOrder S; S.init(NTOK, 2048, C.G, C.bid);
        EpiBf16I8 E{BIG, 2048, SA, SW + SW_C0};
        pg8::gemm_phase<EpiBf16I8, pg8::StaticOrder, true, true, true>(C.lds, g, S, E); } PROBE_T1(8) } SEAM(8);
    if (IN(9)) { PROBE_T0(9) { phase_peer<true>(C, args, TAB, TAB + TAB_BYTES, TSC, TSC + 16384, mod0 + 5 * 1024, args.in[19], mod1, bar); } PROBE_T1(9) } SEAM(9);
    if (IN(10)) { PROBE_T0(10) { pg8::Gemm g{H8B, (const bf16*)(W8 + OUT_W8QKV), NTOK, 3072, DM / 2}; pg8::StaticOrder S; S.init(NTOK, 3072, C.G, C.bid);
        EpiQKV<true> E{BIG, (bf16*)(ws + WS_BIG + 64 * MiB), (bf16*)(ws + WS_BIG + 128 * MiB), args.in[21], args.in[22], SA, SW + SW_QKV};
        pg8::gemm_phase<EpiQKV<true>, pg8::StaticOrder, true, true, true>(C.lds, g, S, E); } PROBE_T1(10) } SEAM(10);
    if (IN(11)) { PROBE_T0(11) { phase_attn_ring(C, args); } PROBE_T1(11) } SEAM(11);
    if (IN(12)) { PROBE_T0(12) { pg8::Gemm g{Hb, (const bf16*)(ws + WS_WOUT1), NTOK, DM, DM}; pg8::StaticOrder S; S.init(NTOK, DM, C.G, C.bid);
        EpiResid<true> E{XB, XB, mod1 + 2 * 1024};
        pg8::gemm_phase<EpiResid<true>, pg8::StaticOrder, true, true>(C.lds, g, S, E); } PROBE_T1(12) } SEAM(12);
    if (IN(13)) { PROBE_T0(13) { phase_rowpass<false, true, true>(C, args, XB, args.in[24], mod1, 3, 4, H8B, SA); } PROBE_T1(13) } SEAM(13);
    if (IN(14)) { PROBE_T0(14) { pg8::Gemm g{H8B, (const bf16*)(W8 + OUT_W8C1), NTOK, 2048, DM / 2}; pg8::StaticOrder S; S.init(NTOK, 2048, C.G, C.bid);
        EpiBf16I8 E{BIG, 2048, SA, SW + SW_C1};
        pg8::gemm_phase<EpiBf16I8, pg8::StaticOrder, true, true, true>(C.lds, g, S, E); } PROBE_T1(14) } SEAM(14);
#ifdef PROBE_DRY
    if (IN(15)) { phase_peer<false, PROBE_DRY>(C, args, TAB + 2 * TAB_BYTES, TAB + 3 * TAB_BYTES, TSC + 2 * 16384, TSC + 3 * 16384, mod1 + 5 * 1024, nullptr, nullptr, bar); GRID_BAR(); }
#endif
    if (IN(15)) { PROBE_T0(15) { phase_peer<false>(C, args, TAB + 2 * TAB_BYTES, TAB + 3 * TAB_BYTES, TSC + 2 * 16384, TSC + 3 * 16384, mod1 + 5 * 1024, nullptr, nullptr, bar); } PROBE_T1(15) }
#undef IN
#undef SEAM
}

extern "C" void kernel_launch(void* const* d_in, const int* in_sizes, int n_in, void* d_out, int out_size, void* d_ws, size_t ws_size, hipStream_t stream) {
    static int grid = 0;
    if (grid == 0) {
        if (n_in != 30 || out_size != NTOK * DM || ws_size < WS_END2) { fprintf(stderr, "kernel_launch: unexpected shapes (n_in %d out %d ws %zu)\n", n_in, out_size, ws_size); grid = -1; return; }
        int dev = 0, cus = 0;
        if (hipGetDevice(&dev) != hipSuccess || hipDeviceGetAttribute(&cus, hipDeviceAttributeMultiprocessorCount, dev) != hipSuccess) { grid = -1; return; }
        if (hipFuncSetAttribute((const void*)mk_fwd, hipFuncAttributeMaxDynamicSharedMemorySize, LDS_BYTES) != hipSuccess) { fprintf(stderr, "kernel_launch: hipFuncSetAttribute failed\n"); grid = -1; return; }
        int per_cu = 0;
        if (hipOccupancyMaxActiveBlocksPerMultiprocessor(&per_cu, (const void*)mk_fwd, NWAVES * 64, LDS_BYTES) != hipSuccess || per_cu < 1) fprintf(stderr, "kernel_launch: occupancy query reports %d\n", per_cu);
        (void)hipGetLastError();
        grid = cus;
    }
    if (grid < 0) return;
    (void)hipMemsetAsync((char*)d_ws + WS_CTL + CW_BAR * 4, 0, XCD_BAR_WORDS * 4, stream);
    Args a{};
    for (int i = 0; i < 30; ++i) a.in[i] = (const float*)d_in[i];
    a.out = (float*)d_out; a.ws = (unsigned char*)d_ws;
#if MK_ONE_LAUNCH
    a.ph_lo = 0; a.ph_hi = N_PHASES;
    hipLaunchKernelGGL(mk_fwd, dim3(grid), dim3(NWAVES * 64), LDS_BYTES, stream, a);
#else
    for (int p = 0; p < N_PHASES; ++p) { a.ph_lo = p; a.ph_hi = p + 1; hipLaunchKernelGGL(mk_fwd, dim3(grid), dim3(NWAVES * 64), LDS_BYTES, stream, a); }
#endif
}
```

```cpp
#include <hip/hip_runtime.h>
#include <cstdio>
#include <cstdint>
#include <cmath>
#define PROBE_MASK 0
namespace pg8 {
#define PG8_LAS __attribute__((address_space(3)))
typedef unsigned short bf16_t;
typedef short bf16x8 __attribute__((ext_vector_type(8)));
typedef float f32x4 __attribute__((ext_vector_type(4)));
typedef unsigned u32x4 __attribute__((ext_vector_type(4)));
constexpr int BM = 256, BK = 64, HALF = 128, HTB = HALF * BK * 2  , STAGE_BYTES = 8 * HTB, NXCD = 8, WGM = 8;

__host__ __device__ __forceinline__ int lds_byte(int r, int c) { const int st = (r >> 4) * 2 + (c >> 5), rr = r & 15, cc = c & 31, ob = rr * 64 + cc * 2; return st * 1024 + (ob ^ (((ob >> 9) & 1) << 5)); }
__host__ __device__ __forceinline__ void stage_rc(int b, int& R, int& C) { const int st = b / 1024, sb = b % 1024, swz = sb ^ (((sb >> 9) & 1) << 5); R = (st >> 1) * 16 + swz / 64; C = (st & 1) * 32 + (swz % 64) / 2; }
__host__ __device__ __forceinline__ int perm32(int rho) { const int n = rho >> 4, i = rho & 15; return 8 * (i >> 2) + 4 * n + (i & 3); }

struct Unit { int pm, pn; };
struct Gemm { const bf16_t* A; const bf16_t* Bt; int M, N, K; };

struct StaticOrder {
    int nM, nN, nwg, G, c;
    __host__ __device__ void init(int M, int N, int G_, int c_) { nM = M / BM; nN = N / BM; nwg = nM * nN; G = G_; c = c_; }
    __host__ __device__ bool next(int i, Unit& u) const {
        const long L = (long)i * G + c; if (L >= nwg) return false;
        int wgid = (int)L; { const int q = nwg / NXCD, r = nwg % NXCD, xcd = wgid % NXCD, off = wgid / NXCD; wgid = (xcd < r ? xcd * (q + 1) : r * (q + 1) + (xcd - r) * q) + off; }
        const int nig = WGM * nN, gid = wgid / nig, fm = gid * WGM, gsz = (nM - fm) < WGM ? (nM - fm) : WGM;
        u.pm = fm + ((wgid % nig) % gsz); u.pn = (wgid % nig) / gsz; return true;
    }
    __device__ __forceinline__ void a_ready(const Unit&) const {}
    __device__ __forceinline__ void done(const Unit&) const {}
};

__device__ __forceinline__ unsigned cvt_pk_bf16(float lo, float hi) { unsigned r; asm volatile("v_cvt_pk_bf16_f32 %0, %1, %2" : "=v"(r) : "v"(lo), "v"(hi)); return r; }
typedef float f32x2 __attribute__((ext_vector_type(2)));
__device__ __forceinline__ f32x2 gelu_pk(f32x2 v) {
    const f32x2 av = __builtin_elementwise_abs(v), d = av * 0.2316418882f + 1.0f;
    f32x2 t; t.x = __builtin_amdgcn_rcpf(d.x); t.y = __builtin_amdgcn_rcpf(d.y);
    f32x2 q = t * 0.5307027145f + (-0.7265760135f); q = q * t + 0.7107068705f; q = q * t + (-0.142248368f); q = q * t + 0.127414796f; q = q * t;
    const f32x2 s = (v * v) * (-0.72134752044f);
    f32x2 e; e.x = __builtin_amdgcn_exp2f(s.x); e.y = __builtin_amdgcn_exp2f(s.y);
    const f32x2 m = v * (q * e), r = v - m;
    f32x2 o; o.x = v.x < 0.f ? m.x : r.x; o.y = v.y < 0.f ? m.y : r.y; return o;
}

template <int ACT  > struct EpiBf16 {
    static constexpr bool PERM = true, AFTER_DRAIN = false; static_assert(ACT == 0 || ACT == 1, "EpiBf16: ACT is 0 (none) or 1 (gelu_pk)");
    bf16_t* O; int ldc; const float* bias; int split_cols; size_t split_stride; float scale0;
    __device__ __forceinline__ void operator()(const f32x4 (&acc)[2][2][4][2], const Unit& u, int wr, int wc, int fr, int fq) const {
        const int row0 = u.pm * BM + wr * 64 + fr; int colt = u.pn * BM; bf16_t* base = O;
        float sc = 1.f; if (split_cols) { const int t = colt / split_cols; base += (size_t)t * split_stride; colt -= t * split_cols; if (t == 0) sc = scale0; }
        const int col0 = colt + wc * 32 + 8 * fq, bcol0 = u.pn * BM + wc * 32 + 8 * fq;
        f32x4 bv[2][2];
#pragma unroll
        for (int bj = 0; bj < 2; ++bj)
#pragma unroll
            for (int n = 0; n < 2; ++n) bv[bj][n] = bias ? *(const f32x4*)(bias + bcol0 + bj * HALF + 4 * n) : (f32x4){0.f, 0.f, 0.f, 0.f};
#pragma unroll
        for (int ai = 0; ai < 2; ++ai)
#pragma unroll
            for (int m = 0; m < 4; ++m) { bf16_t* rowp = base + (size_t)(row0 + ai * HALF + m * 16) * ldc + col0;
#pragma unroll
                for (int bj = 0; bj < 2; ++bj) { f32x4 v0 = acc[ai][bj][m][0] + bv[bj][0], v1 = acc[ai][bj][m][1] + bv[bj][1];
                    if (ACT == 1) { f32x2 a = gelu_pk((f32x2){v0[0], v0[1]}), b = gelu_pk((f32x2){v0[2], v0[3]}), c = gelu_pk((f32x2){v1[0], v1[1]}), d = gelu_pk((f32x2){v1[2], v1[3]});
                        v0 = (f32x4){a.x, a.y, b.x, b.y}; v1 = (f32x4){c.x, c.y, d.x, d.y}; }
                    v0 = v0 * sc; v1 = v1 * sc; u32x4 w; w.x = cvt_pk_bf16(v0[0], v0[1]); w.y = cvt_pk_bf16(v0[2], v0[3]); w.z = cvt_pk_bf16(v1[0], v1[1]); w.w = cvt_pk_bf16(v1[2], v1[3]);
                    *(u32x4*)(rowp + bj * HALF) = w; } }
    }
};
typedef int i32x4 __attribute__((ext_vector_type(4)));
template <bool I8> struct AccSel { typedef f32x4 type; };
template <> struct AccSel<true> { typedef i32x4 type; };
template <class Epi, class Sched, bool ALIGN_EPI = false, bool SP2 = false, bool I8 = false>
__device__ __forceinline__ void gemm_phase(PG8_LAS unsigned char* lds, const Gemm g, const Sched& S, const Epi& E) {
    const int tid = threadIdx.x, wid = __builtin_amdgcn_readfirstlane(tid >> 6), lane = tid & 63, wr = wid >> 2, wc = wid & 3, fr = lane & 15, fq = lane >> 4;
    const int K = g.K, nt = K / BK;
    unsigned voffA[2], voffB[2];
#pragma unroll
    for (int i = 0; i < 2; ++i) { int R, C; stage_rc(tid * 16 + i * 8192, R, C); const int Rb = Epi::PERM ? ((R & ~31) + perm32(R & 31)) : R;
        voffA[i] = (unsigned)(R * K + C) * 2u; voffB[i] = (unsigned)(Rb * K + C) * 2u; }
    const size_t kstep = (size_t)(BK * 2);
    const size_t hstep = (size_t)HALF * K * 2;
    const size_t tstep = 2 * hstep;
    const unsigned ldsw = (unsigned)wid * 1024u;
    const int aoff = lds_byte(wr * 64 + fr, fq * 8), boff = lds_byte(wc * 32 + fr, fq * 8);
#define PG8_SA(b, h) (((b) * 2 + (h)) * HTB)
#define PG8_SB(b, h) ((4 + (b) * 2 + (h)) * HTB)
#define PG8_STAGE(bufoff, gbase, voff) do { _Pragma("unroll") for (int _i = 0; _i < 2; ++_i) \
        __builtin_amdgcn_global_load_lds((const unsigned*)((const char*)(gbase) + (voff)[_i]), (PG8_LAS unsigned*)(lds + (bufoff) + ldsw + _i * 8192), 16, 0, 0); } while (0)
#define PG8_LDA(dst, b, h) do { _Pragma("unroll") for (int m = 0; m < 4; ++m) _Pragma("unroll") for (int k = 0; k < 2; ++k) dst[m][k] = *(const PG8_LAS bf16x8*)(lds + PG8_SA(b, h) + aoff + m * 2048 + k * 1024); } while (0)
#define PG8_LDB(dst, b, h) do { _Pragma("unroll") for (int n = 0; n < 2; ++n) _Pragma("unroll") for (int k = 0; k < 2; ++k) dst[n][k] = *(const PG8_LAS bf16x8*)(lds + PG8_SB(b, h) + boff + n * 2048 + k * 1024); } while (0)
#define PG8_MMA(ai, bj, At, Bt) do { __builtin_amdgcn_s_setprio(1); _Pragma("unroll") for (int m = 0; m < 4; ++m) _Pragma("unroll") for (int n = 0; n < 2; ++n) _Pragma("unroll") for (int k = 0; k < 2; ++k) \
        { if constexpr (I8) acc[ai][bj][m][n] = __builtin_bit_cast(acc_t, __builtin_amdgcn_mfma_i32_16x16x64_i8(__builtin_bit_cast(i32x4, Bt[n][k]), __builtin_bit_cast(i32x4, At[m][k]), __builtin_bit_cast(i32x4, acc[ai][bj][m][n]), 0, 0, 0)); \
          else acc[ai][bj][m][n] = __builtin_bit_cast(acc_t, __builtin_amdgcn_mfma_f32_16x16x32_bf16(Bt[n][k], At[m][k], __builtin_bit_cast(f32x4, acc[ai][bj][m][n]), 0, 0, 0)); } __builtin_amdgcn_s_setprio(0); } while (0)
#define PG8_WAIT_V(n) asm volatile("s_waitcnt vmcnt(" #n ")" ::: "memory")
#define PG8_WAIT_L(n) asm volatile("s_waitcnt lgkmcnt(" #n ")" ::: "memory")
#define PG8_BAR __builtin_amdgcn_s_barrier()
#define PG8_SCHED __builtin_amdgcn_sched_barrier(0)
    Unit cur, nxt; int ui = 0;
    if (!S.next(0, cur)) return;
    typedef typename AccSel<I8>::type acc_t; const acc_t acc_zero = {};
    acc_t acc[2][2][4][2];
#pragma unroll
    for (int a = 0; a < 2; ++a)
#pragma unroll
        for (int b = 0; b < 2; ++b)
#pragma unroll
            for (int m = 0; m < 4; ++m)
#pragma unroll
                for (int n = 0; n < 2; ++n) acc[a][b][m][n] = acc_zero;
    bf16x8 At[4][2], B0[2][2], B1[2][2];
    const char* cA = (const char*)g.A + (size_t)cur.pm * tstep; const char* cB = (const char*)g.Bt + (size_t)cur.pn * tstep;
    S.a_ready(cur);
    if constexpr (SP2) {
        PG8_STAGE(PG8_SB(0, 0), cB, voffB); PG8_STAGE(PG8_SB(0, 1), cB + hstep, voffB); PG8_STAGE(PG8_SA(0, 0), cA, voffA); PG8_STAGE(PG8_SA(0, 1), cA + hstep, voffA);
        if (wr == 1) PG8_BAR;
        PG8_WAIT_V(2); PG8_BAR;
        PG8_STAGE(PG8_SB(1, 0), cB + kstep, voffB); PG8_STAGE(PG8_SA(1, 0), cA + kstep, voffA); PG8_STAGE(PG8_SB(1, 1), cB + hstep + kstep, voffB);
        PG8_WAIT_V(6); PG8_BAR;
    } else {
        PG8_STAGE(PG8_SB(0, 0), cB, voffB); PG8_STAGE(PG8_SA(0, 0), cA, voffA); PG8_STAGE(PG8_SB(0, 1), cB + hstep, voffB); PG8_STAGE(PG8_SA(0, 1), cA + hstep, voffA);
        if (wr == 1) PG8_BAR;
        PG8_WAIT_V(4); PG8_BAR;
        PG8_STAGE(PG8_SB(1, 0), cB + kstep, voffB); PG8_STAGE(PG8_SA(1, 0), cA + kstep, voffA); PG8_STAGE(PG8_SB(1, 1), cB + hstep + kstep, voffB);
        PG8_WAIT_V(6); PG8_BAR;
    }
    for (;;) {
        const bool has_next = S.next(ui + 1, nxt);
        const char* nA = has_next ? (const char*)g.A + (size_t)nxt.pm * tstep : cA; const char* nB = has_next ? (const char*)g.Bt + (size_t)nxt.pn * tstep : cB;
        for (int t = 0; t < nt; t += 2) {
            const bool last = (t == nt - 2);
            const char* a1 = cA + (size_t)(t + 1) * kstep;
            const char* a2 = last ? nA : cA + (size_t)(t + 2) * kstep; const char* b2 = last ? nB : cB + (size_t)(t + 2) * kstep;
            const char* a3 = a2 + kstep; const char* b3 = b2 + kstep;
            if (last && has_next) S.a_ready(nxt);
            if constexpr (SP2) {
            PG8_LDB(B0, 0, 0); PG8_LDB(B1, 0, 1); PG8_SCHED; PG8_LDA(At, 0, 0); PG8_STAGE(PG8_SA(1, 1), a1 + hstep, voffA);
            PG8_WAIT_V(8); PG8_WAIT_L(0); PG8_BAR; PG8_MMA(0, 0, At, B0); PG8_MMA(0, 1, At, B1); PG8_BAR; PG8_SCHED;
            PG8_LDA(At, 0, 1); PG8_STAGE(PG8_SB(0, 0), b2, voffB); PG8_STAGE(PG8_SB(0, 1), b2 + hstep, voffB); PG8_STAGE(PG8_SA(0, 0), a2, voffA);
            PG8_WAIT_V(8); PG8_WAIT_L(0); PG8_BAR; PG8_MMA(1, 0, At, B0); PG8_MMA(1, 1, At, B1); PG8_BAR; PG8_SCHED;
            PG8_LDB(B0, 1, 0); PG8_LDB(B1, 1, 1); PG8_SCHED; PG8_LDA(At, 1, 0); PG8_STAGE(PG8_SA(0, 1), a2 + hstep, voffA);
            PG8_WAIT_V(8); PG8_WAIT_L(0); PG8_BAR; PG8_MMA(0, 0, At, B0); PG8_MMA(0, 1, At, B1); PG8_BAR; PG8_SCHED;
            PG8_LDA(At, 1, 1); PG8_STAGE(PG8_SB(1, 0), b3, voffB); PG8_STAGE(PG8_SB(1, 1), b3 + hstep, voffB); PG8_STAGE(PG8_SA(1, 0), a3, voffA);
            PG8_WAIT_V(8); PG8_WAIT_L(0); PG8_BAR; PG8_MMA(1, 0, At, B0); PG8_MMA(1, 1, At, B1); PG8_BAR; PG8_SCHED;
            } else {
            PG8_LDB(B0, 0, 0); PG8_SCHED; PG8_LDA(At, 0, 0); PG8_STAGE(PG8_SA(1, 1), a1 + hstep, voffA);
            PG8_WAIT_L(8); PG8_BAR; PG8_WAIT_L(0); PG8_MMA(0, 0, At, B0); PG8_BAR; PG8_SCHED;
            PG8_LDB(B1, 0, 1); PG8_STAGE(PG8_SB(0, 0), b2, voffB);
            PG8_BAR; PG8_WAIT_L(0); PG8_MMA(0, 1, At, B1); PG8_BAR;
            PG8_LDA(At, 0, 1); PG8_STAGE(PG8_SA(0, 0), a2, voffA);
            PG8_BAR; PG8_WAIT_L(0); PG8_MMA(1, 0, At, B0); PG8_BAR; PG8_SCHED;
            PG8_STAGE(PG8_SB(0, 1), b2 + hstep, voffB);
            PG8_WAIT_V(6); PG8_BAR; PG8_MMA(1, 1, At, B1); PG8_BAR;
            PG8_LDB(B0, 1, 0); PG8_SCHED; PG8_LDA(At, 1, 0); PG8_STAGE(PG8_SA(0, 1), a2 + hstep, voffA);
            PG8_WAIT_L(8); PG8_BAR; PG8_WAIT_L(0); PG8_MMA(0, 0, At, B0); PG8_BAR; PG8_SCHED;
            PG8_LDB(B1, 1, 1); PG8_STAGE(PG8_SB(1, 0), b3, voffB);
            PG8_BAR; PG8_WAIT_L(0); PG8_MMA(0, 1, At, B1); PG8_BAR;
            PG8_LDA(At, 1, 1); PG8_STAGE(PG8_SA(1, 0), a3, voffA);
            PG8_BAR; PG8_WAIT_L(0); PG8_MMA(1, 0, At, B0); PG8_BAR; PG8_SCHED;
            PG8_STAGE(PG8_SB(1, 1), b3 + hstep, voffB);
            PG8_WAIT_V(6); PG8_BAR; PG8_MMA(1, 1, At, B1); PG8_BAR;
            }
        }
        if constexpr (ALIGN_EPI) { if (wr == 0) PG8_BAR; }
        if constexpr (!Epi::AFTER_DRAIN) { E(acc, cur, wr, wc, fr, fq); S.done(cur); }
        if (!has_next) break;
#pragma unroll
        for (int a = 0; a < 2; ++a)
#pragma unroll
            for (int b = 0; b < 2; ++b)
#pragma unroll
                for (int m = 0; m < 4; ++m)
#pragma unroll
                    for (int n = 0; n < 2; ++n) acc[a][b][m][n] = acc_zero;
        cur = nxt; cA = nA; cB = nB; ++ui;
        if constexpr (ALIGN_EPI) { if (wr == 1) PG8_BAR; }
    }
    PG8_WAIT_V(0);
    if constexpr (!ALIGN_EPI) { if (wr == 0) PG8_BAR; }
    PG8_BAR;
    if constexpr (Epi::AFTER_DRAIN) { E.fused(acc, cur, wr, wc, fr, fq, lds, wid, lane); S.done(cur); }
#undef PG8_SA
#undef PG8_SB
#undef PG8_STAGE
#undef PG8_LDA
#undef PG8_LDB
#undef PG8_MMA
#undef PG8_WAIT_V
#undef PG8_WAIT_L
#undef PG8_BAR
#undef PG8_SCHED
}
}
#define GAS __attribute__((address_space(1)))
#define LAS __attribute__((address_space(3)))
typedef unsigned short bf16;
typedef unsigned v4u __attribute__((ext_vector_type(4)));
typedef unsigned u32x2 __attribute__((ext_vector_type(2)));
typedef float f32x4 __attribute__((ext_vector_type(4)));
typedef short bf16x8 __attribute__((ext_vector_type(8)));
typedef GAS unsigned gu32;
typedef GAS unsigned long long gu64;
#define RLX_AGENT __ATOMIC_RELAXED, __HIP_MEMORY_SCOPE_AGENT
#define LDS_WAIT() asm volatile("s_waitcnt lgkmcnt(0)" ::: "memory")
#define VM_WAIT() asm volatile("s_waitcnt vmcnt(0)" ::: "memory")
__device__ __forceinline__ unsigned long long rt() { return __builtin_amdgcn_s_memrealtime(); }
__device__ __forceinline__ unsigned f2bf(float f) { unsigned u = __builtin_bit_cast(unsigned, f); return (u + 0x7fffu + ((u >> 16) & 1u)) >> 16; }
typedef float pk2_f32x2 __attribute__((ext_vector_type(2))); typedef __bf16 pk2_bf16x2 __attribute__((ext_vector_type(2)));
__device__ __forceinline__ unsigned pk2(float lo, float hi) { const pk2_f32x2 v = {lo, hi}; return __builtin_bit_cast(unsigned, __builtin_convertvector(v, pk2_bf16x2)); }

#define XB_TMO      128
#define XB_XCNT(j)  (256  + 64 * (j))
#define XB_XSUB(j)  (1280 + 64 * (j))
#define XB_XGEN(j)  (2304 + 64 * (j))
#define XB_TOP      3328
#define XB_TOPGEN   3392
#define XCD_BAR_WORDS 3456
#define XB_SPIN_CAP (1u << 18)

__device__ __forceinline__ unsigned xb_ld(unsigned* p)              { return __hip_atomic_load(p, __ATOMIC_RELAXED, __HIP_MEMORY_SCOPE_AGENT); }
__device__ __forceinline__ unsigned xb_add(unsigned* p, unsigned v) { return __hip_atomic_fetch_add(p, v, __ATOMIC_RELAXED, __HIP_MEMORY_SCOPE_AGENT); }
__device__ __forceinline__ unsigned xb_xcc_id() { return (unsigned)__builtin_amdgcn_s_getreg((3 << 11) | 20) & 0xFu; }
#define XB_SPIN(cond, bar) do { unsigned _sp = 0; while (cond) { __builtin_amdgcn_s_sleep(1); \
    if ((++_sp & 255u) == 0u) { if (xb_ld(&(bar)[XB_TMO])) break; if (_sp > XB_SPIN_CAP) { atomicAdd(&(bar)[XB_TMO], 1u); break; } } } } while (0)

struct XcdBarrier {
    unsigned* bar; unsigned x;
    volatile LAS unsigned* st;
};

__device__ __forceinline__ XcdBarrier xcd_barrier_post(unsigned* bar, volatile LAS unsigned* st) {
    XcdBarrier b; b.bar = bar; b.x = xb_xcc_id(); b.st = st;
    if (threadIdx.x == 0) (void)xb_add(&bar[XB_XCNT(b.x)], 1u);
    return b;
}
__device__ __forceinline__ void xcd_barrier_complete(unsigned* bar, unsigned x, unsigned& nloc, unsigned& nx) {
    const unsigned G = gridDim.x * gridDim.y * gridDim.z;
    unsigned sum, cnt, mine, sp = 0u;
    for (;;) {
        sum = 0u; cnt = 0u; mine = 0u;
#pragma unroll
        for (unsigned j = 0; j < 16; ++j) { const unsigned c = xb_ld(&bar[XB_XCNT(j)]); sum += c; cnt += (c > 0u) ? 1u : 0u; mine = (j == x) ? c : mine; }
        if (sum == G) break;
        __builtin_amdgcn_s_sleep(1);
        if ((++sp & 255u) == 0u) { if (xb_ld(&bar[XB_TMO])) break; if (sp > XB_SPIN_CAP) { atomicAdd(&bar[XB_TMO], 1u); break; } }
    }
    nloc = mine > 0u ? mine : 1u; nx = cnt > 0u ? cnt : 1u;
}

__device__ __forceinline__ void xcd_barrier(const XcdBarrier& b) {
    asm volatile("s_waitcnt vmcnt(0)" ::: "memory");
    __syncthreads();
    if (threadIdx.x == 0) {
        unsigned* bar = b.bar;
        __builtin_amdgcn_s_waitcnt(0);
        unsigned nloc = b.st[0], nx = b.st[1];
        if (nloc == 0u) { xcd_barrier_complete(bar, b.x, nloc, nx); b.st[0] = nloc; b.st[1] = nx; }
        const unsigned old = xb_add(&bar[XB_XSUB(b.x)], 1u);
        const unsigned gen = old / nloc;
        if (old + 1u == (gen + 1u) * nloc) {
            __builtin_amdgcn_fence(__ATOMIC_RELEASE, "agent");
            asm volatile("s_waitcnt vmcnt(0)" ::: "memory");
            const unsigned og = xb_add(&bar[XB_TOP], 1u);
            const unsigned tg = og / nx;
            if (og + 1u == (tg + 1u) * nx) xb_add(&bar[XB_TOPGEN], 1u);
            else XB_SPIN(xb_ld(&bar[XB_TOPGEN]) == tg, bar);
            __builtin_amdgcn_fence(__ATOMIC_ACQUIRE, "agent");
            xb_add(&bar[XB_XGEN(b.x)], 1u);
            asm volatile("s_waitcnt vmcnt(0)" ::: "memory");
        } else {
            XB_SPIN(xb_ld(&bar[XB_XGEN(b.x)]) == gen, bar);
            __builtin_amdgcn_fence(__ATOMIC_ACQUIRE, "agent");
            asm volatile("s_waitcnt vmcnt(0)" ::: "memory");
        }
    }
    __syncthreads();
}
#ifndef MK_ONE_LAUNCH
#define MK_ONE_LAUNCH 1
#endif
constexpr int NWAVES = 8;
constexpr int NB = 8, SEQ = 4096, DM = 1024, NTOK = NB * SEQ;
constexpr int INW = 3592, INP = 3584;
constexpr float EPS = 1e-6f;
constexpr size_t MiB = 1u << 20;
constexpr size_t WS_CTL = 0, CTL_ZERO_BYTES = 1 * MiB;
constexpr size_t WS_MOD = 1 * MiB;
constexpr size_t WS_LF = 2 * MiB, WS_LI = WS_LF + 512 * 1024;
constexpr size_t WS_FC = 3 * MiB;
constexpr size_t WS_WIN = 4 * MiB, WS_WOUT0 = 11 * MiB, WS_WC0 = 13 * MiB, WS_WQKV = 17 * MiB, WS_WOUT1 = 23 * MiB, WS_WC1 = 25 * MiB;
constexpr size_t WS_H = 32 * MiB;
constexpr size_t WS_BIG = 96 * MiB;
constexpr size_t WS_IDS = 320 * MiB, WS_GATES = 336 * MiB;
constexpr size_t WS_END = 352 * MiB;
constexpr int CW_BAR = 4096;
constexpr int RING_BYTES = 131072, LDSCTL_OFF = RING_BYTES, MISC_OFF = LDSCTL_OFF + 320, LDS_BYTES = 163840;

__device__ __forceinline__ float wave_sum(float v) {
#pragma unroll
    for (int o = 1; o < 64; o <<= 1) v += __shfl_xor(v, o);
    return v;
}
__device__ __forceinline__ float wave_max(float v) {
#pragma unroll
    for (int o = 1; o < 64; o <<= 1) v = fmaxf(v, __shfl_xor(v, o));
    return v;
}
__device__ __forceinline__ float bf2f(unsigned short b) { return __uint_as_float((unsigned)b << 16); }
__device__ __forceinline__ float bflo(unsigned w) { return __uint_as_float(w << 16); }
__device__ __forceinline__ float bfhi(unsigned w) { return __uint_as_float(w & 0xffff0000u); }
__device__ __forceinline__ float sigmoidf_(float x) { return 1.f / (1.f + __expf(-x)); }
__device__ __forceinline__ float softplusf_(float x) { return fmaxf(x, 0.f) + __logf(1.f + __expf(-fabsf(x))); }
__device__ __forceinline__ float logsigmoidf_(float x) { return fminf(x, 0.f) - __logf(1.f + __expf(-fabsf(x))); }
__device__ __forceinline__ float gelu_exact(float x) { return 0.5f * x * (1.f + erff(x * 0.70710678118654752f)); }
__device__ __forceinline__ float gelu_as(float v) {
    const float av = fabsf(v), t = __builtin_amdgcn_rcpf(av * 0.2316418882f + 1.0f);
    float q = t * 0.5307027145f + (-0.7265760135f); q = q * t + 0.7107068705f; q = q * t + (-0.142248368f); q = q * t + 0.127414796f; q = q * t;
    const float e = __builtin_amdgcn_exp2f((v * v) * (-0.72134752044f));
    const float m = v * (q * e);
    return v < 0.f ? m : v - m;
}

struct Args { const float* in[30]; float* out; unsigned char* ws; int ph_lo, ph_hi; };

struct Ctx {
    LAS unsigned char* lds;
    int tid, lane, wave, G, bid;
    int gw, NGW;
    long gt, NGT;
};
template <bool BASE_BF16>
struct EpiResid {
    static constexpr bool PERM = true, AFTER_DRAIN = false;
    const void* base; bf16* out; const float* gate;
    __device__ __forceinline__ void operator()(const pg8::f32x4 (&acc)[2][2][4][2], const pg8::Unit& u, int wr, int wc, int fr, int fq) const {
        using pg8::f32x4;
        const int col0 = u.pn * 256 + wc * 32 + 8 * fq;
        const float* gp = gate + (size_t)((u.pm * 256) / SEQ) * 6144 + col0;
        f32x4 gv[2][2];
#pragma unroll
        for (int bj = 0; bj < 2; ++bj)
#pragma unroll
            for (int n = 0; n < 2; ++n) { gv[bj][n] = *(const f32x4*)(gp + bj * 128 + 4 * n); gv[bj][n] = gv[bj][n] + 1.0f; }
#pragma unroll
        for (int ai = 0; ai < 2; ++ai)
#pragma unroll
            for (int m = 0; m < 4; ++m) {
                const int r = ai * 128 + wr * 64 + m * 16 + fr; const size_t off = (size_t)(u.pm * 256 + r) * DM + col0;
#pragma unroll
                for (int bj = 0; bj < 2; ++bj) {
                    f32x4 b0, b1;
                    if (BASE_BF16) { const v4u w = *(const v4u*)((const bf16*)base + off + bj * 128); b0 = (f32x4){bflo(w.x), bfhi(w.x), bflo(w.y), bfhi(w.y)}; b1 = (f32x4){bflo(w.z), bfhi(w.z), bflo(w.w), bfhi(w.w)}; }
                    else { b0 = *(const f32x4*)((const float*)base + off + bj * 128); b1 = *(const f32x4*)((const float*)base + off + bj * 128 + 4); }
                    const f32x4 v0 = b0 + gv[bj][0] * acc[ai][bj][m][0], v1 = b1 + gv[bj][1] * acc[ai][bj][m][1];
                    v4u o; o.x = pk2(v0[0], v0[1]); o.y = pk2(v0[2], v0[3]); o.z = pk2(v1[0], v1[1]); o.w = pk2(v1[2], v1[3]);
                    *(v4u*)(out + off + bj * 128) = o;
                }
            }
    }
};

constexpr size_t WS_SA = WS_MOD + 768 * 1024;
constexpr size_t OUT_W8 = 96 * MiB;
constexpr size_t OUT_W8IN = OUT_W8, OUT_W8C0 = OUT_W8 + 4 * MiB, OUT_W8QKV = OUT_W8 + 6 * MiB, OUT_W8C1 = OUT_W8 + 9 * MiB, OUT_SW = OUT_W8 + 11 * MiB;
constexpr int SW_IN = 0, SW_C0 = 4096, SW_QKV = 8192, SW_C1 = 12288;
__device__ __forceinline__ void quantize_rows(const Ctx& C, const bf16* W, int N, unsigned char* W8, float* SW) {
    for (int n = C.gw; n < N; n += C.NGW) {
        const v4u w0 = *(const v4u*)(W + (size_t)n * DM + 16 * C.lane), w1 = *(const v4u*)(W + (size_t)n * DM + 16 * C.lane + 8);
        float x[16] = {bflo(w0.x), bfhi(w0.x), bflo(w0.y), bfhi(w0.y), bflo(w0.z), bfhi(w0.z), bflo(w0.w), bfhi(w0.w), bflo(w1.x), bfhi(w1.x), bflo(w1.y), bfhi(w1.y), bflo(w1.z), bfhi(w1.z), bflo(w1.w), bfhi(w1.w)};
        float am = 0.f;
#pragma unroll
        for (int i = 0; i < 16; ++i) am = fmaxf(am, fabsf(x[i]));
        am = fmaxf(wave_max(am), 1e-30f); const float qi = 127.f / am;
        v4u o;
#pragma unroll
        for (int q = 0; q < 4; ++q) { const int q0 = (int)rintf(x[4 * q] * qi), q1 = (int)rintf(x[4 * q + 1] * qi), q2 = (int)rintf(x[4 * q + 2] * qi), q3 = (int)rintf(x[4 * q + 3] * qi);
            o[q] = ((unsigned)q0 & 255u) | (((unsigned)q1 & 255u) << 8) | (((unsigned)q2 & 255u) << 16) | ((unsigned)q3 << 24); }
        *(v4u*)(W8 + (size_t)n * DM + 16 * C.lane) = o;
        if (C.lane == 0) SW[n] = am * (1.f / 127.f);
    }
}
struct EpiBf16I8 {
    static constexpr bool PERM = true, AFTER_DRAIN = false;
    bf16* O; int ldc; const float* sa; const float* sw;
    __device__ __forceinline__ void operator()(const pg8::i32x4 (&acc)[2][2][4][2], const pg8::Unit& u, int wr, int wc, int fr, int fq) const {
        using pg8::f32x4;
        const int col0 = u.pn * 256 + wc * 32 + 8 * fq;
        f32x4 cs[2][2];
#pragma unroll
        for (int bj = 0; bj < 2; ++bj)
#pragma unroll
            for (int n = 0; n < 2; ++n) cs[bj][n] = *(const f32x4*)(sw + col0 + bj * 128 + 4 * n);
#pragma unroll
        for (int ai = 0; ai < 2; ++ai)
#pragma unroll
            for (int m = 0; m < 4; ++m) { const int row = u.pm * 256 + ai * 128 + wr * 64 + m * 16 + fr; const float rs = sa[row];
                bf16* rowp = O + (size_t)row * ldc + col0;
#pragma unroll
                for (int bj = 0; bj < 2; ++bj) { const pg8::i32x4 a0 = acc[ai][bj][m][0], a1 = acc[ai][bj][m][1];
                    v4u w; w.x = pk2((float)a0[0] * rs * cs[bj][0][0], (float)a0[1] * rs * cs[bj][0][1]); w.y = pk2((float)a0[2] * rs * cs[bj][0][2], (float)a0[3] * rs * cs[bj][0][3]);
                    w.z = pk2((float)a1[0] * rs * cs[bj][1][0], (float)a1[1] * rs * cs[bj][1][1]); w.w = pk2((float)a1[2] * rs * cs[bj][1][2], (float)a1[3] * rs * cs[bj][1][3]);
                    *(v4u*)(rowp + bj * 128) = w; } }
    }
};

__device__ __forceinline__ void transpose_item(const float* W, int ldw, int src_col0, bf16* WT, int K, int dst_row0, int k0, LAS float* scr, int lane) {
#pragma unroll 8
    for (int i = 0; i < 32; ++i) { const int kk = 2 * i + (lane >> 5); scr[kk * 33 + (lane & 31)] = W[(size_t)(k0 + kk) * ldw + src_col0 + (lane & 31)]; }
    LDS_WAIT(); asm volatile("" ::: "memory");
    const int c = lane & 7;
#pragma unroll
    for (int j = 0; j < 4; ++j) { const int n = (lane >> 3) + 8 * j; const LAS float* s = scr + (8 * c) * 33 + n;
        v4u o; o.x = pk2(s[0 * 33], s[1 * 33]); o.y = pk2(s[2 * 33], s[3 * 33]); o.z = pk2(s[4 * 33], s[5 * 33]); o.w = pk2(s[6 * 33], s[7 * 33]);
        *(GAS v4u*)(WT + (size_t)(dst_row0 + n) * K + k0 + 8 * c) = o; }
    LDS_WAIT(); asm volatile("" ::: "memory");
}

__device__ __forceinline__ void phase_prep(const Ctx& C, const Args& A) {
    unsigned char* ws = A.ws;
    {
        LAS float* scr = (LAS float*)(C.lds + C.wave * 16384);
        constexpr int I_IN = 16 * (INP / 32), I_O = 16 * 32, I_QKV = 16 * 96;
        constexpr int NIT = I_IN + I_O + I_QKV + I_O;
        for (int it = C.gw; it < NIT; it += C.NGW) {
            int r = it;
            if (r < I_IN) { const int kb = r / (INP / 32), nb = r % (INP / 32); const int dst = nb * 32, src = dst + (dst >= 2048 ? 8 : 0);
                transpose_item(A.in[5], INW, src, (bf16*)(ws + WS_WIN), 1024, dst, kb * 64, scr, C.lane); continue; } r -= I_IN;
            if (r < I_O) { const int kb = r / 32, nb = r % 32; transpose_item(A.in[10], 1024, nb * 32, (bf16*)(ws + WS_WOUT0), 1024, nb * 32, kb * 64, scr, C.lane); continue; } r -= I_O;
            if (r < I_QKV) { const int kb = r / 96, nb = r % 96; const int src = (nb >> 3) * 256 + 64 * (nb & 3) + 32 * ((nb >> 2) & 1);
                transpose_item(A.in[20], 3072, src, (bf16*)(ws + WS_WQKV), 1024, nb * 32, kb * 64, scr, C.lane); continue; } r -= I_QKV;
            { const int kb = r / 32, nb = r % 32; transpose_item(A.in[23], 1024, nb * 32, (bf16*)(ws + WS_WOUT1), 1024, nb * 32, kb * 64, scr, C.lane); }
        }
    }
    {
        LAS float* sc = (LAS float*)C.lds;
        LAS float* red = (LAS float*)(C.lds + 32768);
        if (C.bid < 96) {
            __syncthreads();
            for (int i = C.tid; i < NB * DM; i += NWAVES * 64) { const float v = A.in[1][i]; sc[i] = v / (1.f + __expf(-v)); }
            __syncthreads();
            for (int item = C.bid; item < 96; item += C.G) {
                const int l = item / 48, jc = item % 48;
                const float* W = A.in[l ? 17 : 2] + 128 * jc + 2 * C.lane;
                float a0[NB], a1[NB];
#pragma unroll
                for (int b = 0; b < NB; ++b) a0[b] = a1[b] = 0.f;
#pragma unroll 32
                for (int kk = 0; kk < 128; ++kk) { const int k = 128 * C.wave + kk; const float2 w = *(const float2*)(W + (size_t)k * 6144);
#pragma unroll
                    for (int b = 0; b < NB; ++b) { const float s = sc[b * DM + k]; a0[b] += s * w.x; a1[b] += s * w.y; } }
#pragma unroll
                for (int b = 0; b < NB; ++b) { red[(C.wave * NB + b) * 128 + 2 * C.lane] = a0[b]; red[(C.wave * NB + b) * 128 + 2 * C.lane + 1] = a1[b]; }
                __syncthreads();
                float* mod = (float*)(ws + WS_MOD);
                for (int o = C.tid; o < NB * 128; o += NWAVES * 64) { const int b = o >> 7, j = o & 127; float s = A.in[l ? 18 : 3][128 * jc + j];
#pragma unroll
                    for (int w = 0; w < NWAVES; ++w) s += red[(w * NB + b) * 128 + j];
                    mod[(size_t)(l * NB + b) * 6144 + 128 * jc + j] = s; }
                __syncthreads();
            }
        }
    }
    {
        LAS float* kt = (LAS float*)C.lds;
        LAS float* wt = (LAS float*)(C.lds + 128 * 132 * 4);
        for (int item = C.bid; item < 512; item += C.G) {
            const int l = item >> 8, hh = (item >> 4) & 15, kb = item & 15;
            const float* Wq = A.in[l ? 25 : 12]; const float* Kh = A.in[l ? ((hh & 1) ? 27 : 26) : ((hh & 1) ? 14 : 13)];
            bf16* Wc = (bf16*)(ws + (l ? WS_WC1 : WS_WC0));
            __syncthreads();
#pragma unroll
            for (int i = 0; i < 8; ++i) { const int id = C.tid + 512 * i, row = id >> 5, c4 = id & 31; *(LAS f32x4*)(kt + row * 132 + 4 * c4) = *(const f32x4*)(Kh + row * 128 + 4 * c4); }
#pragma unroll
            for (int i = 0; i < 4; ++i) { const int id = C.tid + 512 * i, row = id >> 5, c4 = id & 31; *(LAS f32x4*)(wt + row * 132 + 4 * c4) = *(const f32x4*)(Wq + (size_t)(kb * 64 + row) * 2048 + hh * 128 + 4 * c4); }
            __syncthreads();
            const int key = C.tid & 127, kg = C.tid >> 7;
            float acc[16];
#pragma unroll
            for (int i = 0; i < 16; ++i) acc[i] = 0.f;
#pragma unroll 2
            for (int d4 = 0; d4 < 32; ++d4) { const f32x4 kv = *(const LAS f32x4*)(kt + key * 132 + 4 * d4);
#pragma unroll
                for (int i = 0; i < 16; ++i) { const f32x4 wv = *(const LAS f32x4*)(wt + (kg * 16 + i) * 132 + 4 * d4); acc[i] += (kv.x * wv.x + kv.y * wv.y) + (kv.z * wv.z + kv.w * wv.w); } }
            v4u o0, o1; o0.x = pk2(acc[0], acc[1]); o0.y = pk2(acc[2], acc[3]); o0.z = pk2(acc[4], acc[5]); o0.w = pk2(acc[6], acc[7]);
            o1.x = pk2(acc[8], acc[9]); o1.y = pk2(acc[10], acc[11]); o1.z = pk2(acc[12], acc[13]); o1.w = pk2(acc[14], acc[15]);
            bf16* dst = Wc + (size_t)(hh * 128 + key) * 1024 + kb * 64 + kg * 16;
            *(v4u*)dst = o0; *(v4u*)(dst + 8) = o1;
        }
        __syncthreads();
    }
}

template <bool BF> struct RowRaw;
template <> struct RowRaw<true> { typedef u32x2 type; static __device__ __forceinline__ f32x4 cvt(u32x2 w) { return (f32x4){bflo(w.x), bfhi(w.x), bflo(w.y), bfhi(w.y)}; } };
template <> struct RowRaw<false> { typedef f32x4 type; static __device__ __forceinline__ f32x4 cvt(f32x4 w) { return w; } };
template <bool GATES, bool IN_BF16, bool OUT_I8 = false>
__device__ __forceinline__ void phase_rowpass(const Ctx& C, const Args& A, const void* xin, const float* gain, const float* modl  , int ch_shift, int ch_scale, bf16* hout, float* sa = nullptr) {
    f32x4 wg0[GATES ? 16 : 1], wg1[GATES ? 16 : 1];
    if (GATES) {
        const float* Wg = A.in[5] + 2048;
#pragma unroll
        for (int j = 0; j < 4; ++j)
#pragma unroll
            for (int e = 0; e < 4; ++e) { const int k = 4 * C.lane + 256 * j + e; wg0[4 * j + e] = *(const f32x4*)(Wg + (size_t)k * INW); wg1[4 * j + e] = *(const f32x4*)(Wg + (size_t)k * INW + 4); }
    }
    const int per_wave = (NTOK + C.NGW - 1) / C.NGW; const int r0 = C.gw * per_wave, r1 = (r0 + per_wave < NTOK) ? r0 + per_wave : NTOK;
    f32x4 gsc[4], shv[4]; int bcur = -1;
    typedef typename RowRaw<IN_BF16>::type raw_t;
    raw_t cur[4], nxt[4];
    if (r0 < r1) {
#pragma unroll
        for (int j = 0; j < 4; ++j) cur[j] = *(const raw_t*)((const unsigned char*)xin + ((size_t)r0 * DM + 4 * C.lane + 256 * j) * (IN_BF16 ? 2 : 4));
    }
#pragma unroll 2
    for (int row = r0; row < r1; ++row) {
        const int b = row >> 12;
        if (row + 1 < r1) {
#pragma unroll
            for (int j = 0; j < 4; ++j) nxt[j] = *(const raw_t*)((const unsigned char*)xin + ((size_t)(row + 1) * DM + 4 * C.lane + 256 * j) * (IN_BF16 ? 2 : 4));
        }
        if (b != bcur) {
            const float* shp = modl + (size_t)b * 6144 + ch_shift * 1024 + 4 * C.lane; const float* scp = modl + (size_t)b * 6144 + ch_scale * 1024 + 4 * C.lane;
#pragma unroll
            for (int j = 0; j < 4; ++j) { const f32x4 g = *(const f32x4*)(gain + 4 * C.lane + 256 * j), sc = *(const f32x4*)(scp + 256 * j); gsc[j] = g * (sc + 1.0f); shv[j] = *(const f32x4*)(shp + 256 * j); }
            bcur = b;
        }
        f32x4 v[4]; float ss = 0.f;
#pragma unroll
        for (int j = 0; j < 4; ++j) {
            v[j] = RowRaw<IN_BF16>::cvt(cur[j]);
            ss += v[j].x * v[j].x + v[j].y * v[j].y + v[j].z * v[j].z + v[j].w * v[j].w; }
#pragma unroll
        for (int j = 0; j < 4; ++j) cur[j] = nxt[j];
        const float rstd = rsqrtf(wave_sum(ss) * (1.f / DM) + EPS);
        f32x4 h[4];
#pragma unroll
        for (int j = 0; j < 4; ++j) {
            h[j] = v[j] * rstd * gsc[j] + shv[j];
            if (!OUT_I8) { uint2 o; o.x = pk2(h[j].x, h[j].y); o.y = pk2(h[j].z, h[j].w);
                *(uint2*)(hout + (size_t)row * DM + 4 * C.lane + 256 * j) = o; } }
        if (OUT_I8) {
            float am = 0.f;
#pragma unroll
            for (int j = 0; j < 4; ++j) am = fmaxf(am, fmaxf(fmaxf(fabsf(h[j].x), fabsf(h[j].y)), fmaxf(fabsf(h[j].z), fabsf(h[j].w))));
            am = fmaxf(wave_max(am), 1e-20f); const float qi = 127.f / am;
            unsigned char* h8 = (unsigned char*)hout + (size_t)row * DM + 4 * C.lane;
#pragma unroll
            for (int j = 0; j < 4; ++j) { const int q0 = (int)rintf(h[j].x * qi), q1 = (int)rintf(h[j].y * qi), q2 = (int)rintf(h[j].z * qi), q3 = (int)rintf(h[j].w * qi);
                *(unsigned*)(h8 + 256 * j) = ((unsigned)q0 & 255u) | (((unsigned)q1 & 255u) << 8) | (((unsigned)q2 & 255u) << 16) | ((unsigned)q3 << 24); }
            if (C.lane == 0) sa[row] = am * (1.f / 127.f);
        }
        if (GATES) {
            f32x4 d0 = {0.f, 0.f, 0.f, 0.f}, d1 = {0.f, 0.f, 0.f, 0.f};
#pragma unroll
            for (int j = 0; j < 4; ++j)
#pragma unroll
                for (int e = 0; e < 4; ++e) { const float hv = h[j][e]; d0 += wg0[4 * j + e] * hv; d1 += wg1[4 * j + e] * hv; }
            float d[8] = {d0.x, d0.y, d0.z, d0.w, d1.x, d1.y, d1.z, d1.w};
#pragma unroll
            for (int q = 0; q < 8; ++q) d[q] = wave_sum(d[q]);
            if (C.lane == 0) {
                const int s = row & (SEQ - 1); float* LF = (float*)(A.ws + WS_LF); float* LI = (float*)(A.ws + WS_LI);
#pragma unroll
                for (int hh = 0; hh < 4; ++hh) { LI[(size_t)(b * 4 + hh) * SEQ + s] = d[hh] + A.in[6][hh]; LF[(size_t)(b * 4 + hh) * SEQ + s] = logsigmoidf_(d[4 + hh] + A.in[7][hh]); }
            }
        }
    }
}

__device__ __forceinline__ void phase_conv(const Ctx& C, const Args& A) {
    const bf16* P = (const bf16*)(A.ws + WS_BIG); bf16* mix = (bf16*)(A.ws + WS_H); const float* cw = A.in[8];
    for (long it = C.gt; it < (long)NTOK * 64; it += C.NGT) {
        const int cg = (int)(it & 63), tok = (int)(it >> 6), t = tok & (SEQ - 1), c0 = cg * 8;
        float conv[8];
#pragma unroll
        for (int e = 0; e < 8; ++e) conv[e] = 0.f;
#pragma unroll
        for (int k = 0; k < 3; ++k) {
            const int dt = 2 - k;
            if (t - dt >= 0) {
                const bf16* r = P + (size_t)(tok - dt) * INP;
                const v4u cc = *(const v4u*)(r + 2560 + c0), chv = *(const v4u*)(r + 3072 + c0);
                const f32x4 w0 = *(const f32x4*)(cw + k * 512 + c0), w1 = *(const f32x4*)(cw + k * 512 + c0 + 4);
                conv[0] += w0.x * bflo(cc.x) * bflo(chv.x); conv[1] += w0.y * bfhi(cc.x) * bfhi(chv.x);
                conv[2] += w0.z * bflo(cc.y) * bflo(chv.y); conv[3] += w0.w * bfhi(cc.y) * bfhi(chv.y);
                conv[4] += w1.x * bflo(cc.z) * bflo(chv.z); conv[5] += w1.y * bfhi(cc.z) * bfhi(chv.z);
                conv[6] += w1.z * bflo(cc.w) * bflo(chv.w); conv[7] += w1.w * bfhi(cc.w) * bfhi(chv.w);
            }
        }
        const v4u cb = *(const v4u*)(P + (size_t)tok * INP + 2048 + c0);
        v4u o; o.x = pk2(conv[0] * bflo(cb.x), conv[1] * bfhi(cb.x)); o.y = pk2(conv[2] * bflo(cb.y), conv[3] * bfhi(cb.y));
        o.z = pk2(conv[4] * bflo(cb.z), conv[5] * bfhi(cb.z)); o.w = pk2(conv[6] * bflo(cb.w), conv[7] * bfhi(cb.w));
        *(v4u*)(mix + (size_t)tok * DM + 512 + c0) = o;
    }
}
constexpr size_t WS_TAB = 352 * MiB;
constexpr size_t TAB_BYTES = (size_t)16384 * 1024;
constexpr size_t WS_TSC = WS_TAB + 4 * TAB_BYTES;
constexpr size_t WS_XB = 420 * MiB;
constexpr size_t WS_END2 = WS_XB + 64 * MiB;
typedef float f32x2 __attribute__((ext_vector_type(2)));
typedef __bf16 bf16x2_t __attribute__((ext_vector_type(2)));
__device__ __forceinline__ float dot2bf(unsigned a, unsigned b, float c) { return __builtin_amdgcn_fdot2_f32_bf16(__builtin_bit_cast(bf16x2_t, a), __builtin_bit_cast(bf16x2_t, b), c, false); }
template <int CTRL> __device__ __forceinline__ unsigned dppu(unsigned v) { return (unsigned)__builtin_amdgcn_update_dpp(0, (int)v, CTRL, 0xF, 0xF, true); }
__device__ __forceinline__ float wave_sum_dpp(float v) {
    v += __uint_as_float(dppu<0xB1>(__float_as_uint(v)));
    v += __uint_as_float(dppu<0x4E>(__float_as_uint(v)));
    v += __uint_as_float(dppu<0x124>(__float_as_uint(v)));
    v += __uint_as_float(dppu<0x128>(__float_as_uint(v)));
    const unsigned u = __float_as_uint(v);
    return (__uint_as_float(__builtin_amdgcn_readlane(u, 0)) + __uint_as_float(__builtin_amdgcn_readlane(u, 16))) + (__uint_as_float(__builtin_amdgcn_readlane(u, 32)) + __uint_as_float(__builtin_amdgcn_readlane(u, 48)));
}
__device__ __forceinline__ void ins16(unsigned (&val)[16], unsigned k) {
#pragma unroll
    for (int j = 0; j < 16; ++j) { const unsigned t = val[j] < k ? val[j] : k; val[j] = val[j] < k ? k : val[j]; k = t; }
}
#define PEER_CE(x, i, l) { const unsigned a_ = x[i] < x[l] ? x[l] : x[i], b_ = x[i] < x[l] ? x[i] : x[l]; x[i] = a_; x[l] = b_; }
__device__ __forceinline__ void sort16_desc(unsigned (&x)[16]) {
#pragma unroll
    for (int k = 2; k <= 16; k <<= 1)
#pragma unroll
        for (int j = k >> 1; j > 0; j >>= 1)
#pragma unroll
            for (int i = 0; i < 16; ++i) { const int l = i ^ j; if (l > i) { if ((i & k) == 0) { PEER_CE(x, i, l) } else { PEER_CE(x, l, i) } } }
}
__device__ __forceinline__ void merge16_desc(unsigned (&v)[16], const unsigned (&s)[16]) {
#pragma unroll
    for (int i = 0; i < 16; ++i) v[i] = v[i] < s[15 - i] ? s[15 - i] : v[i];
#pragma unroll
    for (int j = 8; j > 0; j >>= 1)
#pragma unroll
        for (int i = 0; i < 16; ++i) { const int l = i ^ j; if (l > i) PEER_CE(v, i, l) }
}
__device__ __forceinline__ unsigned ord32(unsigned b) { return b ^ ((unsigned)((int)b >> 31) | 0x80000000u); }
__device__ __forceinline__ float unord(unsigned o, unsigned mask) { o &= mask; return __uint_as_float((o & 0x80000000u) ? (o ^ 0x80000000u) : (~o & mask)); }

template <bool NEXT, int DRY = 0>
__device__ __forceinline__ void phase_peer(const Ctx& C, const Args& A, const unsigned char* Utab, const unsigned char* Vtab, const float* SU, const float* SV, const float* g2  ,
                                           const float* ngain, const float* nmod  , const XcdBarrier& bar) {
    const bf16* SC = (const bf16*)(A.ws + WS_BIG); bf16* Hb = (bf16*)(A.ws + WS_H);
#ifndef PEER_NBK
#define PEER_NBK 32
#endif
    constexpr int NBK = PEER_NBK, BSH = (NBK == 32 ? 9 : NBK == 64 ? 8 : 7), BPL = NBK / 16;
    LAS unsigned char* wb = C.lds + C.wave * (1024 + 32 * NBK + 8192);
    LAS unsigned char* IDXB = wb; LAS unsigned* CNT = (LAS unsigned*)(wb + 1024); LAS unsigned* PRE = (LAS unsigned*)(wb + 1024 + 16 * NBK); LAS v4u* ENT = (LAS v4u*)(wb + 1024 + 32 * NBK);
#ifndef PEER_SYNC_EVERY
#define PEER_SYNC_EVERY 32
#endif
    const bool wg_uniform = (DRY != 6) && ((NTOK / 4) % C.NGW == 0);
    unsigned flip = 0u;
#ifdef PEER_STAGGER
    if (C.wave >= 4) { const unsigned long long t0_ = __builtin_amdgcn_s_memrealtime(); while (__builtin_amdgcn_s_memrealtime() - t0_ < (unsigned long long)PEER_STAGGER) __builtin_amdgcn_s_sleep(16); }
#endif
    const int gw_ = (DRY == 6) ? ((C.bid >> 1) * NWAVES + C.wave) : C.gw, ngw_ = (DRY == 6) ? (C.NGW >> 1) : C.NGW;
    if (DRY == 6 && (C.bid & 1)) return;
    for (int tb = gw_; tb < NTOK / 4; tb += ngw_) {
        const int tok0 = tb * 4;
#if MK_ONE_LAUNCH && defined(PEER_SYNC)
        if (tb >= C.NGW) xcd_barrier(bar);
#endif
        int lane = C.lane; asm volatile("" : "+v"(lane));
        const int par = lane & 1, tl = lane >> 4, grp = lane & 15, head = grp >> 1, i16 = lane & 15;
        {
            unsigned val[16];
            const v4u* sp = (const v4u*)(SC + (size_t)(tok0 + tl) * 2048 + grp * 128);
            v4u raw[16];
#pragma unroll
            for (int c = 0; c < 16; ++c) raw[c] = sp[c];
#pragma unroll
            for (int c = 0; c < 16; c += 2) {
                const v4u c0 = raw[c], c1 = raw[c + 1];
                const unsigned ib = 127u - 8u * (unsigned)c;
                unsigned ks[16];
#pragma unroll
                for (int e = 0; e < 4; ++e) { ks[2 * e] = (ord32(c0[e] << 16) & 0xFFFF0000u) | (ib - 2u * e); ks[2 * e + 1] = (ord32(c0[e] & 0xFFFF0000u) & 0xFFFF0000u) | (ib - 2u * e - 1u);
                    ks[8 + 2 * e] = (ord32(c1[e] << 16) & 0xFFFF0000u) | (ib - 8u - 2u * e); ks[9 + 2 * e] = (ord32(c1[e] & 0xFFFF0000u) & 0xFFFF0000u) | (ib - 9u - 2u * e); }
                sort16_desc(ks);
                if (c == 0) {
#pragma unroll
                    for (int j = 0; j < 16; ++j) val[j] = ks[j];
                } else merge16_desc(val, ks);
            }
#pragma unroll
            for (int z = 0; z < NBK / 16; ++z) CNT[lane + 64 * z] = 0u;
            float X[16], Y[16];
            v4u ib4 = {0u, 0u, 0u, 0u};
#pragma unroll
            for (int j = 0; j < 16; ++j) { X[j] = unord(val[j], 0xFFFF0000u); Y[j] = unord(dppu<0xB1>(val[j]), 0xFFFF0000u); ib4[j >> 2] |= (127u - (val[j] & 127u)) << (8 * (j & 3)); }
            *(LAS v4u*)(IDXB + lane * 16) = ib4;
            unsigned cand[16], cb2[16];
            unsigned parv = (unsigned)par; asm volatile("" : "+v"(parv));
#define PEER_CKEY(p, q) ((((p) == (q)) && parv) ? 0u : ((ord32(__float_as_uint(X[p] + Y[q])) & 0xFFFFFF00u) | (255u - ((unsigned)((p) * 16 + (q)) + parv * (unsigned)(15 * ((q) - (p)))))))
            cand[0] = PEER_CKEY(0, 0); cand[1] = PEER_CKEY(0, 1); cand[2] = PEER_CKEY(0, 2); cand[3] = PEER_CKEY(0, 3); cand[4] = PEER_CKEY(0, 4); cand[5] = PEER_CKEY(0, 5); cand[6] = PEER_CKEY(0, 6); cand[7] = PEER_CKEY(0, 7);
            cand[8] = PEER_CKEY(0, 8); cand[9] = PEER_CKEY(0, 9); cand[10] = PEER_CKEY(0, 10); cand[11] = PEER_CKEY(0, 11); cand[12] = PEER_CKEY(0, 12); cand[13] = PEER_CKEY(0, 13); cand[14] = PEER_CKEY(0, 14); cand[15] = PEER_CKEY(0, 15);
            cb2[0] = PEER_CKEY(1, 1); cb2[1] = PEER_CKEY(1, 2); cb2[2] = PEER_CKEY(1, 3); cb2[3] = PEER_CKEY(1, 4); cb2[4] = PEER_CKEY(1, 5); cb2[5] = PEER_CKEY(1, 6); cb2[6] = PEER_CKEY(1, 7);
            cb2[7] = PEER_CKEY(2, 2); cb2[8] = PEER_CKEY(2, 3); cb2[9] = PEER_CKEY(2, 4); cb2[10] = PEER_CKEY(3, 3); cb2[11] = 0u; cb2[12] = 0u; cb2[13] = 0u; cb2[14] = 0u; cb2[15] = 0u;
#undef PEER_CKEY
            sort16_desc(cand); sort16_desc(cb2); merge16_desc(cand, cb2);
            unsigned mg[16]; float fv[16]; float mx = -INFINITY;
#pragma unroll
            for (int k = 0; k < 16; ++k) { const unsigned o = dppu<0xB1>(cand[15 - k]); mg[k] = cand[k] < o ? o : cand[k]; fv[k] = unord(mg[k], 0xFFFFFF00u); mx = fmaxf(mx, fv[k]); }
            float ssum = 0.f;
#pragma unroll
            for (int k = 0; k < 16; ++k) { fv[k] = __expf(fv[k] - mx); ssum += fv[k]; }
            const float inv = 1.f / ssum;
            asm volatile("s_waitcnt lgkmcnt(0)" ::: "memory");
            unsigned eid[8], rk[8]; float esu[8], egv[8];
#pragma unroll
            for (int k = 0; k < 8; ++k) { const unsigned fi = 255u - (mg[k] & 255u);
                const unsigned e1 = IDXB[(lane & ~1) * 16 + (fi >> 4)], e2 = IDXB[(lane | 1) * 16 + (fi & 15u)];
                eid[k] = e1 * 128u + e2;
                rk[k] = __hip_atomic_fetch_add(CNT + tl * NBK + (eid[k] >> BSH), 1u, __ATOMIC_RELAXED, __HIP_MEMORY_SCOPE_WORKGROUP);
                esu[k] = SU[eid[k]]; egv[k] = fv[k] * inv * SV[eid[k]]; }
            asm volatile("s_waitcnt lgkmcnt(0)" ::: "memory");
            { unsigned cb[BPL]; unsigned s = 0u;
#pragma unroll
              for (int z = 0; z < BPL; ++z) { cb[z] = CNT[tl * NBK + BPL * i16 + z]; s += cb[z]; }
              const unsigned tot = s;
              s += dppu<0x111>(s); s += dppu<0x112>(s); s += dppu<0x114>(s); s += dppu<0x118>(s);
              unsigned ex = s - tot;
#pragma unroll
              for (int z = 0; z < BPL; ++z) { PRE[tl * NBK + BPL * i16 + z] = ex; ex += cb[z]; } }
            asm volatile("s_waitcnt lgkmcnt(0)" ::: "memory");
#pragma unroll
            for (int k = 0; k < 8; ++k) { unsigned pos = PRE[tl * NBK + (eid[k] >> BSH)] + rk[k]; pos = flip ? 127u - pos : pos;
                ENT[tl * 128 + pos] = (v4u){eid[k], __float_as_uint(esu[k]), __float_as_uint(egv[k]), 0u}; }
            asm volatile("s_waitcnt lgkmcnt(0)" ::: "memory");
            flip ^= 1u;
        }
        if (wg_uniform) __syncthreads();
        if (DRY != 3) {
            const int tok = tok0 + tl; const int b = tok >> 12;
            LAS v4u* E = ENT + tl * 128;
            float cmax = 0.f;
            {
                unsigned hq[16]; const float hs = ((const float*)(A.ws + WS_SA))[tok];
#pragma unroll
                for (int j = 0; j < 4; ++j) { const v4u hw = *(const v4u*)(A.ws + WS_IDS + (size_t)tok * DM + 256 * j + 16 * i16); hq[4 * j] = hw.x; hq[4 * j + 1] = hw.y; hq[4 * j + 2] = hw.z; hq[4 * j + 3] = hw.w; }
                v4u B[8][4]; unsigned idr[8]; float mine = 0.f;
#define PEER_LOADI(R_, tab, id_) { const unsigned off = ((id_) & (DRY == 2 ? 1023u : 16383u)) * 1024u + 16u * (unsigned)i16; \
                _Pragma("unroll") for (int j = 0; j < 4; ++j) R_[j] = (DRY == 5 && j >= 2) ? R_[j - 2] : *(const v4u*)((tab) + off + 256 * j); }
#define PEER_DOTS(U_, t_) { int d0 = 0, d1 = 0, d2 = 0, d3 = 0; \
                _Pragma("unroll") for (int e = 0; e < 4; ++e) { d0 = __builtin_amdgcn_sdot4((int)U_[0][e], (int)hq[e], d0, false); d1 = __builtin_amdgcn_sdot4((int)U_[1][e], (int)hq[4 + e], d1, false); \
                    d2 = __builtin_amdgcn_sdot4((int)U_[2][e], (int)hq[8 + e], d2, false); d3 = __builtin_amdgcn_sdot4((int)U_[3][e], (int)hq[12 + e], d3, false); } \
                unsigned ds_ = (unsigned)((d0 + d1) + (d2 + d3)); ds_ += dppu<0xB1>(ds_); ds_ += dppu<0x4E>(ds_); ds_ += dppu<0x124>(ds_); ds_ += dppu<0x128>(ds_); \
                mine = (i16 == ((t_) & 15)) ? (float)(int)ds_ : mine; }
#pragma unroll
                for (int k = 0; k < 8; ++k) idr[k] = E[k].x;
#pragma unroll
                for (int k = 0; k < 8; ++k) PEER_LOADI(B[k], Utab, idr[k])
#pragma unroll 1
                for (int r = 0; r < 128; r += 8) {
                    if (wg_uniform && (r & (PEER_SYNC_EVERY - 1)) == 0 && r) __syncthreads();
                    if (r + 8 < 128) {
#pragma unroll
                        for (int k = 0; k < 8; ++k) idr[k] = E[r + 8 + k].x;
                    }
#pragma unroll
                    for (int k = 0; k < 8; ++k) { PEER_DOTS(B[k], r + k) if (r + 8 < 128) PEER_LOADI(B[k], Utab, idr[k]) }
                    if (r & 8) {
                        const int t = (r & ~15) + i16; const v4u en = E[t];
                        const float cf = gelu_as(mine * (__uint_as_float(en.y) * hs)) * __uint_as_float(en.z);
                        ((LAS float*)(E + t))[3] = cf; cmax = fmaxf(cmax, fabsf(cf));
                    }
                }
#undef PEER_DOTS
            }
            if (wg_uniform) __syncthreads();
            cmax = fmaxf(cmax, __uint_as_float(dppu<0xB1>(__float_as_uint(cmax)))); cmax = fmaxf(cmax, __uint_as_float(dppu<0x4E>(__float_as_uint(cmax))));
            cmax = fmaxf(cmax, __uint_as_float(dppu<0x124>(__float_as_uint(cmax)))); cmax = fmaxf(cmax, __uint_as_float(dppu<0x128>(__float_as_uint(cmax))));
            cmax = fmaxf(cmax, 1e-30f);
            int acci[4][16];
#pragma unroll
            for (int j = 0; j < 4; ++j)
#pragma unroll
                for (int e = 0; e < 16; ++e) acci[j][e] = 0;
            if (DRY != 4) {
                const float cq = 127.f / cmax;
                asm volatile("s_waitcnt lgkmcnt(0)" ::: "memory");
                unsigned pk0, pk1;
                { int q[8];
#pragma unroll
                  for (int k = 0; k < 8; ++k) q[k] = (int)rintf(((const LAS float*)(E + 8 * i16 + k))[3] * cq);
                  pk0 = ((unsigned)q[0] & 255u) | (((unsigned)q[1] & 255u) << 8) | (((unsigned)q[2] & 255u) << 16) | ((unsigned)q[3] << 24);
                  pk1 = ((unsigned)q[4] & 255u) | (((unsigned)q[5] & 255u) << 8) | (((unsigned)q[6] & 255u) << 16) | ((unsigned)q[7] << 24); }
                asm volatile("s_waitcnt lgkmcnt(0)" ::: "memory");
                ((LAS unsigned*)(E + 2 * i16))[1] = pk0; ((LAS unsigned*)(E + 2 * i16 + 1))[1] = pk1;
                asm volatile("s_waitcnt lgkmcnt(0)" ::: "memory");
                v4u Ba[4][2], Bb[4][2];
#define PEER_LOADG(B_, g_, hf_) { _Pragma("unroll") for (int n = 0; n < 4; ++n) { const unsigned id_ = E[4 * (g_) + n].x; const unsigned off = (id_ & (DRY == 2 ? 1023u : 16383u)) * 1024u + 16u * (unsigned)i16 + 512u * (hf_); \
                    _Pragma("unroll") for (int jj = 0; jj < 2; ++jj) B_[n][jj] = *(const v4u*)(Vtab + off + 256 * jj); } }
#define PEER_GROUP(B_, g_, hf_) { const unsigned a4 = ((const LAS unsigned*)(E + (g_)))[1]; \
                    _Pragma("unroll") for (int jj = 0; jj < 2; ++jj) _Pragma("unroll") for (int e = 0; e < 4; ++e) { \
                        const unsigned p01l = __builtin_amdgcn_perm(B_[1][jj][e], B_[0][jj][e], 0x05010400u), p01h = __builtin_amdgcn_perm(B_[1][jj][e], B_[0][jj][e], 0x07030602u); \
                        const unsigned p23l = __builtin_amdgcn_perm(B_[3][jj][e], B_[2][jj][e], 0x05010400u), p23h = __builtin_amdgcn_perm(B_[3][jj][e], B_[2][jj][e], 0x07030602u); \
                        acci[2 * (hf_) + jj][4 * e + 0] = __builtin_amdgcn_sdot4((int)__builtin_amdgcn_perm(p23l, p01l, 0x05040100u), (int)a4, acci[2 * (hf_) + jj][4 * e + 0], false); \
                        acci[2 * (hf_) + jj][4 * e + 1] = __builtin_amdgcn_sdot4((int)__builtin_amdgcn_perm(p23l, p01l, 0x07060302u), (int)a4, acci[2 * (hf_) + jj][4 * e + 1], false); \
                        acci[2 * (hf_) + jj][4 * e + 2] = __builtin_amdgcn_sdot4((int)__builtin_amdgcn_perm(p23h, p01h, 0x05040100u), (int)a4, acci[2 * (hf_) + jj][4 * e + 2], false); \
                        acci[2 * (hf_) + jj][4 * e + 3] = __builtin_amdgcn_sdot4((int)__builtin_amdgcn_perm(p23h, p01h, 0x07060302u), (int)a4, acci[2 * (hf_) + jj][4 * e + 3], false); } }
                PEER_LOADG(Ba, 0, 0)
#pragma unroll 1
                for (int g = 0; g < 32; ++g) {
                    if (wg_uniform && (g & (PEER_SYNC_EVERY / 4 - 1)) == 0 && g) __syncthreads();
                    PEER_LOADG(Bb, g, 1)
                    PEER_GROUP(Ba, g, 0)
                    if (g + 1 < 32) PEER_LOADG(Ba, g + 1, 0)
                    PEER_GROUP(Bb, g, 1)
                }
#undef PEER_LOADG
#undef PEER_GROUP
            }
            const float osc = cmax * (1.f / 127.f);
            f32x2 acc[4][8];
#pragma unroll
            for (int j = 0; j < 4; ++j)
#pragma unroll
                for (int e = 0; e < 8; ++e) acc[j][e] = (f32x2){(float)acci[j][2 * e] * osc, (float)acci[j][2 * e + 1] * osc};
#undef PEER_LOADI
            float ss = 0.f;
#pragma unroll
            for (int j = 0; j < 4; ++j) { const size_t eo = (size_t)tok * DM + 256 * j + 16 * i16; const float* gp = g2 + (size_t)b * 6144 + 256 * j + 16 * i16;
                bf16* XBp = (bf16*)(A.ws + WS_XB) + eo; const v4u xw0 = *(const v4u*)XBp, xw1 = *(const v4u*)(XBp + 8);
                unsigned ow[8];
#pragma unroll
                for (int q = 0; q < 4; ++q) { const unsigned w0 = q < 2 ? xw0[2 * q] : xw1[2 * q - 4], w1 = q < 2 ? xw0[2 * q + 1] : xw1[2 * q - 3]; const f32x4 g0 = *(const f32x4*)(gp + 4 * q);
                    const f32x4 xn = {bflo(w0) + (1.f + g0[0]) * acc[j][2 * q].x, bfhi(w0) + (1.f + g0[1]) * acc[j][2 * q].y, bflo(w1) + (1.f + g0[2]) * acc[j][2 * q + 1].x, bfhi(w1) + (1.f + g0[3]) * acc[j][2 * q + 1].y};
                    if (NEXT) { ow[2 * q] = pk2(xn[0], xn[1]); ow[2 * q + 1] = pk2(xn[2], xn[3]); }
                    else if (DRY == 0 || xn[0] == 1234.5678f) *(f32x4*)(A.out + eo + 4 * q) = xn;
                    acc[j][2 * q] = (f32x2){xn[0], xn[1]}; acc[j][2 * q + 1] = (f32x2){xn[2], xn[3]};
                    ss += (xn[0] * xn[0] + xn[1] * xn[1]) + (xn[2] * xn[2] + xn[3] * xn[3]); }
                if (NEXT && (DRY == 0 || ss == 1234.5678f)) { *(v4u*)XBp = (v4u){ow[0], ow[1], ow[2], ow[3]}; *(v4u*)(XBp + 8) = (v4u){ow[4], ow[5], ow[6], ow[7]}; } }
            if (DRY != 0) { if (ss == 1234.5678f) A.out[tok] = ss; }
            if (NEXT && DRY == 0) {
                ss += __uint_as_float(dppu<0xB1>(__float_as_uint(ss))); ss += __uint_as_float(dppu<0x4E>(__float_as_uint(ss)));
                ss += __uint_as_float(dppu<0x124>(__float_as_uint(ss))); ss += __uint_as_float(dppu<0x128>(__float_as_uint(ss)));
                const float rstd = rsqrtf(ss * (1.f / DM) + EPS);
                float am = 0.f;
#pragma unroll
                for (int j = 0; j < 4; ++j) { const int c0 = 256 * j + 16 * i16; const float* shp = nmod + (size_t)b * 6144 + c0; const float* scp = shp + 1024;
#pragma unroll
                    for (int q = 0; q < 4; ++q) { const f32x4 gn = *(const f32x4*)(ngain + c0 + 4 * q), sc = *(const f32x4*)(scp + 4 * q), sh = *(const f32x4*)(shp + 4 * q);
                        const f32x2 h0 = {acc[j][2 * q].x * rstd * gn[0] * (1.f + sc[0]) + sh[0], acc[j][2 * q].y * rstd * gn[1] * (1.f + sc[1]) + sh[1]};
                        const f32x2 h1 = {acc[j][2 * q + 1].x * rstd * gn[2] * (1.f + sc[2]) + sh[2], acc[j][2 * q + 1].y * rstd * gn[3] * (1.f + sc[3]) + sh[3]};
                        acc[j][2 * q] = h0; acc[j][2 * q + 1] = h1; am = fmaxf(am, fmaxf(fmaxf(fabsf(h0.x), fabsf(h0.y)), fmaxf(fabsf(h1.x), fabsf(h1.y)))); } }
                am = fmaxf(am, __uint_as_float(dppu<0xB1>(__float_as_uint(am)))); am = fmaxf(am, __uint_as_float(dppu<0x4E>(__float_as_uint(am))));
                am = fmaxf(am, __uint_as_float(dppu<0x124>(__float_as_uint(am)))); am = fmaxf(am, __uint_as_float(dppu<0x128>(__float_as_uint(am))));
                am = fmaxf(am, 1e-20f); const float qi = 127.f / am;
#pragma unroll
                for (int j = 0; j < 4; ++j) { v4u o;
#pragma unroll
                    for (int q = 0; q < 4; ++q) { const int q0 = (int)rintf(acc[j][2 * q].x * qi), q1 = (int)rintf(acc[j][2 * q].y * qi), q2 = (int)rintf(acc[j][2 * q + 1].x * qi), q3 = (int)rintf(acc[j][2 * q + 1].y * qi);
                        o[q] = ((unsigned)q0 & 255u) | (((unsigned)q1 & 255u) << 8) | (((unsigned)q2 & 255u) << 16) | ((unsigned)q3 << 24); }
                    *(v4u*)(A.ws + WS_IDS + (size_t)tok * DM + 256 * j + 16 * i16) = o; }
                if (i16 == 0) ((float*)(A.ws + WS_SA))[tok] = am * (1.f / 127.f);
            }
        }
    }
}
__device__ __forceinline__ void convert_tables_int8(const Ctx& C, const Args& A) {
    unsigned char* T8 = A.ws + WS_TAB; float* TS = (float*)(A.ws + WS_TSC);
    for (int R0 = C.gw * 4; R0 < 4 * 16384; R0 += C.NGW * 4) {
        const int t = R0 >> 14;
        const float* src = A.in[t == 0 ? 15 : t == 1 ? 16 : t == 2 ? 28 : 29] + (size_t)(R0 & 16383) * DM + 16 * C.lane;
        f32x4 x[4][4]; float am[4];
#pragma unroll
        for (int r = 0; r < 4; ++r) { am[r] = 0.f;
#pragma unroll
            for (int q = 0; q < 4; ++q) x[r][q] = *(const f32x4*)(src + (size_t)r * DM + 4 * q); }
#pragma unroll
        for (int r = 0; r < 4; ++r) {
#pragma unroll
            for (int q = 0; q < 4; ++q) am[r] = fmaxf(am[r], fmaxf(fmaxf(fabsf(x[r][q].x), fabsf(x[r][q].y)), fmaxf(fabsf(x[r][q].z), fabsf(x[r][q].w))));
            am[r] = wave_max(am[r]);
            const float sc = (am[r] > 0.f) ? 127.f / am[r] : 1.f, inv = (am[r] > 0.f) ? am[r] * (1.f / 127.f) : 1.f;
            v4u o;
#pragma unroll
            for (int q = 0; q < 4; ++q) { const int q0 = (int)rintf(x[r][q].x * sc), q1 = (int)rintf(x[r][q].y * sc), q2 = (int)rintf(x[r][q].z * sc), q3 = (int)rintf(x[r][q].w * sc);
                o[q] = ((unsigned)q0 & 255u) | (((unsigned)q1 & 255u) << 8) | (((unsigned)q2 & 255u) << 16) | ((unsigned)q3 << 24); }
            *(v4u*)(T8 + (size_t)(R0 + r) * DM + 16 * C.lane) = o;
            if (C.lane == 0) TS[R0 + r] = inv;
        }
    }
}
constexpr size_t WS_NL = 3 * MiB, WS_NP = WS_NL + 512 * 1024;
constexpr size_t WS_GC = WS_MOD + 512 * 1024, WS_ML = WS_GC + 4096, WS_MP = WS_ML + 4096;
constexpr size_t OUT_SL = 0, OUT_SP = 64 * MiB;
typedef float f32x16 __attribute__((ext_vector_type(16)));
typedef short s16x4 __attribute__((ext_vector_type(4)));
__device__ __forceinline__ unsigned offb(unsigned row, unsigned ch) { return 256u * row + 16u * (ch ^ (((row & 3u) << 2) | ((row >> 2) & 3u))); }
__device__ __forceinline__ s16x4 tr_read4(unsigned lds_addr) { s16x4 r; asm volatile("ds_read_b64_tr_b16 %0, %1\n\ts_waitcnt lgkmcnt(0)" : "=&v"(r) : "v"(lds_addr) : "memory"); return r; }
__device__ __forceinline__ void tr_read4x2(s16x4& r0, s16x4& r1, unsigned a0, unsigned a1) {
    asm volatile("ds_read_b64_tr_b16 %0, %2\n\tds_read_b64_tr_b16 %1, %3\n\ts_waitcnt lgkmcnt(0)" : "=&v"(r0), "=&v"(r1) : "v"(a0), "v"(a1) : "memory"); }
__device__ __forceinline__ void tr_read4x6(s16x4 (&r)[6], unsigned a0, unsigned a1, unsigned a2, unsigned a3, unsigned a4, unsigned a5) {
    asm volatile("ds_read_b64_tr_b16 %0, %6\n\tds_read_b64_tr_b16 %1, %7\n\tds_read_b64_tr_b16 %2, %8\n\tds_read_b64_tr_b16 %3, %9\n\tds_read_b64_tr_b16 %4, %10\n\tds_read_b64_tr_b16 %5, %11\n\ts_waitcnt lgkmcnt(0)"
                 : "=&v"(r[0]), "=&v"(r[1]), "=&v"(r[2]), "=&v"(r[3]), "=&v"(r[4]), "=&v"(r[5]) : "v"(a0), "v"(a1), "v"(a2), "v"(a3), "v"(a4), "v"(a5) : "memory"); }
__device__ __forceinline__ void tr_read4x8(s16x4 (&r)[8], unsigned a0, unsigned a1, unsigned a2, unsigned a3, unsigned a4, unsigned a5, unsigned a6, unsigned a7) {
    asm volatile("ds_read_b64_tr_b16 %0, %8\n\tds_read_b64_tr_b16 %1, %9\n\tds_read_b64_tr_b16 %2, %10\n\tds_read_b64_tr_b16 %3, %11\n\tds_read_b64_tr_b16 %4, %12\n\tds_read_b64_tr_b16 %5, %13\n\tds_read_b64_tr_b16 %6, %14\n\tds_read_b64_tr_b16 %7, %15\n\ts_waitcnt lgkmcnt(0)"
                 : "=&v"(r[0]), "=&v"(r[1]), "=&v"(r[2]), "=&v"(r[3]), "=&v"(r[4]), "=&v"(r[5]), "=&v"(r[6]), "=&v"(r[7]) : "v"(a0), "v"(a1), "v"(a2), "v"(a3), "v"(a4), "v"(a5), "v"(a6), "v"(a7) : "memory"); }
__device__ __forceinline__ float scan_sum64(float v, int lane) {
#pragma unroll
    for (int o = 1; o < 64; o <<= 1) { const float t = __shfl_up(v, o); if (lane >= o) v += t; }
    return v;
}
__device__ __forceinline__ float scan_max64(float v, int lane) {
#pragma unroll
    for (int o = 1; o < 64; o <<= 1) { const float t = __shfl_up(v, o); if (lane >= o) v = fmaxf(v, t); }
    return v;
}
__device__ __forceinline__ pg8::bf16x8 mk_frag(s16x4 a, s16x4 b) { return (pg8::bf16x8){a[0], a[1], a[2], a[3], b[0], b[1], b[2], b[3]}; }

__device__ __forceinline__ void phase_mlstm_local(const Ctx& C, const Args& A) {
    const bf16* P = (const bf16*)(A.ws + WS_BIG);
    const float* LF = (const float*)(A.ws + WS_LF); const float* LI = (const float*)(A.ws + WS_LI);
    bf16* SL = (bf16*)((unsigned char*)A.out + OUT_SL); float* NL = (float*)(A.ws + WS_NL);
    float* GC = (float*)(A.ws + WS_GC); float* ML = (float*)(A.ws + WS_ML);
    LAS unsigned char* tK = C.lds; LAS unsigned char* tV = C.lds + 32768; LAS float* wtab = (LAS float*)(C.lds + 65536);
    const unsigned ldsK = (unsigned)(uintptr_t)tK, ldsV = (unsigned)(uintptr_t)tV;
    const int lane = C.lane, wid = C.wave, tid = C.tid;
    for (int unit = C.bid; unit < 1024; unit += C.G) {
        const int bh = unit >> 5, c = unit & 31, b = bh >> 2, hh = bh & 3;
        const size_t tok0 = (size_t)b * SEQ + c * 128;
        v4u kvr[4], vvr[4];
#pragma unroll
        for (int i = 0; i < 4; ++i) { const int id = tid + 512 * i, row = id >> 4, ch = id & 15;
            const bf16* src = P + (tok0 + row) * INP + hh * 128 + ch * 8;
            kvr[i] = *(const v4u*)(src + 512); vvr[i] = *(const v4u*)(src + 1024); }
        if (wid == 0) {
            const float2 lf = *(const float2*)(LF + (size_t)bh * SEQ + c * 128 + 2 * lane), li = *(const float2*)(LI + (size_t)bh * SEQ + c * 128 + 2 * lane);
            const float pr = lf.x + lf.y, inc = scan_sum64(pr, lane), ex = inc - pr;
            const float b0 = ex + lf.x, b1 = b0 + lf.y;
            const float g = __shfl(inc, 63);
            const float a0 = g - b0 + li.x, a1 = g - b1 + li.y;
            const float mloc = wave_max(fmaxf(a0, a1));
            wtab[2 * lane] = __expf(a0 - mloc); wtab[2 * lane + 1] = __expf(a1 - mloc);
            if (lane == 0) { GC[unit] = g; ML[unit] = mloc; }
        }
        __syncthreads();
#pragma unroll
        for (int i = 0; i < 4; ++i) { const int id = tid + 512 * i, row = id >> 4, ch = id & 15;
            const v4u kv = kvr[i], vv = vvr[i];
            const float w = wtab[row];
            v4u ko; ko.x = pk2(bflo(kv.x) * w, bfhi(kv.x) * w); ko.y = pk2(bflo(kv.y) * w, bfhi(kv.y) * w); ko.z = pk2(bflo(kv.z) * w, bfhi(kv.z) * w); ko.w = pk2(bflo(kv.w) * w, bfhi(kv.w) * w);
            *(LAS v4u*)(tK + offb(row, ch)) = ko; *(LAS v4u*)(tV + offb(row, ch)) = vv; }
        __syncthreads();
        if (tid < 128) { const int d = tid; float s = 0.f;
#pragma unroll 8
            for (int l = 0; l < 128; ++l) s += bf2f(*(const LAS unsigned short*)(tK + offb(l, d >> 3) + (d & 7) * 2));
            NL[(size_t)unit * 128 + d] = s; }
        {
            const int db = wid & 3, eh = wid >> 2;
            const unsigned h = lane >> 5, blk = (lane >> 4) & 1, q = (lane & 15) >> 2, p = lane & 3;
            f32x16 acc[2];
#pragma unroll
            for (int eb = 0; eb < 2; ++eb)
#pragma unroll
                for (int r = 0; r < 16; ++r) acc[eb][r] = 0.f;
#pragma unroll
            for (int ks = 0; ks < 8; ++ks) {
                const unsigned r0 = 16 * ks + 8 * h + q, cA = 4 * db + 2 * blk + (p >> 1), cB0 = 4 * (2 * eh) + 2 * blk + (p >> 1), cB1 = cB0 + 4, po = 8 * (p & 1);
                s16x4 t[6];
                tr_read4x6(t, ldsK + offb(r0, cA) + po, ldsK + offb(r0 + 4, cA) + po, ldsV + offb(r0, cB0) + po, ldsV + offb(r0 + 4, cB0) + po, ldsV + offb(r0, cB1) + po, ldsV + offb(r0 + 4, cB1) + po);
                const pg8::bf16x8 af = mk_frag(t[0], t[1]);
                acc[0] = __builtin_amdgcn_mfma_f32_32x32x16_bf16(af, mk_frag(t[2], t[3]), acc[0], 0, 0, 0);
                acc[1] = __builtin_amdgcn_mfma_f32_32x32x16_bf16(af, mk_frag(t[4], t[5]), acc[1], 0, 0, 0);
            }
            const int hi = lane >> 5;
#pragma unroll
            for (int eb = 0; eb < 2; ++eb) { const int e = 32 * (2 * eh + eb) + (lane & 31);
#pragma unroll
                for (int g4 = 0; g4 < 4; ++g4) { uint2 o; o.x = pk2(acc[eb][4 * g4], acc[eb][4 * g4 + 1]); o.y = pk2(acc[eb][4 * g4 + 2], acc[eb][4 * g4 + 3]);
                    *(uint2*)(SL + ((size_t)unit * 128 + e) * 128 + 32 * db + 8 * g4 + 4 * hi) = o; } }
        }
        __syncthreads();
    }
}

__device__ __forceinline__ void phase_mlstm_scan(const Ctx& C, const Args& A) {
    const bf16* SL = (const bf16*)((unsigned char*)A.out + OUT_SL); bf16* SP = (bf16*)((unsigned char*)A.out + OUT_SP);
    const float* NL = (const float*)(A.ws + WS_NL); float* NP = (float*)(A.ws + WS_NP);
    const float* GC = (const float*)(A.ws + WS_GC); const float* ML = (const float*)(A.ws + WS_ML); float* MP = (float*)(A.ws + WS_MP);
    for (long it = C.gt; it < 32L * 128 * 32; it += C.NGT) {
        const int d4 = (int)(it & 31), e = (int)((it >> 5) & 127), bh = (int)(it >> 12);
        f32x4 s = {0.f, 0.f, 0.f, 0.f}, n = {0.f, 0.f, 0.f, 0.f}; float m = 0.f;
        const bool do_n = (e == 0);
#pragma unroll 1
        for (int c0 = 0; c0 < 32; c0 += 16) {
            uint2 xw[16]; float gq[16], mq[16];
#pragma unroll
            for (int k = 0; k < 16; ++k) { const size_t unit = (size_t)bh * 32 + c0 + k;
                xw[k] = *(const uint2*)(SL + (unit * 128 + e) * 128 + 4 * d4); gq[k] = GC[unit]; mq[k] = ML[unit]; }
#pragma unroll
            for (int k = 0; k < 16; ++k) {
                const size_t unit = (size_t)bh * 32 + c0 + k;
                uint2 o; o.x = pk2(s.x, s.y); o.y = pk2(s.z, s.w);
                *(uint2*)(SP + (unit * 128 + e) * 128 + 4 * d4) = o;
                if (do_n) { *(f32x4*)(NP + unit * 128 + 4 * d4) = n; if (d4 == 0) MP[unit] = m; }
                const float g = gq[k], ml = mq[k];
                const float mn = fmaxf(g + m, ml), dec = __expf(g + m - mn), sc = __expf(ml - mn);
                const f32x4 x = {bflo(xw[k].x), bfhi(xw[k].x), bflo(xw[k].y), bfhi(xw[k].y)};
                s = s * dec + x * sc;
                if (do_n) { const f32x4 y = *(const f32x4*)(NL + unit * 128 + 4 * d4); n = n * dec + y * sc; }
                m = mn;
            }
        }
    }
}

__device__ __forceinline__ void phase_mlstm_out(const Ctx& C, const Args& A) {
    const bf16* P = (const bf16*)(A.ws + WS_BIG); bf16* mix = (bf16*)(A.ws + WS_H);
    const float* LF = (const float*)(A.ws + WS_LF); const float* LI = (const float*)(A.ws + WS_LI);
    const bf16* SP = (const bf16*)((unsigned char*)A.out + OUT_SP); const float* NP = (const float*)(A.ws + WS_NP); const float* MP = (const float*)(A.ws + WS_MP);
    const float* gain = A.in[9];
    LAS unsigned char* tV = C.lds; LAS unsigned char* tK = C.lds + 32768; LAS float* abt = (LAS float*)(C.lds + 65536); LAS float* Mt = abt + 128; LAS float* bt = abt + 256; LAS float* npt = abt + 384; LAS float* ssq = abt + 512;
    const unsigned ldsV = (unsigned)(uintptr_t)tV;
    const int lane = C.lane, wid = C.wave, tid = C.tid, hi = lane >> 5, l31 = lane & 31;
    constexpr float QS = 0.08838834764831845f;
    for (int unit = C.bid; unit < 1024; unit += C.G) {
        const int bh = unit >> 5, c = unit & 31, b = bh >> 2, hh = bh & 3;
        const size_t tok0 = (size_t)b * SEQ + c * 128;
        const float mprev = MP[unit];
        const int lb = wid & 3, eh = wid >> 2;
        const int l = 32 * lb + l31;
        v4u vvr[4], kvr[4];
#pragma unroll
        for (int i = 0; i < 4; ++i) { const int id = tid + 512 * i, row = id >> 4, ch = id & 15;
            const bf16* src = P + (tok0 + row) * INP + hh * 128 + ch * 8;
            vvr[i] = *(const v4u*)(src + 1024); kvr[i] = *(const v4u*)(src + 512); }
        pg8::bf16x8 qf[8];
#pragma unroll
        for (int ks = 0; ks < 8; ++ks) qf[ks] = *(const pg8::bf16x8*)(P + (tok0 + l) * INP + hh * 128 + 16 * ks + 8 * hi);
        pg8::bf16x8 spf[2][8];
#pragma unroll
        for (int eb = 0; eb < 2; ++eb) { const bf16* sp = SP + ((size_t)unit * 128 + 32 * (2 * eh + eb) + l31) * 128 + 8 * hi;
#pragma unroll
            for (int ks = 0; ks < 8; ++ks) spf[eb][ks] = *(const pg8::bf16x8*)(sp + 16 * ks); }
        if (wid == 0) {
            const float2 lf = *(const float2*)(LF + (size_t)bh * SEQ + c * 128 + 2 * lane), li = *(const float2*)(LI + (size_t)bh * SEQ + c * 128 + 2 * lane);
            const float pr = lf.x + lf.y, inc = scan_sum64(pr, lane), ex = inc - pr;
            const float b0 = ex + lf.x, b1 = b0 + lf.y;
            const float ab0 = li.x - b0, ab1 = li.y - b1;
            const float pmx = scan_max64(fmaxf(ab0, ab1), lane);
            float pme = __shfl_up(pmx, 1); if (lane == 0) pme = -INFINITY;
            const float pm0 = fmaxf(pme, ab0), pm1 = fmaxf(pm0, ab1);
            abt[2 * lane] = ab0; abt[2 * lane + 1] = ab1; bt[2 * lane] = b0; bt[2 * lane + 1] = b1;
            Mt[2 * lane] = fmaxf(mprev, pm0); Mt[2 * lane + 1] = fmaxf(mprev, pm1);
        }
        if (wid == 1) { npt[2 * lane] = NP[(size_t)unit * 128 + 2 * lane]; npt[2 * lane + 1] = NP[(size_t)unit * 128 + 2 * lane + 1]; }
#pragma unroll
        for (int i = 0; i < 4; ++i) { const int id = tid + 512 * i, row = id >> 4, ch = id & 15;
            *(LAS v4u*)(tV + offb(row, ch)) = vvr[i]; *(LAS v4u*)(tK + offb(row, ch)) = kvr[i]; }
        __syncthreads();
        const float Ml = Mt[l], iw = __expf(mprev - Ml) * QS;
        float qn = 0.f;
#pragma unroll
        for (int ks = 0; ks < 8; ++ks)
#pragma unroll
            for (int j = 0; j < 8; ++j) qn += bf2f((unsigned short)qf[ks][j]) * npt[16 * ks + 8 * hi + j];
        qn += __shfl_xor(qn, 32);
        f32x16 acc[2];
#pragma unroll
        for (int eb = 0; eb < 2; ++eb) {
#pragma unroll
            for (int r = 0; r < 16; ++r) acc[eb][r] = 0.f;
#pragma unroll
            for (int ks = 0; ks < 8; ++ks) acc[eb] = __builtin_amdgcn_mfma_f32_32x32x16_bf16(spf[eb][ks], qf[ks], acc[eb], 0, 0, 0);
#pragma unroll
            for (int r = 0; r < 16; ++r) acc[eb][r] *= iw;
        }
        uint2 owr[2][4]; f32x4 gnr[2][4];
#pragma unroll
        for (int eb = 0; eb < 2; ++eb)
#pragma unroll
            for (int g4 = 0; g4 < 4; ++g4) { const int e = 32 * (2 * eh + eb) + 8 * g4 + 4 * hi;
                owr[eb][g4] = *(const uint2*)(P + (tok0 + l) * INP + 1536 + hh * 128 + e); gnr[eb][g4] = *(const f32x4*)(gain + hh * 128 + e); }
        float den = 0.f;
        const unsigned g16 = lane >> 4, blk = g16 & 1, q = (lane & 15) >> 2, p = lane & 3;
        for (int sb = 0; sb <= lb; ++sb) {
            f32x16 X;
#pragma unroll
            for (int r = 0; r < 16; ++r) X[r] = 0.f;
#pragma unroll
            for (int ks = 0; ks < 8; ++ks) X = __builtin_amdgcn_mfma_f32_32x32x16_bf16(*(const LAS pg8::bf16x8*)(tK + offb(32 * sb + l31, 2 * ks + hi)), qf[ks], X, 0, 0, 0);
            float pv[16];
#pragma unroll
            for (int r = 0; r < 16; ++r) { const int s = 32 * sb + (r & 3) + 8 * (r >> 2) + 4 * hi;
                const float v = X[r] * QS * __expf(abt[s] - Ml);
                pv[r] = (s <= l) ? v : 0.f; den += pv[r]; }
            pg8::bf16x8 pf[2];
#pragma unroll
            for (int st = 0; st < 2; ++st) { v4u t; t.x = pk2(pv[8 * st], pv[8 * st + 1]); t.y = pk2(pv[8 * st + 2], pv[8 * st + 3]); t.z = pk2(pv[8 * st + 4], pv[8 * st + 5]); t.w = pk2(pv[8 * st + 6], pv[8 * st + 7]);
                pf[st] = __builtin_bit_cast(pg8::bf16x8, t); }
            { const unsigned c0 = 4 * (2 * eh) + 2 * blk + (p >> 1), c1 = c0 + 4, ra = 32 * sb + 4 * hi + q, po = 8 * (p & 1);
              s16x4 t[8];
              tr_read4x8(t, ldsV + offb(ra, c0) + po, ldsV + offb(ra + 8, c0) + po, ldsV + offb(ra + 16, c0) + po, ldsV + offb(ra + 24, c0) + po,
                            ldsV + offb(ra, c1) + po, ldsV + offb(ra + 8, c1) + po, ldsV + offb(ra + 16, c1) + po, ldsV + offb(ra + 24, c1) + po);
#pragma unroll
              for (int eb = 0; eb < 2; ++eb)
#pragma unroll
                  for (int st = 0; st < 2; ++st) acc[eb] = __builtin_amdgcn_mfma_f32_32x32x16_bf16(mk_frag(t[4 * eb + 2 * st], t[4 * eb + 2 * st + 1]), pf[st], acc[eb], 0, 0, 0); }
        }
        den += __shfl_xor(den, 32);
        den += iw * qn;
        const float dn = 1.f / fmaxf(fabsf(den), __expf(-(bt[l] + Ml)));
        float ss = 0.f;
#pragma unroll
        for (int eb = 0; eb < 2; ++eb)
#pragma unroll
            for (int r = 0; r < 16; ++r) { acc[eb][r] *= dn; ss += acc[eb][r] * acc[eb][r]; }
        ss += __shfl_xor(ss, 32);
        if (hi == 0) ssq[eh * 128 + l] = ss;
        __syncthreads();
        const float rstd = rsqrtf((ssq[l] + ssq[128 + l]) * (1.f / 128.f) + EPS);
#pragma unroll
        for (int eb = 0; eb < 2; ++eb)
#pragma unroll
            for (int g4 = 0; g4 < 4; ++g4) { const int e = 32 * (2 * eh + eb) + 8 * g4 + 4 * hi;
                const uint2 ow = owr[eb][g4]; const f32x4 gn = gnr[eb][g4];
                uint2 o; o.x = pk2(acc[eb][4 * g4] * rstd * gn.x * sigmoidf_(bflo(ow.x)), acc[eb][4 * g4 + 1] * rstd * gn.y * sigmoidf_(bfhi(ow.x)));
                o.y = pk2(acc[eb][4 * g4 + 2] * rstd * gn.z * sigmoidf_(bflo(ow.y)), acc[eb][4 * g4 + 3] * rstd * gn.w * sigmoidf_(bfhi(ow.y)));
                *(uint2*)(mix + (tok0 + l) * DM + hh * 128 + e) = o; }
        __syncthreads();
    }
}
template <bool I8>
struct EpiQKV {
    static constexpr bool PERM = true, AFTER_DRAIN = false;
    bf16* O; bf16* KF; bf16* VH; const float* qg; const float* kg; const float* sa; const float* sw;
    __device__ __forceinline__ void operator()(const typename pg8::AccSel<I8>::type (&acc)[2][2][4][2], const pg8::Unit& u, int wr, int wc, int fr, int fq) const {
        using pg8::f32x4;
        f32x4 cs[2][2];
#pragma unroll
        for (int bj = 0; bj < 2; ++bj)
#pragma unroll
            for (int n = 0; n < 2; ++n) cs[bj][n] = I8 ? *(const f32x4*)(sw + u.pn * 256 + 128 * bj + 32 * wc + 8 * fq + 4 * n) : (f32x4){1.f, 1.f, 1.f, 1.f};
        const int kind = u.pn >> 2;
        const float* gp = (kind == 0) ? qg : kg;
        const float post = (kind == 0) ? 0.125f * 1.4426950408889634f : 1.0f;
        f32x4 gv[2][2];
#pragma unroll
        for (int bj = 0; bj < 2; ++bj)
#pragma unroll
            for (int n = 0; n < 2; ++n) gv[bj][n] = (kind < 2) ? *(const f32x4*)(gp + 32 * bj + 8 * fq + 4 * n) * post : (f32x4){1.f, 1.f, 1.f, 1.f};
#pragma unroll
        for (int ai = 0; ai < 2; ++ai)
#pragma unroll
            for (int m = 0; m < 4; ++m) {
                const int row = u.pm * 256 + ai * 128 + wr * 64 + m * 16 + fr;
                f32x4 xv[2][2]; float ss = 0.f;
                { const float rsc = I8 ? sa[row] : 1.f;
#pragma unroll
                  for (int bj = 0; bj < 2; ++bj)
#pragma unroll
                      for (int n = 0; n < 2; ++n) { const auto a = acc[ai][bj][m][n]; const f32x4 x = (f32x4){(float)a[0], (float)a[1], (float)a[2], (float)a[3]} * cs[bj][n] * rsc; xv[bj][n] = x;
                          ss += (x[0] * x[0] + x[1] * x[1]) + (x[2] * x[2] + x[3] * x[3]); } }
                ss += __shfl_xor(ss, 16); ss += __shfl_xor(ss, 32);
                const float rs = (kind < 2) ? rsqrtf(ss * (1.f / 64.f) + EPS) : 1.0f;
                bf16* dst = (kind == 1) ? KF + ((size_t)(((row >> 12) * 16 + (u.pn - 4) * 4 + wc) * 128 + ((row & 4095) >> 5)) * 2048 + (size_t)((fq >> 1) * 512 + ((fq & 1) * 32 + (row & 31)) * 8))
                                        : (kind == 2) ? VH + ((size_t)(((row >> 12) * 16 + (u.pn & 3) * 4 + wc) * 4096 + (row & 4095)) * 64 + 8 * fq)
                                        : O + (size_t)row * 1024 + (u.pn & 3) * 256 + 64 * wc + 8 * fq;
                const int bjstep = (kind == 1) ? 1024 : 32;
#pragma unroll
                for (int bj = 0; bj < 2; ++bj) { const f32x4 v0 = xv[bj][0] * gv[bj][0] * rs, v1 = xv[bj][1] * gv[bj][1] * rs;
                    v4u w; w.x = pk2(v0[0], v0[1]); w.y = pk2(v0[2], v0[3]); w.z = pk2(v1[0], v1[1]); w.w = pk2(v1[2], v1[3]);
                    *(v4u*)(dst + bjstep * bj) = w; }
            }
    }
};

__device__ __forceinline__ unsigned voff(unsigned row, unsigned ch) { return row * 128u + 16u * (ch ^ (row & 7u)); }
__device__ __forceinline__ void phase_attn(const Ctx& C, const Args& A) {
    const bf16* QV = (const bf16*)(A.ws + WS_BIG); const bf16* KF = (const bf16*)(A.ws + WS_BIG + 64 * MiB); const bf16* VH = (const bf16*)(A.ws + WS_BIG + 128 * MiB); bf16* O = (bf16*)(A.ws + WS_H);
    LAS unsigned char* tV = C.lds + C.wave * 4096;
    const unsigned ldsV = (unsigned)(uintptr_t)tV;
    const int lane = C.lane, hi = lane >> 5, l31 = lane & 31;
    const unsigned blk = (lane >> 4) & 1, q4 = (lane & 15) >> 2, p = lane & 3;
    const int per_wave = (16384 + C.NGW - 1) / C.NGW;
    for (int u = C.gw * per_wave; u < C.gw * per_wave + per_wave; ++u) {
        if (u >= 16384) break;
        const int bh = u >> 7, qt = u & 127, b = bh >> 4, hd = bh & 15;
        const size_t tokb = (size_t)b * SEQ;
        const int l = qt * 32 + l31;
        pg8::bf16x8 qf[4];
#pragma unroll
        for (int ks = 0; ks < 4; ++ks) qf[ks] = *(const pg8::bf16x8*)(QV + (tokb + l) * 1024 + hd * 64 + 16 * ks + 8 * hi);
        f32x16 acc[2];
#pragma unroll
        for (int eb = 0; eb < 2; ++eb)
#pragma unroll
            for (int r = 0; r < 16; ++r) acc[eb][r] = 0.f;
        float carry = 1.f;
        pg8::bf16x8 kf[4]; v4u vv[4];
#define ATT_LOAD(kt_) { const size_t s0_ = tokb + (size_t)(kt_) * 32; const bf16* kp_ = KF + ((size_t)(bh * 128 + (kt_)) * 2048 + lane * 8); \
            _Pragma("unroll") for (int ks = 0; ks < 4; ++ks) kf[ks] = *(const pg8::bf16x8*)(kp_ + ks * 512); \
            _Pragma("unroll") for (int i = 0; i < 4; ++i) { const int id = lane + 64 * i; vv[i] = *(const v4u*)(VH + ((size_t)bh * 4096 + (size_t)(kt_) * 32) * 64 + id * 8); } }
        ATT_LOAD(qt)
        for (int kt = qt; kt >= 0; --kt) {
            f32x16 X;
#pragma unroll
            for (int r = 0; r < 16; ++r) X[r] = 0.f;
#pragma unroll
            for (int ks = 0; ks < 4; ++ks) X = __builtin_amdgcn_mfma_f32_32x32x16_bf16(kf[ks], qf[ks], X, 0, 0, 0);
#pragma unroll
            for (int i = 0; i < 4; ++i) { const int id = lane + 64 * i; *(LAS v4u*)(tV + voff(id >> 3, id & 7)) = vv[i]; }
            if (kt > 0) ATT_LOAD(kt - 1)
            const int sbase = kt * 32 + 4 * hi;
            float rr[16];
#pragma unroll
            for (int r = 0; r < 16; ++r) rr[r] = __builtin_amdgcn_rcpf(1.f + __builtin_amdgcn_exp2f(X[r]));
            if (kt == qt) {
#pragma unroll
                for (int r = 0; r < 16; ++r) { const int s = sbase + (r & 3) + 8 * (r >> 2); rr[r] = (s < l) ? rr[r] : 1.f; }
            }
            float To[4], Tp[4];
#pragma unroll
            for (int g = 0; g < 4; ++g) { To[g] = (rr[4 * g] * rr[4 * g + 1]) * (rr[4 * g + 2] * rr[4 * g + 3]); Tp[g] = __shfl_xor(To[g], 32); }
            float base[4]; float run = 1.f;
#pragma unroll
            for (int g = 3; g >= 0; --g) { base[g] = carry * run * (hi == 0 ? Tp[g] : 1.f); run *= To[g] * Tp[g]; }
            float att[16];
#pragma unroll
            for (int g = 0; g < 4; ++g) { float w = base[g];
#pragma unroll
                for (int i = 3; i >= 0; --i) { const int r = 4 * g + i; att[r] = (1.f - rr[r]) * w; w *= rr[r]; } }
            carry *= run;
            pg8::bf16x8 pf[2];
#pragma unroll
            for (int st = 0; st < 2; ++st) { v4u t; t.x = pg8::cvt_pk_bf16(att[8 * st], att[8 * st + 1]); t.y = pg8::cvt_pk_bf16(att[8 * st + 2], att[8 * st + 3]); t.z = pg8::cvt_pk_bf16(att[8 * st + 4], att[8 * st + 5]); t.w = pg8::cvt_pk_bf16(att[8 * st + 6], att[8 * st + 7]);
                pf[st] = __builtin_bit_cast(pg8::bf16x8, t); }
            s16x4 vf[8];
            { const unsigned a0 = ldsV + voff(4 * hi + q4, 2 * blk + (p >> 1)) + 8 * (p & 1), a1 = ldsV + voff(4 * hi + q4 + 8, 2 * blk + (p >> 1)) + 8 * (p & 1);
              const unsigned a2 = ldsV + voff(16 + 4 * hi + q4, 2 * blk + (p >> 1)) + 8 * (p & 1), a3 = ldsV + voff(24 + 4 * hi + q4, 2 * blk + (p >> 1)) + 8 * (p & 1);
              const unsigned a4 = ldsV + voff(4 * hi + q4, 4 + 2 * blk + (p >> 1)) + 8 * (p & 1), a5 = ldsV + voff(4 * hi + q4 + 8, 4 + 2 * blk + (p >> 1)) + 8 * (p & 1);
              const unsigned a6 = ldsV + voff(16 + 4 * hi + q4, 4 + 2 * blk + (p >> 1)) + 8 * (p & 1), a7 = ldsV + voff(24 + 4 * hi + q4, 4 + 2 * blk + (p >> 1)) + 8 * (p & 1);
              asm volatile("ds_read_b64_tr_b16 %0, %8\n\tds_read_b64_tr_b16 %1, %9\n\tds_read_b64_tr_b16 %2, %10\n\tds_read_b64_tr_b16 %3, %11\n\t"
                           "ds_read_b64_tr_b16 %4, %12\n\tds_read_b64_tr_b16 %5, %13\n\tds_read_b64_tr_b16 %6, %14\n\tds_read_b64_tr_b16 %7, %15\n\ts_waitcnt lgkmcnt(0)"
                           : "=&v"(vf[0]), "=&v"(vf[1]), "=&v"(vf[2]), "=&v"(vf[3]), "=&v"(vf[4]), "=&v"(vf[5]), "=&v"(vf[6]), "=&v"(vf[7])
                           : "v"(a0), "v"(a1), "v"(a2), "v"(a3), "v"(a4), "v"(a5), "v"(a6), "v"(a7) : "memory"); }
#pragma unroll
            for (int eb = 0; eb < 2; ++eb)
#pragma unroll
                for (int st = 0; st < 2; ++st) acc[eb] = __builtin_amdgcn_mfma_f32_32x32x16_bf16(mk_frag(vf[4 * eb + 2 * st], vf[4 * eb + 2 * st + 1]), pf[st], acc[eb], 0, 0, 0);
            if (__all(carry == 0.f)) break;
        }
#undef ATT_LOAD
#pragma unroll
        for (int eb = 0; eb < 2; ++eb)
#pragma unroll
            for (int g4 = 0; g4 < 4; ++g4) { const u32x2 o = {pk2(acc[eb][4 * g4], acc[eb][4 * g4 + 1]), pk2(acc[eb][4 * g4 + 2], acc[eb][4 * g4 + 3])};
                const unsigned c8 = (unsigned)(8 * eb + 2 * g4 + hi);
                *(LAS u32x2*)(tV + l31 * 128 + ((c8 ^ ((unsigned)(l31 & 7) << 1)) << 3)) = o; }
        asm volatile("s_waitcnt lgkmcnt(0)" ::: "memory");
#pragma unroll
        for (int i = 0; i < 4; ++i) { const int id = lane + 64 * i, rr = id >> 3, q = id & 7;
            const v4u w = *(const LAS v4u*)(tV + rr * 128 + (((unsigned)(2 * q) ^ ((unsigned)(rr & 7) << 1)) << 3));
            *(v4u*)(O + (tokb + qt * 32 + rr) * DM + hd * 64 + 8 * q) = w; }
        asm volatile("s_waitcnt lgkmcnt(0)" ::: "memory");
    }
}

__device__ __forceinline__ void phase_attn_ring(const Ctx& C, const Args& A) {
    const bf16* QV = (const bf16*)(A.ws + WS_BIG); const bf16* KF = (const bf16*)(A.ws + WS_BIG + 64 * MiB); const bf16* VH = (const bf16*)(A.ws + WS_BIG + 128 * MiB); bf16* O = (bf16*)(A.ws + WS_H);
    LAS unsigned char* ring = C.lds;
    LAS unsigned char* tV = C.lds + (C.wave < 4 ? 114688 + C.wave * 4096 : 147456 + (C.wave - 4) * 4096);
    const unsigned ldsR = (unsigned)(uintptr_t)ring, ldsP = (unsigned)(uintptr_t)tV;
    const int lane = C.lane, hi = lane >> 5, l31 = lane & 31;
    const unsigned blk = (lane >> 4) & 1, q4 = (lane & 15) >> 2, p = lane & 3;
    const unsigned trA = voff(4 * hi + q4, 2 * blk + (p >> 1)) + 8 * (p & 1), trB = voff(4 * hi + q4, 4 + 2 * blk + (p >> 1)) + 8 * (p & 1);
    const int nblk = C.G, per = (2048 + nblk - 1) / nblk;
    const int bu_lo = C.bid * per, bu_hi = (bu_lo + per < 2048) ? bu_lo + per : 2048;
    if (bu_lo >= bu_hi) return;
    const int cidx = C.tid & 255; const bool isV = C.tid >= 256;
    const bf16* srcb = (isV ? VH : KF) + cidx * 8;
    const unsigned dstoff = isV ? 4096u + voff((unsigned)cidx >> 3, (unsigned)cidx & 7) : (unsigned)cidx * 16u;
    pg8::bf16x8 qf[4];
    {
        const int bh = bu_lo >> 4, G = bu_lo & 15;
        for (int t = 8 * G - 6; t <= 8 * G + 7; ++t) if (t >= 0) { const v4u w = *(const v4u*)(srcb + (size_t)(bh * 128 + t) * 2048); *(LAS v4u*)(ring + (t % 14) * 8192 + dstoff) = w; }
        const int qt = 8 * G + C.wave; const size_t row = (size_t)(bh >> 4) * SEQ + qt * 32 + l31;
#pragma unroll
        for (int ks = 0; ks < 4; ++ks) qf[ks] = *(const pg8::bf16x8*)(QV + row * 1024 + (bh & 15) * 64 + 16 * ks + 8 * hi);
    }
    __syncthreads();
    for (int bu = bu_lo; bu < bu_hi; ++bu) {
        const int bh = bu >> 4, G = bu & 15, b = bh >> 4, hd = bh & 15;
        const int qt = 8 * G + C.wave;
        const size_t tokb = (size_t)b * SEQ;
        const int l = qt * 32 + l31;
        const bool more = bu + 1 < bu_hi; const int nbh = (bu + 1) >> 4, nG = (bu + 1) & 15;
        v4u st[8]; pg8::bf16x8 qn[4];
        if (more) {
#pragma unroll
            for (int i = 0; i < 8; ++i) st[i] = *(const v4u*)(srcb + (size_t)(nbh * 128 + 8 * nG + i) * 2048);
            const size_t row = (size_t)(nbh >> 4) * SEQ + (8 * nG + C.wave) * 32 + l31;
#pragma unroll
            for (int ks = 0; ks < 4; ++ks) qn[ks] = *(const pg8::bf16x8*)(QV + row * 1024 + (nbh & 15) * 64 + 16 * ks + 8 * hi);
        }
        f32x16 acc[2];
#pragma unroll
        for (int eb = 0; eb < 2; ++eb)
#pragma unroll
            for (int r = 0; r < 16; ++r) acc[eb][r] = 0.f;
        float carry = 1.f;
        const int lowt = (8 * G - 6 > 0) ? 8 * G - 6 : 0;
        int slot = qt % 14;
        pg8::bf16x8 kf[4];
#define ATT_KLOAD(kt_, slot_) { if ((kt_) >= lowt) { const LAS unsigned char* sp_ = ring + (slot_) * 8192 + lane * 16; \
                _Pragma("unroll") for (int ks = 0; ks < 4; ++ks) kf[ks] = *(const LAS pg8::bf16x8*)(sp_ + ks * 1024); } \
            else { const bf16* kp_ = KF + ((size_t)(bh * 128 + (kt_)) * 2048 + lane * 8); \
                _Pragma("unroll") for (int ks = 0; ks < 4; ++ks) kf[ks] = *(const pg8::bf16x8*)(kp_ + ks * 512); } }
        ATT_KLOAD(qt, slot)
        for (int kt = qt; kt >= 0; --kt) {
            unsigned vb;
            if (kt >= lowt) vb = ldsR + (unsigned)slot * 8192u + 4096u;
            else {
#pragma unroll
                for (int i = 0; i < 4; ++i) { const int id = lane + 64 * i; const v4u w = *(const v4u*)(VH + ((size_t)bh * 4096 + (size_t)kt * 32) * 64 + id * 8); *(LAS v4u*)(tV + voff(id >> 3, id & 7)) = w; }
                vb = ldsP;
            }
            slot = slot == 0 ? 13 : slot - 1;
            f32x16 X;
#pragma unroll
            for (int r = 0; r < 16; ++r) X[r] = 0.f;
#pragma unroll
            for (int ks = 0; ks < 4; ++ks) X = __builtin_amdgcn_mfma_f32_32x32x16_bf16(kf[ks], qf[ks], X, 0, 0, 0);
            if (kt > 0) ATT_KLOAD(kt - 1, slot)
            s16x4 vf[8];
            { const unsigned a0 = vb + trA, a4 = vb + trB;
              asm volatile("ds_read_b64_tr_b16 %0, %8\n\tds_read_b64_tr_b16 %1, %8 offset:1024\n\tds_read_b64_tr_b16 %2, %8 offset:2048\n\tds_read_b64_tr_b16 %3, %8 offset:3072\n\t"
                           "ds_read_b64_tr_b16 %4, %9\n\tds_read_b64_tr_b16 %5, %9 offset:1024\n\tds_read_b64_tr_b16 %6, %9 offset:2048\n\tds_read_b64_tr_b16 %7, %9 offset:3072\n\ts_waitcnt lgkmcnt(0)"
                           : "=&v"(vf[0]), "=&v"(vf[1]), "=&v"(vf[2]), "=&v"(vf[3]), "=&v"(vf[4]), "=&v"(vf[5]), "=&v"(vf[6]), "=&v"(vf[7])
                           : "v"(a0), "v"(a4) : "memory"); }
            const int sbase = kt * 32 + 4 * hi;
            float rr[16];
#pragma unroll
            for (int r = 0; r < 16; ++r) rr[r] = __builtin_amdgcn_rcpf(1.f + __builtin_amdgcn_exp2f(X[r]));
            if (kt == qt) {
#pragma unroll
                for (int r = 0; r < 16; ++r) { const int s = sbase + (r & 3) + 8 * (r >> 2); rr[r] = (s < l) ? rr[r] : 1.f; }
            }
            float To[4], Tp[4];
#pragma unroll
            for (int g = 0; g < 4; ++g) { To[g] = (rr[4 * g] * rr[4 * g + 1]) * (rr[4 * g + 2] * rr[4 * g + 3]); const auto sw_ = __builtin_amdgcn_permlane32_swap(__float_as_uint(To[g]), __float_as_uint(To[g]), false, false); Tp[g] = __uint_as_float(hi ? sw_[0] : sw_[1]); }
            float base[4]; float run = 1.f;
#pragma unroll
            for (int g = 3; g >= 0; --g) { base[g] = carry * run * (hi == 0 ? Tp[g] : 1.f); run *= To[g] * Tp[g]; }
            float att[16];
#pragma unroll
            for (int g = 0; g < 4; ++g) { float w = base[g];
#pragma unroll
                for (int i = 3; i >= 0; --i) { const int r = 4 * g + i; att[r] = (1.f - rr[r]) * w; w *= rr[r]; } }
            carry *= run;
            pg8::bf16x8 pf[2];
#pragma unroll
            for (int st_ = 0; st_ < 2; ++st_) { v4u t; t.x = pg8::cvt_pk_bf16(att[8 * st_], att[8 * st_ + 1]); t.y = pg8::cvt_pk_bf16(att[8 * st_ + 2], att[8 * st_ + 3]); t.z = pg8::cvt_pk_bf16(att[8 * st_ + 4], att[8 * st_ + 5]); t.w = pg8::cvt_pk_bf16(att[8 * st_ + 6], att[8 * st_ + 7]);
                pf[st_] = __builtin_bit_cast(pg8::bf16x8, t); }
#pragma unroll
            for (int eb = 0; eb < 2; ++eb)
#pragma unroll
                for (int st_ = 0; st_ < 2; ++st_) acc[eb] = __builtin_amdgcn_mfma_f32_32x32x16_bf16(mk_frag(vf[4 * eb + 2 * st_], vf[4 * eb + 2 * st_ + 1]), pf[st_], acc[eb], 0, 0, 0);
            if (__all(carry == 0.f)) break;
        }
#undef ATT_KLOAD
#pragma unroll
        for (int eb = 0; eb < 2; ++eb)
#pragma unroll
            for (int g4 = 0; g4 < 4; ++g4) { const u32x2 o = {pk2(acc[eb][4 * g4], acc[eb][4 * g4 + 1]), pk2(acc[eb][4 * g4 + 2], acc[eb][4 * g4 + 3])};
                const unsigned c8 = (unsigned)(8 * eb + 2 * g4 + hi);
                *(LAS u32x2*)(tV + l31 * 128 + ((c8 ^ ((unsigned)(l31 & 7) << 1)) << 3)) = o; }
        asm volatile("s_waitcnt lgkmcnt(0)" ::: "memory");
#pragma unroll
        for (int i = 0; i < 4; ++i) { const int id = lane + 64 * i, rr_ = id >> 3, q = id & 7;
            const v4u w = *(const LAS v4u*)(tV + rr_ * 128 + (((unsigned)(2 * q) ^ ((unsigned)(rr_ & 7) << 1)) << 3));
            *(v4u*)(O + (tokb + qt * 32 + rr_) * DM + hd * 64 + 8 * q) = w; }
        __syncthreads();
        if (more) {
#pragma unroll
            for (int i = 0; i < 8; ++i) *(LAS v4u*)(ring + ((8 * nG + i) % 14) * 8192 + dstoff) = st[i];
#pragma unroll
            for (int ks = 0; ks < 4; ++ks) qf[ks] = qn[ks];
        }
        __syncthreads();
    }
}
constexpr int N_PHASES = 16;
#ifndef MK_ONE_LAUNCH
#define MK_ONE_LAUNCH 1
#endif

__global__ void __launch_bounds__(NWAVES * 64, 2) mk_fwd(Args args) {
    extern __shared__ __attribute__((aligned(16))) unsigned char lds_raw[];
    Ctx C;
    C.lds = (LAS unsigned char*)lds_raw;
    C.tid = threadIdx.x; C.lane = C.tid & 63; C.wave = __builtin_amdgcn_readfirstlane(C.tid >> 6);
    C.G = gridDim.x; C.bid = blockIdx.x;
    C.gw = C.bid * NWAVES + C.wave; C.NGW = C.G * NWAVES;
    C.gt = (long)C.bid * (NWAVES * 64) + C.tid; C.NGT = (long)C.G * (NWAVES * 64);
    unsigned char* ws = args.ws;
    volatile LAS unsigned* MISC = (volatile LAS unsigned*)(C.lds + MISC_OFF);
    for (int u = C.tid; u < (LDS_BYTES - LDSCTL_OFF) / 4; u += NWAVES * 64) ((LAS unsigned*)(C.lds + LDSCTL_OFF))[u] = 0u;
    __syncthreads();
#if MK_ONE_LAUNCH
    XcdBarrier bar = xcd_barrier_post((unsigned*)((gu32*)(ws + WS_CTL) + CW_BAR), MISC + 8);
#ifdef PROBE_DBLBAR
#define GRID_BAR() do { xcd_barrier(bar); xcd_barrier(bar); } while (0)
#else
#define GRID_BAR() xcd_barrier(bar)
#endif
#else
    (void)MISC; XcdBarrier bar; bar.bar = nullptr; bar.x = 0; bar.st = nullptr;
#define GRID_BAR() do {} while (0)
#endif
    const int lo = args.ph_lo, hi = args.ph_hi;
#define IN(k) (lo <= (k) && (k) < hi)
#ifndef PROBE_MASK
#define PROBE_MASK 0
#endif
#define PROBE_T0(k) unsigned long long pt0_ = 0; if ((PROBE_MASK >> (k)) & 1) pt0_ = __builtin_amdgcn_s_memrealtime();
#define PROBE_T1(k) if ((PROBE_MASK >> (k)) & 1) { const unsigned long long t1_ = __builtin_amdgcn_s_memrealtime(); const unsigned long long d_ = t1_ - pt0_; while (__builtin_amdgcn_s_memrealtime() - t1_ < d_) __builtin_amdgcn_s_sleep(8); }
#define SEAM(k) do { if (IN(k) && IN((k) + 1)) GRID_BAR(); } while (0)
    float* mod0 = (float*)(ws + WS_MOD); float* mod1 = mod0 + (size_t)NB * 6144;
    bf16* Hb = (bf16*)(ws + WS_H); bf16* BIG = (bf16*)(ws + WS_BIG); bf16* XB = (bf16*)(ws + WS_XB);

    const unsigned char* TAB = ws + WS_TAB; const float* TSC = (const float*)(ws + WS_TSC);
#ifdef PROBE_INSTR
    {
        unsigned xs[16]; float fs[16];
#pragma unroll
        for (int i = 0; i < 16; ++i) { xs[i] = (unsigned)(C.tid * 2654435761u + i * 40503u); fs[i] = (float)(C.tid * 7 + i) * 0.37f; }
#pragma unroll 1
        for (int it = 0; it < 4096; ++it) {
#pragma unroll
            for (int rep = 0; rep < 2; ++rep) {
#pragma unroll
                for (int i = 0; i < 16; i += 2) {
#if PROBE_INSTR == 10
                    { const unsigned a = xs[i], b = xs[i + 1]; xs[i] = a < b ? b : a; xs[i + 1] = (a < b ? a : b) + (unsigned)it; }
#elif PROBE_INSTR == 11
                    { const float a = fs[i], b = fs[i + 1]; fs[i] = fmaxf(a, b); fs[i + 1] = fminf(a, b) + 1.0f; }
#elif PROBE_INSTR == 12
                    { const unsigned a = xs[i], b = xs[i + 1]; xs[i] = a + b; xs[i + 1] = (a ^ b) + (unsigned)it; }
#endif
                }
            }
        }
        float sm = 0.f;
#pragma unroll
        for (int i = 0; i < 16; ++i) sm += fs[i] + __uint_as_float(xs[i] & 0x3fffffffu);
        if (sm == 1234.5678f) args.out[C.tid] = sm;
    }
#endif
    if (IN(0)) { PROBE_T0(0) { phase_prep(C, args); convert_tables_int8(C, args); } PROBE_T1(0) } SEAM(0);
    bf16* H8B = (bf16*)(ws + WS_IDS);
    unsigned char* W8 = (unsigned char*)args.out; float* SW = (float*)((unsigned char*)args.out + OUT_SW); float* SA = (float*)(ws + WS_SA);
    if (IN(1)) { PROBE_T0(1) { phase_rowpass<true, false, true>(C, args, args.in[0], args.in[4], mod0, 0, 1, Hb, SA);
        quantize_rows(C, (const bf16*)(ws + WS_WIN), INP, W8 + OUT_W8IN, SW + SW_IN);
        quantize_rows(C, (const bf16*)(ws + WS_WC0), 2048, W8 + OUT_W8C0, SW + SW_C0); quantize_rows(C, (const bf16*)(ws + WS_WC1), 2048, W8 + OUT_W8C1, SW + SW_C1);
        quantize_rows(C, (const bf16*)(ws + WS_WQKV), 3072, W8 + OUT_W8QKV, SW + SW_QKV); } PROBE_T1(1) } SEAM(1);
    if (IN(2)) { PROBE_T0(2) { pg8::Gemm g{Hb, (const bf16*)(W8 + OUT_W8IN), NTOK, INP, DM / 2}; pg8::StaticOrder S; S.init(NTOK, INP, C.G, C.bid);
        EpiBf16I8 E{BIG, INP, SA, SW + SW_IN};
        pg8::gemm_phase<EpiBf16I8, pg8::StaticOrder, true, true, true>(C.lds, g, S, E); } PROBE_T1(2) } SEAM(2);
    if (IN(3)) { PROBE_T0(3) { phase_mlstm_local(C, args); phase_conv(C, args); } PROBE_T1(3) } SEAM(3);
    if (IN(4)) { PROBE_T0(4) { phase_mlstm_scan(C, args); } PROBE_T1(4) } SEAM(4);
    if (IN(5)) { PROBE_T0(5) { phase_mlstm_out(C, args); } PROBE_T1(5) } SEAM(5);
    if (IN(6)) { PROBE_T0(6) { pg8::Gemm g{Hb, (const bf16*)(ws + WS_WOUT0), NTOK, DM, DM}; pg8::StaticOrder S; S.init(NTOK, DM, C.G, C.bid);
        EpiResid<false> E{args.in[0], XB, mod0 + 2 * 1024};
        pg8::gemm_phase<EpiResid<false>, pg8::StaticOrder, true, true>(C.lds, g, S, E); } PROBE_T1(6) } SEAM(6);
    if (IN(7)) { PROBE_T0(7) { phase_rowpass<false, true, true>(C, args, XB, args.in[11], mod0, 3, 4, H8B, SA); } PROBE_T1(7) } SEAM(7);
    if (IN(8)) { PROBE_T0(8) { pg8::Gemm g{H8B, (const bf16*)(W8 + OUT_W8C0), NTOK, 2048, DM / 2}; pg8::StaticOrder S; S.init(NTOK, 2048, C.G, C.bid);
        EpiBf16I8 E{BIG, 2048, SA, SW + SW_C0};
        pg8::gemm_phase<EpiBf16I8, pg8::StaticOrder, true, true, true>(C.lds, g, S, E); } PROBE_T1(8) } SEAM(8);
    if (IN(9)) { PROBE_T0(9) { phase_peer<true>(C, args, TAB, TAB + TAB_BYTES, TSC, TSC + 16384, mod0 + 5 * 1024, args.in[19], mod1, bar); } PROBE_T1(9) } SEAM(9);
    if (IN(10)) { PROBE_T0(10) { pg8::Gemm g{H8B, (const bf16*)(W8 + OUT_W8QKV), NTOK, 3072, DM / 2}; pg8::StaticOrder S; S.init(NTOK, 3072, C.G, C.bid);
        EpiQKV<true> E{BIG, (bf16*)(ws + WS_BIG + 64 * MiB), (bf16*)(ws + WS_BIG + 128 * MiB), args.in[21], args.in[22], SA, SW + SW_QKV};
        pg8::gemm_phase<EpiQKV<true>, pg8::StaticOrder, true, true, true>(C.lds, g, S, E); } PROBE_T1(10) } SEAM(10);
    if (IN(11)) { PROBE_T0(11) { phase_attn_ring(C, args); } PROBE_T1(11) } SEAM(11);
    if (IN(12)) { PROBE_T0(12) { pg8::Gemm g{Hb, (const bf16*)(ws + WS_WOUT1), NTOK, DM, DM}; pg8::StaticOrder S; S.init(NTOK, DM, C.G, C.bid);
        EpiResid<true> E{XB, XB, mod1 + 2 * 1024};
        pg8::gemm_phase<EpiResid<true>, pg8::StaticOrder, true, true>(C.lds, g, S, E); } PROBE_T1(12) } SEAM(12);
    if (IN(13)) { PROBE_T0(13) { phase_rowpass<false, true, true>(C, args, XB, args.in[24], mod1, 3, 4, H8B, SA); } PROBE_T1(13) } SEAM(13);
    if (IN(14)) { PROBE_T0(14) { pg8::Gemm g{H8B, (const bf16*)(W8 + OUT_W8C1), NTOK, 2048, DM / 2}; pg8::StaticOrder S; S.init(NTOK, 2048, C.G, C.bid);
        EpiBf16I8 E{BIG, 2048, SA, SW + SW_C1};
        pg8::gemm_phase<EpiBf16I8, pg8::StaticOrder, true, true, true>(C.lds, g, S, E); } PROBE_T1(14) } SEAM(14);
#ifdef PROBE_DRY
    if (IN(15)) { phase_peer<false, PROBE_DRY>(C, args, TAB + 2 * TAB_BYTES, TAB + 3 * TAB_BYTES, TSC + 2 * 16384, TSC + 3 * 16384, mod1 + 5 * 1024, nullptr, nullptr, bar); GRID_BAR(); }
#endif
    if (IN(15)) { PROBE_T0(15) { phase_peer<false>(C, args, TAB + 2 * TAB_BYTES, TAB + 3 * TAB_BYTES, TSC + 2 * 16384, TSC + 3 * 16384, mod1 + 5 * 1024, nullptr, nullptr, bar); } PROBE_T1(15) }
#undef IN
#undef SEAM
}

extern "C" void kernel_launch(void* const* d_in, const int* in_sizes, int n_in, void* d_out, int out_size, void* d_ws, size_t ws_size, hipStream_t stream) {
    static int grid = 0;
    if (grid == 0) {
        if (n_in != 30 || out_size != NTOK * DM || ws_size < WS_END2) { fprintf(stderr, "kernel_launch: unexpected shapes (n_in %d out %d ws %zu)\n", n_in, out_size, ws_size); grid = -1; return; }
        int dev = 0, cus = 0;
        if (hipGetDevice(&dev) != hipSuccess || hipDeviceGetAttribute(&cus, hipDeviceAttributeMultiprocessorCount, dev) != hipSuccess) { grid = -1; return; }
        if (hipFuncSetAttribute((const void*)mk_fwd, hipFuncAttributeMaxDynamicSharedMemorySize, LDS_BYTES) != hipSuccess) { fprintf(stderr, "kernel_launch: hipFuncSetAttribute failed\n"); grid = -1; return; }
        int per_cu = 0;
        if (hipOccupancyMaxActiveBlocksPerMultiprocessor(&per_cu, (const void*)mk_fwd, NWAVES * 64, LDS_BYTES) != hipSuccess || per_cu < 1) fprintf(stderr, "kernel_launch: occupancy query reports %d\n", per_cu);
        (void)hipGetLastError();
        grid = cus;
    }
    if (grid < 0) return;
    (void)hipMemsetAsync((char*)d_ws + WS_CTL + CW_BAR * 4, 0, XCD_BAR_WORDS * 4, stream);
    Args a{};
    for (int i = 0; i < 30; ++i) a.in[i] = (const float*)d_in[i];
    a.out = (float*)d_out; a.ws = (unsigned char*)d_ws;
#if MK_ONE_LAUNCH
    a.ph_lo = 0; a.ph_hi = N_PHASES;
    hipLaunchKernelGGL(mk_fwd, dim3(grid), dim3(NWAVES * 64), LDS_BYTES, stream, a);
#else
    for (int p = 0; p < N_PHASES; ++p) { a.ph_lo = p; a.ph_hi = p + 1; hipLaunchKernelGGL(mk_fwd, dim3(grid), dim3(NWAVES * 64), LDS_BYTES, stream, a); }
#endif
}
```

```cpp
#include <hip/hip_runtime.h>
#include <cstdio>
#include <cstdint>
#include <cmath>
#define PROBE_MASK 0
namespace pg8 {
#define PG8_LAS __attribute__((address_space(3)))
typedef unsigned short bf16_t;
typedef short bf16x8 __attribute__((ext_vector_type(8)));
typedef float f32x4 __attribute__((ext_vector_type(4)));
typedef unsigned u32x4 __attribute__((ext_vector_type(4)));
constexpr int BM = 256, BK = 64, HALF = 128, HTB = HALF * BK * 2  , STAGE_BYTES = 8 * HTB, NXCD = 8, WGM = 8;

__host__ __device__ __forceinline__ int lds_byte(int r, int c) { const int st = (r >> 4) * 2 + (c >> 5), rr = r & 15, cc = c & 31, ob = rr * 64 + cc * 2; return st * 1024 + (ob ^ (((ob >> 9) & 1) << 5)); }
__host__ __device__ __forceinline__ void stage_rc(int b, int& R, int& C) { const int st = b / 1024, sb = b % 1024, swz = sb ^ (((sb >> 9) & 1) << 5); R = (st >> 1) * 16 + swz / 64; C = (st & 1) * 32 + (swz % 64) / 2; }
__host__ __device__ __forceinline__ int perm32(int rho) { const int n = rho >> 4, i = rho & 15; return 8 * (i >> 2) + 4 * n + (i & 3); }

struct Unit { int pm, pn; };
struct Gemm { const bf16_t* A; const bf16_t* Bt; int M, N, K; };

struct StaticOrder {
    int nM, nN, nwg, G, c;
    __host__ __device__ void init(int M, int N, int G_, int c_) { nM = M / BM; nN = N / BM; nwg = nM * nN; G = G_; c = c_; }
    __host__ __device__ bool next(int i, Unit& u) const {
        const long L = (long)i * G + c; if (L >= nwg) return false;
        int wgid = (int)L; { const int q = nwg / NXCD, r = nwg % NXCD, xcd = wgid % NXCD, off = wgid / NXCD; wgid = (xcd < r ? xcd * (q + 1) : r * (q + 1) + (xcd - r) * q) + off; }
        const int nig = WGM * nN, gid = wgid / nig, fm = gid * WGM, gsz = (nM - fm) < WGM ? (nM - fm) : WGM;
        u.pm = fm + ((wgid % nig) % gsz); u.pn = (wgid % nig) / gsz; return true;
    }
    __device__ __forceinline__ void a_ready(const Unit&) const {}
    __device__ __forceinline__ void done(const Unit&) const {}
};

__device__ __forceinline__ unsigned cvt_pk_bf16(float lo, float hi) { unsigned r; asm volatile("v_cvt_pk_bf16_f32 %0, %1, %2" : "=v"(r) : "v"(lo), "v"(hi)); return r; }
typedef float f32x2 __attribute__((ext_vector_type(2)));
__device__ __forceinline__ f32x2 gelu_pk(f32x2 v) {
    const f32x2 av = __builtin_elementwise_abs(v), d = av * 0.2316418882f + 1.0f;
    f32x2 t; t.x = __builtin_amdgcn_rcpf(d.x); t.y = __builtin_amdgcn_rcpf(d.y);
    f32x2 q = t * 0.5307027145f + (-0.7265760135f); q = q * t + 0.7107068705f; q = q * t + (-0.142248368f); q = q * t + 0.127414796f; q = q * t;
    const f32x2 s = (v * v) * (-0.72134752044f);
    f32x2 e; e.x = __builtin_amdgcn_exp2f(s.x); e.y = __builtin_amdgcn_exp2f(s.y);
    const f32x2 m = v * (q * e), r = v - m;
    f32x2 o; o.x = v.x < 0.f ? m.x : r.x; o.y = v.y < 0.f ? m.y : r.y; return o;
}

template <int ACT  > struct EpiBf16 {
    static constexpr bool PERM = true, AFTER_DRAIN = false; static_assert(ACT == 0 || ACT == 1, "EpiBf16: ACT is 0 (none) or 1 (gelu_pk)");
    bf16_t* O; int ldc; const float* bias; int split_cols; size_t split_stride; float scale0;
    __device__ __forceinline__ void operator()(const f32x4 (&acc)[2][2][4][2], const Unit& u, int wr, int wc, int fr, int fq) const {
        const int row0 = u.pm * BM + wr * 64 + fr; int colt = u.pn * BM; bf16_t* base = O;
        float sc = 1.f; if (split_cols) { const int t = colt / split_cols; base += (size_t)t * split_stride; colt -= t * split_cols; if (t == 0) sc = scale0; }
        const int col0 = colt + wc * 32 + 8 * fq, bcol0 = u.pn * BM + wc * 32 + 8 * fq;
        f32x4 bv[2][2];
#pragma unroll
        for (int bj = 0; bj < 2; ++bj)
#pragma unroll
            for (int n = 0; n < 2; ++n) bv[bj][n] = bias ? *(const f32x4*)(bias + bcol0 + bj * HALF + 4 * n) : (f32x4){0.f, 0.f, 0.f, 0.f};
#pragma unroll
        for (int ai = 0; ai < 2; ++ai)
#pragma unroll
            for (int m = 0; m < 4; ++m) { bf16_t* rowp = base + (size_t)(row0 + ai * HALF + m * 16) * ldc + col0;
#pragma unroll
                for (int bj = 0; bj < 2; ++bj) { f32x4 v0 = acc[ai][bj][m][0] + bv[bj][0], v1 = acc[ai][bj][m][1] + bv[bj][1];
                    if (ACT == 1) { f32x2 a = gelu_pk((f32x2){v0[0], v0[1]}), b = gelu_pk((f32x2){v0[2], v0[3]}), c = gelu_pk((f32x2){v1[0], v1[1]}), d = gelu_pk((f32x2){v1[2], v1[3]});
                        v0 = (f32x4){a.x, a.y, b.x, b.y}; v1 = (f32x4){c.x, c.y, d.x, d.y}; }
                    v0 = v0 * sc; v1 = v1 * sc; u32x4 w; w.x = cvt_pk_bf16(v0[0], v0[1]); w.y = cvt_pk_bf16(v0[2], v0[3]); w.z = cvt_pk_bf16(v1[0], v1[1]); w.w = cvt_pk_bf16(v1[2], v1[3]);
                    *(u32x4*)(rowp + bj * HALF) = w; } }
    }
};
typedef int i32x4 __attribute__((ext_vector_type(4)));
template <bool I8> struct AccSel { typedef f32x4 type; };
template <> struct AccSel<true> { typedef i32x4 type; };
template <class Epi, class Sched, bool ALIGN_EPI = false, bool SP2 = false, bool I8 = false>
__device__ __forceinline__ void gemm_phase(PG8_LAS unsigned char* lds, const Gemm g, const Sched& S, const Epi& E) {
    const int tid = threadIdx.x, wid = __builtin_amdgcn_readfirstlane(tid >> 6), lane = tid & 63, wr = wid >> 2, wc = wid & 3, fr = lane & 15, fq = lane >> 4;
    const int K = g.K, nt = K / BK;
    unsigned voffA[2], voffB[2];
#pragma unroll
    for (int i = 0; i < 2; ++i) { int R, C; stage_rc(tid * 16 + i * 8192, R, C); const int Rb = Epi::PERM ? ((R & ~31) + perm32(R & 31)) : R;
        voffA[i] = (unsigned)(R * K + C) * 2u; voffB[i] = (unsigned)(Rb * K + C) * 2u; }
    const size_t kstep = (size_t)(BK * 2);
    const size_t hstep = (size_t)HALF * K * 2;
    const size_t tstep = 2 * hstep;
    const unsigned ldsw = (unsigned)wid * 1024u;
    const int aoff = lds_byte(wr * 64 + fr, fq * 8), boff = lds_byte(wc * 32 + fr, fq * 8);
#define PG8_SA(b, h) (((b) * 2 + (h)) * HTB)
#define PG8_SB(b, h) ((4 + (b) * 2 + (h)) * HTB)
#define PG8_STAGE(bufoff, gbase, voff) do { _Pragma("unroll") for (int _i = 0; _i < 2; ++_i) \
        __builtin_amdgcn_global_load_lds((const unsigned*)((const char*)(gbase) + (voff)[_i]), (PG8_LAS unsigned*)(lds + (bufoff) + ldsw + _i * 8192), 16, 0, 0); } while (0)
#define PG8_LDA(dst, b, h) do { _Pragma("unroll") for (int m = 0; m < 4; ++m) _Pragma("unroll") for (int k = 0; k < 2; ++k) dst[m][k] = *(const PG8_LAS bf16x8*)(lds + PG8_SA(b, h) + aoff + m * 2048 + k * 1024); } while (0)
#define PG8_LDB(dst, b, h) do { _Pragma("unroll") for (int n = 0; n < 2; ++n) _Pragma("unroll") for (int k = 0; k < 2; ++k) dst[n][k] = *(const PG8_LAS bf16x8*)(lds + PG8_SB(b, h) + boff + n * 2048 + k * 1024); } while (0)
#define PG8_MMA(ai, bj, At, Bt) do { __builtin_amdgcn_s_setprio(1); _Pragma("unroll") for (int m = 0; m < 4; ++m) _Pragma("unroll") for (int n = 0; n < 2; ++n) _Pragma("unroll") for (int k = 0; k < 2; ++k) \
        { if constexpr (I8) acc[ai][bj][m][n] = __builtin_bit_cast(acc_t, __builtin_amdgcn_mfma_i32_16x16x64_i8(__builtin_bit_cast(i32x4, Bt[n][k]), __builtin_bit_cast(i32x4, At[m][k]), __builtin_bit_cast(i32x4, acc[ai][bj][m][n]), 0, 0, 0)); \
          else acc[ai][bj][m][n] = __builtin_bit_cast(acc_t, __builtin_amdgcn_mfma_f32_16x16x32_bf16(Bt[n][k], At[m][k], __builtin_bit_cast(f32x4, acc[ai][bj][m][n]), 0, 0, 0)); } __builtin_amdgcn_s_setprio(0); } while (0)
#define PG8_WAIT_V(n) asm volatile("s_waitcnt vmcnt(" #n ")" ::: "memory")
#define PG8_WAIT_L(n) asm volatile("s_waitcnt lgkmcnt(" #n ")" ::: "memory")
#define PG8_BAR __builtin_amdgcn_s_barrier()
#define PG8_SCHED __builtin_amdgcn_sched_barrier(0)
    Unit cur, nxt; int ui = 0;
    if (!S.next(0, cur)) return;
    typedef typename AccSel<I8>::type acc_t; const acc_t acc_zero = {};
    acc_t acc[2][2][4][2];
#pragma unroll
    for (int a = 0; a < 2; ++a)
#pragma unroll
        for (int b = 0; b < 2; ++b)
#pragma unroll
            for (int m = 0; m < 4; ++m)
#pragma unroll
                for (int n = 0; n < 2; ++n) acc[a][b][m][n] = acc_zero;
    bf16x8 At[4][2], B0[2][2], B1[2][2];
    const char* cA = (const char*)g.A + (size_t)cur.pm * tstep; const char* cB = (const char*)g.Bt + (size_t)cur.pn * tstep;
    S.a_ready(cur);
    if constexpr (SP2) {
        PG8_STAGE(PG8_SB(0, 0), cB, voffB); PG8_STAGE(PG8_SB(0, 1), cB + hstep, voffB); PG8_STAGE(PG8_SA(0, 0), cA, voffA); PG8_STAGE(PG8_SA(0, 1), cA + hstep, voffA);
        if (wr == 1) PG8_BAR;
        PG8_WAIT_V(2); PG8_BAR;
        PG8_STAGE(PG8_SB(1, 0), cB + kstep, voffB); PG8_STAGE(PG8_SA(1, 0), cA + kstep, voffA); PG8_STAGE(PG8_SB(1, 1), cB + hstep + kstep, voffB);
        PG8_WAIT_V(6); PG8_BAR;
    } else {
        PG8_STAGE(PG8_SB(0, 0), cB, voffB); PG8_STAGE(PG8_SA(0, 0), cA, voffA); PG8_STAGE(PG8_SB(0, 1), cB + hstep, voffB); PG8_STAGE(PG8_SA(0, 1), cA + hstep, voffA);
        if (wr == 1) PG8_BAR;
        PG8_WAIT_V(4); PG8_BAR;
        PG8_STAGE(PG8_SB(1, 0), cB + kstep, voffB); PG8_STAGE(PG8_SA(1, 0), cA + kstep, voffA); PG8_STAGE(PG8_SB(1, 1), cB + hstep + kstep, voffB);
        PG8_WAIT_V(6); PG8_BAR;
    }
    for (;;) {
        const bool has_next = S.next(ui + 1, nxt);
        const char* nA = has_next ? (const char*)g.A + (size_t)nxt.pm * tstep : cA; const char* nB = has_next ? (const char*)g.Bt + (size_t)nxt.pn * tstep : cB;
        for (int t = 0; t < nt; t += 2) {
            const bool last = (t == nt - 2);
            const char* a1 = cA + (size_t)(t + 1) * kstep;
            const char* a2 = last ? nA : cA + (size_t)(t + 2) * kstep; const char* b2 = last ? nB : cB + (size_t)(t + 2) * kstep;
            const char* a3 = a2 + kstep; const char* b3 = b2 + kstep;
            if (last && has_next) S.a_ready(nxt);
            if constexpr (SP2) {
            PG8_LDB(B0, 0, 0); PG8_LDB(B1, 0, 1); PG8_SCHED; PG8_LDA(At, 0, 0); PG8_STAGE(PG8_SA(1, 1), a1 + hstep, voffA);
            PG8_WAIT_V(8); PG8_WAIT_L(0); PG8_BAR; PG8_MMA(0, 0, At, B0); PG8_MMA(0, 1, At, B1); PG8_BAR; PG8_SCHED;
            PG8_LDA(At, 0, 1); PG8_STAGE(PG8_SB(0, 0), b2, voffB); PG8_STAGE(PG8_SB(0, 1), b2 + hstep, voffB); PG8_STAGE(PG8_SA(0, 0), a2, voffA);
            PG8_WAIT_V(8); PG8_WAIT_L(0); PG8_BAR; PG8_MMA(1, 0, At, B0); PG8_MMA(1, 1, At, B1); PG8_BAR; PG8_SCHED;
            PG8_LDB(B0, 1, 0); PG8_LDB(B1, 1, 1); PG8_SCHED; PG8_LDA(At, 1, 0); PG8_STAGE(PG8_SA(0, 1), a2 + hstep, voffA);
            PG8_WAIT_V(8); PG8_WAIT_L(0); PG8_BAR; PG8_MMA(0, 0, At, B0); PG8_MMA(0, 1, At, B1); PG8_BAR; PG8_SCHED;
            PG8_LDA(At, 1, 1); PG8_STAGE(PG8_SB(1, 0), b3, voffB); PG8_STAGE(PG8_SB(1, 1), b3 + hstep, voffB); PG8_STAGE(PG8_SA(1, 0), a3, voffA);
            PG8_WAIT_V(8); PG8_WAIT_L(0); PG8_BAR; PG8_MMA(1, 0, At, B0); PG8_MMA(1, 1, At, B1); PG8_BAR; PG8_SCHED;
            } else {
            PG8_LDB(B0, 0, 0); PG8_SCHED; PG8_LDA(At, 0, 0); PG8_STAGE(PG8_SA(1, 1), a1 + hstep, voffA);
            PG8_WAIT_L(8); PG8_BAR; PG8_WAIT_L(0); PG8_MMA(0, 0, At, B0); PG8_BAR; PG8_SCHED;
            PG8_LDB(B1, 0, 1); PG8_STAGE(PG8_SB(0, 0), b2, voffB);
            PG8_BAR; PG8_WAIT_L(0); PG8_MMA(0, 1, At, B1); PG8_BAR;
            PG8_LDA(At, 0, 1); PG8_STAGE(PG8_SA(0, 0), a2, voffA);
            PG8_BAR; PG8_WAIT_L(0); PG8_MMA(1, 0, At, B0); PG8_BAR; PG8_SCHED;
            PG8_STAGE(PG8_SB(0, 1), b2 + hstep, voffB);
            PG8_WAIT_V(6); PG8_BAR; PG8_MMA(1, 1, At, B1); PG8_BAR;
            PG8_LDB(B0, 1, 0); PG8_SCHED; PG8_LDA(At, 1, 0); PG8_STAGE(PG8_SA(0, 1), a2 + hstep, voffA);
            PG8_WAIT_L(8); PG8_BAR; PG8_WAIT_L(0); PG8_MMA(0, 0, At, B0); PG8_BAR; PG8_SCHED;
            PG8_LDB(B1, 1, 1); PG8_STAGE(PG8_SB(1, 0), b3, voffB);
            PG8_BAR; PG8_WAIT_L(0); PG8_MMA(0, 1, At, B1); PG8_BAR;
            PG8_LDA(At, 1, 1); PG8_STAGE(PG8_SA(1, 0), a3, voffA);
            PG8_BAR; PG8_WAIT_L(0); PG8_MMA(1, 0, At, B0); PG8_BAR; PG8_SCHED;
            PG8_STAGE(PG8_SB(1, 1), b3 + hstep, voffB);
            PG8_WAIT_V(6); PG8_BAR; PG8_MMA(1, 1, At, B1); PG8_BAR;
            }
        }
        if constexpr (ALIGN_EPI) { if (wr == 0) PG8_BAR; }
        if constexpr (!Epi::AFTER_DRAIN) { E(acc, cur, wr, wc, fr, fq); S.done(cur); }
        if (!has_next) break;
#pragma unroll
        for (int a = 0; a < 2; ++a)
#pragma unroll
            for (int b = 0; b < 2; ++b)
#pragma unroll
                for (int m = 0; m < 4; ++m)
#pragma unroll
                    for (int n = 0; n < 2; ++n) acc[a][b][m][n] = acc_zero;
        cur = nxt; cA = nA; cB = nB; ++ui;
        if constexpr (ALIGN_EPI) { if (wr == 1) PG8_BAR; }
    }
    PG8_WAIT_V(0);
    if constexpr (!ALIGN_EPI) { if (wr == 0) PG8_BAR; }
    PG8_BAR;
    if constexpr (Epi::AFTER_DRAIN) { E.fused(acc, cur, wr, wc, fr, fq, lds, wid, lane); S.done(cur); }
#undef PG8_SA
#undef PG8_SB
#undef PG8_STAGE
#undef PG8_LDA
#undef PG8_LDB
#undef PG8_MMA
#undef PG8_WAIT_V
#undef PG8_WAIT_L
#undef PG8_BAR
#undef PG8_SCHED
}
}
#define GAS __attribute__((address_space(1)))
#define LAS __attribute__((address_space(3)))
typedef unsigned short bf16;
typedef unsigned v4u __attribute__((ext_vector_type(4)));
typedef unsigned u32x2 __attribute__((ext_vector_type(2)));
typedef float f32x16 __attribute__((ext_vector_type(16)));
typedef float f32x4 __attribute__((ext_vector_type(4)));
typedef short bf16x8 __attribute__((ext_vector_type(8)));
typedef GAS unsigned gu32;
typedef GAS unsigned long long gu64;
#define RLX_AGENT __ATOMIC_RELAXED, __HIP_MEMORY_SCOPE_AGENT
#define LDS_WAIT() asm volatile("s_waitcnt lgkmcnt(0)" ::: "memory")
#define VM_WAIT() asm volatile("s_waitcnt vmcnt(0)" ::: "memory")
__device__ __forceinline__ unsigned long long rt() { return __builtin_amdgcn_s_memrealtime(); }
__device__ __forceinline__ unsigned f2bf(float f) { unsigned u = __builtin_bit_cast(unsigned, f); return (u + 0x7fffu + ((u >> 16) & 1u)) >> 16; }
typedef float pk2_f32x2 __attribute__((ext_vector_type(2))); typedef __bf16 pk2_bf16x2 __attribute__((ext_vector_type(2)));
__device__ __forceinline__ unsigned pk2(float lo, float hi) { const pk2_f32x2 v = {lo, hi}; return __builtin_bit_cast(unsigned, __builtin_convertvector(v, pk2_bf16x2)); }

#define XB_TMO      128
#define XB_XCNT(j)  (256  + 64 * (j))
#define XB_XSUB(j)  (1280 + 64 * (j))
#define XB_XGEN(j)  (2304 + 64 * (j))
#define XB_TOP      3328
#define XB_TOPGEN   3392
#define XCD_BAR_WORDS 3456
#define XB_SPIN_CAP (1u << 18)

__device__ __forceinline__ unsigned xb_ld(unsigned* p)              { return __hip_atomic_load(p, __ATOMIC_RELAXED, __HIP_MEMORY_SCOPE_AGENT); }
__device__ __forceinline__ unsigned xb_add(unsigned* p, unsigned v) { return __hip_atomic_fetch_add(p, v, __ATOMIC_RELAXED, __HIP_MEMORY_SCOPE_AGENT); }
__device__ __forceinline__ unsigned xb_xcc_id() { return (unsigned)__builtin_amdgcn_s_getreg((3 << 11) | 20) & 0xFu; }
#define XB_SPIN(cond, bar) do { unsigned _sp = 0; while (cond) { __builtin_amdgcn_s_sleep(1); \
    if ((++_sp & 255u) == 0u) { if (xb_ld(&(bar)[XB_TMO])) break; if (_sp > XB_SPIN_CAP) { atomicAdd(&(bar)[XB_TMO], 1u); break; } } } } while (0)

struct XcdBarrier {
    unsigned* bar; unsigned x;
    volatile LAS unsigned* st;
};

__device__ __forceinline__ XcdBarrier xcd_barrier_post(unsigned* bar, volatile LAS unsigned* st) {
    XcdBarrier b; b.bar = bar; b.x = xb_xcc_id(); b.st = st;
    if (threadIdx.x == 0) (void)xb_add(&bar[XB_XCNT(b.x)], 1u);
    return b;
}
__device__ __forceinline__ void xcd_barrier_complete(unsigned* bar, unsigned x, unsigned& nloc, unsigned& nx) {
    const unsigned G = gridDim.x * gridDim.y * gridDim.z;
    unsigned sum, cnt, mine, sp = 0u;
    for (;;) {
        sum = 0u; cnt = 0u; mine = 0u;
#pragma unroll
        for (unsigned j = 0; j < 16; ++j) { const unsigned c = xb_ld(&bar[XB_XCNT(j)]); sum += c; cnt += (c > 0u) ? 1u : 0u; mine = (j == x) ? c : mine; }
        if (sum == G) break;
        __builtin_amdgcn_s_sleep(1);
        if ((++sp & 255u) == 0u) { if (xb_ld(&bar[XB_TMO])) break; if (sp > XB_SPIN_CAP) { atomicAdd(&bar[XB_TMO], 1u); break; } }
    }
    nloc = mine > 0u ? mine : 1u; nx = cnt > 0u ? cnt : 1u;
}

__device__ __forceinline__ void xcd_barrier(const XcdBarrier& b) {
    asm volatile("s_waitcnt vmcnt(0)" ::: "memory");
    __syncthreads();
    if (threadIdx.x == 0) {
        unsigned* bar = b.bar;
        __builtin_amdgcn_s_waitcnt(0);
        unsigned nloc = b.st[0], nx = b.st[1];
        if (nloc == 0u) { xcd_barrier_complete(bar, b.x, nloc, nx); b.st[0] = nloc; b.st[1] = nx; }
        const unsigned old = xb_add(&bar[XB_XSUB(b.x)], 1u);
        const unsigned gen = old / nloc;
        if (old + 1u == (gen + 1u) * nloc) {
            __builtin_amdgcn_fence(__ATOMIC_RELEASE, "agent");
            asm volatile("s_waitcnt vmcnt(0)" ::: "memory");
            const unsigned og = xb_add(&bar[XB_TOP], 1u);
            const unsigned tg = og / nx;
            if (og + 1u == (tg + 1u) * nx) xb_add(&bar[XB_TOPGEN], 1u);
            else XB_SPIN(xb_ld(&bar[XB_TOPGEN]) == tg, bar);
            __builtin_amdgcn_fence(__ATOMIC_ACQUIRE, "agent");
            xb_add(&bar[XB_XGEN(b.x)], 1u);
            asm volatile("s_waitcnt vmcnt(0)" ::: "memory");
        } else {
            XB_SPIN(xb_ld(&bar[XB_XGEN(b.x)]) == gen, bar);
            __builtin_amdgcn_fence(__ATOMIC_ACQUIRE, "agent");
            asm volatile("s_waitcnt vmcnt(0)" ::: "memory");
        }
    }
    __syncthreads();
}
#ifndef MK_ONE_LAUNCH
#define MK_ONE_LAUNCH 1
#endif
constexpr int NWAVES = 8;
constexpr int NB = 8, SEQ = 4096, DM = 1024, NTOK = NB * SEQ;
constexpr int INW = 3592, INP = 3584;
constexpr float EPS = 1e-6f;
constexpr size_t MiB = 1u << 20;
constexpr size_t WS_CTL = 0, CTL_ZERO_BYTES = 1 * MiB;
constexpr size_t WS_MOD = 1 * MiB;
constexpr size_t WS_LF = 2 * MiB, WS_LI = WS_LF + 512 * 1024;
constexpr size_t WS_FC = 3 * MiB;
constexpr size_t WS_WIN = 4 * MiB, WS_WOUT0 = 11 * MiB, WS_WC0 = 13 * MiB, WS_WQKV = 17 * MiB, WS_WOUT1 = 23 * MiB, WS_WC1 = 25 * MiB;
constexpr size_t WS_H = 32 * MiB;
constexpr size_t WS_BIG = 96 * MiB;
constexpr size_t WS_IDS = 320 * MiB, WS_GATES = 336 * MiB;
constexpr size_t WS_END = 352 * MiB;
constexpr int CW_BAR = 4096;
constexpr int RING_BYTES = 131072, LDSCTL_OFF = RING_BYTES, MISC_OFF = LDSCTL_OFF + 320, LDS_BYTES = 163840;

template <int CTRL> __device__ __forceinline__ unsigned dppu(unsigned v) { return (unsigned)__builtin_amdgcn_update_dpp(0, (int)v, CTRL, 0xF, 0xF, true); }
__device__ __forceinline__ float wave_sum(float v) {
    v += __uint_as_float(dppu<0xB1>(__float_as_uint(v)));
    v += __uint_as_float(dppu<0x4E>(__float_as_uint(v)));
    v += __uint_as_float(dppu<0x124>(__float_as_uint(v)));
    v += __uint_as_float(dppu<0x128>(__float_as_uint(v)));
    const unsigned u = __float_as_uint(v);
    return (__uint_as_float(__builtin_amdgcn_readlane(u, 0)) + __uint_as_float(__builtin_amdgcn_readlane(u, 16))) + (__uint_as_float(__builtin_amdgcn_readlane(u, 32)) + __uint_as_float(__builtin_amdgcn_readlane(u, 48)));
}
__device__ __forceinline__ float wave_max(float v) {
    v = fmaxf(v, __uint_as_float(dppu<0xB1>(__float_as_uint(v))));
    v = fmaxf(v, __uint_as_float(dppu<0x4E>(__float_as_uint(v))));
    v = fmaxf(v, __uint_as_float(dppu<0x124>(__float_as_uint(v))));
    v = fmaxf(v, __uint_as_float(dppu<0x128>(__float_as_uint(v))));
    const unsigned u = __float_as_uint(v);
    return fmaxf(fmaxf(__uint_as_float(__builtin_amdgcn_readlane(u, 0)), __uint_as_float(__builtin_amdgcn_readlane(u, 16))), fmaxf(__uint_as_float(__builtin_amdgcn_readlane(u, 32)), __uint_as_float(__builtin_amdgcn_readlane(u, 48))));
}
__device__ __forceinline__ float lane_xor16(float v, int lane) { const auto s = __builtin_amdgcn_permlane16_swap(__float_as_uint(v), __float_as_uint(v), false, false); return __uint_as_float(((lane >> 4) & 1) ? s[0] : s[1]); }
__device__ __forceinline__ float lane_xor32(float v, int lane) { const auto s = __builtin_amdgcn_permlane32_swap(__float_as_uint(v), __float_as_uint(v), false, false); return __uint_as_float((lane >> 5) ? s[0] : s[1]); }
__device__ __forceinline__ float bf2f(unsigned short b) { return __uint_as_float((unsigned)b << 16); }
__device__ __forceinline__ float bflo(unsigned w) { return __uint_as_float(w << 16); }
__device__ __forceinline__ float bfhi(unsigned w) { return __uint_as_float(w & 0xffff0000u); }
__device__ __forceinline__ float sigmoidf_(float x) { return 1.f / (1.f + __expf(-x)); }
__device__ __forceinline__ float softplusf_(float x) { return fmaxf(x, 0.f) + __logf(1.f + __expf(-fabsf(x))); }
__device__ __forceinline__ float logsigmoidf_(float x) { return fminf(x, 0.f) - __logf(1.f + __expf(-fabsf(x))); }
__device__ __forceinline__ float gelu_exact(float x) { return 0.5f * x * (1.f + erff(x * 0.70710678118654752f)); }
__device__ __forceinline__ float gelu_as(float v) {
    const float av = fabsf(v), t = __builtin_amdgcn_rcpf(av * 0.2316418882f + 1.0f);
    float q = t * 0.5307027145f + (-0.7265760135f); q = q * t + 0.7107068705f; q = q * t + (-0.142248368f); q = q * t + 0.127414796f; q = q * t;
    const float e = __builtin_amdgcn_exp2f((v * v) * (-0.72134752044f));
    const float m = v * (q * e);
    return v < 0.f ? m : v - m;
}

struct Args { const float* in[30]; float* out; unsigned char* ws; int ph_lo, ph_hi; };

struct Ctx {
    LAS unsigned char* lds;
    int tid, lane, wave, G, bid;
    int gw, NGW;
    long gt, NGT;
};
template <bool BASE_BF16>
struct EpiResid {
    static constexpr bool PERM = true, AFTER_DRAIN = false;
    const void* base; bf16* out; const float* gate;
    __device__ __forceinline__ void operator()(const pg8::f32x4 (&acc)[2][2][4][2], const pg8::Unit& u, int wr, int wc, int fr, int fq) const {
        using pg8::f32x4;
        const int col0 = u.pn * 256 + wc * 32 + 8 * fq;
        const float* gp = gate + (size_t)((u.pm * 256) / SEQ) * 6144 + col0;
        f32x4 gv[2][2];
#pragma unroll
        for (int bj = 0; bj < 2; ++bj)
#pragma unroll
            for (int n = 0; n < 2; ++n) { gv[bj][n] = *(const f32x4*)(gp + bj * 128 + 4 * n); gv[bj][n] = gv[bj][n] + 1.0f; }
#pragma unroll
        for (int ai = 0; ai < 2; ++ai)
#pragma unroll
            for (int m = 0; m < 4; ++m) {
                const int r = ai * 128 + wr * 64 + m * 16 + fr; const size_t off = (size_t)(u.pm * 256 + r) * DM + col0;
#pragma unroll
                for (int bj = 0; bj < 2; ++bj) {
                    f32x4 b0, b1;
                    if (BASE_BF16) { const v4u w = *(const v4u*)((const bf16*)base + off + bj * 128); b0 = (f32x4){bflo(w.x), bfhi(w.x), bflo(w.y), bfhi(w.y)}; b1 = (f32x4){bflo(w.z), bfhi(w.z), bflo(w.w), bfhi(w.w)}; }
                    else { b0 = *(const f32x4*)((const float*)base + off + bj * 128); b1 = *(const f32x4*)((const float*)base + off + bj * 128 + 4); }
                    const f32x4 v0 = b0 + gv[bj][0] * acc[ai][bj][m][0], v1 = b1 + gv[bj][1] * acc[ai][bj][m][1];
                    v4u o; o.x = pk2(v0[0], v0[1]); o.y = pk2(v0[2], v0[3]); o.z = pk2(v1[0], v1[1]); o.w = pk2(v1[2], v1[3]);
                    *(v4u*)(out + off + bj * 128) = o;
                }
            }
    }
};

constexpr size_t WS_SA = WS_MOD + 768 * 1024;
constexpr size_t OUT_W8 = 96 * MiB;
constexpr size_t OUT_W8IN = OUT_W8, OUT_W8C0 = OUT_W8 + 4 * MiB, OUT_W8QKV = OUT_W8 + 6 * MiB, OUT_W8C1 = OUT_W8 + 9 * MiB, OUT_SW = OUT_W8 + 11 * MiB;
constexpr int SW_IN = 0, SW_C0 = 4096, SW_QKV = 8192, SW_C1 = 12288;
__device__ __forceinline__ void quantize_row1(const Ctx& C, v4u w0, v4u w1, int n, unsigned char* W8, float* SW) {
    float x[16] = {bflo(w0.x), bfhi(w0.x), bflo(w0.y), bfhi(w0.y), bflo(w0.z), bfhi(w0.z), bflo(w0.w), bfhi(w0.w), bflo(w1.x), bfhi(w1.x), bflo(w1.y), bfhi(w1.y), bflo(w1.z), bfhi(w1.z), bflo(w1.w), bfhi(w1.w)};
    float am = 0.f;
#pragma unroll
    for (int i = 0; i < 16; ++i) am = fmaxf(am, fabsf(x[i]));
    am = fmaxf(wave_max(am), 1e-30f); const float qi = 127.f / am;
    v4u o;
#pragma unroll
    for (int q = 0; q < 4; ++q) { const int q0 = (int)rintf(x[4 * q] * qi), q1 = (int)rintf(x[4 * q + 1] * qi), q2 = (int)rintf(x[4 * q + 2] * qi), q3 = (int)rintf(x[4 * q + 3] * qi);
        o[q] = ((unsigned)q0 & 255u) | (((unsigned)q1 & 255u) << 8) | (((unsigned)q2 & 255u) << 16) | ((unsigned)q3 << 24); }
    *(v4u*)(W8 + (size_t)n * DM + 16 * C.lane) = o;
    if (C.lane == 0) SW[n] = am * (1.f / 127.f);
}
__device__ __forceinline__ void quantize_rows(const Ctx& C, const bf16* W, int N, unsigned char* W8, float* SW, int first) {
    for (int n = first; n < N; n += C.NGW) {
        const v4u w0 = *(const v4u*)(W + (size_t)n * DM + 16 * C.lane), w1 = *(const v4u*)(W + (size_t)n * DM + 16 * C.lane + 8);
        quantize_row1(C, w0, w1, n, W8, SW);
    }
}
__device__ __forceinline__ void quantize_rows4(const Ctx& C, const bf16* const (&W)[4], const int (&N)[4], unsigned char* const (&W8)[4], float* const (&SW)[4]) {
    v4u w0[4][2], w1[4][2];
#pragma unroll
    for (int m = 0; m < 4; ++m)
#pragma unroll
        for (int k = 0; k < 2; ++k) { const int n = C.gw + k * C.NGW;
            if (n < N[m]) { w0[m][k] = *(const v4u*)(W[m] + (size_t)n * DM + 16 * C.lane); w1[m][k] = *(const v4u*)(W[m] + (size_t)n * DM + 16 * C.lane + 8); } }
#pragma unroll
    for (int m = 0; m < 4; ++m) {
#pragma unroll
        for (int k = 0; k < 2; ++k) { const int n = C.gw + k * C.NGW; if (n < N[m]) quantize_row1(C, w0[m][k], w1[m][k], n, W8[m], SW[m]); }
        quantize_rows(C, W[m], N[m], W8[m], SW[m], C.gw + 2 * C.NGW);
    }
}
template <bool ORD = false, bool FUSE_U = false>
struct EpiBf16I8 {
    static constexpr bool PERM = true, AFTER_DRAIN = false;
    static __device__ __forceinline__ unsigned ord2(unsigned w) { const unsigned neg = (w >> 15) & 0x00010001u; return ORD ? (w ^ (neg * 0xFFFFu | 0x80008000u)) : w; }
    bf16* O; int ldc; const float* sa; const float* sw;
    __device__ __forceinline__ void operator()(const pg8::i32x4 (&acc)[2][2][4][2], const pg8::Unit& u, int wr, int wc, int fr, int fq) const {
        using pg8::f32x4;
        const int col0 = u.pn * 256 + wc * 32 + 8 * fq;
        f32x4 cs[2][2];
#pragma unroll
        for (int bj = 0; bj < 2; ++bj)
#pragma unroll
            for (int n = 0; n < 2; ++n) cs[bj][n] = *(const f32x4*)(sw + col0 + bj * 128 + 4 * n);
#pragma unroll
        for (int ai = 0; ai < 2; ++ai)
#pragma unroll
            for (int m = 0; m < 4; ++m) { const int row = u.pm * 256 + ai * 128 + wr * 64 + m * 16 + fr; const float rs = sa[row];
                bf16* rowp = O + (size_t)row * ldc + col0;
                if (FUSE_U && u.pn >= 10) {
                    const pg8::i32x4 c0 = acc[ai][0][m][0], c1 = acc[ai][0][m][1], h0 = acc[ai][1][m][0], h1 = acc[ai][1][m][1];
                    const float r2 = rs * rs;
                    v4u w; w.x = pk2((float)c0[0] * (float)h0[0] * (r2 * cs[0][0][0] * cs[1][0][0]), (float)c0[1] * (float)h0[1] * (r2 * cs[0][0][1] * cs[1][0][1]));
                    w.y = pk2((float)c0[2] * (float)h0[2] * (r2 * cs[0][0][2] * cs[1][0][2]), (float)c0[3] * (float)h0[3] * (r2 * cs[0][0][3] * cs[1][0][3]));
                    w.z = pk2((float)c1[0] * (float)h1[0] * (r2 * cs[0][1][0] * cs[1][1][0]), (float)c1[1] * (float)h1[1] * (r2 * cs[0][1][1] * cs[1][1][1]));
                    w.w = pk2((float)c1[2] * (float)h1[2] * (r2 * cs[0][1][2] * cs[1][1][2]), (float)c1[3] * (float)h1[3] * (r2 * cs[0][1][3] * cs[1][1][3]));
                    *(v4u*)(O + (size_t)row * ldc + 2560 + 128 * (u.pn - 10) + wc * 32 + 8 * fq) = w;
                    continue;
                }
#pragma unroll
                for (int bj = 0; bj < 2; ++bj) { const pg8::i32x4 a0 = acc[ai][bj][m][0], a1 = acc[ai][bj][m][1];
                    v4u w; w.x = ord2(pk2((float)a0[0] * rs * cs[bj][0][0], (float)a0[1] * rs * cs[bj][0][1])); w.y = ord2(pk2((float)a0[2] * rs * cs[bj][0][2], (float)a0[3] * rs * cs[bj][0][3]));
                    w.z = ord2(pk2((float)a1[0] * rs * cs[bj][1][0], (float)a1[1] * rs * cs[bj][1][1])); w.w = ord2(pk2((float)a1[2] * rs * cs[bj][1][2], (float)a1[3] * rs * cs[bj][1][3]));
                    *(v4u*)(rowp + bj * 128) = w; } }
    }
};

__device__ __forceinline__ void transpose_item(const float* W, int ldw, int src_col0, bf16* WT, int K, int dst_row0, int k0, LAS float* scr, int lane) {
#pragma unroll 8
    for (int i = 0; i < 32; ++i) { const int kk = 2 * i + (lane >> 5); scr[kk * 33 + (lane & 31)] = W[(size_t)(k0 + kk) * ldw + src_col0 + (lane & 31)]; }
    LDS_WAIT(); asm volatile("" ::: "memory");
    const int c = lane & 7;
#pragma unroll
    for (int j = 0; j < 4; ++j) { const int n = (lane >> 3) + 8 * j; const LAS float* s = scr + (8 * c) * 33 + n;
        v4u o; o.x = pk2(s[0 * 33], s[1 * 33]); o.y = pk2(s[2 * 33], s[3 * 33]); o.z = pk2(s[4 * 33], s[5 * 33]); o.w = pk2(s[6 * 33], s[7 * 33]);
        *(GAS v4u*)(WT + (size_t)(dst_row0 + n) * K + k0 + 8 * c) = o; }
    LDS_WAIT(); asm volatile("" ::: "memory");
}

__device__ __forceinline__ void phase_prep(const Ctx& C, const Args& A) {
    unsigned char* ws = A.ws;
    {
        LAS float* scr = (LAS float*)(C.lds + C.wave * 16384);
        constexpr int I_IN = 16 * (INP / 32), I_O = 16 * 32, I_QKV = 16 * 96;
        constexpr int NIT = I_IN + I_O + I_QKV + I_O;
        for (int it = C.gw; it < NIT; it += C.NGW) {
            int r = it;
            if (r < I_IN) { const int kb = r / (INP / 32), nb = r % (INP / 32); const int dst = nb * 32;
                int lc = dst; if (dst >= 2560) { const int w = dst - 2560, tile = w >> 8, bjh = (w >> 7) & 1, i = w & 127; lc = (bjh ? 3072 : 2560) + 128 * tile + i; }
                const int src = lc + (lc >= 2048 ? 8 : 0);
                transpose_item(A.in[5], INW, src, (bf16*)(ws + WS_WIN), 1024, dst, kb * 64, scr, C.lane); continue; } r -= I_IN;
            if (r < I_O) { const int kb = r / 32, nb = r % 32; transpose_item(A.in[10], 1024, nb * 32, (bf16*)(ws + WS_WOUT0), 1024, nb * 32, kb * 64, scr, C.lane); continue; } r -= I_O;
            if (r < I_QKV) { const int kb = r / 96, nb = r % 96; const int src = (nb >> 3) * 256 + 64 * (nb & 3) + 32 * ((nb >> 2) & 1);
                transpose_item(A.in[20], 3072, src, (bf16*)(ws + WS_WQKV), 1024, nb * 32, kb * 64, scr, C.lane); continue; } r -= I_QKV;
            { const int kb = r / 32, nb = r % 32; transpose_item(A.in[23], 1024, nb * 32, (bf16*)(ws + WS_WOUT1), 1024, nb * 32, kb * 64, scr, C.lane); }
        }
    }
    {
        LAS float* sc = (LAS float*)C.lds;
        LAS float* red = (LAS float*)(C.lds + 32768);
        if (C.bid < 96) {
            __syncthreads();
            for (int i = C.tid; i < NB * DM; i += NWAVES * 64) { const float v = A.in[1][i]; sc[i] = v / (1.f + __expf(-v)); }
            __syncthreads();
            for (int item = C.bid; item < 96; item += C.G) {
                const int l = item / 48, jc = item % 48;
                const float* W = A.in[l ? 17 : 2] + 128 * jc + 2 * C.lane;
                float a0[NB], a1[NB];
#pragma unroll
                for (int b = 0; b < NB; ++b) a0[b] = a1[b] = 0.f;
#pragma unroll 32
                for (int kk = 0; kk < 128; ++kk) { const int k = 128 * C.wave + kk; const float2 w = *(const float2*)(W + (size_t)k * 6144);
#pragma unroll
                    for (int b = 0; b < NB; ++b) { const float s = sc[b * DM + k]; a0[b] += s * w.x; a1[b] += s * w.y; } }
#pragma unroll
                for (int b = 0; b < NB; ++b) { red[(C.wave * NB + b) * 128 + 2 * C.lane] = a0[b]; red[(C.wave * NB + b) * 128 + 2 * C.lane + 1] = a1[b]; }
                __syncthreads();
                float* mod = (float*)(ws + WS_MOD);
                for (int o = C.tid; o < NB * 128; o += NWAVES * 64) { const int b = o >> 7, j = o & 127; float s = A.in[l ? 18 : 3][128 * jc + j];
#pragma unroll
                    for (int w = 0; w < NWAVES; ++w) s += red[(w * NB + b) * 128 + j];
                    mod[(size_t)(l * NB + b) * 6144 + 128 * jc + j] = s; }
                __syncthreads();
            }
        }
    }
    {
        LAS unsigned char* kt = C.lds;
        LAS unsigned char* wt = C.lds + 128 * 272;
        const int l31 = C.lane & 31, hi = C.lane >> 5, kq = C.wave & 3, kk = C.wave >> 2;
        for (int item = C.bid; item < 512; item += C.G) {
            const int l = item >> 8, hh = (item >> 4) & 15, kb = item & 15;
            const float* Wq = A.in[l ? 25 : 12]; const float* Kh = A.in[l ? ((hh & 1) ? 27 : 26) : ((hh & 1) ? 14 : 13)];
            bf16* Wc = (bf16*)(ws + (l ? WS_WC1 : WS_WC0));
            f32x4 kr[8], wr[4];
#pragma unroll
            for (int i = 0; i < 8; ++i) { const int id = C.tid + 512 * i, row = id >> 5, c4 = id & 31; kr[i] = *(const f32x4*)(Kh + row * 128 + 4 * c4); }
#pragma unroll
            for (int i = 0; i < 4; ++i) { const int id = C.tid + 512 * i, row = id >> 5, c4 = id & 31; wr[i] = *(const f32x4*)(Wq + (size_t)(kb * 64 + row) * 2048 + hh * 128 + 4 * c4); }
            __syncthreads();
#pragma unroll
            for (int i = 0; i < 8; ++i) { const int id = C.tid + 512 * i, row = id >> 5, c4 = id & 31; *(LAS u32x2*)(kt + row * 272 + 8 * c4) = (u32x2){pk2(kr[i].x, kr[i].y), pk2(kr[i].z, kr[i].w)}; }
#pragma unroll
            for (int i = 0; i < 4; ++i) { const int id = C.tid + 512 * i, row = id >> 5, c4 = id & 31; *(LAS u32x2*)(wt + row * 272 + 8 * c4) = (u32x2){pk2(wr[i].x, wr[i].y), pk2(wr[i].z, wr[i].w)}; }
            __syncthreads();
            f32x16 acc;
#pragma unroll
            for (int r = 0; r < 16; ++r) acc[r] = 0.f;
#pragma unroll
            for (int ks = 0; ks < 8; ++ks) acc = __builtin_amdgcn_mfma_f32_32x32x16_bf16(*(const LAS pg8::bf16x8*)(wt + (32 * kk + l31) * 272 + 32 * ks + 16 * hi), *(const LAS pg8::bf16x8*)(kt + (32 * kq + l31) * 272 + 32 * ks + 16 * hi), acc, 0, 0, 0);
            bf16* dst = Wc + (size_t)(hh * 128 + 32 * kq + l31) * 1024 + kb * 64 + 32 * kk + 4 * hi;
#pragma unroll
            for (int g4 = 0; g4 < 4; ++g4) *(u32x2*)(dst + 8 * g4) = (u32x2){pk2(acc[4 * g4], acc[4 * g4 + 1]), pk2(acc[4 * g4 + 2], acc[4 * g4 + 3])};
        }
        __syncthreads();
    }
}

template <bool BF> struct RowRaw;
template <> struct RowRaw<true> { typedef u32x2 type; static __device__ __forceinline__ f32x4 cvt(u32x2 w) { return (f32x4){bflo(w.x), bfhi(w.x), bflo(w.y), bfhi(w.y)}; } };
template <> struct RowRaw<false> { typedef f32x4 type; static __device__ __forceinline__ f32x4 cvt(f32x4 w) { return w; } };
template <bool GATES, bool IN_BF16, bool OUT_I8 = false>
__device__ __forceinline__ void phase_rowpass(const Ctx& C, const Args& A, const void* xin, const float* gain, const float* modl  , int ch_shift, int ch_scale, bf16* hout, float* sa = nullptr) {
    f32x4 wg0[GATES ? 16 : 1], wg1[GATES ? 16 : 1];
    if (GATES) {
        const float* Wg = A.in[5] + 2048;
#pragma unroll
        for (int j = 0; j < 4; ++j)
#pragma unroll
            for (int e = 0; e < 4; ++e) { const int k = 4 * C.lane + 256 * j + e; wg0[4 * j + e] = *(const f32x4*)(Wg + (size_t)k * INW); wg1[4 * j + e] = *(const f32x4*)(Wg + (size_t)k * INW + 4); }
    }
    const int per_wave = (NTOK + C.NGW - 1) / C.NGW; const int r0 = C.gw * per_wave, r1 = (r0 + per_wave < NTOK) ? r0 + per_wave : NTOK;
    f32x4 gsc[4], shv[4]; int bcur = -1;
    typedef typename RowRaw<IN_BF16>::type raw_t;
    raw_t cur[4], nxt[4];
    if (r0 < r1) {
#pragma unroll
        for (int j = 0; j < 4; ++j) cur[j] = *(const raw_t*)((const unsigned char*)xin + ((size_t)r0 * DM + 4 * C.lane + 256 * j) * (IN_BF16 ? 2 : 4));
    }
#pragma unroll 2
    for (int row = r0; row < r1; ++row) {
        const int b = row >> 12;
        if (row + 1 < r1) {
#pragma unroll
            for (int j = 0; j < 4; ++j) nxt[j] = *(const raw_t*)((const unsigned char*)xin + ((size_t)(row + 1) * DM + 4 * C.lane + 256 * j) * (IN_BF16 ? 2 : 4));
        }
        if (b != bcur) {
            const float* shp = modl + (size_t)b * 6144 + ch_shift * 1024 + 4 * C.lane; const float* scp = modl + (size_t)b * 6144 + ch_scale * 1024 + 4 * C.lane;
#pragma unroll
            for (int j = 0; j < 4; ++j) { const f32x4 g = *(const f32x4*)(gain + 4 * C.lane + 256 * j), sc = *(const f32x4*)(scp + 256 * j); gsc[j] = g * (sc + 1.0f); shv[j] = *(const f32x4*)(shp + 256 * j); }
            bcur = b;
        }
        f32x4 v[4]; float ss = 0.f;
#pragma unroll
        for (int j = 0; j < 4; ++j) {
            v[j] = RowRaw<IN_BF16>::cvt(cur[j]);
            ss += v[j].x * v[j].x + v[j].y * v[j].y + v[j].z * v[j].z + v[j].w * v[j].w; }
#pragma unroll
        for (int j = 0; j < 4; ++j) cur[j] = nxt[j];
        const float rstd = rsqrtf(wave_sum(ss) * (1.f / DM) + EPS);
        f32x4 h[4];
#pragma unroll
        for (int j = 0; j < 4; ++j) {
            h[j] = v[j] * rstd * gsc[j] + shv[j];
            if (!OUT_I8) { uint2 o; o.x = pk2(h[j].x, h[j].y); o.y = pk2(h[j].z, h[j].w);
                *(uint2*)(hout + (size_t)row * DM + 4 * C.lane + 256 * j) = o; } }
        if (OUT_I8) {
            float am = 0.f;
#pragma unroll
            for (int j = 0; j < 4; ++j) am = fmaxf(am, fmaxf(fmaxf(fabsf(h[j].x), fabsf(h[j].y)), fmaxf(fabsf(h[j].z), fabsf(h[j].w))));
            am = fmaxf(wave_max(am), 1e-20f); const float qi = 127.f / am;
            unsigned char* h8 = (unsigned char*)hout + (size_t)row * DM + 4 * C.lane;
#pragma unroll
            for (int j = 0; j < 4; ++j) { const int q0 = (int)rintf(h[j].x * qi), q1 = (int)rintf(h[j].y * qi), q2 = (int)rintf(h[j].z * qi), q3 = (int)rintf(h[j].w * qi);
                *(unsigned*)(h8 + 256 * j) = ((unsigned)q0 & 255u) | (((unsigned)q1 & 255u) << 8) | (((unsigned)q2 & 255u) << 16) | ((unsigned)q3 << 24); }
            if (C.lane == 0) sa[row] = am * (1.f / 127.f);
        }
        if (GATES) {
            f32x4 d0 = {0.f, 0.f, 0.f, 0.f}, d1 = {0.f, 0.f, 0.f, 0.f};
#pragma unroll
            for (int j = 0; j < 4; ++j)
#pragma unroll
                for (int e = 0; e < 4; ++e) { const float hv = h[j][e]; d0 += wg0[4 * j + e] * hv; d1 += wg1[4 * j + e] * hv; }
            const bool b0 = C.lane & 1, b1 = (C.lane >> 1) & 1, b4 = (C.lane >> 4) & 1, b5 = C.lane >> 5;
            const float d[8] = {d0.x, d0.y, d0.z, d0.w, d1.x, d1.y, d1.z, d1.w};
            float e4[4], f2[2];
#pragma unroll
            for (int i = 0; i < 4; ++i) { const float keep = b0 ? d[4 + i] : d[i], send = b0 ? d[i] : d[4 + i]; e4[i] = keep + __uint_as_float(dppu<0xB1>(__float_as_uint(send))); }
#pragma unroll
            for (int i = 0; i < 2; ++i) { const float keep = b1 ? e4[2 + i] : e4[i], send = b1 ? e4[i] : e4[2 + i]; float f = keep + __uint_as_float(dppu<0x4E>(__float_as_uint(send)));
                f += __uint_as_float(dppu<0x124>(__float_as_uint(f))); f += __uint_as_float(dppu<0x128>(__float_as_uint(f))); f2[i] = f; }
            float gsum;
            { const float keep = b4 ? f2[1] : f2[0], send = b4 ? f2[0] : f2[1];
              const auto s16 = __builtin_amdgcn_permlane16_swap(__float_as_uint(send), __float_as_uint(send), false, false);
              gsum = keep + __uint_as_float(b4 ? s16[0] : s16[1]);
              const auto s32 = __builtin_amdgcn_permlane32_swap(__float_as_uint(gsum), __float_as_uint(gsum), false, false);
              gsum += __uint_as_float(b5 ? s32[0] : s32[1]); }
            if ((C.lane & ~19) == 0) {
                const int q = 4 * (C.lane & 1) + 2 * ((C.lane >> 1) & 1) + ((C.lane >> 4) & 1), hh = q & 3;
                const int s = row & (SEQ - 1); float* LF = (float*)(A.ws + WS_LF); float* LI = (float*)(A.ws + WS_LI);
                if (q < 4) LI[(size_t)(b * 4 + hh) * SEQ + s] = gsum + A.in[6][hh];
                else LF[(size_t)(b * 4 + hh) * SEQ + s] = logsigmoidf_(gsum + A.in[7][hh]);
            }
        }
    }
}

__device__ __forceinline__ void phase_conv(const Ctx& C, const Args& A) {
    const bf16* P = (const bf16*)(A.ws + WS_BIG); bf16* mix = (bf16*)(A.ws + WS_H); const float* cw = A.in[8];
    const int c0 = C.lane * 8;
    const int per_wave = (NTOK + C.NGW - 1) / C.NGW; const int t0 = C.gw * per_wave, t1 = (t0 + per_wave < NTOK) ? t0 + per_wave : NTOK;
    if (t0 >= t1) return;
    f32x4 w[3][2];
#pragma unroll
    for (int k = 0; k < 3; ++k) { w[k][0] = *(const f32x4*)(cw + k * 512 + c0); w[k][1] = *(const f32x4*)(cw + k * 512 + c0 + 4); }
    f32x4 um1[2], um2[2];
    { const int p0 = t0 & (SEQ - 1);
      const v4u u1 = *(const v4u*)(P + (size_t)(t0 - (p0 >= 1 ? 1 : 0)) * INP + 2560 + c0), u2 = *(const v4u*)(P + (size_t)(t0 - (p0 >= 2 ? 2 : 0)) * INP + 2560 + c0);
      const float z1 = p0 >= 1 ? 1.f : 0.f, z2 = p0 >= 2 ? 1.f : 0.f;
      um1[0] = (f32x4){bflo(u1.x), bfhi(u1.x), bflo(u1.y), bfhi(u1.y)} * z1; um1[1] = (f32x4){bflo(u1.z), bfhi(u1.z), bflo(u1.w), bfhi(u1.w)} * z1;
      um2[0] = (f32x4){bflo(u2.x), bfhi(u2.x), bflo(u2.y), bfhi(u2.y)} * z2; um2[1] = (f32x4){bflo(u2.z), bfhi(u2.z), bflo(u2.w), bfhi(u2.w)} * z2; }
#pragma unroll 1
    for (int tb = t0; tb < t1; tb += 8) {
        v4u uu[8], cb[8];
#pragma unroll
        for (int i = 0; i < 8; ++i) { const int tk = (tb + i < t1) ? tb + i : t1 - 1; const bf16* r = P + (size_t)tk * INP;
            uu[i] = *(const v4u*)(r + 2560 + c0); cb[i] = *(const v4u*)(r + 2048 + c0); }
#pragma unroll
        for (int i = 0; i < 8; ++i) {
            const int tok = tb + i;
            if ((tok & (SEQ - 1)) == 0) { um1[0] = um1[1] = um2[0] = um2[1] = (f32x4){0.f, 0.f, 0.f, 0.f}; }
            const f32x4 u0 = {bflo(uu[i].x), bfhi(uu[i].x), bflo(uu[i].y), bfhi(uu[i].y)}, u1 = {bflo(uu[i].z), bfhi(uu[i].z), bflo(uu[i].w), bfhi(uu[i].w)};
            const f32x4 v0 = w[0][0] * um2[0] + w[1][0] * um1[0] + w[2][0] * u0, v1 = w[0][1] * um2[1] + w[1][1] * um1[1] + w[2][1] * u1;
            v4u o; o.x = pk2(v0[0] * bflo(cb[i].x), v0[1] * bfhi(cb[i].x)); o.y = pk2(v0[2] * bflo(cb[i].y), v0[3] * bfhi(cb[i].y));
            o.z = pk2(v1[0] * bflo(cb[i].z), v1[1] * bfhi(cb[i].z)); o.w = pk2(v1[2] * bflo(cb[i].w), v1[3] * bfhi(cb[i].w));
            if (tok < t1) *(v4u*)(mix + (size_t)tok * DM + 512 + c0) = o;
            um2[0] = um1[0]; um2[1] = um1[1]; um1[0] = u0; um1[1] = u1;
        }
    }
}
constexpr size_t WS_TAB = 352 * MiB;
constexpr size_t TAB_BYTES = (size_t)16384 * 1024;
constexpr size_t WS_TSC = WS_TAB + 4 * TAB_BYTES;
__device__ __forceinline__ int tsc_index(int R) { return (((R >> 15) * 16384 + (R & 16383)) << 1) + ((R >> 14) & 1); }
constexpr size_t WS_XB = 420 * MiB;
constexpr size_t WS_END2 = WS_XB + 64 * MiB;
typedef float f32x2 __attribute__((ext_vector_type(2)));
typedef __bf16 bf16x2_t __attribute__((ext_vector_type(2)));
__device__ __forceinline__ float dot2bf(unsigned a, unsigned b, float c) { return __builtin_amdgcn_fdot2_f32_bf16(__builtin_bit_cast(bf16x2_t, a), __builtin_bit_cast(bf16x2_t, b), c, false); }
__device__ __forceinline__ float wave_sum_dpp(float v) {
    v += __uint_as_float(dppu<0xB1>(__float_as_uint(v)));
    v += __uint_as_float(dppu<0x4E>(__float_as_uint(v)));
    v += __uint_as_float(dppu<0x124>(__float_as_uint(v)));
    v += __uint_as_float(dppu<0x128>(__float_as_uint(v)));
    const unsigned u = __float_as_uint(v);
    return (__uint_as_float(__builtin_amdgcn_readlane(u, 0)) + __uint_as_float(__builtin_amdgcn_readlane(u, 16))) + (__uint_as_float(__builtin_amdgcn_readlane(u, 32)) + __uint_as_float(__builtin_amdgcn_readlane(u, 48)));
}
__device__ __forceinline__ void ins16(unsigned (&val)[16], unsigned k) {
#pragma unroll
    for (int j = 0; j < 16; ++j) { const unsigned t = val[j] < k ? val[j] : k; val[j] = val[j] < k ? k : val[j]; k = t; }
}
#define PEER_CE(x, i, l) { const unsigned a_ = x[i] < x[l] ? x[l] : x[i], b_ = x[i] < x[l] ? x[i] : x[l]; x[i] = a_; x[l] = b_; }
__device__ __forceinline__ void sort16_desc(unsigned (&x)[16]) {
#pragma unroll
    for (int p = 1; p < 16; p <<= 1)
#pragma unroll
        for (int k = p; k >= 1; k >>= 1)
#pragma unroll
            for (int j = k % p; j + k < 16; j += 2 * k)
#pragma unroll
                for (int i = 0; i < k; ++i)
                    if (i + j + k < 16 && (i + j) / (2 * p) == (i + j + k) / (2 * p)) PEER_CE(x, i + j, i + j + k)
}
__device__ __forceinline__ void merge16_desc(unsigned (&v)[16], const unsigned (&s)[16]) {
#pragma unroll
    for (int i = 0; i < 16; ++i) v[i] = v[i] < s[15 - i] ? s[15 - i] : v[i];
#pragma unroll
    for (int j = 8; j > 0; j >>= 1)
#pragma unroll
        for (int i = 0; i < 16; ++i) { const int l = i ^ j; if (l > i) PEER_CE(v, i, l) }
}
__device__ __forceinline__ unsigned ord32(unsigned b) { return b ^ ((unsigned)((int)b >> 31) | 0x80000000u); }
__device__ __forceinline__ float unord(unsigned o, unsigned mask) { o &= mask; return __uint_as_float((o & 0x80000000u) ? (o ^ 0x80000000u) : (~o & mask)); }

template <bool NEXT, int DRY = 0>
__device__ __forceinline__ void phase_peer(const Ctx& C, const Args& A, const unsigned char* Utab, const unsigned char* Vtab, const float* SU, const float* SV, const float* g2  ,
                                           const float* ngain, const float* nmod  , const XcdBarrier& bar) {
    const bf16* SC = (const bf16*)(A.ws + WS_BIG); bf16* Hb = (bf16*)(A.ws + WS_H);
#ifndef PEER_NBK
#define PEER_NBK 32
#endif
    constexpr int NBK = PEER_NBK, BSH = (NBK == 32 ? 9 : NBK == 64 ? 8 : 7), BPL = NBK / 16;
    LAS unsigned char* wb = C.lds + C.wave * (1024 + 32 * NBK + 8192);
    LAS unsigned char* IDXB = wb; LAS unsigned* CNT = (LAS unsigned*)(wb + 1024); LAS unsigned* PRE = (LAS unsigned*)(wb + 1024 + 16 * NBK); LAS v4u* ENT = (LAS v4u*)(wb + 1024 + 32 * NBK);
#ifndef PEER_SYNC_EVERY
#define PEER_SYNC_EVERY 32
#endif
    const bool wg_uniform = (DRY != 6) && ((NTOK / 4) % C.NGW == 0);
    unsigned flip = 0u, stepi = 0u;
#ifdef PEER_STAGGER
    if (C.wave >= 4) { const unsigned long long t0_ = __builtin_amdgcn_s_memrealtime(); while (__builtin_amdgcn_s_memrealtime() - t0_ < (unsigned long long)PEER_STAGGER) __builtin_amdgcn_s_sleep(16); }
#endif
    const int gw_ = (DRY == 6) ? ((C.bid >> 1) * NWAVES + C.wave) : C.gw, ngw_ = (DRY == 6) ? (C.NGW >> 1) : C.NGW;
    if (DRY == 6 && (C.bid & 1)) return;
    v4u rawp[8];
    if (gw_ < NTOK / 4) { const v4u* sp0 = (const v4u*)(SC + (size_t)(gw_ * 4 + (C.lane >> 4)) * 2048 + (C.lane & 15) * 128);
#pragma unroll
        for (int c = 0; c < 8; ++c) rawp[c] = sp0[c]; }
    for (int tb = gw_; tb < NTOK / 4; tb += ngw_) {
        const int tok0 = tb * 4;
#if MK_ONE_LAUNCH && defined(PEER_SYNC)
        if (tb >= C.NGW) xcd_barrier(bar);
#endif
        int lane = C.lane; asm volatile("" : "+v"(lane));
        LAS float* MB = (LAS float*)(C.lds + 81920 + (int)(stepi & 1u) * 12288);
        if (wg_uniform) { const int bq = tok0 >> 12;
#pragma unroll
            for (int z = 0; z < 2; ++z) { const int c = C.tid + 512 * z; MB[c] = 1.f + g2[(size_t)bq * 6144 + c];
                if (NEXT) { MB[1024 + c] = ngain[c] * (1.f + nmod[(size_t)bq * 6144 + 1024 + c]); MB[2048 + c] = nmod[(size_t)bq * 6144 + c]; } } }
        ++stepi;
        const int par = lane & 1, tl = lane >> 4, grp = lane & 15, head = grp >> 1, i16 = lane & 15;
        {
            unsigned val[16];
            v4u raw[16];
            { const v4u* sp = (const v4u*)(SC + (size_t)(tok0 + tl) * 2048 + grp * 128);
#pragma unroll
              for (int c = 8; c < 16; ++c) raw[c] = sp[c];
#pragma unroll
              for (int c = 0; c < 8; ++c) raw[c] = rawp[c]; }
#pragma unroll
            for (int c = 0; c < 16; c += 2) {
                const v4u c0 = raw[c], c1 = raw[c + 1];
                const unsigned ib = 127u - 8u * (unsigned)c;
                unsigned ks[16];
#pragma unroll
                for (int e = 0; e < 4; ++e) { ks[2 * e] = (c0[e] << 16) | (ib - 2u * e); ks[2 * e + 1] = (c0[e] & 0xFFFF0000u) | (ib - 2u * e - 1u);
                    ks[8 + 2 * e] = (c1[e] << 16) | (ib - 8u - 2u * e); ks[9 + 2 * e] = (c1[e] & 0xFFFF0000u) | (ib - 9u - 2u * e); }
                sort16_desc(ks);
                if (c == 0) {
#pragma unroll
                    for (int j = 0; j < 16; ++j) val[j] = ks[j];
                } else merge16_desc(val, ks);
            }
#pragma unroll
            for (int z = 0; z < NBK / 16; ++z) CNT[lane + 64 * z] = 0u;
            float X[16], Y[16];
            v4u ib4 = {0u, 0u, 0u, 0u};
#pragma unroll
            for (int j = 0; j < 16; ++j) { X[j] = unord(val[j], 0xFFFF0000u); Y[j] = unord(dppu<0xB1>(val[j]), 0xFFFF0000u); ib4[j >> 2] |= (127u - (val[j] & 127u)) << (8 * (j & 3)); }
            *(LAS v4u*)(IDXB + lane * 16) = ib4;
            unsigned cand[16], cb2[16];
            unsigned parv = (unsigned)par; asm volatile("" : "+v"(parv));
#define PEER_CKEY(p, q) ((((p) == (q)) && parv) ? 0u : ((ord32(__float_as_uint(X[p] + Y[q])) & 0xFFFFFF00u) | (255u - ((unsigned)((p) * 16 + (q)) + parv * (unsigned)(15 * ((q) - (p)))))))
            cand[0] = PEER_CKEY(0, 0); cand[1] = PEER_CKEY(0, 1); cand[2] = PEER_CKEY(0, 2); cand[3] = PEER_CKEY(0, 3); cand[4] = PEER_CKEY(0, 4); cand[5] = PEER_CKEY(0, 5); cand[6] = PEER_CKEY(0, 6); cand[7] = PEER_CKEY(0, 7);
            cand[8] = PEER_CKEY(0, 8); cand[9] = PEER_CKEY(0, 9); cand[10] = PEER_CKEY(0, 10); cand[11] = PEER_CKEY(0, 11); cand[12] = PEER_CKEY(0, 12); cand[13] = PEER_CKEY(0, 13); cand[14] = PEER_CKEY(0, 14); cand[15] = PEER_CKEY(0, 15);
            cb2[0] = PEER_CKEY(1, 1); cb2[1] = PEER_CKEY(1, 2); cb2[2] = PEER_CKEY(1, 3); cb2[3] = PEER_CKEY(1, 4); cb2[4] = PEER_CKEY(1, 5); cb2[5] = PEER_CKEY(1, 6); cb2[6] = PEER_CKEY(1, 7);
            cb2[7] = PEER_CKEY(2, 2); cb2[8] = PEER_CKEY(2, 3); cb2[9] = PEER_CKEY(2, 4); cb2[10] = PEER_CKEY(3, 3); cb2[11] = 0u; cb2[12] = 0u; cb2[13] = 0u; cb2[14] = 0u; cb2[15] = 0u;
#undef PEER_CKEY
            sort16_desc(cand); sort16_desc(cb2); merge16_desc(cand, cb2);
            unsigned mg[16]; float fv[16]; float mx = -INFINITY;
#pragma unroll
            for (int k = 0; k < 16; ++k) { const unsigned o = dppu<0xB1>(cand[15 - k]); mg[k] = cand[k] < o ? o : cand[k]; fv[k] = unord(mg[k], 0xFFFFFF00u); mx = fmaxf(mx, fv[k]); }
            float ssum = 0.f;
#pragma unroll
            for (int k = 0; k < 16; ++k) { fv[k] = __expf(fv[k] - mx); ssum += fv[k]; }
            const float inv = 1.f / ssum;
            asm volatile("s_waitcnt lgkmcnt(0)" ::: "memory");
            unsigned eid[8], rk[8]; float esu[8], egv[8];
#pragma unroll
            for (int k = 0; k < 8; ++k) { const unsigned fi = 255u - (mg[k] & 255u);
                const unsigned e1 = IDXB[(lane & ~1) * 16 + (fi >> 4)], e2 = IDXB[(lane | 1) * 16 + (fi & 15u)];
                eid[k] = e1 * 128u + e2;
                rk[k] = __hip_atomic_fetch_add(CNT + tl * NBK + (eid[k] >> BSH), 1u, __ATOMIC_RELAXED, __HIP_MEMORY_SCOPE_WORKGROUP);
                const f32x2 suv = *(const f32x2*)(SU + 2 * eid[k]); esu[k] = suv.x; egv[k] = fv[k] * inv * suv.y; }
            asm volatile("s_waitcnt lgkmcnt(0)" ::: "memory");
            { unsigned cb[BPL]; unsigned s = 0u;
#pragma unroll
              for (int z = 0; z < BPL; ++z) { cb[z] = CNT[tl * NBK + BPL * i16 + z]; s += cb[z]; }
              const unsigned tot = s;
              s += dppu<0x111>(s); s += dppu<0x112>(s); s += dppu<0x114>(s); s += dppu<0x118>(s);
              unsigned ex = s - tot;
#pragma unroll
              for (int z = 0; z < BPL; ++z) { PRE[tl * NBK + BPL * i16 + z] = ex; ex += cb[z]; } }
            asm volatile("s_waitcnt lgkmcnt(0)" ::: "memory");
#pragma unroll
            for (int k = 0; k < 8; ++k) { unsigned pos = PRE[tl * NBK + (eid[k] >> BSH)] + rk[k]; pos = flip ? 127u - pos : pos;
                ENT[tl * 128 + pos] = (v4u){eid[k], __float_as_uint(esu[k]), __float_as_uint(egv[k]), 0u}; }
            asm volatile("s_waitcnt lgkmcnt(0)" ::: "memory");
            flip ^= 1u;
        }
        if (DRY != 3) {
            const int tok = tok0 + tl; const int b = tok >> 12;
            LAS v4u* E = ENT + tl * 128;
            float cmax = 0.f;
            {
                unsigned hq[16]; const float hs = ((const float*)(A.ws + WS_SA))[tok];
#pragma unroll
                for (int j = 0; j < 4; ++j) { const v4u hw = *(const v4u*)(A.ws + WS_IDS + (size_t)tok * DM + 256 * j + 16 * i16); hq[4 * j] = hw.x; hq[4 * j + 1] = hw.y; hq[4 * j + 2] = hw.z; hq[4 * j + 3] = hw.w; }
                v4u B[8][4]; unsigned idr[8]; float mine = 0.f;
#define PEER_LOADI(R_, tab, id_) { const unsigned off = ((id_) & (DRY == 2 ? 1023u : 16383u)) * 1024u + 16u * (unsigned)i16; \
                _Pragma("unroll") for (int j = 0; j < 4; ++j) R_[j] = (DRY == 5 && j >= 2) ? R_[j - 2] : *(const v4u*)((tab) + off + 256 * j); }
#define PEER_DOTS(U_, t_) { int d0 = 0, d1 = 0, d2 = 0, d3 = 0; \
                _Pragma("unroll") for (int e = 0; e < 4; ++e) { d0 = __builtin_amdgcn_sdot4((int)U_[0][e], (int)hq[e], d0, false); d1 = __builtin_amdgcn_sdot4((int)U_[1][e], (int)hq[4 + e], d1, false); \
                    d2 = __builtin_amdgcn_sdot4((int)U_[2][e], (int)hq[8 + e], d2, false); d3 = __builtin_amdgcn_sdot4((int)U_[3][e], (int)hq[12 + e], d3, false); } \
                unsigned ds_ = (unsigned)((d0 + d1) + (d2 + d3)); ds_ += dppu<0xB1>(ds_); ds_ += dppu<0x4E>(ds_); ds_ += dppu<0x124>(ds_); ds_ += dppu<0x128>(ds_); \
                mine = (i16 == ((t_) & 15)) ? (float)(int)ds_ : mine; }
#pragma unroll
                for (int k = 0; k < 8; ++k) idr[k] = E[k].x;
#pragma unroll
                for (int k = 0; k < 8; ++k) PEER_LOADI(B[k], Utab, idr[k])
                if (wg_uniform) __syncthreads();
#pragma unroll 1
                for (int r = 0; r < 128; r += 8) {
                    if (wg_uniform && (r & (PEER_SYNC_EVERY - 1)) == 0 && r) __syncthreads();
                    if (r + 8 < 128) {
#pragma unroll
                        for (int k = 0; k < 8; ++k) idr[k] = E[r + 8 + k].x;
                    }
#pragma unroll
                    for (int k = 0; k < 8; ++k) { PEER_DOTS(B[k], r + k) if (r + 8 < 128) PEER_LOADI(B[k], Utab, idr[k]) }
                    if (r & 8) {
                        const int t = (r & ~15) + i16; const v4u en = E[t];
                        const float cf = gelu_as(mine * (__uint_as_float(en.y) * hs)) * __uint_as_float(en.z);
                        ((LAS float*)(E + t))[3] = cf; cmax = fmaxf(cmax, fabsf(cf));
                    }
                }
#undef PEER_DOTS
            }
            v4u Ba[4][2], Bb[4][2];
            if (DRY != 4) {
#pragma unroll
                for (int n = 0; n < 4; ++n) { const unsigned id_ = E[n].x; const unsigned off = (id_ & (DRY == 2 ? 1023u : 16383u)) * 1024u + 16u * (unsigned)i16;
#pragma unroll
                    for (int jj = 0; jj < 2; ++jj) Ba[n][jj] = *(const v4u*)(Vtab + off + 256 * jj); } }
            cmax = fmaxf(cmax, __uint_as_float(dppu<0xB1>(__float_as_uint(cmax)))); cmax = fmaxf(cmax, __uint_as_float(dppu<0x4E>(__float_as_uint(cmax))));
            cmax = fmaxf(cmax, __uint_as_float(dppu<0x124>(__float_as_uint(cmax)))); cmax = fmaxf(cmax, __uint_as_float(dppu<0x128>(__float_as_uint(cmax))));
            cmax = fmaxf(cmax, 1e-30f);
            v4u xw0r[4], xw1r[4];
#pragma unroll
            for (int j = 0; j < 4; ++j) { const bf16* XBq = (const bf16*)(A.ws + WS_XB) + (size_t)tok * DM + 256 * j + 16 * i16; xw0r[j] = *(const v4u*)XBq; xw1r[j] = *(const v4u*)(XBq + 8); }
            int acci[4][16];
#pragma unroll
            for (int j = 0; j < 4; ++j)
#pragma unroll
                for (int e = 0; e < 16; ++e) acci[j][e] = 0;
            if (DRY != 4) {
                const float cq = 127.f / cmax;
                asm volatile("s_waitcnt lgkmcnt(0)" ::: "memory");
                unsigned pk0, pk1;
                { int q[8];
#pragma unroll
                  for (int k = 0; k < 8; ++k) q[k] = (int)rintf(((const LAS float*)(E + 8 * i16 + k))[3] * cq);
                  pk0 = ((unsigned)q[0] & 255u) | (((unsigned)q[1] & 255u) << 8) | (((unsigned)q[2] & 255u) << 16) | ((unsigned)q[3] << 24);
                  pk1 = ((unsigned)q[4] & 255u) | (((unsigned)q[5] & 255u) << 8) | (((unsigned)q[6] & 255u) << 16) | ((unsigned)q[7] << 24); }
                asm volatile("s_waitcnt lgkmcnt(0)" ::: "memory");
                ((LAS unsigned*)(E + 2 * i16))[1] = pk0; ((LAS unsigned*)(E + 2 * i16 + 1))[1] = pk1;
                asm volatile("s_waitcnt lgkmcnt(0)" ::: "memory");
#define PEER_LOADG(B_, g_, hf_) { _Pragma("unroll") for (int n = 0; n < 4; ++n) { const unsigned id_ = E[4 * (g_) + n].x; const unsigned off = (id_ & (DRY == 2 ? 1023u : 16383u)) * 1024u + 16u * (unsigned)i16 + 512u * (hf_); \
                    _Pragma("unroll") for (int jj = 0; jj < 2; ++jj) B_[n][jj] = *(const v4u*)(Vtab + off + 256 * jj); } }
#define PEER_GROUP(B_, g_, hf_) { const unsigned a4 = ((const LAS unsigned*)(E + (g_)))[1]; \
                    _Pragma("unroll") for (int jj = 0; jj < 2; ++jj) _Pragma("unroll") for (int e = 0; e < 4; ++e) { \
                        const unsigned p01l = __builtin_amdgcn_perm(B_[1][jj][e], B_[0][jj][e], 0x05010400u), p01h = __builtin_amdgcn_perm(B_[1][jj][e], B_[0][jj][e], 0x07030602u); \
                        const unsigned p23l = __builtin_amdgcn_perm(B_[3][jj][e], B_[2][jj][e], 0x05010400u), p23h = __builtin_amdgcn_perm(B_[3][jj][e], B_[2][jj][e], 0x07030602u); \
                        acci[2 * (hf_) + jj][4 * e + 0] = __builtin_amdgcn_sdot4((int)__builtin_amdgcn_perm(p23l, p01l, 0x05040100u), (int)a4, acci[2 * (hf_) + jj][4 * e + 0], false); \
                        acci[2 * (hf_) + jj][4 * e + 1] = __builtin_amdgcn_sdot4((int)__builtin_amdgcn_perm(p23l, p01l, 0x07060302u), (int)a4, acci[2 * (hf_) + jj][4 * e + 1], false); \
                        acci[2 * (hf_) + jj][4 * e + 2] = __builtin_amdgcn_sdot4((int)__builtin_amdgcn_perm(p23h, p01h, 0x05040100u), (int)a4, acci[2 * (hf_) + jj][4 * e + 2], false); \
                        acci[2 * (hf_) + jj][4 * e + 3] = __builtin_amdgcn_sdot4((int)__builtin_amdgcn_perm(p23h, p01h, 0x07060302u), (int)a4, acci[2 * (hf_) + jj][4 * e + 3], false); } }
#pragma unroll 1
                for (int g = 0; g < 32; ++g) {
                    if (wg_uniform && (g & (PEER_SYNC_EVERY / 4 - 1)) == 0 && g) __syncthreads();
                    PEER_LOADG(Bb, g, 1)
                    PEER_GROUP(Ba, g, 0)
                    if (g + 1 < 32) PEER_LOADG(Ba, g + 1, 0)
                    PEER_GROUP(Bb, g, 1)
                }
#undef PEER_LOADG
#undef PEER_GROUP
            }
            const float osc = cmax * (1.f / 127.f);
            f32x2 acc[4][8];
#pragma unroll
            for (int j = 0; j < 4; ++j)
#pragma unroll
                for (int e = 0; e < 8; ++e) acc[j][e] = (f32x2){(float)acci[j][2 * e] * osc, (float)acci[j][2 * e + 1] * osc};
#undef PEER_LOADI
            float ss = 0.f;
#pragma unroll
            for (int j = 0; j < 4; ++j) { const size_t eo = (size_t)tok * DM + 256 * j + 16 * i16; const float* gp = g2 + (size_t)b * 6144 + 256 * j + 16 * i16;
                bf16* XBp = (bf16*)(A.ws + WS_XB) + eo; const v4u xw0 = xw0r[j], xw1 = xw1r[j];
                unsigned ow[8];
#pragma unroll
                for (int q = 0; q < 4; ++q) { const unsigned w0 = q < 2 ? xw0[2 * q] : xw1[2 * q - 4], w1 = q < 2 ? xw0[2 * q + 1] : xw1[2 * q - 3]; const f32x4 g0 = wg_uniform ? *(const LAS f32x4*)(MB + 256 * j + 16 * i16 + 4 * q) : (*(const f32x4*)(gp + 4 * q) + 1.f);
                    const f32x4 xn = {bflo(w0) + g0[0] * acc[j][2 * q].x, bfhi(w0) + g0[1] * acc[j][2 * q].y, bflo(w1) + g0[2] * acc[j][2 * q + 1].x, bfhi(w1) + g0[3] * acc[j][2 * q + 1].y};
                    if (NEXT) { ow[2 * q] = pk2(xn[0], xn[1]); ow[2 * q + 1] = pk2(xn[2], xn[3]); }
                    else if (DRY == 0 || xn[0] == 1234.5678f) *(f32x4*)(A.out + eo + 4 * q) = xn;
                    acc[j][2 * q] = (f32x2){xn[0], xn[1]}; acc[j][2 * q + 1] = (f32x2){xn[2], xn[3]};
                    ss += (xn[0] * xn[0] + xn[1] * xn[1]) + (xn[2] * xn[2] + xn[3] * xn[3]); }
                if (NEXT && (DRY == 0 || ss == 1234.5678f)) { *(v4u*)XBp = (v4u){ow[0], ow[1], ow[2], ow[3]}; *(v4u*)(XBp + 8) = (v4u){ow[4], ow[5], ow[6], ow[7]}; } }
            if (DRY != 0) { if (ss == 1234.5678f) A.out[tok] = ss; }
            if (tb + ngw_ < NTOK / 4) { const v4u* spn = (const v4u*)(SC + (size_t)((tb + ngw_) * 4 + tl) * 2048 + grp * 128);
#pragma unroll
                for (int c = 0; c < 8; ++c) rawp[c] = spn[c]; }
            if (NEXT && DRY == 0) {
                ss += __uint_as_float(dppu<0xB1>(__float_as_uint(ss))); ss += __uint_as_float(dppu<0x4E>(__float_as_uint(ss)));
                ss += __uint_as_float(dppu<0x124>(__float_as_uint(ss))); ss += __uint_as_float(dppu<0x128>(__float_as_uint(ss)));
                const float rstd = rsqrtf(ss * (1.f / DM) + EPS);
                float am = 0.f;
#pragma unroll
                for (int j = 0; j < 4; ++j) { const int c0 = 256 * j + 16 * i16; const float* shp = nmod + (size_t)b * 6144 + c0; const float* scp = shp + 1024;
#pragma unroll
                    for (int q = 0; q < 4; ++q) { f32x4 gn, sh;
                        if (wg_uniform) { gn = *(const LAS f32x4*)(MB + 1024 + c0 + 4 * q); sh = *(const LAS f32x4*)(MB + 2048 + c0 + 4 * q); }
                        else { gn = *(const f32x4*)(ngain + c0 + 4 * q) * (*(const f32x4*)(scp + 4 * q) + 1.f); sh = *(const f32x4*)(shp + 4 * q); }
                        const f32x2 h0 = {acc[j][2 * q].x * rstd * gn[0] + sh[0], acc[j][2 * q].y * rstd * gn[1] + sh[1]};
                        const f32x2 h1 = {acc[j][2 * q + 1].x * rstd * gn[2] + sh[2], acc[j][2 * q + 1].y * rstd * gn[3] + sh[3]};
                        acc[j][2 * q] = h0; acc[j][2 * q + 1] = h1; am = fmaxf(am, fmaxf(fmaxf(fabsf(h0.x), fabsf(h0.y)), fmaxf(fabsf(h1.x), fabsf(h1.y)))); } }
                am = fmaxf(am, __uint_as_float(dppu<0xB1>(__float_as_uint(am)))); am = fmaxf(am, __uint_as_float(dppu<0x4E>(__float_as_uint(am))));
                am = fmaxf(am, __uint_as_float(dppu<0x124>(__float_as_uint(am)))); am = fmaxf(am, __uint_as_float(dppu<0x128>(__float_as_uint(am))));
                am = fmaxf(am, 1e-20f); const float qi = 127.f / am;
#pragma unroll
                for (int j = 0; j < 4; ++j) { v4u o;
#pragma unroll
                    for (int q = 0; q < 4; ++q) { const int q0 = (int)rintf(acc[j][2 * q].x * qi), q1 = (int)rintf(acc[j][2 * q].y * qi), q2 = (int)rintf(acc[j][2 * q + 1].x * qi), q3 = (int)rintf(acc[j][2 * q + 1].y * qi);
                        o[q] = ((unsigned)q0 & 255u) | (((unsigned)q1 & 255u) << 8) | (((unsigned)q2 & 255u) << 16) | ((unsigned)q3 << 24); }
                    *(v4u*)(A.ws + WS_IDS + (size_t)tok * DM + 256 * j + 16 * i16) = o; }
                if (i16 == 0) ((float*)(A.ws + WS_SA))[tok] = am * (1.f / 127.f);
            }
        }
    }
}
constexpr int TAB_P0_ROWS = 2 * 16384;
__device__ __forceinline__ void convert_tables_int8(const Ctx& C, const Args& A) {
    unsigned char* T8 = A.ws + WS_TAB; float* TS = (float*)(A.ws + WS_TSC);
    constexpr int NCH = TAB_P0_ROWS / 32;
    unsigned* ctr = (unsigned*)(A.ws + WS_CTL) + CW_BAR + XCD_BAR_WORDS;
    volatile LAS unsigned* slot = (volatile LAS unsigned*)C.lds;
    __syncthreads();
    if (C.tid == 0) { slot[0] = __hip_atomic_fetch_add(ctr, 1u, __ATOMIC_RELAXED, __HIP_MEMORY_SCOPE_AGENT); slot[1] = __hip_atomic_fetch_add(ctr, 1u, __ATOMIC_RELAXED, __HIP_MEMORY_SCOPE_AGENT); }
    __syncthreads();
    unsigned cur = slot[0], nxt = slot[1];
    __syncthreads();
    f32x4 x[4][4], xn[4][4];
#define CT_LOAD(X_, R0_) { const int t_ = (R0_) >> 14; const float* src_ = A.in[t_ == 0 ? 15 : t_ == 1 ? 16 : t_ == 2 ? 28 : 29] + (size_t)((R0_) & 16383) * DM + 16 * C.lane; \
        _Pragma("unroll") for (int r = 0; r < 4; ++r) _Pragma("unroll") for (int q = 0; q < 4; ++q) X_[r][q] = *(const f32x4*)(src_ + (size_t)r * DM + 4 * q); }
    if (cur < (unsigned)NCH) CT_LOAD(x, (int)cur * 32 + 4 * C.wave)
    while (cur < (unsigned)NCH) {
        const int R0 = (int)cur * 32 + 4 * C.wave;
        if (nxt < (unsigned)NCH) CT_LOAD(xn, (int)nxt * 32 + 4 * C.wave)
        if (C.tid == 0) slot[0] = __hip_atomic_fetch_add(ctr, 1u, __ATOMIC_RELAXED, __HIP_MEMORY_SCOPE_AGENT);
#pragma unroll
        for (int r = 0; r < 4; ++r) {
            float am = 0.f;
#pragma unroll
            for (int q = 0; q < 4; ++q) am = fmaxf(am, fmaxf(fmaxf(fabsf(x[r][q].x), fabsf(x[r][q].y)), fmaxf(fabsf(x[r][q].z), fabsf(x[r][q].w))));
            am = wave_max(am);
            const float sc = (am > 0.f) ? 127.f / am : 1.f, inv = (am > 0.f) ? am * (1.f / 127.f) : 1.f;
            v4u o;
#pragma unroll
            for (int q = 0; q < 4; ++q) { const int q0 = (int)rintf(x[r][q].x * sc), q1 = (int)rintf(x[r][q].y * sc), q2 = (int)rintf(x[r][q].z * sc), q3 = (int)rintf(x[r][q].w * sc);
                o[q] = ((unsigned)q0 & 255u) | (((unsigned)q1 & 255u) << 8) | (((unsigned)q2 & 255u) << 16) | ((unsigned)q3 << 24); }
            *(v4u*)(T8 + (size_t)(R0 + r) * DM + 16 * C.lane) = o;
            if (C.lane == 0) TS[tsc_index(R0 + r)] = inv;
        }
        __syncthreads();
        const unsigned nn = slot[0];
        __syncthreads();
#pragma unroll
        for (int r = 0; r < 4; ++r)
#pragma unroll
            for (int q = 0; q < 4; ++q) x[r][q] = xn[r][q];
        cur = nxt; nxt = nn;
    }
#undef CT_LOAD
}
__device__ __forceinline__ void convert_row_int8(const Ctx& C, const Args& A, const f32x4 (&x)[4], int R) {
    unsigned char* T8 = A.ws + WS_TAB; float* TS = (float*)(A.ws + WS_TSC);
    float am = 0.f;
#pragma unroll
    for (int q = 0; q < 4; ++q) am = fmaxf(am, fmaxf(fmaxf(fabsf(x[q].x), fabsf(x[q].y)), fmaxf(fabsf(x[q].z), fabsf(x[q].w))));
    am = wave_max(am);
    const float sc = (am > 0.f) ? 127.f / am : 1.f, inv = (am > 0.f) ? am * (1.f / 127.f) : 1.f;
    v4u o;
#pragma unroll
    for (int q = 0; q < 4; ++q) {
        const unsigned u0 = __float_as_uint(__builtin_fmaf(x[q].x, sc, 12582912.f)), u1 = __float_as_uint(__builtin_fmaf(x[q].y, sc, 12582912.f));
        const unsigned u2 = __float_as_uint(__builtin_fmaf(x[q].z, sc, 12582912.f)), u3 = __float_as_uint(__builtin_fmaf(x[q].w, sc, 12582912.f));
        o[q] = __builtin_amdgcn_perm(__builtin_amdgcn_perm(u3, u2, 0x0C0C0400u), __builtin_amdgcn_perm(u1, u0, 0x0C0C0400u), 0x05040100u); }
    *(v4u*)(T8 + (size_t)R * DM + 16 * C.lane) = o;
    if (C.lane == 0) TS[tsc_index(R)] = inv;
}
constexpr size_t WS_NL = 3 * MiB, WS_NP = WS_NL + 512 * 1024;
constexpr size_t WS_GC = WS_MOD + 512 * 1024, WS_ML = WS_GC + 4096, WS_MP = WS_ML + 4096;
constexpr size_t OUT_SL = 0, OUT_SP = 64 * MiB;
typedef short s16x4 __attribute__((ext_vector_type(4)));
__device__ __forceinline__ unsigned offb(unsigned row, unsigned ch) { return 256u * row + 16u * (ch ^ (((row & 3u) << 2) | ((row >> 2) & 3u))); }
__device__ __forceinline__ s16x4 tr_read4(unsigned lds_addr) { s16x4 r; asm volatile("ds_read_b64_tr_b16 %0, %1\n\ts_waitcnt lgkmcnt(0)" : "=&v"(r) : "v"(lds_addr) : "memory"); return r; }
__device__ __forceinline__ void tr_read4x2(s16x4& r0, s16x4& r1, unsigned a0, unsigned a1) {
    asm volatile("ds_read_b64_tr_b16 %0, %2\n\tds_read_b64_tr_b16 %1, %3\n\ts_waitcnt lgkmcnt(0)" : "=&v"(r0), "=&v"(r1) : "v"(a0), "v"(a1) : "memory"); }
__device__ __forceinline__ void tr_read4x6(s16x4 (&r)[6], unsigned a0, unsigned a1, unsigned a2, unsigned a3, unsigned a4, unsigned a5) {
    asm volatile("ds_read_b64_tr_b16 %0, %6\n\tds_read_b64_tr_b16 %1, %7\n\tds_read_b64_tr_b16 %2, %8\n\tds_read_b64_tr_b16 %3, %9\n\tds_read_b64_tr_b16 %4, %10\n\tds_read_b64_tr_b16 %5, %11\n\ts_waitcnt lgkmcnt(0)"
                 : "=&v"(r[0]), "=&v"(r[1]), "=&v"(r[2]), "=&v"(r[3]), "=&v"(r[4]), "=&v"(r[5]) : "v"(a0), "v"(a1), "v"(a2), "v"(a3), "v"(a4), "v"(a5) : "memory"); }
__device__ __forceinline__ void tr_read4x8(s16x4 (&r)[8], unsigned a0, unsigned a1, unsigned a2, unsigned a3, unsigned a4, unsigned a5, unsigned a6, unsigned a7) {
    asm volatile("ds_read_b64_tr_b16 %0, %8\n\tds_read_b64_tr_b16 %1, %9\n\tds_read_b64_tr_b16 %2, %10\n\tds_read_b64_tr_b16 %3, %11\n\tds_read_b64_tr_b16 %4, %12\n\tds_read_b64_tr_b16 %5, %13\n\tds_read_b64_tr_b16 %6, %14\n\tds_read_b64_tr_b16 %7, %15\n\ts_waitcnt lgkmcnt(0)"
                 : "=&v"(r[0]), "=&v"(r[1]), "=&v"(r[2]), "=&v"(r[3]), "=&v"(r[4]), "=&v"(r[5]), "=&v"(r[6]), "=&v"(r[7]) : "v"(a0), "v"(a1), "v"(a2), "v"(a3), "v"(a4), "v"(a5), "v"(a6), "v"(a7) : "memory"); }
__device__ __forceinline__ float scan_sum64(float v, int lane) {
#pragma unroll
    for (int o = 1; o < 64; o <<= 1) { const float t = __shfl_up(v, o); if (lane >= o) v += t; }
    return v;
}
__device__ __forceinline__ float scan_max64(float v, int lane) {
#pragma unroll
    for (int o = 1; o < 64; o <<= 1) { const float t = __shfl_up(v, o); if (lane >= o) v = fmaxf(v, t); }
    return v;
}
__device__ __forceinline__ pg8::bf16x8 mk_frag(s16x4 a, s16x4 b) { return (pg8::bf16x8){a[0], a[1], a[2], a[3], b[0], b[1], b[2], b[3]}; }

__device__ __forceinline__ void phase_mlstm_local(const Ctx& C, const Args& A) {
    const bf16* P = (const bf16*)(A.ws + WS_BIG);
    const float* LF = (const float*)(A.ws + WS_LF); const float* LI = (const float*)(A.ws + WS_LI);
    bf16* SL = (bf16*)((unsigned char*)A.out + OUT_SL); float* NL = (float*)(A.ws + WS_NL);
    float* GC = (float*)(A.ws + WS_GC); float* ML = (float*)(A.ws + WS_ML);
    LAS unsigned char* tK = C.lds; LAS unsigned char* tV = C.lds + 32768; LAS float* wtab = (LAS float*)(C.lds + 65536);
    const unsigned ldsK = (unsigned)(uintptr_t)tK, ldsV = (unsigned)(uintptr_t)tV;
    const int lane = C.lane, wid = C.wave, tid = C.tid;
    v4u kvr[4], vvr[4]; float2 lfr = {0.f, 0.f}, lir = {0.f, 0.f};
#define ML_PREFETCH(unit_) { const int bh_ = (unit_) >> 5, c_ = (unit_) & 31; const size_t tk_ = (size_t)(bh_ >> 2) * SEQ + c_ * 128; \
        _Pragma("unroll") for (int i = 0; i < 4; ++i) { const int id = tid + 512 * i, row = id >> 4, ch = id & 15; const bf16* src = P + (tk_ + row) * INP + (bh_ & 3) * 128 + ch * 8; \
            kvr[i] = *(const v4u*)(src + 512); vvr[i] = *(const v4u*)(src + 1024); } \
        if (wid == 0) { lfr = *(const float2*)(LF + (size_t)bh_ * SEQ + c_ * 128 + 2 * lane); lir = *(const float2*)(LI + (size_t)bh_ * SEQ + c_ * 128 + 2 * lane); } }
    if (C.bid < 1024) ML_PREFETCH(C.bid)
    for (int unit = C.bid; unit < 1024; unit += C.G) {
        const int bh = unit >> 5, c = unit & 31, b = bh >> 2, hh = bh & 3;
        const size_t tok0 = (size_t)b * SEQ + c * 128;
        if (wid == 0) {
            const float2 lf = lfr, li = lir;
            const float pr = lf.x + lf.y, inc = scan_sum64(pr, lane), ex = inc - pr;
            const float b0 = ex + lf.x, b1 = b0 + lf.y;
            const float g = __shfl(inc, 63);
            const float a0 = g - b0 + li.x, a1 = g - b1 + li.y;
            const float mloc = wave_max(fmaxf(a0, a1));
            wtab[2 * lane] = __expf(a0 - mloc); wtab[2 * lane + 1] = __expf(a1 - mloc);
            if (lane == 0) { GC[unit] = g; ML[unit] = mloc; }
        }
        __syncthreads();
#pragma unroll
        for (int i = 0; i < 4; ++i) { const int id = tid + 512 * i, row = id >> 4, ch = id & 15;
            const v4u kv = kvr[i], vv = vvr[i];
            const float w = wtab[row];
            v4u ko; ko.x = pk2(bflo(kv.x) * w, bfhi(kv.x) * w); ko.y = pk2(bflo(kv.y) * w, bfhi(kv.y) * w); ko.z = pk2(bflo(kv.z) * w, bfhi(kv.z) * w); ko.w = pk2(bflo(kv.w) * w, bfhi(kv.w) * w);
            *(LAS v4u*)(tK + offb(row, ch)) = ko; *(LAS v4u*)(tV + offb(row, ch)) = vv; }
        if (unit + C.G < 1024) ML_PREFETCH(unit + C.G)
        __syncthreads();
        if (tid < 128) { const int d = tid; float s = 0.f;
#pragma unroll 8
            for (int l = 0; l < 128; ++l) s += bf2f(*(const LAS unsigned short*)(tK + offb(l, d >> 3) + (d & 7) * 2));
            NL[(size_t)unit * 128 + d] = s; }
        {
            const int db = wid & 3, eh = wid >> 2;
            const unsigned h = lane >> 5, blk = (lane >> 4) & 1, q = (lane & 15) >> 2, p = lane & 3;
            f32x16 acc[2];
#pragma unroll
            for (int eb = 0; eb < 2; ++eb)
#pragma unroll
                for (int r = 0; r < 16; ++r) acc[eb][r] = 0.f;
#pragma unroll
            for (int ks = 0; ks < 8; ++ks) {
                const unsigned r0 = 16 * ks + 8 * h + q, cA = 4 * db + 2 * blk + (p >> 1), cB0 = 4 * (2 * eh) + 2 * blk + (p >> 1), cB1 = cB0 + 4, po = 8 * (p & 1);
                s16x4 t[6];
                tr_read4x6(t, ldsK + offb(r0, cA) + po, ldsK + offb(r0 + 4, cA) + po, ldsV + offb(r0, cB0) + po, ldsV + offb(r0 + 4, cB0) + po, ldsV + offb(r0, cB1) + po, ldsV + offb(r0 + 4, cB1) + po);
                const pg8::bf16x8 af = mk_frag(t[0], t[1]);
                acc[0] = __builtin_amdgcn_mfma_f32_32x32x16_bf16(af, mk_frag(t[2], t[3]), acc[0], 0, 0, 0);
                acc[1] = __builtin_amdgcn_mfma_f32_32x32x16_bf16(af, mk_frag(t[4], t[5]), acc[1], 0, 0, 0);
            }
            const int hi = lane >> 5;
#pragma unroll
            for (int eb = 0; eb < 2; ++eb) { const int e = 32 * (2 * eh + eb) + (lane & 31);
#pragma unroll
                for (int g4 = 0; g4 < 4; ++g4) { uint2 o; o.x = pk2(acc[eb][4 * g4], acc[eb][4 * g4 + 1]); o.y = pk2(acc[eb][4 * g4 + 2], acc[eb][4 * g4 + 3]);
                    *(uint2*)(SL + ((size_t)unit * 128 + e) * 128 + 32 * db + 8 * g4 + 4 * hi) = o; } }
        }
        __syncthreads();
    }
}
#undef ML_PREFETCH

__device__ __forceinline__ void phase_mlstm_scan(const Ctx& C, const Args& A) {
    const bf16* SL = (const bf16*)((unsigned char*)A.out + OUT_SL); bf16* SP = (bf16*)((unsigned char*)A.out + OUT_SP);
    const float* NL = (const float*)(A.ws + WS_NL); float* NP = (float*)(A.ws + WS_NP);
    const float* GC = (const float*)(A.ws + WS_GC); const float* ML = (const float*)(A.ws + WS_ML); float* MP = (float*)(A.ws + WS_MP);
    for (long it = C.gt; it < 32L * 128 * 32; it += C.NGT) {
        const int d4 = (int)(it & 31), e = (int)((it >> 5) & 127), bh = (int)(it >> 12);
        f32x4 s = {0.f, 0.f, 0.f, 0.f}, n = {0.f, 0.f, 0.f, 0.f}; float m = 0.f;
        const bool do_n = (e == 0);
#pragma unroll 1
        for (int c0 = 0; c0 < 32; c0 += 16) {
            uint2 xw[16]; float gq[16], mq[16];
#pragma unroll
            for (int k = 0; k < 16; ++k) { const size_t unit = (size_t)bh * 32 + c0 + k;
                xw[k] = *(const uint2*)(SL + (unit * 128 + e) * 128 + 4 * d4); gq[k] = GC[unit]; mq[k] = ML[unit]; }
#pragma unroll
            for (int k = 0; k < 16; ++k) {
                const size_t unit = (size_t)bh * 32 + c0 + k;
                uint2 o; o.x = pk2(s.x, s.y); o.y = pk2(s.z, s.w);
                *(uint2*)(SP + (unit * 128 + e) * 128 + 4 * d4) = o;
                if (do_n) { *(f32x4*)(NP + unit * 128 + 4 * d4) = n; if (d4 == 0) MP[unit] = m; }
                const float g = gq[k], ml = mq[k];
                const float mn = fmaxf(g + m, ml), dec = __expf(g + m - mn), sc = __expf(ml - mn);
                const f32x4 x = {bflo(xw[k].x), bfhi(xw[k].x), bflo(xw[k].y), bfhi(xw[k].y)};
                s = s * dec + x * sc;
                if (do_n) { const f32x4 y = *(const f32x4*)(NL + unit * 128 + 4 * d4); n = n * dec + y * sc; }
                m = mn;
            }
        }
    }
}

__device__ __forceinline__ void phase_mlstm_out(const Ctx& C, const Args& A) {
    const bf16* P = (const bf16*)(A.ws + WS_BIG); bf16* mix = (bf16*)(A.ws + WS_H);
    const float* LF = (const float*)(A.ws + WS_LF); const float* LI = (const float*)(A.ws + WS_LI);
    const bf16* SP = (const bf16*)((unsigned char*)A.out + OUT_SP); const float* NP = (const float*)(A.ws + WS_NP); const float* MP = (const float*)(A.ws + WS_MP);
    const float* gain = A.in[9];
    LAS unsigned char* tV = C.lds; LAS unsigned char* tK = C.lds + 32768; LAS float* abt = (LAS float*)(C.lds + 65536); LAS float* Mt = abt + 128; LAS float* bt = abt + 256; LAS float* npt = abt + 384; LAS float* ssq = abt + 512;
    const unsigned ldsV = (unsigned)(uintptr_t)tV;
    const int lane = C.lane, wid = C.wave, tid = C.tid, hi = lane >> 5, l31 = lane & 31;
    constexpr float QS = 0.08838834764831845f;
    const int eh = wid >> 2, lb = eh ? 3 - (wid & 3) : (wid & 3);
    const int l = 32 * lb + l31;
    v4u vvr[4], kvr[4]; pg8::bf16x8 qf[8]; float mprev_n = 0.f; float2 lfr = {0.f, 0.f}, lir = {0.f, 0.f}, npr = {0.f, 0.f};
#define MO_PREFETCH(unit_) { const int bh_ = (unit_) >> 5, c_ = (unit_) & 31; const size_t tk_ = (size_t)(bh_ >> 2) * SEQ + c_ * 128; const int hh_ = bh_ & 3; \
        _Pragma("unroll") for (int i = 0; i < 4; ++i) { const int id = tid + 512 * i, row = id >> 4, ch = id & 15; const bf16* src = P + (tk_ + row) * INP + hh_ * 128 + ch * 8; \
            vvr[i] = *(const v4u*)(src + 1024); kvr[i] = *(const v4u*)(src + 512); } \
        _Pragma("unroll") for (int ks = 0; ks < 8; ++ks) qf[ks] = *(const pg8::bf16x8*)(P + (tk_ + l) * INP + hh_ * 128 + 16 * ks + 8 * hi); \
        mprev_n = MP[(unit_)]; \
        if (wid == 0) { lfr = *(const float2*)(LF + (size_t)bh_ * SEQ + c_ * 128 + 2 * lane); lir = *(const float2*)(LI + (size_t)bh_ * SEQ + c_ * 128 + 2 * lane); } \
        if (wid == 1) npr = *(const float2*)(NP + (size_t)(unit_) * 128 + 2 * lane); }
    if (C.bid < 1024) MO_PREFETCH(C.bid)
    for (int unit = C.bid; unit < 1024; unit += C.G) {
        const int bh = unit >> 5, c = unit & 31, b = bh >> 2, hh = bh & 3;
        const size_t tok0 = (size_t)b * SEQ + c * 128;
        const float mprev = mprev_n;
        pg8::bf16x8 spf[2][8];
#pragma unroll
        for (int eb = 0; eb < 2; ++eb) { const bf16* sp = SP + ((size_t)unit * 128 + 32 * (2 * eh + eb) + l31) * 128 + 8 * hi;
#pragma unroll
            for (int ks = 0; ks < 8; ++ks) spf[eb][ks] = *(const pg8::bf16x8*)(sp + 16 * ks); }
        if (wid == 0) {
            const float2 lf = lfr, li = lir;
            const float pr = lf.x + lf.y, inc = scan_sum64(pr, lane), ex = inc - pr;
            const float b0 = ex + lf.x, b1 = b0 + lf.y;
            const float ab0 = li.x - b0, ab1 = li.y - b1;
            const float pmx = scan_max64(fmaxf(ab0, ab1), lane);
            float pme = __shfl_up(pmx, 1); if (lane == 0) pme = -INFINITY;
            const float pm0 = fmaxf(pme, ab0), pm1 = fmaxf(pm0, ab1);
            abt[2 * lane] = ab0; abt[2 * lane + 1] = ab1; bt[2 * lane] = b0; bt[2 * lane + 1] = b1;
            Mt[2 * lane] = fmaxf(mprev, pm0); Mt[2 * lane + 1] = fmaxf(mprev, pm1);
        }
        if (wid == 1) { npt[2 * lane] = npr.x; npt[2 * lane + 1] = npr.y; }
#pragma unroll
        for (int i = 0; i < 4; ++i) { const int id = tid + 512 * i, row = id >> 4, ch = id & 15;
            *(LAS v4u*)(tV + offb(row, ch)) = vvr[i]; *(LAS v4u*)(tK + offb(row, ch)) = kvr[i]; }
        __syncthreads();
        const float Ml = Mt[l], iw = __expf(mprev - Ml) * QS;
        float qn = 0.f;
#pragma unroll
        for (int ks = 0; ks < 8; ++ks)
#pragma unroll
            for (int j = 0; j < 8; ++j) qn += bf2f((unsigned short)qf[ks][j]) * npt[16 * ks + 8 * hi + j];
        qn += lane_xor32(qn, lane);
        f32x16 acc[2];
#pragma unroll
        for (int eb = 0; eb < 2; ++eb) {
#pragma unroll
            for (int r = 0; r < 16; ++r) acc[eb][r] = 0.f;
#pragma unroll
            for (int ks = 0; ks < 8; ++ks) acc[eb] = __builtin_amdgcn_mfma_f32_32x32x16_bf16(spf[eb][ks], qf[ks], acc[eb], 0, 0, 0);
#pragma unroll
            for (int r = 0; r < 16; ++r) acc[eb][r] *= iw;
        }
        uint2 owr[2][4]; f32x4 gnr[2][4];
#pragma unroll
        for (int eb = 0; eb < 2; ++eb)
#pragma unroll
            for (int g4 = 0; g4 < 4; ++g4) { const int e = 32 * (2 * eh + eb) + 8 * g4 + 4 * hi;
                owr[eb][g4] = *(const uint2*)(P + (tok0 + l) * INP + 1536 + hh * 128 + e); gnr[eb][g4] = *(const f32x4*)(gain + hh * 128 + e); }
        float den = 0.f;
        const unsigned g16 = lane >> 4, blk = g16 & 1, q = (lane & 15) >> 2, p = lane & 3;
        for (int sb = 0; sb <= lb; ++sb) {
            f32x16 X;
#pragma unroll
            for (int r = 0; r < 16; ++r) X[r] = 0.f;
#pragma unroll
            for (int ks = 0; ks < 8; ++ks) X = __builtin_amdgcn_mfma_f32_32x32x16_bf16(*(const LAS pg8::bf16x8*)(tK + offb(32 * sb + l31, 2 * ks + hi)), qf[ks], X, 0, 0, 0);
            float pv[16];
#pragma unroll
            for (int r = 0; r < 16; ++r) { const int s = 32 * sb + (r & 3) + 8 * (r >> 2) + 4 * hi;
                const float v = X[r] * QS * __expf(abt[s] - Ml);
                pv[r] = (s <= l) ? v : 0.f; den += pv[r]; }
            pg8::bf16x8 pf[2];
#pragma unroll
            for (int st = 0; st < 2; ++st) { v4u t; t.x = pk2(pv[8 * st], pv[8 * st + 1]); t.y = pk2(pv[8 * st + 2], pv[8 * st + 3]); t.z = pk2(pv[8 * st + 4], pv[8 * st + 5]); t.w = pk2(pv[8 * st + 6], pv[8 * st + 7]);
                pf[st] = __builtin_bit_cast(pg8::bf16x8, t); }
            { const unsigned c0 = 4 * (2 * eh) + 2 * blk + (p >> 1), c1 = c0 + 4, ra = 32 * sb + 4 * hi + q, po = 8 * (p & 1);
              s16x4 t[8];
              tr_read4x8(t, ldsV + offb(ra, c0) + po, ldsV + offb(ra + 8, c0) + po, ldsV + offb(ra + 16, c0) + po, ldsV + offb(ra + 24, c0) + po,
                            ldsV + offb(ra, c1) + po, ldsV + offb(ra + 8, c1) + po, ldsV + offb(ra + 16, c1) + po, ldsV + offb(ra + 24, c1) + po);
#pragma unroll
              for (int eb = 0; eb < 2; ++eb)
#pragma unroll
                  for (int st = 0; st < 2; ++st) acc[eb] = __builtin_amdgcn_mfma_f32_32x32x16_bf16(mk_frag(t[4 * eb + 2 * st], t[4 * eb + 2 * st + 1]), pf[st], acc[eb], 0, 0, 0); }
        }
        if (unit + C.G < 1024) MO_PREFETCH(unit + C.G)
        den += lane_xor32(den, lane);
        den += iw * qn;
        const float dn = 1.f / fmaxf(fabsf(den), __expf(-(bt[l] + Ml)));
        float ss = 0.f;
#pragma unroll
        for (int eb = 0; eb < 2; ++eb)
#pragma unroll
            for (int r = 0; r < 16; ++r) { acc[eb][r] *= dn; ss += acc[eb][r] * acc[eb][r]; }
        ss += lane_xor32(ss, lane);
        if (hi == 0) ssq[eh * 128 + l] = ss;
        __syncthreads();
        const float rstd = rsqrtf((ssq[l] + ssq[128 + l]) * (1.f / 128.f) + EPS);
#pragma unroll
        for (int eb = 0; eb < 2; ++eb)
#pragma unroll
            for (int g4 = 0; g4 < 4; ++g4) { const int e = 32 * (2 * eh + eb) + 8 * g4 + 4 * hi;
                const uint2 ow = owr[eb][g4]; const f32x4 gn = gnr[eb][g4];
                uint2 o; o.x = pk2(acc[eb][4 * g4] * rstd * gn.x * sigmoidf_(bflo(ow.x)), acc[eb][4 * g4 + 1] * rstd * gn.y * sigmoidf_(bfhi(ow.x)));
                o.y = pk2(acc[eb][4 * g4 + 2] * rstd * gn.z * sigmoidf_(bflo(ow.y)), acc[eb][4 * g4 + 3] * rstd * gn.w * sigmoidf_(bfhi(ow.y)));
                *(uint2*)(mix + (tok0 + l) * DM + hh * 128 + e) = o; }
        __syncthreads();
    }
}
#undef MO_PREFETCH
template <bool I8>
struct EpiQKV {
    static constexpr bool PERM = true, AFTER_DRAIN = false;
    bf16* O; bf16* KF; bf16* VH; const float* qg; const float* kg; const float* sa; const float* sw;
    __device__ __forceinline__ void operator()(const typename pg8::AccSel<I8>::type (&acc)[2][2][4][2], const pg8::Unit& u, int wr, int wc, int fr, int fq) const {
        using pg8::f32x4;
        f32x4 cs[2][2];
#pragma unroll
        for (int bj = 0; bj < 2; ++bj)
#pragma unroll
            for (int n = 0; n < 2; ++n) cs[bj][n] = I8 ? *(const f32x4*)(sw + u.pn * 256 + 128 * bj + 32 * wc + 8 * fq + 4 * n) : (f32x4){1.f, 1.f, 1.f, 1.f};
        const int kind = u.pn >> 2;
        const float* gp = (kind == 0) ? qg : kg;
        const float post = (kind == 0) ? 0.125f * 1.4426950408889634f : 1.0f;
        f32x4 gv[2][2];
#pragma unroll
        for (int bj = 0; bj < 2; ++bj)
#pragma unroll
            for (int n = 0; n < 2; ++n) gv[bj][n] = (kind < 2) ? *(const f32x4*)(gp + 32 * bj + 8 * fq + 4 * n) * post : (f32x4){1.f, 1.f, 1.f, 1.f};
#pragma unroll
        for (int ai = 0; ai < 2; ++ai)
#pragma unroll
            for (int m = 0; m < 4; ++m) {
                const int row = u.pm * 256 + ai * 128 + wr * 64 + m * 16 + fr;
                f32x4 xv[2][2]; float ss = 0.f;
                { const float rsc = I8 ? sa[row] : 1.f;
#pragma unroll
                  for (int bj = 0; bj < 2; ++bj)
#pragma unroll
                      for (int n = 0; n < 2; ++n) { const auto a = acc[ai][bj][m][n]; const f32x4 x = (f32x4){(float)a[0], (float)a[1], (float)a[2], (float)a[3]} * cs[bj][n] * rsc; xv[bj][n] = x;
                          ss += (x[0] * x[0] + x[1] * x[1]) + (x[2] * x[2] + x[3] * x[3]); } }
                { const int ln_ = (int)(threadIdx.x & 63); ss += lane_xor16(ss, ln_); ss += lane_xor32(ss, ln_); }
                const float rs = (kind < 2) ? rsqrtf(ss * (1.f / 64.f) + EPS) : 1.0f;
                bf16* dst = (kind == 1) ? KF + ((size_t)(((row >> 12) * 16 + (u.pn - 4) * 4 + wc) * 128 + ((row & 4095) >> 5)) * 2048 + (size_t)((fq >> 1) * 512 + ((fq & 1) * 32 + (row & 31)) * 8))
                                        : (kind == 2) ? VH + ((size_t)(((row >> 12) * 16 + (u.pn & 3) * 4 + wc) * 4096 + (row & 4095)) * 64 + 8 * fq)
                                        : O + (size_t)row * 1024 + (u.pn & 3) * 256 + 64 * wc + 8 * fq;
                const int bjstep = (kind == 1) ? 1024 : 32;
#pragma unroll
                for (int bj = 0; bj < 2; ++bj) { const f32x4 v0 = xv[bj][0] * gv[bj][0] * rs, v1 = xv[bj][1] * gv[bj][1] * rs;
                    v4u w; w.x = pk2(v0[0], v0[1]); w.y = pk2(v0[2], v0[3]); w.z = pk2(v1[0], v1[1]); w.w = pk2(v1[2], v1[3]);
                    *(v4u*)(dst + bjstep * bj) = w; }
            }
    }
};

__device__ __forceinline__ unsigned voff(unsigned row, unsigned ch) { return row * 128u + 16u * (ch ^ (row & 7u)); }
__device__ __forceinline__ void phase_attn(const Ctx& C, const Args& A) {
    const bf16* QV = (const bf16*)(A.ws + WS_BIG); const bf16* KF = (const bf16*)(A.ws + WS_BIG + 64 * MiB); const bf16* VH = (const bf16*)(A.ws + WS_BIG + 128 * MiB); bf16* O = (bf16*)(A.ws + WS_H);
    LAS unsigned char* tV = C.lds + C.wave * 4096;
    const unsigned ldsV = (unsigned)(uintptr_t)tV;
    const int lane = C.lane, hi = lane >> 5, l31 = lane & 31;
    const unsigned blk = (lane >> 4) & 1, q4 = (lane & 15) >> 2, p = lane & 3;
    const int per_wave = (16384 + C.NGW - 1) / C.NGW;
    for (int u = C.gw * per_wave; u < C.gw * per_wave + per_wave; ++u) {
        if (u >= 16384) break;
        const int bh = u >> 7, qt = u & 127, b = bh >> 4, hd = bh & 15;
        const size_t tokb = (size_t)b * SEQ;
        const int l = qt * 32 + l31;
        pg8::bf16x8 qf[4];
#pragma unroll
        for (int ks = 0; ks < 4; ++ks) qf[ks] = *(const pg8::bf16x8*)(QV + (tokb + l) * 1024 + hd * 64 + 16 * ks + 8 * hi);
        f32x16 acc[2];
#pragma unroll
        for (int eb = 0; eb < 2; ++eb)
#pragma unroll
            for (int r = 0; r < 16; ++r) acc[eb][r] = 0.f;
        float carry = 1.f;
        pg8::bf16x8 kf[4]; v4u vv[4];
#define ATT_LOAD(kt_) { const size_t s0_ = tokb + (size_t)(kt_) * 32; const bf16* kp_ = KF + ((size_t)(bh * 128 + (kt_)) * 2048 + lane * 8); \
            _Pragma("unroll") for (int ks = 0; ks < 4; ++ks) kf[ks] = *(const pg8::bf16x8*)(kp_ + ks * 512); \
            _Pragma("unroll") for (int i = 0; i < 4; ++i) { const int id = lane + 64 * i; vv[i] = *(const v4u*)(VH + ((size_t)bh * 4096 + (size_t)(kt_) * 32) * 64 + id * 8); } }
        ATT_LOAD(qt)
        for (int kt = qt; kt >= 0; --kt) {
            f32x16 X;
#pragma unroll
            for (int r = 0; r < 16; ++r) X[r] = 0.f;
#pragma unroll
            for (int ks = 0; ks < 4; ++ks) X = __builtin_amdgcn_mfma_f32_32x32x16_bf16(kf[ks], qf[ks], X, 0, 0, 0);
#pragma unroll
            for (int i = 0; i < 4; ++i) { const int id = lane + 64 * i; *(LAS v4u*)(tV + voff(id >> 3, id & 7)) = vv[i]; }
            if (kt > 0) ATT_LOAD(kt - 1)
            const int sbase = kt * 32 + 4 * hi;
            float rr[16];
#pragma unroll
            for (int r = 0; r < 16; ++r) rr[r] = __builtin_amdgcn_rcpf(1.f + __builtin_amdgcn_exp2f(X[r]));
            if (kt == qt) {
#pragma unroll
                for (int r = 0; r < 16; ++r) { const int s = sbase + (r & 3) + 8 * (r >> 2); rr[r] = (s < l) ? rr[r] : 1.f; }
            }
            float To[4], Tp[4];
#pragma unroll
            for (int g = 0; g < 4; ++g) { To[g] = (rr[4 * g] * rr[4 * g + 1]) * (rr[4 * g + 2] * rr[4 * g + 3]); Tp[g] = __shfl_xor(To[g], 32); }
            float base[4]; float run = 1.f;
#pragma unroll
            for (int g = 3; g >= 0; --g) { base[g] = carry * run * (hi == 0 ? Tp[g] : 1.f); run *= To[g] * Tp[g]; }
            float att[16];
#pragma unroll
            for (int g = 0; g < 4; ++g) { float w = base[g];
#pragma unroll
                for (int i = 3; i >= 0; --i) { const int r = 4 * g + i; att[r] = (1.f - rr[r]) * w; w *= rr[r]; } }
            carry *= run;
            pg8::bf16x8 pf[2];
#pragma unroll
            for (int st = 0; st < 2; ++st) { v4u t; t.x = pg8::cvt_pk_bf16(att[8 * st], att[8 * st + 1]); t.y = pg8::cvt_pk_bf16(att[8 * st + 2], att[8 * st + 3]); t.z = pg8::cvt_pk_bf16(att[8 * st + 4], att[8 * st + 5]); t.w = pg8::cvt_pk_bf16(att[8 * st + 6], att[8 * st + 7]);
                pf[st] = __builtin_bit_cast(pg8::bf16x8, t); }
            s16x4 vf[8];
            { const unsigned a0 = ldsV + voff(4 * hi + q4, 2 * blk + (p >> 1)) + 8 * (p & 1), a1 = ldsV + voff(4 * hi + q4 + 8, 2 * blk + (p >> 1)) + 8 * (p & 1);
              const unsigned a2 = ldsV + voff(16 + 4 * hi + q4, 2 * blk + (p >> 1)) + 8 * (p & 1), a3 = ldsV + voff(24 + 4 * hi + q4, 2 * blk + (p >> 1)) + 8 * (p & 1);
              const unsigned a4 = ldsV + voff(4 * hi + q4, 4 + 2 * blk + (p >> 1)) + 8 * (p & 1), a5 = ldsV + voff(4 * hi + q4 + 8, 4 + 2 * blk + (p >> 1)) + 8 * (p & 1);
              const unsigned a6 = ldsV + voff(16 + 4 * hi + q4, 4 + 2 * blk + (p >> 1)) + 8 * (p & 1), a7 = ldsV + voff(24 + 4 * hi + q4, 4 + 2 * blk + (p >> 1)) + 8 * (p & 1);
              asm volatile("ds_read_b64_tr_b16 %0, %8\n\tds_read_b64_tr_b16 %1, %9\n\tds_read_b64_tr_b16 %2, %10\n\tds_read_b64_tr_b16 %3, %11\n\t"
                           "ds_read_b64_tr_b16 %4, %12\n\tds_read_b64_tr_b16 %5, %13\n\tds_read_b64_tr_b16 %6, %14\n\tds_read_b64_tr_b16 %7, %15\n\ts_waitcnt lgkmcnt(0)"
                           : "=&v"(vf[0]), "=&v"(vf[1]), "=&v"(vf[2]), "=&v"(vf[3]), "=&v"(vf[4]), "=&v"(vf[5]), "=&v"(vf[6]), "=&v"(vf[7])
                           : "v"(a0), "v"(a1), "v"(a2), "v"(a3), "v"(a4), "v"(a5), "v"(a6), "v"(a7) : "memory"); }
#pragma unroll
            for (int eb = 0; eb < 2; ++eb)
#pragma unroll
                for (int st = 0; st < 2; ++st) acc[eb] = __builtin_amdgcn_mfma_f32_32x32x16_bf16(mk_frag(vf[4 * eb + 2 * st], vf[4 * eb + 2 * st + 1]), pf[st], acc[eb], 0, 0, 0);
            if (__all(carry == 0.f)) break;
        }
#undef ATT_LOAD
#pragma unroll
        for (int eb = 0; eb < 2; ++eb)
#pragma unroll
            for (int g4 = 0; g4 < 4; ++g4) { const u32x2 o = {pk2(acc[eb][4 * g4], acc[eb][4 * g4 + 1]), pk2(acc[eb][4 * g4 + 2], acc[eb][4 * g4 + 3])};
                const unsigned c8 = (unsigned)(8 * eb + 2 * g4 + hi);
                *(LAS u32x2*)(tV + l31 * 128 + ((c8 ^ ((unsigned)(l31 & 7) << 1)) << 3)) = o; }
        asm volatile("s_waitcnt lgkmcnt(0)" ::: "memory");
#pragma unroll
        for (int i = 0; i < 4; ++i) { const int id = lane + 64 * i, rr = id >> 3, q = id & 7;
            const v4u w = *(const LAS v4u*)(tV + rr * 128 + (((unsigned)(2 * q) ^ ((unsigned)(rr & 7) << 1)) << 3));
            *(v4u*)(O + (tokb + qt * 32 + rr) * DM + hd * 64 + 8 * q) = w; }
        asm volatile("s_waitcnt lgkmcnt(0)" ::: "memory");
    }
}

#ifndef ATT_WIN
#define ATT_WIN 6
#endif
__device__ __forceinline__ void phase_attn_ring(const Ctx& C, const Args& A) {
    const bf16* QV = (const bf16*)(A.ws + WS_BIG); const bf16* KF = (const bf16*)(A.ws + WS_BIG + 64 * MiB); const bf16* VH = (const bf16*)(A.ws + WS_BIG + 128 * MiB); bf16* O = (bf16*)(A.ws + WS_H);
    LAS unsigned char* ring = C.lds;
    LAS unsigned char* tV = C.lds + (C.wave < 4 ? 114688 + C.wave * 4096 : 147456 + (C.wave - 4) * 4096);
    const unsigned ldsR = (unsigned)(uintptr_t)ring, ldsP = (unsigned)(uintptr_t)tV;
    const int lane = C.lane, hi = lane >> 5, l31 = lane & 31;
    const unsigned blk = (lane >> 4) & 1, q4 = (lane & 15) >> 2, p = lane & 3;
    const unsigned trA = voff(4 * hi + q4, 2 * blk + (p >> 1)) + 8 * (p & 1), trB = voff(4 * hi + q4, 4 + 2 * blk + (p >> 1)) + 8 * (p & 1);
    const int nblk = C.G, per = (2048 + nblk - 1) / nblk;
    const int bu_lo = C.bid * per, bu_hi = (bu_lo + per < 2048) ? bu_lo + per : 2048;
    if (bu_lo >= bu_hi) return;
    const int cidx = C.tid & 255; const bool isV = C.tid >= 256;
    const bf16* srcb = (isV ? VH : KF) + cidx * 8;
    const unsigned dstoff = isV ? 4096u + voff((unsigned)cidx >> 3, (unsigned)cidx & 7) : (unsigned)cidx * 16u;
    pg8::bf16x8 qf[4];
    {
        const int bh = bu_lo >> 4, G = bu_lo & 15;
        for (int t = 8 * G - 6; t <= 8 * G + 7; ++t) if (t >= 0) { const v4u w = *(const v4u*)(srcb + (size_t)(bh * 128 + t) * 2048); *(LAS v4u*)(ring + (t % 14) * 8192 + dstoff) = w; }
        const int qt = 8 * G + C.wave; const size_t row = (size_t)(bh >> 4) * SEQ + qt * 32 + l31;
#pragma unroll
        for (int ks = 0; ks < 4; ++ks) qf[ks] = *(const pg8::bf16x8*)(QV + row * 1024 + (bh & 15) * 64 + 16 * ks + 8 * hi);
    }
    __syncthreads();
    for (int bu = bu_lo; bu < bu_hi; ++bu) {
        const int bh = bu >> 4, G = bu & 15, b = bh >> 4, hd = bh & 15;
        const int qt = 8 * G + C.wave;
        const size_t tokb = (size_t)b * SEQ;
        const int l = qt * 32 + l31;
        const bool more = bu + 1 < bu_hi; const int nbh = (bu + 1) >> 4, nG = (bu + 1) & 15;
        v4u st[8]; pg8::bf16x8 qn[4];
        if (more) {
#pragma unroll
            for (int i = 0; i < 8; ++i) st[i] = *(const v4u*)(srcb + (size_t)(nbh * 128 + 8 * nG + i) * 2048);
            const size_t row = (size_t)(nbh >> 4) * SEQ + (8 * nG + C.wave) * 32 + l31;
#pragma unroll
            for (int ks = 0; ks < 4; ++ks) qn[ks] = *(const pg8::bf16x8*)(QV + row * 1024 + (nbh & 15) * 64 + 16 * ks + 8 * hi);
        }
        const int trow = 2 * 16384 + 16 * bu + 2 * C.wave;
        f32x4 tx0[4], tx1[4];
        { const float* src = A.in[(trow >> 14) == 2 ? 28 : 29] + (size_t)(trow & 16383) * DM + 16 * lane;
#pragma unroll
          for (int q = 0; q < 4; ++q) { tx0[q] = *(const f32x4*)(src + 4 * q); tx1[q] = *(const f32x4*)(src + DM + 4 * q); } }
        f32x16 acc[2];
#pragma unroll
        for (int eb = 0; eb < 2; ++eb)
#pragma unroll
            for (int r = 0; r < 16; ++r) acc[eb][r] = 0.f;
        float carry = 1.f;
        const int lowt = (8 * G - ATT_WIN > 0) ? 8 * G - ATT_WIN : 0;
        int slot = qt % 14;
        pg8::bf16x8 kf[4];
#define ATT_KLOAD(kt_, slot_) { if ((kt_) >= lowt) { const LAS unsigned char* sp_ = ring + (slot_) * 8192 + lane * 16; \
                _Pragma("unroll") for (int ks = 0; ks < 4; ++ks) kf[ks] = *(const LAS pg8::bf16x8*)(sp_ + ks * 1024); } \
            else { const bf16* kp_ = KF + ((size_t)(bh * 128 + (kt_)) * 2048 + lane * 8); \
                _Pragma("unroll") for (int ks = 0; ks < 4; ++ks) kf[ks] = *(const pg8::bf16x8*)(kp_ + ks * 512); } }
        ATT_KLOAD(qt, slot)
        for (int kt = qt; kt >= 0; --kt) {
            unsigned vb;
            if (kt >= lowt) vb = ldsR + (unsigned)slot * 8192u + 4096u;
            else {
#pragma unroll
                for (int i = 0; i < 4; ++i) { const int id = lane + 64 * i; const v4u w = *(const v4u*)(VH + ((size_t)bh * 4096 + (size_t)kt * 32) * 64 + id * 8); *(LAS v4u*)(tV + voff(id >> 3, id & 7)) = w; }
                vb = ldsP;
            }
            slot = slot == 0 ? 13 : slot - 1;
            f32x16 X;
#pragma unroll
            for (int r = 0; r < 16; ++r) X[r] = 0.f;
#pragma unroll
            for (int ks = 0; ks < 4; ++ks) X = __builtin_amdgcn_mfma_f32_32x32x16_bf16(kf[ks], qf[ks], X, 0, 0, 0);
            if (kt > 0) ATT_KLOAD(kt - 1, slot)
            s16x4 vf[8];
            { const unsigned a0 = vb + trA, a4 = vb + trB;
              asm volatile("ds_read_b64_tr_b16 %0, %8\n\tds_read_b64_tr_b16 %1, %8 offset:1024\n\tds_read_b64_tr_b16 %2, %8 offset:2048\n\tds_read_b64_tr_b16 %3, %8 offset:3072\n\t"
                           "ds_read_b64_tr_b16 %4, %9\n\tds_read_b64_tr_b16 %5, %9 offset:1024\n\tds_read_b64_tr_b16 %6, %9 offset:2048\n\tds_read_b64_tr_b16 %7, %9 offset:3072\n\ts_waitcnt lgkmcnt(0)"
                           : "=&v"(vf[0]), "=&v"(vf[1]), "=&v"(vf[2]), "=&v"(vf[3]), "=&v"(vf[4]), "=&v"(vf[5]), "=&v"(vf[6]), "=&v"(vf[7])
                           : "v"(a0), "v"(a4) : "memory"); }
            const int sbase = kt * 32 + 4 * hi;
            float rr[16];
#pragma unroll
            for (int r = 0; r < 16; ++r) rr[r] = __builtin_amdgcn_rcpf(1.f + __builtin_amdgcn_exp2f(X[r]));
            if (kt == qt) {
#pragma unroll
                for (int r = 0; r < 16; ++r) { const int s = sbase + (r & 3) + 8 * (r >> 2); rr[r] = (s < l) ? rr[r] : 1.f; }
            }
            float To[4], Tp[4];
#pragma unroll
            for (int g = 0; g < 4; ++g) { To[g] = (rr[4 * g] * rr[4 * g + 1]) * (rr[4 * g + 2] * rr[4 * g + 3]); const auto sw_ = __builtin_amdgcn_permlane32_swap(__float_as_uint(To[g]), __float_as_uint(To[g]), false, false); Tp[g] = __uint_as_float(hi ? sw_[0] : sw_[1]); }
            float base[4]; float run = 1.f;
#pragma unroll
            for (int g = 3; g >= 0; --g) { base[g] = carry * run * (hi == 0 ? Tp[g] : 1.f); run *= To[g] * Tp[g]; }
            float att[16];
#pragma unroll
            for (int g = 0; g < 4; ++g) { float w = base[g];
#pragma unroll
                for (int i = 3; i >= 0; --i) { const int r = 4 * g + i; const float t = rr[r] * w; att[r] = w - t; w = t; } }
            carry *= run;
            pg8::bf16x8 pf[2];
#pragma unroll
            for (int st_ = 0; st_ < 2; ++st_) { v4u t; t.x = pg8::cvt_pk_bf16(att[8 * st_], att[8 * st_ + 1]); t.y = pg8::cvt_pk_bf16(att[8 * st_ + 2], att[8 * st_ + 3]); t.z = pg8::cvt_pk_bf16(att[8 * st_ + 4], att[8 * st_ + 5]); t.w = pg8::cvt_pk_bf16(att[8 * st_ + 6], att[8 * st_ + 7]);
                pf[st_] = __builtin_bit_cast(pg8::bf16x8, t); }
#pragma unroll
            for (int eb = 0; eb < 2; ++eb)
#pragma unroll
                for (int st_ = 0; st_ < 2; ++st_) acc[eb] = __builtin_amdgcn_mfma_f32_32x32x16_bf16(mk_frag(vf[4 * eb + 2 * st_], vf[4 * eb + 2 * st_ + 1]), pf[st_], acc[eb], 0, 0, 0);
            if (__all(carry < 1.17549435e-38f)) break;
        }
#undef ATT_KLOAD
#pragma unroll
        for (int eb = 0; eb < 2; ++eb)
#pragma unroll
            for (int g4 = 0; g4 < 4; ++g4) { const u32x2 o = {pk2(acc[eb][4 * g4], acc[eb][4 * g4 + 1]), pk2(acc[eb][4 * g4 + 2], acc[eb][4 * g4 + 3])};
                const unsigned c8 = (unsigned)(8 * eb + 2 * g4 + hi);
                *(LAS u32x2*)(tV + l31 * 128 + ((c8 ^ ((unsigned)(l31 & 7) << 1)) << 3)) = o; }
        asm volatile("s_waitcnt lgkmcnt(0)" ::: "memory");
#pragma unroll
        for (int i = 0; i < 4; ++i) { const int id = lane + 64 * i, rr_ = id >> 3, q = id & 7;
            const v4u w = *(const LAS v4u*)(tV + rr_ * 128 + (((unsigned)(2 * q) ^ ((unsigned)(rr_ & 7) << 1)) << 3));
            *(v4u*)(O + (tokb + qt * 32 + rr_) * DM + hd * 64 + 8 * q) = w; }
        convert_row_int8(C, A, tx0, trow); convert_row_int8(C, A, tx1, trow + 1);
        __syncthreads();
        if (more) {
#pragma unroll
            for (int i = 0; i < 8; ++i) *(LAS v4u*)(ring + ((8 * nG + i) % 14) * 8192 + dstoff) = st[i];
#pragma unroll
            for (int ks = 0; ks < 4; ++ks) qf[ks] = qn[ks];
        }
        __syncthreads();
    }
}
constexpr int N_PHASES = 16;
#ifndef MK_ONE_LAUNCH
#define MK_ONE_LAUNCH 1
#endif

__global__ void __launch_bounds__(NWAVES * 64, 2) mk_fwd(Args args) {
    extern __shared__ __attribute__((aligned(16))) unsigned char lds_raw[];
    Ctx C;
    C.lds = (LAS unsigned char*)lds_raw;
    C.tid = threadIdx.x; C.lane = C.tid & 63; C.wave = __builtin_amdgcn_readfirstlane(C.tid >> 6);
    C.G = gridDim.x; C.bid = blockIdx.x;
    C.gw = C.bid * NWAVES + C.wave; C.NGW = C.G * NWAVES;
    C.gt = (long)C.bid * (NWAVES * 64) + C.tid; C.NGT = (long)C.G * (NWAVES * 64);
    unsigned char* ws = args.ws;
    volatile LAS unsigned* MISC = (volatile LAS unsigned*)(C.lds + MISC_OFF);
    for (int u = C.tid; u < (LDS_BYTES - LDSCTL_OFF) / 4; u += NWAVES * 64) ((LAS unsigned*)(C.lds + LDSCTL_OFF))[u] = 0u;
    __syncthreads();
#if MK_ONE_LAUNCH
    XcdBarrier bar = xcd_barrier_post((unsigned*)((gu32*)(ws + WS_CTL) + CW_BAR), MISC + 8);
#ifdef PROBE_DBLBAR
#define GRID_BAR() do { xcd_barrier(bar); xcd_barrier(bar); } while (0)
#else
#define GRID_BAR() xcd_barrier(bar)
#endif
#else
    (void)MISC; XcdBarrier bar; bar.bar = nullptr; bar.x = 0; bar.st = nullptr;
#define GRID_BAR() do {} while (0)
#endif
    const int lo = args.ph_lo, hi = args.ph_hi;
#define IN(k) (lo <= (k) && (k) < hi)
#ifndef PROBE_MASK
#define PROBE_MASK 0
#endif
#define PROBE_T0(k) unsigned long long pt0_ = 0; if ((PROBE_MASK >> (k)) & 1) pt0_ = __builtin_amdgcn_s_memrealtime();
#define PROBE_T1(k) if ((PROBE_MASK >> (k)) & 1) { const unsigned long long t1_ = __builtin_amdgcn_s_memrealtime(); const unsigned long long d_ = t1_ - pt0_; while (__builtin_amdgcn_s_memrealtime() - t1_ < d_) __builtin_amdgcn_s_sleep(8); }
#define SEAM(k) do { if (IN(k) && IN((k) + 1)) GRID_BAR(); } while (0)
    float* mod0 = (float*)(ws + WS_MOD); float* mod1 = mod0 + (size_t)NB * 6144;
    bf16* Hb = (bf16*)(ws + WS_H); bf16* BIG = (bf16*)(ws + WS_BIG); bf16* XB = (bf16*)(ws + WS_XB);

    const unsigned char* TAB = ws + WS_TAB; const float* TSC = (const float*)(ws + WS_TSC);
#ifdef PROBE_INSTR
    {
        unsigned xs[16]; float fs[16];
#pragma unroll
        for (int i = 0; i < 16; ++i) { xs[i] = (unsigned)(C.tid * 2654435761u + i * 40503u); fs[i] = (float)(C.tid * 7 + i) * 0.37f; }
#pragma unroll 1
        for (int it = 0; it < 4096; ++it) {
#pragma unroll
            for (int rep = 0; rep < 2; ++rep) {
#pragma unroll
                for (int i = 0; i < 16; i += 2) {
#if PROBE_INSTR == 10
                    { const unsigned a = xs[i], b = xs[i + 1]; xs[i] = a < b ? b : a; xs[i + 1] = (a < b ? a : b) + (unsigned)it; }
#elif PROBE_INSTR == 11
                    { const float a = fs[i], b = fs[i + 1]; fs[i] = fmaxf(a, b); fs[i + 1] = fminf(a, b) + 1.0f; }
#elif PROBE_INSTR == 12
                    { const unsigned a = xs[i], b = xs[i + 1]; xs[i] = a + b; xs[i + 1] = (a ^ b) + (unsigned)it; }
#endif
                }
            }
        }
        float sm = 0.f;
#pragma unroll
        for (int i = 0; i < 16; ++i) sm += fs[i] + __uint_as_float(xs[i] & 0x3fffffffu);
        if (sm == 1234.5678f) args.out[C.tid] = sm;
    }
#endif
    if (IN(0)) { PROBE_T0(0) { { PROBE_T0(19) phase_prep(C, args); PROBE_T1(19) } { PROBE_T0(18) convert_tables_int8(C, args); PROBE_T1(18) } } PROBE_T1(0) } SEAM(0);
    bf16* H8B = (bf16*)(ws + WS_IDS);
    unsigned char* W8 = (unsigned char*)args.out; float* SW = (float*)((unsigned char*)args.out + OUT_SW); float* SA = (float*)(ws + WS_SA);
    if (IN(1)) { PROBE_T0(1) { phase_rowpass<true, false, true>(C, args, args.in[0], args.in[4], mod0, 0, 1, Hb, SA);
        { PROBE_T0(16)
          const bf16* const qW[4] = {(const bf16*)(ws + WS_WIN), (const bf16*)(ws + WS_WC0), (const bf16*)(ws + WS_WC1), (const bf16*)(ws + WS_WQKV)}; const int qN[4] = {INP, 2048, 2048, 3072};
          unsigned char* const q8[4] = {W8 + OUT_W8IN, W8 + OUT_W8C0, W8 + OUT_W8C1, W8 + OUT_W8QKV}; float* const qS[4] = {SW + SW_IN, SW + SW_C0, SW + SW_C1, SW + SW_QKV};
          quantize_rows4(C, qW, qN, q8, qS); PROBE_T1(16) } } PROBE_T1(1) } SEAM(1);
    if (IN(2)) { PROBE_T0(2) { pg8::Gemm g{Hb, (const bf16*)(W8 + OUT_W8IN), NTOK, INP, DM / 2}; pg8::StaticOrder S; S.init(NTOK, INP, C.G, C.bid);
        EpiBf16I8<false, true> E{BIG, INP, SA, SW + SW_IN};
        pg8::gemm_phase<EpiBf16I8<false, true>, pg8::StaticOrder, true, true, true>(C.lds, g, S, E); } PROBE_T1(2) } SEAM(2);
    if (IN(3)) { PROBE_T0(3) { phase_mlstm_local(C, args); { PROBE_T0(17) phase_conv(C, args); PROBE_T1(17) } } PROBE_T1(3) } SEAM(3);
    if (IN(4)) { PROBE_T0(4) { phase_mlstm_scan(C, args); } PROBE_T1(4) } SEAM(4);
    if (IN(5)) { PROBE_T0(5) { phase_mlstm_out(C, args); } PROBE_T1(5) } SEAM(5);
    if (IN(6)) { PROBE_T0(6) { pg8::Gemm g{Hb, (const bf16*)(ws + WS_WOUT0), NTOK, DM, DM}; pg8::StaticOrder S; S.init(NTOK, DM, C.G, C.bid);
        EpiResid<false> E{args.in[0], XB, mod0 + 2 * 1024};
        pg8::gemm_phase<EpiResid<false>, pg8::StaticOrder, true, true>(C.lds, g, S, E); } PROBE_T1(6) } SEAM(6);
    if (IN(7)) { PROBE_T0(7) { phase_rowpass<false, true, true>(C, args, XB, args.in[11], mod0, 3, 4, H8B, SA); } PROBE_T1(7) } SEAM(7);
    if (IN(8)) { PROBE_T0(8) { pg8::Gemm g{H8B, (const bf16*)(W8 + OUT_W8C0), NTOK, 2048, DM / 2}; pg8::StaticOrder S; S.init(NTOK, 2048, C.G, C.bid);
        EpiBf16I8<true> E{BIG, 2048, SA, SW + SW_C0};
        pg8::gemm_phase<EpiBf16I8<true>, pg8::StaticOrder, true, true, true>(C.lds, g, S, E); } PROBE_T1(8) } SEAM(8);
    if (IN(9)) { PROBE_T0(9) { phase_peer<true>(C, args, TAB, TAB + TAB_BYTES, TSC, TSC, mod0 + 5 * 1024, args.in[19], mod1, bar); } PROBE_T1(9) } SEAM(9);
    if (IN(10)) { PROBE_T0(10) { pg8::Gemm g{H8B, (const bf16*)(W8 + OUT_W8QKV), NTOK, 3072, DM / 2}; pg8::StaticOrder S; S.init(NTOK, 3072, C.G, C.bid);
        EpiQKV<true> E{BIG, (bf16*)(ws + WS_BIG + 64 * MiB), (bf16*)(ws + WS_BIG + 128 * MiB), args.in[21], args.in[22], SA, SW + SW_QKV};
        pg8::gemm_phase<EpiQKV<true>, pg8::StaticOrder, true, true, true>(C.lds, g, S, E); } PROBE_T1(10) } SEAM(10);
    if (IN(11)) { PROBE_T0(11) { phase_attn_ring(C, args); } PROBE_T1(11) } SEAM(11);
    if (IN(12)) { PROBE_T0(12) { pg8::Gemm g{Hb, (const bf16*)(ws + WS_WOUT1), NTOK, DM, DM}; pg8::StaticOrder S; S.init(NTOK, DM, C.G, C.bid);
        EpiResid<true> E{XB, XB, mod1 + 2 * 1024};
        pg8::gemm_phase<EpiResid<true>, pg8::StaticOrder, true, true>(C.lds, g, S, E); } PROBE_T1(12) } SEAM(12);
    if (IN(13)) { PROBE_T0(13) { phase_rowpass<false, true, true>(C, args, XB, args.in[24], mod1, 3, 4, H8B, SA); } PROBE_T1(13) } SEAM(13);
    if (IN(14)) { PROBE_T0(14) { pg8::Gemm g{H8B, (const bf16*)(W8 + OUT_W8C1), NTOK, 2048, DM / 2}; pg8::StaticOrder S; S.init(NTOK, 2048, C.G, C.bid);
        EpiBf16I8<true> E{BIG, 2048, SA, SW + SW_C1};
        pg8::gemm_phase<EpiBf16I8<true>, pg8::StaticOrder, true, true, true>(C.lds, g, S, E); } PROBE_T1(14) } SEAM(14);
#ifdef PROBE_DRY
    if (IN(15)) { phase_peer<false, PROBE_DRY>(C, args, TAB + 2 * TAB_BYTES, TAB + 3 * TAB_BYTES, TSC + 2 * 16384, TSC + 2 * 16384, mod1 + 5 * 1024, nullptr, nullptr, bar); GRID_BAR(); }
#endif
    if (IN(15)) { PROBE_T0(15) { phase_peer<false>(C, args, TAB + 2 * TAB_BYTES, TAB + 3 * TAB_BYTES, TSC + 2 * 16384, TSC + 2 * 16384, mod1 + 5 * 1024, nullptr, nullptr, bar); } PROBE_T1(15) }
#undef IN
#undef SEAM
}

extern "C" void kernel_launch(void* const* d_in, const int* in_sizes, int n_in, void* d_out, int out_size, void* d_ws, size_t ws_size, hipStream_t stream) {
    static int grid = 0;
    if (grid == 0) {
        if (n_in != 30 || out_size != NTOK * DM || ws_size < WS_END2) { fprintf(stderr, "kernel_launch: unexpected shapes (n_in %d out %d ws %zu)\n", n_in, out_size, ws_size); grid = -1; return; }
        int dev = 0, cus = 0;
        if (hipGetDevice(&dev) != hipSuccess || hipDeviceGetAttribute(&cus, hipDeviceAttributeMultiprocessorCount, dev) != hipSuccess) { grid = -1; return; }
        if (hipFuncSetAttribute((const void*)mk_fwd, hipFuncAttributeMaxDynamicSharedMemorySize, LDS_BYTES) != hipSuccess) { fprintf(stderr, "kernel_launch: hipFuncSetAttribute failed\n"); grid = -1; return; }
        int per_cu = 0;
        if (hipOccupancyMaxActiveBlocksPerMultiprocessor(&per_cu, (const void*)mk_fwd, NWAVES * 64, LDS_BYTES) != hipSuccess || per_cu < 1) fprintf(stderr, "kernel_launch: occupancy query reports %d\n", per_cu);
        (void)hipGetLastError();
        grid = cus;
    }
    if (grid < 0) return;
    (void)hipMemsetAsync((char*)d_ws + WS_CTL + CW_BAR * 4, 0, (XCD_BAR_WORDS + 16) * 4, stream);
    Args a{};
    for (int i = 0; i < 30; ++i) a.in[i] = (const float*)d_in[i];
    a.out = (float*)d_out; a.ws = (unsigned char*)d_ws;
#if MK_ONE_LAUNCH
    a.ph_lo = 0; a.ph_hi = N_PHASES;
    hipLaunchKernelGGL(mk_fwd, dim3(grid), dim3(NWAVES * 64), LDS_BYTES, stream, a);
#else
    for (int p = 0; p < N_PHASES; ++p) { a.ph_lo = p; a.ph_hi = p + 1; hipLaunchKernelGGL(mk_fwd, dim3(grid), dim3(NWAVES * 64), LDS_BYTES, stream, a); }
#endif
}
```
